# Optimizing an MI355X kernel written in HIP

```python
import math
import jax, jax.numpy as jnp
from jax import lax
import numpy as np

D_MODEL = 1024
BATCH = 4
SEQ = 4096
DEPTH = 1
DEC_BATCH = 32
DEC_SEQ = 8
PAST_LEN = 16384
PAGE_SIZE = 128

D_PLE = 256
HEAD_DIM = 64
D_ATTN = D_MODEL // 2
N_ATTN_HEADS = D_ATTN // HEAD_DIM
DILATED_BRANCHES = ((128, 1), (512, 4), (2048, 16))
N_STEPS = 128
MAX_WINDOW = 2048
BLK = 128
N_BUCKETS = 32
MAX_DISTANCE = 2048
D_SSM = D_MODEL // 2
SSM_HEAD_DIM = 64
N_SSM_HEADS = D_SSM // SSM_HEAD_DIM
D_STATE = 128
N_SSM_GROUPS = 2
HEADS_PER_GROUP = N_SSM_HEADS // N_SSM_GROUPS
SSM_CONV = 4
CONV_DIM = D_SSM + 2 * N_SSM_GROUPS * D_STATE
SSD_CHUNK = 128
D_MIX = D_ATTN + D_SSM
IN_DIM = 3 * D_ATTN + D_SSM + CONV_DIM + N_SSM_HEADS
D_FF = ((8 * D_MODEL // 3 + 127) // 128) * 128
FFN_CONV = 3
EPS = 1e-6

kernel_name = "hymba_dilated_ssd_convffn_step"

F32 = jnp.float32


def rms_norm(x, g):
    xf = x.astype(F32)
    y = xf * lax.rsqrt(jnp.mean(xf * xf, axis=-1, keepdims=True) + EPS)
    return (y * g.astype(F32)).astype(x.dtype)


def rel_bucket(dist):
    dist = jnp.asarray(dist, jnp.int32)
    max_exact = N_BUCKETS // 2
    d = jnp.maximum(dist, 1).astype(F32)
    large = max_exact + (jnp.log(d / max_exact) / math.log(MAX_DISTANCE / max_exact)
                         * (N_BUCKETS - max_exact)).astype(jnp.int32)
    large = jnp.minimum(large, N_BUCKETS - 1)
    return jnp.where(dist < max_exact, dist, large)


def causal_dwconv(x, prefix, w, b):
    K = w.shape[0]
    L = x.shape[1]
    xp = jnp.concatenate([prefix.astype(x.dtype), x], axis=1)
    y = b + w[0] * xp[:, 0:L]
    for k in range(1, K):
        y = y + w[k] * xp[:, k:k + L]
    return y, xp[:, xp.shape[1] - (K - 1):]


def combine_branches(outs, lses):
    w = jax.nn.softmax(jnp.stack(lses, axis=-1), axis=-1)
    acc = w[..., 0, None] * outs[0].astype(F32)
    for n in range(1, len(outs)):
        acc = acc + w[..., n, None] * outs[n].astype(F32)
    return acc.astype(outs[0].dtype)


def dilated_attn_prompt(q, k, v, rel_bias):
    Bsz, S, H, E = q.shape
    scale = E ** -0.5
    i = jnp.arange(BLK)[:, None]
    c = jnp.arange(2 * BLK)[None, :]
    j = BLK + i - c
    band = (j >= 0) & (j <= N_STEPS)
    outs, lses = [], []
    for window, dil in DILATED_BRANCHES:
        L = S // dil
        nb = -(-L // BLK)
        Lp = nb * BLK

        def to_sub(t):
            t = t.reshape(Bsz, L, dil, H, E).transpose(0, 2, 1, 3, 4)
            t = jnp.pad(t, ((0, 0), (0, 0), (0, Lp - L), (0, 0), (0, 0)))
            return t.reshape(Bsz, dil, nb, BLK, H, E)

        def with_prev(t):
            prev = jnp.pad(t, ((0, 0), (0, 0), (1, 0), (0, 0), (0, 0), (0, 0)))[:, :, :-1]
            return jnp.concatenate([prev, t], axis=3)

        qs = to_sub(q)
        kk = with_prev(to_sub(k))
        vv = with_prev(to_sub(v))
        l_q = jnp.arange(nb)[:, None, None] * BLK + i[None]
        valid = band[None] & (l_q - j[None] >= 0)
        bias = rel_bias[rel_bucket(jnp.clip(j, 0, N_STEPS) * dil)]
        s = jnp.einsum('bdnqhe,bdnkhe->bdnhqk', qs, kk).astype(F32) * scale
        s = s + bias.astype(F32).transpose(2, 0, 1)[None, None, None]
        s = jnp.where(valid[None, None, :, None], s, -jnp.inf)
        m = jnp.max(s, axis=-1, keepdims=True)
        pe = jnp.exp(s - m)
        den = jnp.sum(pe, axis=-1, keepdims=True)
        o = jnp.einsum('bdnhqk,bdnkhe->bdnqhe', (pe / den).astype(v.dtype), vv)
        lse = (m + jnp.log(den))[..., 0]
        o = o.reshape(Bsz, dil, Lp, H, E)[:, :, :L].transpose(0, 2, 1, 3, 4).reshape(Bsz, S, H, E)
        lse = lse.transpose(0, 1, 2, 4, 3).reshape(Bsz, dil, Lp, H)[:, :, :L]
        lse = lse.transpose(0, 2, 1, 3).reshape(Bsz, S, H)
        outs.append(o)
        lses.append(lse)
    return combine_branches(outs, lses)


def dilated_attn_sample(q, k_new, v_new, k_buf, v_buf, rel_bias):
    T = q.shape[1]
    Wb = k_buf.shape[1]
    scale = q.shape[-1] ** -0.5
    kc = jnp.concatenate([k_buf.astype(k_new.dtype), k_new], axis=1)
    vc = jnp.concatenate([v_buf.astype(v_new.dtype), v_new], axis=1)
    steps = jnp.arange(N_STEPS + 1)
    outs, lses = [], []
    for window, dil in DILATED_BRANCHES:
        idx = Wb + jnp.arange(T)[:, None] - steps[None] * dil
        valid = idx >= 0
        idxc = jnp.maximum(idx, 0)
        kg = kc[:, idxc]
        vg = vc[:, idxc]
        bias = rel_bias[rel_bucket(steps * dil)]
        s = jnp.einsum('bthe,btjhe->bthj', q, kg).astype(F32) * scale
        s = s + bias.astype(F32).T[None, None]
        s = jnp.where(valid[None, :, None, :], s, -jnp.inf)
        m = jnp.max(s, axis=-1, keepdims=True)
        pe = jnp.exp(s - m)
        den = jnp.sum(pe, axis=-1, keepdims=True)
        o = jnp.einsum('bthj,btjhe->bthe', (pe / den).astype(vg.dtype), vg)
        outs.append(o)
        lses.append((m + jnp.log(den))[..., 0])
    return combine_branches(outs, lses)


def ssd_scan(x, dt, A, Bm, Cm, state0, chunk):
    b, L = x.shape[:2]
    nc = L // chunk
    G, HG, P, N = N_SSM_GROUPS, HEADS_PER_GROUP, SSM_HEAD_DIM, D_STATE
    xg = x.astype(F32).reshape(b, nc, chunk, G, HG, P)
    dtg = dt.reshape(b, nc, chunk, G, HG)
    Bc = Bm.astype(F32).reshape(b, nc, chunk, G, N)
    Cc = Cm.astype(F32).reshape(b, nc, chunk, G, N)
    acum = jnp.cumsum(dtg * A.reshape(G, HG), axis=2)
    tri = jnp.tril(jnp.ones((chunk, chunk), bool))[:, :, None, None]
    seg = acum[:, :, :, None] - acum[:, :, None]
    decay = jnp.where(tri, jnp.exp(jnp.where(tri, seg, 0.0)), 0.0)
    cb = jnp.einsum('bctgn,bcsgn->bctsg', Cc, Bc)
    y_diag = jnp.einsum('bctsgh,bcsghp->bctghp', cb[..., None] * decay * dtg[:, :, None], xg)
    decay_end = jnp.exp(acum[:, :, -1:] - acum) * dtg
    chunk_states = jnp.einsum('bclgn,bclgh,bclghp->bcghpn', Bc, decay_end, xg)
    chunk_decay = jnp.exp(acum[:, :, -1])
    s0 = state0.astype(F32).reshape(b, G, HG, P, N)

    def step(s, inp):
        dec, st = inp
        return s * dec[..., None, None] + st, s

    final, prev = lax.scan(step, s0, (chunk_decay.transpose(1, 0, 2, 3),
                                      chunk_states.transpose(1, 0, 2, 3, 4, 5)))
    prev = prev.transpose(1, 0, 2, 3, 4, 5)
    y_off = jnp.einsum('bctgn,bctgh,bcghpn->bctghp', Cc, jnp.exp(acum), prev)
    y = (y_diag + y_off).reshape(b, L, N_SSM_HEADS, P)
    return y, final.reshape(b, N_SSM_HEADS, P, N)


def gated_group_rmsnorm(y, z, g):
    yf = y.astype(F32) * jax.nn.silu(z.astype(F32))
    yg = yf.reshape(*yf.shape[:-1], N_SSM_GROUPS, D_SSM // N_SSM_GROUPS)
    yg = yg * lax.rsqrt(jnp.mean(yg * yg, axis=-1, keepdims=True) + EPS)
    return (yg.reshape(yf.shape) * g.astype(F32)).astype(z.dtype)


def layer(h, p_i, attn_fn, conv_prefix, ssm_state0, ffn_prefix, chunk,
          g_mix, w_in, conv_w, conv_b, dt_bias, a_log, d_skip, g_ssm, w_out,
          g_ffn, w_up, ffn_conv_w, ffn_conv_b, w_down, w_ple_proj, g_ple, w_ple_gate):
    b, L, _ = h.shape
    xn = rms_norm(h, g_mix)
    proj = xn @ w_in
    o1, o2, o3 = D_ATTN, 2 * D_ATTN, 3 * D_ATTN
    o4 = o3 + D_SSM
    o5 = o4 + CONV_DIM
    q = proj[..., :o1].reshape(b, L, N_ATTN_HEADS, HEAD_DIM)
    k = proj[..., o1:o2].reshape(b, L, N_ATTN_HEADS, HEAD_DIM)
    v = proj[..., o2:o3].reshape(b, L, N_ATTN_HEADS, HEAD_DIM)
    z = proj[..., o3:o4]
    xbc = proj[..., o4:o5]
    dt_raw = proj[..., o5:]
    attn_o = attn_fn(q, k, v).reshape(b, L, D_ATTN)
    xbc_c, conv_state = causal_dwconv(xbc, conv_prefix, conv_w, conv_b)
    xbc_c = jax.nn.silu(xbc_c)
    GN = N_SSM_GROUPS * D_STATE
    xs = xbc_c[..., :D_SSM].reshape(b, L, N_SSM_HEADS, SSM_HEAD_DIM)
    Bm = xbc_c[..., D_SSM:D_SSM + GN].reshape(b, L, N_SSM_GROUPS, D_STATE)
    Cm = xbc_c[..., D_SSM + GN:].reshape(b, L, N_SSM_GROUPS, D_STATE)
    dt = jax.nn.softplus(dt_raw.astype(F32) + dt_bias.astype(F32))
    A = -jnp.exp(a_log.astype(F32))
    y, ssm_state = ssd_scan(xs, dt, A, Bm, Cm, ssm_state0, chunk)
    y = y + d_skip.astype(F32)[:, None] * xs.astype(F32)
    y = gated_group_rmsnorm(y.reshape(b, L, D_SSM), z, g_ssm)
    h = h + jnp.concatenate([attn_o, y.astype(attn_o.dtype)], axis=-1) @ w_out
    hn = rms_norm(h, g_ffn)
    u = hn @ w_up
    u_c, ffn_state = causal_dwconv(u, ffn_prefix, ffn_conv_w, ffn_conv_b)
    h = h + (jax.nn.silu(u_c[..., :D_FF]) * u_c[..., D_FF:]) @ w_down
    e = rms_norm(p_i @ w_ple_proj, g_ple)
    h = h + jax.nn.sigmoid((h @ w_ple_gate).astype(F32)).astype(h.dtype) * e
    return h, k, v, ssm_state, conv_state, ffn_state


def setup_inputs(seed: int = 0) -> dict:
    key = jax.random.key(seed)
    ks = jax.random.split(key, 32)

    def nrm(k, shape, scale):
        return jax.random.normal(k, shape, F32) * scale

    w_buf = min(MAX_WINDOW, PAST_LEN)
    dt0 = jnp.exp(jax.random.uniform(ks[10], (DEPTH, N_SSM_HEADS), F32,
                                     math.log(1e-3), math.log(1e-1)))
    return {
        "x_prompt": nrm(ks[0], (BATCH, SEQ, D_MODEL), 1.0),
        "x_sample": nrm(ks[1], (DEC_BATCH, DEC_SEQ, D_MODEL), 1.0),
        "p_prompt": nrm(ks[2], (DEPTH, BATCH, SEQ, D_PLE), 1.0),
        "p_sample": nrm(ks[3], (DEPTH, DEC_BATCH, DEC_SEQ, D_PLE), 1.0),
        "cache_k": nrm(ks[4], (DEPTH, DEC_BATCH, w_buf, N_ATTN_HEADS, HEAD_DIM), 1.0),
        "cache_v": nrm(ks[5], (DEPTH, DEC_BATCH, w_buf, N_ATTN_HEADS, HEAD_DIM), 1.0),
        "state_ssm": nrm(ks[6], (DEPTH, DEC_BATCH, N_SSM_HEADS, SSM_HEAD_DIM, D_STATE), 0.1),
        "state_conv": nrm(ks[7], (DEPTH, DEC_BATCH, SSM_CONV - 1, CONV_DIM), 1.0),
        "state_ffn_conv": nrm(ks[8], (DEPTH, DEC_BATCH, FFN_CONV - 1, 2 * D_FF), 1.0),
        "rel_bias": nrm(ks[9], (N_BUCKETS, N_ATTN_HEADS), 0.1),
        "g_mix": 1.0 + nrm(ks[11], (DEPTH, D_MODEL), 0.02),
        "w_in": nrm(ks[12], (DEPTH, D_MODEL, IN_DIM), D_MODEL ** -0.5),
        "conv_w": nrm(ks[13], (DEPTH, SSM_CONV, CONV_DIM), SSM_CONV ** -0.5),
        "conv_b": nrm(ks[14], (DEPTH, CONV_DIM), 0.01),
        "dt_bias": dt0 + jnp.log(-jnp.expm1(-dt0)),
        "a_log": jnp.log(jax.random.uniform(ks[15], (DEPTH, N_SSM_HEADS), F32, 1.0, 16.0)),
        "d_skip": 1.0 + nrm(ks[16], (DEPTH, N_SSM_HEADS), 0.02),
        "g_ssm": 1.0 + nrm(ks[17], (DEPTH, D_SSM), 0.02),
        "w_out": nrm(ks[18], (DEPTH, D_MIX, D_MODEL), D_MIX ** -0.5),
        "g_ffn": 1.0 + nrm(ks[19], (DEPTH, D_MODEL), 0.02),
        "w_up": nrm(ks[20], (DEPTH, D_MODEL, 2 * D_FF), D_MODEL ** -0.5),
        "ffn_conv_w": nrm(ks[21], (DEPTH, FFN_CONV, 2 * D_FF), FFN_CONV ** -0.5),
        "ffn_conv_b": nrm(ks[22], (DEPTH, 2 * D_FF), 0.01),
        "w_down": nrm(ks[23], (DEPTH, D_FF, D_MODEL), D_FF ** -0.5),
        "w_ple_proj": nrm(ks[24], (DEPTH, D_PLE, D_MODEL), D_PLE ** -0.5),
        "g_ple": 1.0 + nrm(ks[25], (DEPTH, D_MODEL), 0.02),
        "w_ple_gate": nrm(ks[26], (DEPTH, D_MODEL, D_MODEL), D_MODEL ** -0.5),
        "g_final": 1.0 + nrm(ks[27], (D_MODEL,), 0.02),
    }


def reference(x_prompt, x_sample, p_prompt, p_sample, cache_k, cache_v, state_ssm,
              state_conv, state_ffn_conv, rel_bias, g_mix, w_in, conv_w, conv_b,
              dt_bias, a_log, d_skip, g_ssm, w_out, g_ffn, w_up, ffn_conv_w,
              ffn_conv_b, w_down, w_ple_proj, g_ple, w_ple_gate, g_final):
    bp, S, _ = x_prompt.shape
    T = x_sample.shape[1]
    n_keep = min(MAX_WINDOW, S)
    hp, hs = x_prompt, x_sample
    kp_l, vp_l, ks_l, vs_l = [], [], [], []
    sp_l, ss_l, cp_l, cs_l, fp_l, fs_l = [], [], [], [], [], []
    for i in range(DEPTH):
        wi = (g_mix[i], w_in[i], conv_w[i], conv_b[i], dt_bias[i], a_log[i], d_skip[i],
              g_ssm[i], w_out[i], g_ffn[i], w_up[i], ffn_conv_w[i], ffn_conv_b[i],
              w_down[i], w_ple_proj[i], g_ple[i], w_ple_gate[i])
        hp, kp, vp, sp, cp, fp = layer(
            hp, p_prompt[i],
            lambda q, k, v: dilated_attn_prompt(q, k, v, rel_bias),
            jnp.zeros((bp, SSM_CONV - 1, CONV_DIM), x_prompt.dtype),
            jnp.zeros((bp, N_SSM_HEADS, SSM_HEAD_DIM, D_STATE), F32),
            jnp.zeros((bp, FFN_CONV - 1, 2 * D_FF), x_prompt.dtype),
            SSD_CHUNK, *wi)
        hs, ksn, vsn, ssn, csn, fsn = layer(
            hs, p_sample[i],
            lambda q, k, v, kb=cache_k[i], vb=cache_v[i]: dilated_attn_sample(q, k, v, kb, vb, rel_bias),
            state_conv[i], state_ssm[i], state_ffn_conv[i],
            T, *wi)
        kp_l.append(kp[:, S - n_keep:])
        vp_l.append(vp[:, S - n_keep:])
        ks_l.append(ksn)
        vs_l.append(vsn)
        sp_l.append(sp)
        ss_l.append(ssn)
        cp_l.append(cp)
        cs_l.append(csn)
        fp_l.append(fp)
        fs_l.append(fsn)
    y_prompt = rms_norm(hp, g_final)
    y_sample = rms_norm(hs, g_final)
    return (y_prompt, y_sample,
            jnp.stack(kp_l), jnp.stack(vp_l), jnp.stack(ks_l), jnp.stack(vs_l),
            jnp.stack(sp_l), jnp.stack(ss_l), jnp.stack(cp_l), jnp.stack(cs_l),
            jnp.stack(fp_l), jnp.stack(fs_l))
```

```cpp
#include <hip/hip_runtime.h>
#include <cstdio>
#include <cstdint>
namespace pg8 {
#define PG8_LAS __attribute__((address_space(3)))
typedef unsigned short bf16_t;
typedef short bf16x8 __attribute__((ext_vector_type(8)));
typedef float f32x4 __attribute__((ext_vector_type(4)));
typedef unsigned u32x4 __attribute__((ext_vector_type(4)));
constexpr int BM = 256, BK = 64, HALF = 128, HTB = HALF * BK * 2  , STAGE_BYTES = 8 * HTB, NXCD = 8, WGM = 8;

__host__ __device__ __forceinline__ int lds_byte(int r, int c) { const int st = (r >> 4) * 2 + (c >> 5), rr = r & 15, cc = c & 31, ob = rr * 64 + cc * 2; return st * 1024 + (ob ^ (((ob >> 9) & 1) << 5)); }
__host__ __device__ __forceinline__ void stage_rc(int b, int& R, int& C) { const int st = b / 1024, sb = b % 1024, swz = sb ^ (((sb >> 9) & 1) << 5); R = (st >> 1) * 16 + swz / 64; C = (st & 1) * 32 + (swz % 64) / 2; }
__host__ __device__ __forceinline__ int perm32(int rho) { const int n = rho >> 4, i = rho & 15; return 8 * (i >> 2) + 4 * n + (i & 3); }

struct Unit { int pm, pn; };
struct Gemm { const bf16_t* A; const bf16_t* Bt; int M, N, K; };

struct StaticOrder {
    int nM, nN, nwg, G, c;
    __host__ __device__ void init(int M, int N, int G_, int c_) { nM = M / BM; nN = N / BM; nwg = nM * nN; G = G_; c = c_; }
    __host__ __device__ bool next(int i, Unit& u) const {
        const long L = (long)i * G + c; if (L >= nwg) return false;
        int wgid = (int)L; { const int q = nwg / NXCD, r = nwg % NXCD, xcd = wgid % NXCD, off = wgid / NXCD; wgid = (xcd < r ? xcd * (q + 1) : r * (q + 1) + (xcd - r) * q) + off; }
        const int nig = WGM * nN, gid = wgid / nig, fm = gid * WGM, gsz = (nM - fm) < WGM ? (nM - fm) : WGM;
        u.pm = fm + ((wgid % nig) % gsz); u.pn = (wgid % nig) / gsz; return true;
    }
    __device__ __forceinline__ void a_ready(const Unit&) const {}
    __device__ __forceinline__ void done(const Unit&) const {}
};

__device__ __forceinline__ unsigned cvt_pk_bf16(float lo, float hi) { unsigned r; asm volatile("v_cvt_pk_bf16_f32 %0, %1, %2" : "=v"(r) : "v"(lo), "v"(hi)); return r; }
typedef float f32x2 __attribute__((ext_vector_type(2)));
template <class Epi, class Sched, bool ALIGN_EPI = false, bool SP2 = false>
__device__ __forceinline__ void gemm_phase(PG8_LAS unsigned char* lds, const Gemm g, const Sched& S, const Epi& E) {
    const int tid = threadIdx.x, wid = __builtin_amdgcn_readfirstlane(tid >> 6), lane = tid & 63, wr = wid >> 2, wc = wid & 3, fr = lane & 15, fq = lane >> 4;
    const int K = g.K, nt = K / BK;
    unsigned voffA[2], voffB[2];
#pragma unroll
    for (int i = 0; i < 2; ++i) { int R, C; stage_rc(tid * 16 + i * 8192, R, C); const int Rb = Epi::PERM ? ((R & ~31) + perm32(R & 31)) : R;
        voffA[i] = (unsigned)(R * K + C) * 2u; voffB[i] = (unsigned)(Rb * K + C) * 2u; }
    const size_t kstep = (size_t)(BK * 2);
    const size_t hstep = (size_t)HALF * K * 2;
    const size_t tstep = 2 * hstep;
    const unsigned ldsw = (unsigned)wid * 1024u;
    const int aoff = lds_byte(wr * 64 + fr, fq * 8), boff = lds_byte(wc * 32 + fr, fq * 8);
#define PG8_SA(b, h) (((b) * 2 + (h)) * HTB)
#define PG8_SB(b, h) ((4 + (b) * 2 + (h)) * HTB)
#define PG8_STAGE(bufoff, gbase, voff) do { _Pragma("unroll") for (int _i = 0; _i < 2; ++_i) \
        __builtin_amdgcn_global_load_lds((const unsigned*)((const char*)(gbase) + (voff)[_i]), (PG8_LAS unsigned*)(lds + (bufoff) + ldsw + _i * 8192), 16, 0, 0); } while (0)
#define PG8_LDA(dst, b, h) do { _Pragma("unroll") for (int m = 0; m < 4; ++m) _Pragma("unroll") for (int k = 0; k < 2; ++k) dst[m][k] = *(const PG8_LAS bf16x8*)(lds + PG8_SA(b, h) + aoff + m * 2048 + k * 1024); } while (0)
#define PG8_LDB(dst, b, h) do { _Pragma("unroll") for (int n = 0; n < 2; ++n) _Pragma("unroll") for (int k = 0; k < 2; ++k) dst[n][k] = *(const PG8_LAS bf16x8*)(lds + PG8_SB(b, h) + boff + n * 2048 + k * 1024); } while (0)
#define PG8_MMA(ai, bj, At, Bt) do { __builtin_amdgcn_s_setprio(1); _Pragma("unroll") for (int m = 0; m < 4; ++m) _Pragma("unroll") for (int n = 0; n < 2; ++n) _Pragma("unroll") for (int k = 0; k < 2; ++k) \
        acc[ai][bj][m][n] = __builtin_amdgcn_mfma_f32_16x16x32_bf16(Bt[n][k], At[m][k], acc[ai][bj][m][n], 0, 0, 0); __builtin_amdgcn_s_setprio(0); } while (0)
#define PG8_WAIT_V(n) asm volatile("s_waitcnt vmcnt(" #n ")" ::: "memory")
#define PG8_WAIT_L(n) asm volatile("s_waitcnt lgkmcnt(" #n ")" ::: "memory")
#define PG8_BAR __builtin_amdgcn_s_barrier()
#define PG8_SCHED __builtin_amdgcn_sched_barrier(0)
    Unit cur, nxt; int ui = 0;
    if (!S.next(0, cur)) return;
    f32x4 acc[2][2][4][2];
#pragma unroll
    for (int a = 0; a < 2; ++a)
#pragma unroll
        for (int b = 0; b < 2; ++b)
#pragma unroll
            for (int m = 0; m < 4; ++m)
#pragma unroll
                for (int n = 0; n < 2; ++n) acc[a][b][m][n] = (f32x4){0.f, 0.f, 0.f, 0.f};
    bf16x8 At[4][2], B0[2][2], B1[2][2];
    const char* cA = (const char*)g.A + (size_t)cur.pm * tstep; const char* cB = (const char*)g.Bt + (size_t)cur.pn * tstep;
    S.a_ready(cur);
    if constexpr (SP2) {
        PG8_STAGE(PG8_SB(0, 0), cB, voffB); PG8_STAGE(PG8_SB(0, 1), cB + hstep, voffB); PG8_STAGE(PG8_SA(0, 0), cA, voffA); PG8_STAGE(PG8_SA(0, 1), cA + hstep, voffA);
        if (wr == 1) PG8_BAR;
        PG8_WAIT_V(2); PG8_BAR;
        PG8_STAGE(PG8_SB(1, 0), cB + kstep, voffB); PG8_STAGE(PG8_SA(1, 0), cA + kstep, voffA); PG8_STAGE(PG8_SB(1, 1), cB + hstep + kstep, voffB);
        PG8_WAIT_V(6); PG8_BAR;
    } else {
        PG8_STAGE(PG8_SB(0, 0), cB, voffB); PG8_STAGE(PG8_SA(0, 0), cA, voffA); PG8_STAGE(PG8_SB(0, 1), cB + hstep, voffB); PG8_STAGE(PG8_SA(0, 1), cA + hstep, voffA);
        if (wr == 1) PG8_BAR;
        PG8_WAIT_V(4); PG8_BAR;
        PG8_STAGE(PG8_SB(1, 0), cB + kstep, voffB); PG8_STAGE(PG8_SA(1, 0), cA + kstep, voffA); PG8_STAGE(PG8_SB(1, 1), cB + hstep + kstep, voffB);
        PG8_WAIT_V(6); PG8_BAR;
    }
    for (;;) {
        const bool has_next = S.next(ui + 1, nxt);
        const char* nA = has_next ? (const char*)g.A + (size_t)nxt.pm * tstep : cA; const char* nB = has_next ? (const char*)g.Bt + (size_t)nxt.pn * tstep : cB;
        for (int t = 0; t < nt; t += 2) {
            const bool last = (t == nt - 2);
            const char* a1 = cA + (size_t)(t + 1) * kstep;
            const char* a2 = last ? nA : cA + (size_t)(t + 2) * kstep; const char* b2 = last ? nB : cB + (size_t)(t + 2) * kstep;
            const char* a3 = a2 + kstep; const char* b3 = b2 + kstep;
            if (last && has_next) S.a_ready(nxt);
            if constexpr (SP2) {
            PG8_LDB(B0, 0, 0); PG8_LDB(B1, 0, 1); PG8_SCHED; PG8_LDA(At, 0, 0); PG8_STAGE(PG8_SA(1, 1), a1 + hstep, voffA);
            PG8_WAIT_V(8); PG8_WAIT_L(0); PG8_BAR; PG8_MMA(0, 0, At, B0); PG8_MMA(0, 1, At, B1); PG8_BAR; PG8_SCHED;
            PG8_LDA(At, 0, 1); PG8_STAGE(PG8_SB(0, 0), b2, voffB); PG8_STAGE(PG8_SB(0, 1), b2 + hstep, voffB); PG8_STAGE(PG8_SA(0, 0), a2, voffA);
            PG8_WAIT_V(8); PG8_WAIT_L(0); PG8_BAR; PG8_MMA(1, 0, At, B0); PG8_MMA(1, 1, At, B1); PG8_BAR; PG8_SCHED;
            PG8_LDB(B0, 1, 0); PG8_LDB(B1, 1, 1); PG8_SCHED; PG8_LDA(At, 1, 0); PG8_STAGE(PG8_SA(0, 1), a2 + hstep, voffA);
            PG8_WAIT_V(8); PG8_WAIT_L(0); PG8_BAR; PG8_MMA(0, 0, At, B0); PG8_MMA(0, 1, At, B1); PG8_BAR; PG8_SCHED;
            PG8_LDA(At, 1, 1); PG8_STAGE(PG8_SB(1, 0), b3, voffB); PG8_STAGE(PG8_SB(1, 1), b3 + hstep, voffB); PG8_STAGE(PG8_SA(1, 0), a3, voffA);
            PG8_WAIT_V(8); PG8_WAIT_L(0); PG8_BAR; PG8_MMA(1, 0, At, B0); PG8_MMA(1, 1, At, B1); PG8_BAR; PG8_SCHED;
            } else {
            PG8_LDB(B0, 0, 0); PG8_SCHED; PG8_LDA(At, 0, 0); PG8_STAGE(PG8_SA(1, 1), a1 + hstep, voffA);
            PG8_WAIT_L(8); PG8_BAR; PG8_WAIT_L(0); PG8_MMA(0, 0, At, B0); PG8_BAR; PG8_SCHED;
            PG8_LDB(B1, 0, 1); PG8_STAGE(PG8_SB(0, 0), b2, voffB);
            PG8_BAR; PG8_WAIT_L(0); PG8_MMA(0, 1, At, B1); PG8_BAR;
            PG8_LDA(At, 0, 1); PG8_STAGE(PG8_SA(0, 0), a2, voffA);
            PG8_BAR; PG8_WAIT_L(0); PG8_MMA(1, 0, At, B0); PG8_BAR; PG8_SCHED;
            PG8_STAGE(PG8_SB(0, 1), b2 + hstep, voffB);
            PG8_WAIT_V(6); PG8_BAR; PG8_MMA(1, 1, At, B1); PG8_BAR;
            PG8_LDB(B0, 1, 0); PG8_SCHED; PG8_LDA(At, 1, 0); PG8_STAGE(PG8_SA(0, 1), a2 + hstep, voffA);
            PG8_WAIT_L(8); PG8_BAR; PG8_WAIT_L(0); PG8_MMA(0, 0, At, B0); PG8_BAR; PG8_SCHED;
            PG8_LDB(B1, 1, 1); PG8_STAGE(PG8_SB(1, 0), b3, voffB);
            PG8_BAR; PG8_WAIT_L(0); PG8_MMA(0, 1, At, B1); PG8_BAR;
            PG8_LDA(At, 1, 1); PG8_STAGE(PG8_SA(1, 0), a3, voffA);
            PG8_BAR; PG8_WAIT_L(0); PG8_MMA(1, 0, At, B0); PG8_BAR; PG8_SCHED;
            PG8_STAGE(PG8_SB(1, 1), b3 + hstep, voffB);
            PG8_WAIT_V(6); PG8_BAR; PG8_MMA(1, 1, At, B1); PG8_BAR;
            }
        }
        if constexpr (ALIGN_EPI) { if (wr == 0) PG8_BAR; }
        if constexpr (!Epi::AFTER_DRAIN) { E(acc, cur, wr, wc, fr, fq); S.done(cur); }
        if (!has_next) break;
#pragma unroll
        for (int a = 0; a < 2; ++a)
#pragma unroll
            for (int b = 0; b < 2; ++b)
#pragma unroll
                for (int m = 0; m < 4; ++m)
#pragma unroll
                    for (int n = 0; n < 2; ++n) acc[a][b][m][n] = (f32x4){0.f, 0.f, 0.f, 0.f};
        cur = nxt; cA = nA; cB = nB; ++ui;
        if constexpr (ALIGN_EPI) { if (wr == 1) PG8_BAR; }
    }
    PG8_WAIT_V(0);
    if constexpr (!ALIGN_EPI) { if (wr == 0) PG8_BAR; }
    PG8_BAR;
    if constexpr (Epi::AFTER_DRAIN) { E.fused(acc, cur, wr, wc, fr, fq, lds, wid, lane); S.done(cur); }
#undef PG8_SA
#undef PG8_SB
#undef PG8_STAGE
#undef PG8_LDA
#undef PG8_LDB
#undef PG8_MMA
#undef PG8_WAIT_V
#undef PG8_WAIT_L
#undef PG8_BAR
#undef PG8_SCHED
}
}

#ifndef PG8_SP2
#define PG8_SP2 true
#endif
#ifndef PG8_ALIGN
#define PG8_ALIGN true
#endif
#define GAS __attribute__((address_space(1)))
#define LAS __attribute__((address_space(3)))
typedef unsigned short bf16;
typedef unsigned v4u __attribute__((ext_vector_type(4)));
typedef float f32x4 __attribute__((ext_vector_type(4)));
typedef short bf16x8 __attribute__((ext_vector_type(8)));
typedef GAS unsigned gu32;
typedef GAS unsigned long long gu64;
#define RLX_AGENT __ATOMIC_RELAXED, __HIP_MEMORY_SCOPE_AGENT
#define LDS_WAIT() asm volatile("s_waitcnt lgkmcnt(0)" ::: "memory")
#define VM_WAIT() asm volatile("s_waitcnt vmcnt(0)" ::: "memory")
__device__ __forceinline__ unsigned long long rt() { return __builtin_amdgcn_s_memrealtime(); }
__device__ __forceinline__ unsigned f2bf(float f) { unsigned u = __builtin_bit_cast(unsigned, f); return (u + 0x7fffu + ((u >> 16) & 1u)) >> 16; }
__device__ __forceinline__ unsigned pk2(float lo, float hi) { return f2bf(lo) | (f2bf(hi) << 16); }

#define XB_TMO      128
#define XB_XCNT(j)  (256  + 64 * (j))
#define XB_XSUB(j)  (1280 + 64 * (j))
#define XB_XGEN(j)  (2304 + 64 * (j))
#define XB_TOP      3328
#define XB_TOPGEN   3392
#define XCD_BAR_WORDS 3456
#define XB_SPIN_CAP (1u << 18)

__device__ __forceinline__ unsigned xb_ld(unsigned* p)              { return __hip_atomic_load(p, __ATOMIC_RELAXED, __HIP_MEMORY_SCOPE_AGENT); }
__device__ __forceinline__ unsigned xb_add(unsigned* p, unsigned v) { return __hip_atomic_fetch_add(p, v, __ATOMIC_RELAXED, __HIP_MEMORY_SCOPE_AGENT); }
__device__ __forceinline__ unsigned xb_xcc_id() { return (unsigned)__builtin_amdgcn_s_getreg((3 << 11) | 20) & 0xFu; }
#define XB_SPIN(cond, bar) do { unsigned _sp = 0; while (cond) { __builtin_amdgcn_s_sleep(1); \
    if ((++_sp & 255u) == 0u) { if (xb_ld(&(bar)[XB_TMO])) break; if (_sp > XB_SPIN_CAP) { atomicAdd(&(bar)[XB_TMO], 1u); break; } } } } while (0)

struct XcdBarrier {
    unsigned* bar; unsigned x;
    volatile LAS unsigned* st;
};

__device__ __forceinline__ XcdBarrier xcd_barrier_post(unsigned* bar, volatile LAS unsigned* st) {
    XcdBarrier b; b.bar = bar; b.x = xb_xcc_id(); b.st = st;
    if (threadIdx.x == 0) (void)xb_add(&bar[XB_XCNT(b.x)], 1u);
    return b;
}
__device__ __forceinline__ void xcd_barrier_complete(unsigned* bar, unsigned x, unsigned& nloc, unsigned& nx) {
    const unsigned G = gridDim.x * gridDim.y * gridDim.z;
    unsigned sum, cnt, mine, sp = 0u;
    for (;;) {
        sum = 0u; cnt = 0u; mine = 0u;
#pragma unroll
        for (unsigned j = 0; j < 16; ++j) { const unsigned c = xb_ld(&bar[XB_XCNT(j)]); sum += c; cnt += (c > 0u) ? 1u : 0u; mine = (j == x) ? c : mine; }
        if (sum == G) break;
        __builtin_amdgcn_s_sleep(1);
        if ((++sp & 255u) == 0u) { if (xb_ld(&bar[XB_TMO])) break; if (sp > XB_SPIN_CAP) { atomicAdd(&bar[XB_TMO], 1u); break; } }
    }
    nloc = mine > 0u ? mine : 1u; nx = cnt > 0u ? cnt : 1u;
}

__device__ __forceinline__ void xcd_barrier(const XcdBarrier& b) {
    asm volatile("s_waitcnt vmcnt(0)" ::: "memory");
    __syncthreads();
    if (threadIdx.x == 0) {
        unsigned* bar = b.bar;
        __builtin_amdgcn_s_waitcnt(0);
        unsigned nloc = b.st[0], nx = b.st[1];
        if (nloc == 0u) { xcd_barrier_complete(bar, b.x, nloc, nx); b.st[0] = nloc; b.st[1] = nx; }
        const unsigned old = xb_add(&bar[XB_XSUB(b.x)], 1u);
        const unsigned gen = old / nloc;
        if (old + 1u == (gen + 1u) * nloc) {
            __builtin_amdgcn_fence(__ATOMIC_RELEASE, "agent");
            asm volatile("s_waitcnt vmcnt(0)" ::: "memory");
            const unsigned og = xb_add(&bar[XB_TOP], 1u);
            const unsigned tg = og / nx;
            if (og + 1u == (tg + 1u) * nx) xb_add(&bar[XB_TOPGEN], 1u);
            else XB_SPIN(xb_ld(&bar[XB_TOPGEN]) == tg, bar);
            __builtin_amdgcn_fence(__ATOMIC_ACQUIRE, "agent");
            xb_add(&bar[XB_XGEN(b.x)], 1u);
            asm volatile("s_waitcnt vmcnt(0)" ::: "memory");
        } else {
            XB_SPIN(xb_ld(&bar[XB_XGEN(b.x)]) == gen, bar);
            __builtin_amdgcn_fence(__ATOMIC_ACQUIRE, "agent");
            asm volatile("s_waitcnt vmcnt(0)" ::: "memory");
        }
    }
    __syncthreads();
}


constexpr int NWAVES = 8;
constexpr int DM = 1024, SEQ = 4096, NBP = 4, NBS = 32, TS = 8;
constexpr int MP = NBP * SEQ, MS = NBS * TS, MT = MP + MS;
constexpr int NH = 8, HD = 64, DSSM = 512, NST = 128, IN_LD = 3080, NIN = 3072;
constexpr int DFF = 2816, DFF2 = 5632, DPLE = 256, WBUF = 2048;
constexpr float EPS = 1e-6f, LOG2E = 1.4426950408889634f, C2 = 0.125f * 1.4426950408889634f;
constexpr int PC_K = 512, PC_V = 1024, PC_Z = 1536, PC_X = 2048;
constexpr size_t O_Y = 0, O_YS = 16777216, O_KP = 17039360, O_VP = 21233664, O_KS = 25427968, O_VS = 25559040, O_SP = 25690112, O_SS = 25952256,
                 O_CP = 28049408, O_CS = 28061696, O_FP = 28160000, O_FS = 28205056, O_END = 28565504;
constexpr size_t MiB = 1u << 20;
constexpr size_t WS_CTL = 0, CTL_ZERO_BYTES = 1 * MiB;
constexpr size_t WS_RS1 = 256 * 1024, WS_RSE = 384 * 1024, WS_RS3 = 512 * 1024;
constexpr size_t WS_WIN = 2 * MiB, WS_WOUT = 8 * MiB, WS_WUP = 10 * MiB, WS_WDOWN = 21 * MiB, WS_WPLE = 27 * MiB, WS_WGATE = 28 * MiB;
constexpr size_t WS_DT = 30 * MiB, WS_PB = 31 * MiB, WS_XN = 40 * MiB, WS_MIX = 73 * MiB, WS_H1 = 106 * MiB, WS_E = 171 * MiB;
constexpr size_t WS_PROJ = 236 * MiB, WS_OBR = 334 * MiB, WS_LSE = 382 * MiB, WS_XBCC = 384 * MiB, WS_YS = 449 * MiB;
constexpr size_t WS_U = 236 * MiB, WS_ACT = 415 * MiB, WS_END = 505 * MiB;
static_assert(WS_PROJ + (size_t)MT * NIN * 2 <= WS_OBR && WS_OBR + (size_t)3 * MP * 512 * 2 <= WS_LSE && WS_LSE + (size_t)3 * MP * 8 * 4 <= WS_XBCC, "ws map A");
static_assert(WS_XBCC + (size_t)MT * 1024 * 4 <= WS_YS && WS_YS + (size_t)MT * 512 * 4 <= WS_END, "ws map B");
static_assert(WS_U + (size_t)MT * DFF2 * 2 <= WS_ACT && WS_ACT + (size_t)MT * DFF * 2 <= WS_END, "ws map C");
static_assert(WS_XN + (size_t)MT * DM * 2 <= WS_MIX && WS_MIX + (size_t)MT * DM * 2 <= WS_H1 && WS_H1 + (size_t)MT * DM * 4 <= WS_E && WS_E + (size_t)MT * DM * 4 <= WS_PROJ, "ws map D");
static_assert(WS_PB + (size_t)MT * DPLE * 2 <= WS_XN && WS_DT + (size_t)MT * 8 * 4 <= WS_PB, "ws map E");
constexpr int CW_TMO = 0, CW_BAR = 4096;
constexpr int RING_BYTES = 131072, LDSCTL_OFF = RING_BYTES, MISC_OFF = LDSCTL_OFF + 320, LDS_BYTES = 147456;

typedef float f32x16 __attribute__((ext_vector_type(16)));
typedef short v4i16_t __attribute__((ext_vector_type(4)));
typedef unsigned u32x2 __attribute__((ext_vector_type(2)));

__device__ const unsigned char BUCKET_TAB[3][132] = {
 {0,1,2,3,4,5,6,7,8,9,10,11,12,13,14,15,16,16,16,16,16,16,17,17,17,17,17,17,17,17,18,18,18,18,18,18,18,18,18,18,19,19,19,19,19,19,19,19,19,19,19,19,19,19,20,20,20,20,20,20,20,20,20,20,20,20,20,20,20,20,20,20,20,21,21,21,21,21,21,21,21,21,21,21,21,21,21,21,21,21,21,21,21,21,21,21,21,21,21,22,22,22,22,22,22,22,22,22,22,22,22,22,22,22,22,22,22,22,22,22,22,22,22,22,22,22,22,22,22,0,0,0},
 {0,4,8,12,16,16,17,17,18,18,19,19,19,19,20,20,20,20,20,21,21,21,21,21,21,22,22,22,22,22,22,22,22,22,23,23,23,23,23,23,23,23,23,23,23,23,24,24,24,24,24,24,24,24,24,24,24,24,24,24,24,24,25,25,25,25,25,25,25,25,25,25,25,25,25,25,25,25,25,25,25,25,25,26,26,26,26,26,26,26,26,26,26,26,26,26,26,26,26,26,26,26,26,26,26,26,26,26,26,26,26,26,26,27,27,27,27,27,27,27,27,27,27,27,27,27,27,27,27,0,0,0},
 {0,16,18,19,20,21,21,22,22,23,23,23,24,24,24,24,25,25,25,25,25,26,26,26,26,26,26,26,26,27,27,27,27,27,27,27,27,27,27,28,28,28,28,28,28,28,28,28,28,28,28,28,29,29,29,29,29,29,29,29,29,29,29,29,29,29,29,29,29,29,30,30,30,30,30,30,30,30,30,30,30,30,30,30,30,30,30,30,30,30,30,30,30,30,30,31,31,31,31,31,31,31,31,31,31,31,31,31,31,31,31,31,31,31,31,31,31,31,31,31,31,31,31,31,31,31,31,31,31,0,0,0}};

__device__ __forceinline__ float wave_sum(float v) {
#pragma unroll
    for (int o = 1; o < 64; o <<= 1) v += __shfl_xor(v, o);
    return v;
}
__device__ __forceinline__ float wave_max(float v) {
#pragma unroll
    for (int o = 1; o < 64; o <<= 1) v = fmaxf(v, __shfl_xor(v, o));
    return v;
}
__device__ __forceinline__ float bf2f(unsigned short b) { return __uint_as_float((unsigned)b << 16); }
__device__ __forceinline__ float bflo(unsigned w) { return __uint_as_float(w << 16); }
__device__ __forceinline__ float bfhi(unsigned w) { return __uint_as_float(w & 0xffff0000u); }
__device__ __forceinline__ float siluf(float x) { return x / (1.f + __expf(-x)); }
__device__ __forceinline__ float softplusf(float x) { return fmaxf(x, 0.f) + log1pf(__expf(-fabsf(x))); }
__device__ __forceinline__ int crow(int r, int hi) { return (r & 3) + 8 * (r >> 2) + 4 * hi; }

struct Args { const float* in[28]; float* out; unsigned char* ws; int ph_lo, ph_hi, li, pad; };

struct EpiIn {
    static constexpr bool PERM = true, AFTER_DRAIN = false;
    pg8::bf16_t* PROJ; float* out;
    __device__ __forceinline__ void operator()(const pg8::f32x4 (&acc)[2][2][4][2], const pg8::Unit& u, int wr, int wc, int fr, int fq) const {
        const int pn = u.pn; const float sc = (pn < 2) ? C2 : 1.f;
        const int colb = pn * 256 + wc * 32 + 8 * fq;
#pragma unroll
        for (int ai = 0; ai < 2; ++ai)
#pragma unroll
            for (int m = 0; m < 4; ++m) {
                const int row = u.pm * 256 + ai * 128 + wr * 64 + m * 16 + fr;
#pragma unroll
                for (int bj = 0; bj < 2; ++bj) {
                    const int col = colb + bj * 128; const pg8::f32x4 v0 = acc[ai][bj][m][0], v1 = acc[ai][bj][m][1];
                    pg8::u32x4 w; w.x = pg8::cvt_pk_bf16(v0[0] * sc, v0[1] * sc); w.y = pg8::cvt_pk_bf16(v0[2] * sc, v0[3] * sc); w.z = pg8::cvt_pk_bf16(v1[0] * sc, v1[1] * sc); w.w = pg8::cvt_pk_bf16(v1[2] * sc, v1[3] * sc);
                    *(pg8::u32x4*)(PROJ + (size_t)row * NIN + col) = w;
                    float* dst = nullptr;
                    if (pn >= 2 && pn < 6) {
                        const bool isk = pn < 4; const int c = col - (isk ? PC_K : PC_V);
                        if (row < MP) { const int t = row & (SEQ - 1), b = row >> 12; if (t >= SEQ - WBUF) dst = out + (isk ? O_KP : O_VP) + ((size_t)(b * WBUF + t - (SEQ - WBUF))) * 512 + c; }
                        else dst = out + (isk ? O_KS : O_VS) + (size_t)(row - MP) * 512 + c;
                    } else if (pn >= 8) {
                        const int c = col - PC_X;
                        if (row < MP) { const int t = row & (SEQ - 1), b = row >> 12; if (t >= SEQ - 3) dst = out + O_CP + (size_t)(b * 3 + t - (SEQ - 3)) * 1024 + c; }
                        else { const int r = row - MP, t = r & 7, b = r >> 3; if (t >= TS - 3) dst = out + O_CS + (size_t)(b * 3 + t - (TS - 3)) * 1024 + c; }
                    }
                    if (dst) { *(pg8::f32x4*)dst = v0; *(pg8::f32x4*)(dst + 4) = v1; }
                }
            }
    }
};
struct EpiOut {
    static constexpr bool PERM = false, AFTER_DRAIN = false;
    const float* xp; const float* xs; float* H1; pg8::bf16_t* H1b; float* RS;
    __device__ __forceinline__ void operator()(const pg8::f32x4 (&acc)[2][2][4][2], const pg8::Unit& u, int wr, int wc, int fr, int fq) const {
        const int col0 = u.pn * 256 + wc * 32 + 4 * fq;
#pragma unroll
        for (int ai = 0; ai < 2; ++ai)
#pragma unroll
            for (int m = 0; m < 4; ++m) {
                const int row = u.pm * 256 + ai * 128 + wr * 64 + m * 16 + fr;
                const float* xrow = (row < MP) ? xp + (size_t)row * DM : xs + (size_t)(row - MP) * DM;
                float ss = 0.f;
#pragma unroll
                for (int bj = 0; bj < 2; ++bj)
#pragma unroll
                    for (int n = 0; n < 2; ++n) {
                        const int c = col0 + bj * 128 + n * 16;
                        const pg8::f32x4 h = *(const pg8::f32x4*)(xrow + c) + acc[ai][bj][m][n];
                        *(pg8::f32x4*)(H1 + (size_t)row * DM + c) = h;
                        u32x2 w; w.x = pg8::cvt_pk_bf16(h[0], h[1]); w.y = pg8::cvt_pk_bf16(h[2], h[3]);
                        *(u32x2*)(H1b + (size_t)row * DM + c) = w;
                        ss += (h[0] * h[0] + h[1] * h[1]) + (h[2] * h[2] + h[3] * h[3]);
                    }
                ss += __shfl_xor(ss, 16); ss += __shfl_xor(ss, 32);
                if (fq == 0) atomicAdd(RS + row, ss);
                asm volatile("" ::: "memory");
            }
    }
};
struct EpiUp {
    static constexpr bool PERM = true, AFTER_DRAIN = false;
    pg8::bf16_t* U; const float* RS; float* out;
    __device__ __forceinline__ void operator()(const pg8::f32x4 (&acc)[2][2][4][2], const pg8::Unit& u, int wr, int wc, int fr, int fq) const {
        const int colb = u.pn * 256 + wc * 32 + 8 * fq;
#pragma unroll
        for (int ai = 0; ai < 2; ++ai)
#pragma unroll
            for (int m = 0; m < 4; ++m) {
                const int row = u.pm * 256 + ai * 128 + wr * 64 + m * 16 + fr;
                const float rs = 1.0f / sqrtf(RS[row] * (1.f / DM) + EPS);
                float* dstb = nullptr;
                if (row < MP) { const int t = row & (SEQ - 1), b = row >> 12; if (t >= SEQ - 2) dstb = out + O_FP + (size_t)(b * 2 + t - (SEQ - 2)) * DFF2; }
                else { const int r = row - MP, t = r & 7, b = r >> 3; if (t >= TS - 2) dstb = out + O_FS + (size_t)(b * 2 + t - (TS - 2)) * DFF2; }
#pragma unroll
                for (int bj = 0; bj < 2; ++bj) {
                    const int col = colb + bj * 128; const pg8::f32x4 v0 = acc[ai][bj][m][0] * rs, v1 = acc[ai][bj][m][1] * rs;
                    pg8::u32x4 w; w.x = pg8::cvt_pk_bf16(v0[0], v0[1]); w.y = pg8::cvt_pk_bf16(v0[2], v0[3]); w.z = pg8::cvt_pk_bf16(v1[0], v1[1]); w.w = pg8::cvt_pk_bf16(v1[2], v1[3]);
                    *(pg8::u32x4*)(U + (size_t)row * DFF2 + col) = w;
                    if (dstb) { *(pg8::f32x4*)(dstb + col) = v0; *(pg8::f32x4*)(dstb + col + 4) = v1; }
                }
            }
    }
};
struct EpiDown {
    static constexpr bool PERM = false, AFTER_DRAIN = false;
    float* H1; pg8::bf16_t* H2b;
    __device__ __forceinline__ void operator()(const pg8::f32x4 (&acc)[2][2][4][2], const pg8::Unit& u, int wr, int wc, int fr, int fq) const {
        const int col0 = u.pn * 256 + wc * 32 + 4 * fq;
#pragma unroll
        for (int ai = 0; ai < 2; ++ai)
#pragma unroll
            for (int m = 0; m < 4; ++m) {
                const int row = u.pm * 256 + ai * 128 + wr * 64 + m * 16 + fr;
#pragma unroll
                for (int bj = 0; bj < 2; ++bj)
#pragma unroll
                    for (int n = 0; n < 2; ++n) {
                        const int c = col0 + bj * 128 + n * 16; float* hp = H1 + (size_t)row * DM + c;
                        const pg8::f32x4 h = *(const pg8::f32x4*)hp + acc[ai][bj][m][n];
                        *(pg8::f32x4*)hp = h;
                        u32x2 w; w.x = pg8::cvt_pk_bf16(h[0], h[1]); w.y = pg8::cvt_pk_bf16(h[2], h[3]);
                        *(u32x2*)(H2b + (size_t)row * DM + c) = w;
                    }
                asm volatile("" ::: "memory");
            }
    }
};
struct EpiPle {
    static constexpr bool PERM = false, AFTER_DRAIN = false;
    float* E; float* RS;
    __device__ __forceinline__ void operator()(const pg8::f32x4 (&acc)[2][2][4][2], const pg8::Unit& u, int wr, int wc, int fr, int fq) const {
        const int col0 = u.pn * 256 + wc * 32 + 4 * fq;
#pragma unroll
        for (int ai = 0; ai < 2; ++ai)
#pragma unroll
            for (int m = 0; m < 4; ++m) {
                const int row = u.pm * 256 + ai * 128 + wr * 64 + m * 16 + fr; float ss = 0.f;
#pragma unroll
                for (int bj = 0; bj < 2; ++bj)
#pragma unroll
                    for (int n = 0; n < 2; ++n) {
                        const int c = col0 + bj * 128 + n * 16; const pg8::f32x4 h = acc[ai][bj][m][n];
                        *(pg8::f32x4*)(E + (size_t)row * DM + c) = h;
                        ss += (h[0] * h[0] + h[1] * h[1]) + (h[2] * h[2] + h[3] * h[3]);
                    }
                ss += __shfl_xor(ss, 16); ss += __shfl_xor(ss, 32);
                if (fq == 0) atomicAdd(RS + row, ss);
            }
    }
};
struct EpiGate {
    static constexpr bool PERM = false, AFTER_DRAIN = false;
    const float* H2; const float* E; const float* RSE; const float* gple; float* out; float* RS3;
    __device__ __forceinline__ void operator()(const pg8::f32x4 (&acc)[2][2][4][2], const pg8::Unit& u, int wr, int wc, int fr, int fq) const {
        const int col0 = u.pn * 256 + wc * 32 + 4 * fq;
        pg8::f32x4 gp[2][2];
#pragma unroll
        for (int bj = 0; bj < 2; ++bj)
#pragma unroll
            for (int n = 0; n < 2; ++n) gp[bj][n] = *(const pg8::f32x4*)(gple + col0 + bj * 128 + n * 16);
#pragma unroll
        for (int ai = 0; ai < 2; ++ai)
#pragma unroll
            for (int m = 0; m < 4; ++m) {
                const int row = u.pm * 256 + ai * 128 + wr * 64 + m * 16 + fr;
                const float rse = 1.0f / sqrtf(RSE[row] * (1.f / DM) + EPS);
                float* orow = (row < MP) ? out + O_Y + (size_t)row * DM : out + O_YS + (size_t)(row - MP) * DM;
                float ss = 0.f;
#pragma unroll
                for (int bj = 0; bj < 2; ++bj)
#pragma unroll
                    for (int n = 0; n < 2; ++n) {
                        const int c = col0 + bj * 128 + n * 16;
                        const pg8::f32x4 a = acc[ai][bj][m][n], e = *(const pg8::f32x4*)(E + (size_t)row * DM + c), h2 = *(const pg8::f32x4*)(H2 + (size_t)row * DM + c);
                        pg8::f32x4 h;
#pragma unroll
                        for (int k = 0; k < 4; ++k) { const float g = 1.f / (1.f + __expf(-a[k])); h[k] = h2[k] + g * (e[k] * rse * gp[bj][n][k]); }
                        *(pg8::f32x4*)(orow + c) = h;
                        ss += (h[0] * h[0] + h[1] * h[1]) + (h[2] * h[2] + h[3] * h[3]);
                    }
                ss += __shfl_xor(ss, 16); ss += __shfl_xor(ss, 32);
                if (fq == 0) atomicAdd(RS3 + row, ss);
                asm volatile("" ::: "memory");
            }
    }
};

__device__ __forceinline__ void p0_transpose_item(const float* W, int ldn, int K, int N, bf16* WT, const float* gk, LAS float* scr, int item, int lane) {
    const int nblk = N / 32, kb = item / nblk, nb = item % nblk, k0 = 64 * kb, n0 = 32 * nb;
#pragma unroll 8
    for (int i = 0; i < 32; ++i) { const int kk = 2 * i + (lane >> 5); float w = W[(size_t)(k0 + kk) * ldn + n0 + (lane & 31)]; if (gk) w *= gk[k0 + kk]; scr[kk * 33 + (lane & 31)] = w; }
    LDS_WAIT(); asm volatile("" ::: "memory");
    const int c = lane & 7;
#pragma unroll
    for (int j = 0; j < 4; ++j) { const int n = (lane >> 3) + 8 * j; const LAS float* s = scr + (8 * c) * 33 + n;
        v4u o; o.x = pk2(s[0 * 33], s[1 * 33]); o.y = pk2(s[2 * 33], s[3 * 33]); o.z = pk2(s[4 * 33], s[5 * 33]); o.w = pk2(s[6 * 33], s[7 * 33]);
        *(GAS v4u*)(WT + (size_t)(n0 + n) * K + k0 + 8 * c) = o; }
    LDS_WAIT(); asm volatile("" ::: "memory");
}
__device__ __forceinline__ void p0_prologue(const Args& a, LAS unsigned char* lds, int gw, int NGW, int wave, int lane) {
    unsigned char* ws = a.ws;
    LAS float* scr = (LAS float*)(lds + wave * 16384);
    constexpr int I_IN = (DM / 64) * (NIN / 32), I_OUT = (DM / 64) * (DM / 32), I_UP = (DM / 64) * (DFF2 / 32), I_DN = (DFF / 64) * (DM / 32), I_PLE = (DPLE / 64) * (DM / 32), I_G = I_OUT;
    constexpr int NITEMS = I_IN + I_OUT + I_UP + I_DN + I_PLE + I_G;
    for (int it = gw; it < NITEMS; it += NGW) {
        int r = it;
        if (r < I_IN)  { p0_transpose_item(a.in[11], IN_LD, DM, NIN, (bf16*)(ws + WS_WIN), a.in[10], scr, r, lane); continue; } r -= I_IN;
        if (r < I_OUT) { p0_transpose_item(a.in[18], DM, DM, DM, (bf16*)(ws + WS_WOUT), nullptr, scr, r, lane); continue; } r -= I_OUT;
        if (r < I_UP)  { p0_transpose_item(a.in[20], DFF2, DM, DFF2, (bf16*)(ws + WS_WUP), a.in[19], scr, r, lane); continue; } r -= I_UP;
        if (r < I_DN)  { p0_transpose_item(a.in[23], DM, DFF, DM, (bf16*)(ws + WS_WDOWN), nullptr, scr, r, lane); continue; } r -= I_DN;
        if (r < I_PLE) { p0_transpose_item(a.in[24], DM, DPLE, DM, (bf16*)(ws + WS_WPLE), nullptr, scr, r, lane); continue; } r -= I_PLE;
        p0_transpose_item(a.in[26], DM, DM, DM, (bf16*)(ws + WS_WGATE), nullptr, scr, r, lane);
    }
    const float* gmix = a.in[10]; const float* win = a.in[11]; const float* dtb = a.in[14];
    bf16* XN = (bf16*)(ws + WS_XN); bf16* PB = (bf16*)(ws + WS_PB); float* DT = (float*)(ws + WS_DT);
    for (int m = gw; m < MT; m += NGW) {
        const float* xrow = (m < MP) ? a.in[0] + (size_t)m * DM : a.in[1] + (size_t)(m - MP) * DM;
        const GAS f32x4* xr = (const GAS f32x4*)xrow + lane;
        f32x4 v[4]; float s = 0.f;
#pragma unroll
        for (int j = 0; j < 4; ++j) { v[j] = xr[64 * j]; s += (v[j].x * v[j].x + v[j].y * v[j].y) + (v[j].z * v[j].z + v[j].w * v[j].w); }
        const float rstd = 1.0f / sqrtf(wave_sum(s) * (1.f / DM) + EPS);
        GAS unsigned long long* o8 = (GAS unsigned long long*)(XN + (size_t)m * DM) + lane;
        float dacc[8];
#pragma unroll
        for (int h = 0; h < 8; ++h) dacc[h] = 0.f;
#pragma unroll
        for (int j = 0; j < 4; ++j) {
            v[j] = v[j] * rstd;
            o8[64 * j] = (unsigned long long)pk2(v[j].x, v[j].y) | ((unsigned long long)pk2(v[j].z, v[j].w) << 32);
#pragma unroll
            for (int e = 0; e < 4; ++e) {
                const int k = 256 * j + 4 * lane + e; const float xv = v[j][e] * gmix[k];
                const f32x4 w0 = *(const f32x4*)(win + (size_t)k * IN_LD + NIN), w1 = *(const f32x4*)(win + (size_t)k * IN_LD + NIN + 4);
                dacc[0] += xv * w0.x; dacc[1] += xv * w0.y; dacc[2] += xv * w0.z; dacc[3] += xv * w0.w;
                dacc[4] += xv * w1.x; dacc[5] += xv * w1.y; dacc[6] += xv * w1.z; dacc[7] += xv * w1.w;
            }
        }
#pragma unroll
        for (int h = 0; h < 8; ++h) dacc[h] = softplusf(wave_sum(dacc[h]) + dtb[h]);
        if (lane == 0) { *(f32x4*)(DT + (size_t)m * 8) = (f32x4){dacc[0], dacc[1], dacc[2], dacc[3]}; *(f32x4*)(DT + (size_t)m * 8 + 4) = (f32x4){dacc[4], dacc[5], dacc[6], dacc[7]}; }
        const float* prow = (m < MP) ? a.in[2] + (size_t)m * DPLE : a.in[3] + (size_t)(m - MP) * DPLE;
        const f32x4 pv = *((const f32x4*)prow + lane);
        *((GAS unsigned long long*)(PB + (size_t)m * DPLE) + lane) = (unsigned long long)pk2(pv.x, pv.y) | ((unsigned long long)pk2(pv.z, pv.w) << 32);
    }
}

__device__ __forceinline__ void load8bf(const bf16* p, float (&o)[8]) {
    const v4u w = *(const v4u*)p;
    o[0] = bflo(w.x); o[1] = bfhi(w.x); o[2] = bflo(w.y); o[3] = bfhi(w.y); o[4] = bflo(w.z); o[5] = bfhi(w.z); o[6] = bflo(w.w); o[7] = bfhi(w.w);
}
__device__ __forceinline__ void load8f(const float* p, float (&o)[8]) {
    const f32x4 a = *(const f32x4*)p, b = *(const f32x4*)(p + 4);
    o[0] = a.x; o[1] = a.y; o[2] = a.z; o[3] = a.w; o[4] = b.x; o[5] = b.y; o[6] = b.z; o[7] = b.w;
}
__device__ __forceinline__ void conv_xbc_pass(const Args& a, int gtid, int NT) {
    const bf16* PROJ = (const bf16*)(a.ws + WS_PROJ); float* XB = (float*)(a.ws + WS_XBCC);
    const float* cw = a.in[12]; const float* cb = a.in[13]; const float* sconv = a.in[7];
    for (int it = gtid; it < (MT / 8) * 128; it += NT) {
        const int rb = it >> 7, c = (it & 127) * 8, m0 = rb * 8;
        float w0[8], w1[8], w2[8], w3[8], bb[8], x3[8], x2[8], x1[8];
        load8f(cw + c, w0); load8f(cw + 1024 + c, w1); load8f(cw + 2048 + c, w2); load8f(cw + 3072 + c, w3); load8f(cb + c, bb);
        if (m0 < MP) {
            if ((m0 & (SEQ - 1)) == 0) {
#pragma unroll
                for (int k = 0; k < 8; ++k) { x3[k] = 0.f; x2[k] = 0.f; x1[k] = 0.f; }
            } else { load8bf(PROJ + (size_t)(m0 - 3) * NIN + PC_X + c, x3); load8bf(PROJ + (size_t)(m0 - 2) * NIN + PC_X + c, x2); load8bf(PROJ + (size_t)(m0 - 1) * NIN + PC_X + c, x1); }
        } else { const int b = (m0 - MP) >> 3; load8f(sconv + (size_t)(b * 3 + 0) * 1024 + c, x3); load8f(sconv + (size_t)(b * 3 + 1) * 1024 + c, x2); load8f(sconv + (size_t)(b * 3 + 2) * 1024 + c, x1); }
#pragma unroll
        for (int r = 0; r < 8; ++r) {
            float cur[8], y[8]; load8bf(PROJ + (size_t)(m0 + r) * NIN + PC_X + c, cur);
#pragma unroll
            for (int k = 0; k < 8; ++k) { y[k] = siluf(bb[k] + w0[k] * x3[k] + w1[k] * x2[k] + w2[k] * x1[k] + w3[k] * cur[k]); x3[k] = x2[k]; x2[k] = x1[k]; x1[k] = cur[k]; }
            float* o = XB + (size_t)(m0 + r) * 1024 + c;
            *(f32x4*)o = (f32x4){y[0], y[1], y[2], y[3]}; *(f32x4*)(o + 4) = (f32x4){y[4], y[5], y[6], y[7]};
        }
    }
}

constexpr int ATT_WAVE_BYTES = 8704, ATT_VB = 0, ATT_STG = 4096, ATT_WSF = 8192, ATT_BTAB_OFF = 8 * ATT_WAVE_BYTES  , ATT_BT_LD = 132;
__device__ __forceinline__ v4i16_t vtr(const LAS unsigned char* p) { return __builtin_amdgcn_ds_read_tr16_b64_v4i16((LAS v4i16_t*)p); }
__device__ __forceinline__ unsigned cvtpk_s(float lo, float hi) { typedef float f2 __attribute__((ext_vector_type(2))); typedef __bf16 b2 __attribute__((ext_vector_type(2))); f2 v = {lo, hi}; b2 b = __builtin_convertvector(v, b2); return __builtin_bit_cast(unsigned, b); }

__device__ __forceinline__ void attn_build_btab(const Args& a, LAS unsigned char* lds, int tid) {
    LAS float* bt = (LAS float*)(lds + ATT_BTAB_OFF); const float* rb = a.in[9];
    for (int i = tid; i < 3 * 8 * 129; i += NWAVES * 64) { const int br = i / (8 * 129), rem = i % (8 * 129), h = rem / 129, j = rem % 129; bt[(br * 8 + h) * ATT_BT_LD + j] = rb[BUCKET_TAB[br][j] * 8 + h] * LOG2E; }
}
__device__ __forceinline__ void attn_prompt_unit(const Args& a, LAS unsigned char* lds, int unit, int wave, int lane) {
    const bf16* PROJ = (const bf16*)(a.ws + WS_PROJ);
    const int r32 = lane & 31, hi = lane >> 5;
    const int rq = unit & 127, bhb = unit >> 7, br = bhb % 3, bh = bhb / 3, h = bh & 7, b = bh >> 3;
    const int sh = 2 * br, dil = 1 << sh, nqb = 128 >> sh, r = rq / nqb, qb = rq % nqb, l0 = qb * 32;
    const size_t rowb = (size_t)b * SEQ;
    LAS unsigned char* wl = lds + wave * ATT_WAVE_BYTES;
    const LAS float* bt = (const LAS float*)(lds + ATT_BTAB_OFF) + (br * 8 + h) * ATT_BT_LD;
    bf16x8 qr[4];
    { const bf16* qp = PROJ + (rowb + (size_t)(l0 + r32) * dil + r) * NIN + h * 64 + hi * 8;
#pragma unroll
      for (int d0 = 0; d0 < 4; ++d0) qr[d0] = *(const bf16x8*)(qp + d0 * 16); }
    const int kb0 = (l0 >= 128) ? 0 : (4 - (l0 >> 5));
    f32x16 s[5];
#pragma unroll
    for (int kb = 0; kb < 5; ++kb) {
#pragma unroll
        for (int i = 0; i < 16; ++i) s[kb][i] = 0.f;
        if (kb >= kb0) {
            int kk = l0 - 128 + 32 * kb + r32; kk = kk < 0 ? 0 : kk;
            const bf16* kp = PROJ + (rowb + (size_t)kk * dil + r) * NIN + PC_K + h * 64 + hi * 8;
            bf16x8 kf[4];
#pragma unroll
            for (int d0 = 0; d0 < 4; ++d0) kf[d0] = *(const bf16x8*)(kp + d0 * 16);
#pragma unroll
            for (int d0 = 0; d0 < 4; ++d0) s[kb] = __builtin_amdgcn_mfma_f32_32x32x16_bf16(kf[d0], qr[d0], s[kb], 0, 0, 0);
        }
    }
    float mx = -INFINITY;
#pragma unroll
    for (int kb = 0; kb < 5; ++kb)
#pragma unroll
        for (int i = 0; i < 16; ++i) {
            const int c = crow(i, hi), j = r32 - c + 128 - 32 * kb, kk = l0 - 128 + 32 * kb + c;
            const bool valid = (j >= 0) && (j <= 128) && (kk >= 0) && (kb >= kb0);
            const int jc = j < 0 ? 0 : (j > 128 ? 128 : j);
            const float v = valid ? s[kb][i] + bt[jc] : -INFINITY;
            s[kb][i] = v; mx = fmaxf(mx, v);
        }
    mx = fmaxf(mx, __shfl_xor(mx, 32));
    float l = 0.f;
#pragma unroll
    for (int kb = 0; kb < 5; ++kb)
#pragma unroll
        for (int i = 0; i < 16; ++i) { const float p = __builtin_amdgcn_exp2f(s[kb][i] - mx); s[kb][i] = p; l += p; }
    l += __shfl_xor(l, 32);
    f32x16 o[2];
#pragma unroll
    for (int i = 0; i < 16; ++i) { o[0][i] = 0.f; o[1][i] = 0.f; }
    const LAS unsigned char* vrd = wl + ATT_VB + ((lane >> 4) & 1) * 32 + (lane & 3) * 8 + (4 * hi + ((lane & 15) >> 2)) * 64;
#pragma unroll
    for (int kb = 0; kb < 5; ++kb) {
        if (kb >= kb0) {
#pragma unroll
            for (int i = 0; i < 4; ++i) {
                const int idx = i * 64 + lane, key = idx >> 3, ch = idx & 7;
                int kk = l0 - 128 + 32 * kb + key; kk = kk < 0 ? 0 : kk;
                const v4u vv = *(const v4u*)(PROJ + (rowb + (size_t)kk * dil + r) * NIN + PC_V + h * 64 + ch * 8);
                *(LAS v4u*)(wl + ATT_VB + (ch >> 2) * 2048 + (key >> 4) * 1024 + (key & 15) * 64 + (ch & 3) * 16) = vv;
            }
            LDS_WAIT();
#pragma unroll
            for (int ks = 0; ks < 2; ++ks) {
                v4u pw;
                pw.x = cvtpk_s(s[kb][8 * ks + 0], s[kb][8 * ks + 1]); pw.y = cvtpk_s(s[kb][8 * ks + 2], s[kb][8 * ks + 3]);
                pw.z = cvtpk_s(s[kb][8 * ks + 4], s[kb][8 * ks + 5]); pw.w = cvtpk_s(s[kb][8 * ks + 6], s[kb][8 * ks + 7]);
                const bf16x8 pa = __builtin_bit_cast(bf16x8, pw);
#pragma unroll
                for (int d0 = 0; d0 < 2; ++d0) {
                    const v4i16_t lo = vtr(vrd + d0 * 2048 + ks * 1024), hh = vtr(vrd + d0 * 2048 + ks * 1024 + 512);
                    const bf16x8 vb = (bf16x8){lo[0], lo[1], lo[2], lo[3], hh[0], hh[1], hh[2], hh[3]};
                    o[d0] = __builtin_amdgcn_mfma_f32_32x32x16_bf16(pa, vb, o[d0], 0, 0, 0);
                }
            }
            LDS_WAIT();
        }
    }
    LAS float* wsf = (LAS float*)(wl + ATT_WSF);
    if (hi == 0) wsf[r32] = l;
    LDS_WAIT();
    LAS bf16* stg = (LAS bf16*)(wl + ATT_STG);
#pragma unroll
    for (int i = 0; i < 16; ++i) {
        const int orow = crow(i, hi); const float rl = 1.0f / wsf[orow];
        stg[orow * 64 + r32] = (bf16)f2bf(o[0][i] * rl); stg[orow * 64 + 32 + r32] = (bf16)f2bf(o[1][i] * rl);
    }
    LDS_WAIT();
    bf16* OBR = (bf16*)(a.ws + WS_OBR) + (size_t)br * MP * 512;
#pragma unroll
    for (int i = 0; i < 4; ++i) {
        const int row = i * 8 + (lane >> 3), ch = lane & 7;
        const v4u v = *(const LAS v4u*)(stg + row * 64 + ch * 8);
        *(v4u*)(OBR + (rowb + (size_t)(l0 + row) * dil + r) * 512 + h * 64 + ch * 8) = v;
    }
    if (hi == 0) { float* LSE = (float*)(a.ws + WS_LSE) + (size_t)br * MP * 8; LSE[(rowb + (size_t)(l0 + r32) * dil + r) * 8 + h] = mx + __builtin_amdgcn_logf(l); }
    LDS_WAIT();
}

__device__ __forceinline__ void attn_sample_task(const Args& a, LAS unsigned char* lds, int task, int wave, int lane) {
    const int h = task & 7, t = (task >> 3) & 7, b = task >> 6;
    const bf16* PROJ = (const bf16*)(a.ws + WS_PROJ);
    const float* ck = a.in[4]; const float* cv = a.in[5]; const float* kn = a.out + O_KS; const float* vn = a.out + O_VS;
    LAS float* pl = (LAS float*)(lds + wave * ATT_WAVE_BYTES + ATT_STG);
    float q[64];
    { const bf16* qp = PROJ + (size_t)(MP + b * 8 + t) * NIN + h * 64;
#pragma unroll
      for (int i = 0; i < 8; ++i) { float tmp[8]; load8bf(qp + i * 8, tmp);
#pragma unroll
          for (int k = 0; k < 8; ++k) q[i * 8 + k] = tmp[k]; } }
    float mx = -INFINITY;
#pragma unroll 1
    for (int br = 0; br < 3; ++br) {
        const int dil = 1 << (2 * br);
        const LAS float* bt = (const LAS float*)(lds + ATT_BTAB_OFF) + (br * 8 + h) * ATT_BT_LD;
#pragma unroll 1
        for (int jj = 0; jj < 3; ++jj) {
            const int j = jj * 64 + lane;
            if (j <= 128) {
                const int idx = WBUF + t - j * dil;
                const float* kp = (idx < WBUF) ? ck + ((size_t)(b * WBUF + idx) * 8 + h) * 64 : kn + ((size_t)(b * 8 + (idx - WBUF)) * 8 + h) * 64;
                float d = 0.f;
#pragma unroll
                for (int i = 0; i < 16; ++i) { const f32x4 kv = *(const f32x4*)(kp + i * 4); d += q[4 * i] * kv.x + q[4 * i + 1] * kv.y + q[4 * i + 2] * kv.z + q[4 * i + 3] * kv.w; }
                const float v = d + bt[j];
                pl[br * ATT_BT_LD + j] = v; mx = fmaxf(mx, v);
            }
        }
    }
    mx = wave_max(mx);
    LDS_WAIT(); asm volatile("" ::: "memory");
    float l = 0.f;
#pragma unroll 1
    for (int i = lane; i < 3 * ATT_BT_LD; i += 64) { const int j = i % ATT_BT_LD; if (j <= 128) { const float p = __builtin_amdgcn_exp2f(pl[i] - mx); pl[i] = p; l += p; } }
    l = wave_sum(l);
    LDS_WAIT(); asm volatile("" ::: "memory");
    float o = 0.f;
#pragma unroll
    for (int br = 0; br < 3; ++br) {
        const int dil = 1 << (2 * br);
#pragma unroll 4
        for (int j = 0; j <= 128; ++j) {
            const int idx = WBUF + t - j * dil;
            const float* vp = (idx < WBUF) ? cv + ((size_t)(b * WBUF + idx) * 8 + h) * 64 : vn + ((size_t)(b * 8 + (idx - WBUF)) * 8 + h) * 64;
            o += pl[br * ATT_BT_LD + j] * vp[lane];
        }
    }
    bf16* MIX = (bf16*)(a.ws + WS_MIX);
    MIX[(size_t)(MP + b * 8 + t) * DM + h * 64 + lane] = (bf16)f2bf(o / l);
    LDS_WAIT(); asm volatile("" ::: "memory");
}

__device__ __forceinline__ void ssd_task(const Args& a, int task, int lane) {
    const float* XB = (const float*)(a.ws + WS_XBCC); const float* DT = (const float*)(a.ws + WS_DT); float* YS = (float*)(a.ws + WS_YS);
    int b, h, p, T, row0; float s0, s1; float* sout;
    if (task < NBP * 512) { b = task >> 9; h = (task >> 6) & 7; p = task & 63; T = SEQ; row0 = b * SEQ; s0 = 0.f; s1 = 0.f; sout = a.out + O_SP + ((size_t)((b * 8 + h) * 64 + p)) * 128; }
    else { const int k = task - NBP * 512; b = k >> 9; h = (k >> 6) & 7; p = k & 63; T = TS; row0 = MP + b * TS; const float* si = a.in[6] + ((size_t)((b * 8 + h) * 64 + p)) * 128; s0 = si[lane]; s1 = si[lane + 64]; sout = a.out + O_SS + ((size_t)((b * 8 + h) * 64 + p)) * 128; }
    const int g = h >> 2; const float A = -__expf(a.in[15][h]);
    for (int t = 0; t < T; t += 4) {
        float dtv[4], xv[4], B0[4], B1[4], C0[4], C1[4];
#pragma unroll
        for (int k = 0; k < 4; ++k) { const size_t m = (size_t)(row0 + t + k); dtv[k] = DT[m * 8 + h]; const float* xr = XB + m * 1024; xv[k] = xr[h * 64 + p]; B0[k] = xr[512 + g * 128 + lane]; B1[k] = xr[512 + g * 128 + 64 + lane]; C0[k] = xr[768 + g * 128 + lane]; C1[k] = xr[768 + g * 128 + 64 + lane]; }
        float y[4];
#pragma unroll
        for (int k = 0; k < 4; ++k) { const float da = __expf(dtv[k] * A), xd = dtv[k] * xv[k]; s0 = da * s0 + xd * B0[k]; s1 = da * s1 + xd * B1[k]; y[k] = C0[k] * s0 + C1[k] * s1; }
#pragma unroll
        for (int k = 0; k < 4; ++k) y[k] = wave_sum(y[k]);
        if (lane == 0) {
#pragma unroll
            for (int k = 0; k < 4; ++k) YS[(size_t)(row0 + t + k) * 512 + h * 64 + p] = y[k];
        }
    }
    sout[lane] = s0; sout[lane + 64] = s1;
}
__device__ __forceinline__ void attn_combine_pass(const Args& a, int gtid, int NT) {
    const bf16* OBR = (const bf16*)(a.ws + WS_OBR); const float* LSE = (const float*)(a.ws + WS_LSE); bf16* MIX = (bf16*)(a.ws + WS_MIX);
    for (int it = gtid; it < MP * 64; it += NT) {
        const int row = it >> 6, c8 = it & 63, h = c8 >> 3;
        const float l0 = LSE[(size_t)row * 8 + h], l1 = LSE[(size_t)(MP + row) * 8 + h], l2 = LSE[(size_t)(2 * MP + row) * 8 + h];
        const float mx = fmaxf(l0, fmaxf(l1, l2));
        float w0 = __builtin_amdgcn_exp2f(l0 - mx), w1 = __builtin_amdgcn_exp2f(l1 - mx), w2 = __builtin_amdgcn_exp2f(l2 - mx);
        const float inv = 1.f / (w0 + w1 + w2); w0 *= inv; w1 *= inv; w2 *= inv;
        float o0[8], o1[8], o2[8];
        load8bf(OBR + (size_t)row * 512 + c8 * 8, o0); load8bf(OBR + ((size_t)MP + row) * 512 + c8 * 8, o1); load8bf(OBR + ((size_t)2 * MP + row) * 512 + c8 * 8, o2);
        float r[8];
#pragma unroll
        for (int k = 0; k < 8; ++k) r[k] = w0 * o0[k] + w1 * o1[k] + w2 * o2[k];
        v4u w; w.x = pk2(r[0], r[1]); w.y = pk2(r[2], r[3]); w.z = pk2(r[4], r[5]); w.w = pk2(r[6], r[7]);
        *(v4u*)(MIX + (size_t)row * DM + c8 * 8) = w;
    }
}
__device__ __forceinline__ void ssd_finish_pass(const Args& a, int gw, int NGW, int lane) {
    const float* XB = (const float*)(a.ws + WS_XBCC); const float* YS = (const float*)(a.ws + WS_YS); const bf16* PROJ = (const bf16*)(a.ws + WS_PROJ); bf16* MIX = (bf16*)(a.ws + WS_MIX);
    const float* dsk = a.in[16]; const float* gs = a.in[17];
    const int c = lane * 8; const float dh = dsk[c >> 6];
    float g8[8]; load8f(gs + c, g8);
    for (int m = gw; m < MT; m += NGW) {
        float y[8], x[8], z[8], v[8]; load8f(YS + (size_t)m * 512 + c, y); load8f(XB + (size_t)m * 1024 + c, x); load8bf(PROJ + (size_t)m * NIN + PC_Z + c, z);
        float ss = 0.f;
#pragma unroll
        for (int k = 0; k < 8; ++k) { v[k] = (y[k] + dh * x[k]) * siluf(z[k]); ss += v[k] * v[k]; }
#pragma unroll
        for (int o = 1; o < 32; o <<= 1) ss += __shfl_xor(ss, o);
        const float rs = 1.0f / sqrtf(ss * (1.f / 256.f) + EPS);
        v4u w; w.x = pk2(v[0] * rs * g8[0], v[1] * rs * g8[1]); w.y = pk2(v[2] * rs * g8[2], v[3] * rs * g8[3]); w.z = pk2(v[4] * rs * g8[4], v[5] * rs * g8[5]); w.w = pk2(v[6] * rs * g8[6], v[7] * rs * g8[7]);
        *(v4u*)(MIX + (size_t)m * DM + 512 + c) = w;
    }
}
__device__ __forceinline__ void ffn_conv_pass(const Args& a, int gtid, int NT) {
    const bf16* U = (const bf16*)(a.ws + WS_U); bf16* ACT = (bf16*)(a.ws + WS_ACT);
    const float* fw = a.in[21]; const float* fb = a.in[22]; const float* sf = a.in[8];
    constexpr int NC8 = DFF / 8, NPB = MP / 16, NITEMS = (NPB + NBS) * NC8;
    for (int it = gtid; it < NITEMS; it += NT) {
        const int blk = it / NC8, c = (it % NC8) * 8;
        float wa0[8], wa1[8], wa2[8], wb0[8], wb1[8], wb2[8], ba[8], bb[8], a2[8], a1[8], b2[8], b1[8];
        load8f(fw + c, wa0); load8f(fw + DFF2 + c, wa1); load8f(fw + 2 * DFF2 + c, wa2); load8f(fb + c, ba);
        load8f(fw + DFF + c, wb0); load8f(fw + DFF2 + DFF + c, wb1); load8f(fw + 2 * DFF2 + DFF + c, wb2); load8f(fb + DFF + c, bb);
        int m0, nr;
        if (blk < NPB) { m0 = blk * 16; nr = 16;
            if ((m0 & (SEQ - 1)) == 0) {
#pragma unroll
                for (int k = 0; k < 8; ++k) { a2[k] = 0.f; a1[k] = 0.f; b2[k] = 0.f; b1[k] = 0.f; }
            } else { load8bf(U + (size_t)(m0 - 2) * DFF2 + c, a2); load8bf(U + (size_t)(m0 - 1) * DFF2 + c, a1); load8bf(U + (size_t)(m0 - 2) * DFF2 + DFF + c, b2); load8bf(U + (size_t)(m0 - 1) * DFF2 + DFF + c, b1); }
        } else { const int b = blk - NPB; m0 = MP + b * 8; nr = 8;
            load8f(sf + (size_t)(b * 2) * DFF2 + c, a2); load8f(sf + (size_t)(b * 2 + 1) * DFF2 + c, a1); load8f(sf + (size_t)(b * 2) * DFF2 + DFF + c, b2); load8f(sf + (size_t)(b * 2 + 1) * DFF2 + DFF + c, b1); }
        for (int r = 0; r < nr; ++r) {
            float ua[8], ub[8], o[8]; load8bf(U + (size_t)(m0 + r) * DFF2 + c, ua); load8bf(U + (size_t)(m0 + r) * DFF2 + DFF + c, ub);
#pragma unroll
            for (int k = 0; k < 8; ++k) {
                const float ya = ba[k] + wa0[k] * a2[k] + wa1[k] * a1[k] + wa2[k] * ua[k], yb = bb[k] + wb0[k] * b2[k] + wb1[k] * b1[k] + wb2[k] * ub[k];
                o[k] = siluf(ya) * yb; a2[k] = a1[k]; a1[k] = ua[k]; b2[k] = b1[k]; b1[k] = ub[k];
            }
            v4u w; w.x = pk2(o[0], o[1]); w.y = pk2(o[2], o[3]); w.z = pk2(o[4], o[5]); w.w = pk2(o[6], o[7]);
            *(v4u*)(ACT + (size_t)(m0 + r) * DFF + c) = w;
        }
    }
}
__device__ __forceinline__ void final_norm_pass(const Args& a, int gw, int NGW, int lane) {
    const float* RS3 = (const float*)(a.ws + WS_RS3); const float* gf = a.in[27];
    f32x4 g[4];
#pragma unroll
    for (int j = 0; j < 4; ++j) g[j] = *((const f32x4*)gf + lane + 64 * j);
    for (int m = gw; m < MT; m += NGW) {
        float* orow = (m < MP) ? a.out + O_Y + (size_t)m * DM : a.out + O_YS + (size_t)(m - MP) * DM;
        const float rs = 1.0f / sqrtf(RS3[m] * (1.f / DM) + EPS);
#pragma unroll
        for (int j = 0; j < 4; ++j) { f32x4* p = (f32x4*)orow + lane + 64 * j; *p = (*p) * rs * g[j]; }
    }
}

constexpr int NPH = 11;
#ifndef MK_N_LAUNCHES
#define MK_N_LAUNCHES 11
#endif
constexpr int N_LAUNCHES = MK_N_LAUNCHES;
__global__ void __launch_bounds__(NWAVES * 64, 2) mk_fwd(Args args) {
    extern __shared__ __attribute__((aligned(16))) unsigned char lds_raw[];
    LAS unsigned char* lds = (LAS unsigned char*)lds_raw;
    volatile LAS unsigned* MISC = (volatile LAS unsigned*)(lds + MISC_OFF);
    const int tid = threadIdx.x, lane = tid & 63, wave = __builtin_amdgcn_readfirstlane(tid >> 6);
    const int G = gridDim.x, bx = blockIdx.x, vcu = (G % 8 == 0) ? (bx % 8) * (G / 8) + bx / 8 : bx;
    const int gw = vcu * NWAVES + wave, NGW = G * NWAVES, gtid = vcu * (NWAVES * 64) + tid, NT = G * NWAVES * 64;
    unsigned char* ws = args.ws;
    gu32* ctl = (gu32*)(ws + WS_CTL);
    for (int u = tid; u < (LDS_BYTES - LDSCTL_OFF) / 4; u += NWAVES * 64) ((LAS unsigned*)(lds + LDSCTL_OFF))[u] = 0u;
    __syncthreads();
    XcdBarrier bar; bar.bar = (unsigned*)(ctl + CW_BAR); bar.x = 0; bar.st = nullptr;
    if (N_LAUNCHES == 1) bar = xcd_barrier_post((unsigned*)(ctl + CW_BAR), MISC + 8);
    const int lo = args.ph_lo, hi = args.ph_hi;
#ifndef PHMASK
#define PHMASK 0x7ff
#endif
#define IN(k) (((PHMASK >> (k)) & 1) && lo <= (k) && (k) < hi)
#define SEAM(k) do { if (IN(k) && IN((k) + 1)) xcd_barrier(bar); } while (0)

    if (IN(0)) { p0_prologue(args, lds, gw, NGW, wave, lane); VM_WAIT(); __syncthreads(); }
    SEAM(0);
    if (IN(1)) {
        pg8::Gemm g{(const pg8::bf16_t*)(ws + WS_XN), (const pg8::bf16_t*)(ws + WS_WIN), MT, NIN, DM}; pg8::StaticOrder S; S.init(MT, NIN, G, bx);
        EpiIn E{(pg8::bf16_t*)(ws + WS_PROJ), args.out};
        pg8::gemm_phase<EpiIn, pg8::StaticOrder, PG8_ALIGN, PG8_SP2>(lds, g, S, E);
    }
    SEAM(1);
    if (IN(2)) {
        attn_build_btab(args, lds, tid);
        __syncthreads();
#ifndef P2SUB
#define P2SUB 7
#endif
        if (P2SUB & 1) conv_xbc_pass(args, gtid, NT);
        if (P2SUB & 2) for (int task = gw; task < NBS * TS * NH; task += NGW) attn_sample_task(args, lds, task, wave, lane);
        if (P2SUB & 4) for (int unit = gw; unit < NBP * NH * 3 * 128; unit += NGW) attn_prompt_unit(args, lds, unit, wave, lane);
        VM_WAIT(); __syncthreads();
    }
    SEAM(2);
    if (IN(3)) {
        for (int task = gw; task < NBP * 512 + NBS * 512; task += NGW) ssd_task(args, task, lane);
        attn_combine_pass(args, gtid, NT);
        VM_WAIT(); __syncthreads();
    }
    SEAM(3);
    if (IN(4)) { ssd_finish_pass(args, gw, NGW, lane); VM_WAIT(); __syncthreads(); }
    SEAM(4);
    if (IN(5)) {
        { pg8::Gemm g{(const pg8::bf16_t*)(ws + WS_MIX), (const pg8::bf16_t*)(ws + WS_WOUT), MT, DM, DM}; pg8::StaticOrder S; S.init(MT, DM, G, bx);
          EpiOut E{args.in[0], args.in[1], (float*)(ws + WS_H1), (pg8::bf16_t*)(ws + WS_XN), (float*)(ws + WS_RS1)};
          pg8::gemm_phase<EpiOut, pg8::StaticOrder, PG8_ALIGN, PG8_SP2>(lds, g, S, E); }
        { pg8::Gemm g{(const pg8::bf16_t*)(ws + WS_PB), (const pg8::bf16_t*)(ws + WS_WPLE), MT, DM, DPLE}; pg8::StaticOrder S; S.init(MT, DM, G, bx);
          EpiPle E{(float*)(ws + WS_E), (float*)(ws + WS_RSE)};
          pg8::gemm_phase<EpiPle, pg8::StaticOrder, PG8_ALIGN, PG8_SP2>(lds, g, S, E); }
    }
    SEAM(5);
    if (IN(6)) {
        pg8::Gemm g{(const pg8::bf16_t*)(ws + WS_XN), (const pg8::bf16_t*)(ws + WS_WUP), MT, DFF2, DM}; pg8::StaticOrder S; S.init(MT, DFF2, G, bx);
        EpiUp E{(pg8::bf16_t*)(ws + WS_U), (const float*)(ws + WS_RS1), args.out};
        pg8::gemm_phase<EpiUp, pg8::StaticOrder, PG8_ALIGN, PG8_SP2>(lds, g, S, E);
    }
    SEAM(6);
    if (IN(7)) { ffn_conv_pass(args, gtid, NT); VM_WAIT(); __syncthreads(); }
    SEAM(7);
    if (IN(8)) {
        pg8::Gemm g{(const pg8::bf16_t*)(ws + WS_ACT), (const pg8::bf16_t*)(ws + WS_WDOWN), MT, DM, DFF}; pg8::StaticOrder S; S.init(MT, DM, G, bx);
        EpiDown E{(float*)(ws + WS_H1), (pg8::bf16_t*)(ws + WS_XN)};
        pg8::gemm_phase<EpiDown, pg8::StaticOrder, PG8_ALIGN, PG8_SP2>(lds, g, S, E);
    }
    SEAM(8);
    if (IN(9)) {
        pg8::Gemm g{(const pg8::bf16_t*)(ws + WS_XN), (const pg8::bf16_t*)(ws + WS_WGATE), MT, DM, DM}; pg8::StaticOrder S; S.init(MT, DM, G, bx);
        EpiGate E{(const float*)(ws + WS_H1), (const float*)(ws + WS_E), (const float*)(ws + WS_RSE), args.in[25], args.out, (float*)(ws + WS_RS3)};
        pg8::gemm_phase<EpiGate, pg8::StaticOrder, PG8_ALIGN, PG8_SP2>(lds, g, S, E);
    }
    SEAM(9);
    if (IN(10)) { final_norm_pass(args, gw, NGW, lane); }
#undef IN
#undef SEAM
}

extern "C" void kernel_launch(void* const* d_in, const int* in_sizes, int n_in, void* d_out, int out_size, void* d_ws, size_t ws_size, hipStream_t stream) {
    static int grid = 0;
    if (grid == 0) {
        if (n_in != 28 || out_size != (int)O_END || ws_size < WS_END) { fprintf(stderr, "kernel_launch: unexpected shapes: n_in %d out %d ws %zu\n", n_in, out_size, ws_size); grid = -1; return; }
        int dev = 0, cus = 0, per_cu = 0;
        if (hipGetDevice(&dev) != hipSuccess || hipDeviceGetAttribute(&cus, hipDeviceAttributeMultiprocessorCount, dev) != hipSuccess) { grid = -1; return; }
        if (hipFuncSetAttribute((const void*)mk_fwd, hipFuncAttributeMaxDynamicSharedMemorySize, LDS_BYTES) != hipSuccess) { fprintf(stderr, "kernel_launch: hipFuncSetAttribute failed\n"); grid = -1; return; }
        if (hipOccupancyMaxActiveBlocksPerMultiprocessor(&per_cu, (const void*)mk_fwd, NWAVES * 64, LDS_BYTES) != hipSuccess || per_cu < 1) fprintf(stderr, "kernel_launch: occupancy query says %d\n", per_cu);
        (void)hipGetLastError();
        grid = cus;
    }
    if (grid < 0) return;
    if (hipMemsetAsync((char*)d_ws + WS_CTL, 0, CTL_ZERO_BYTES, stream) != hipSuccess) { fprintf(stderr, "kernel_launch: memset failed\n"); return; }
    Args a{};
    for (int i = 0; i < 28; ++i) a.in[i] = (const float*)d_in[i];
    a.out = (float*)d_out; a.ws = (unsigned char*)d_ws;
    for (int li = 0; li < N_LAUNCHES; ++li) {
        if (N_LAUNCHES == 1) { a.ph_lo = 0; a.ph_hi = NPH; } else { a.ph_lo = li; a.ph_hi = li + 1; }
        a.li = li;
        hipLaunchKernelGGL(mk_fwd, dim3(grid), dim3(NWAVES * 64), LDS_BYTES, stream, a);
        const hipError_t le = hipPeekAtLastError();
        if (le != hipSuccess) { fprintf(stderr, "kernel_launch: launch %d failed: %s\n", li, hipGetErrorName(le)); break; }
    }
}
```

```cpp
#include <hip/hip_runtime.h>
#include <cstdio>
#include <cstdint>
namespace pg8 {
#define PG8_LAS __attribute__((address_space(3)))
typedef unsigned short bf16_t;
typedef short bf16x8 __attribute__((ext_vector_type(8)));
typedef float f32x4 __attribute__((ext_vector_type(4)));
typedef unsigned u32x4 __attribute__((ext_vector_type(4)));
constexpr int BM = 256, BK = 64, HALF = 128, HTB = HALF * BK * 2  , STAGE_BYTES = 8 * HTB, NXCD = 8, WGM = 8;

__host__ __device__ __forceinline__ int lds_byte(int r, int c) { const int st = (r >> 4) * 2 + (c >> 5), rr = r & 15, cc = c & 31, ob = rr * 64 + cc * 2; return st * 1024 + (ob ^ (((ob >> 9) & 1) << 5)); }
__host__ __device__ __forceinline__ void stage_rc(int b, int& R, int& C) { const int st = b / 1024, sb = b % 1024, swz = sb ^ (((sb >> 9) & 1) << 5); R = (st >> 1) * 16 + swz / 64; C = (st & 1) * 32 + (swz % 64) / 2; }
__host__ __device__ __forceinline__ int perm32(int rho) { const int n = rho >> 4, i = rho & 15; return 8 * (i >> 2) + 4 * n + (i & 3); }

struct Unit { int pm, pn; };
struct Gemm { const bf16_t* A; const bf16_t* Bt; int M, N, K; };

struct StaticOrder {
    int nM, nN, nwg, G, c;
    __host__ __device__ void init(int M, int N, int G_, int c_) { nM = M / BM; nN = N / BM; nwg = nM * nN; G = G_; c = c_; }
    __host__ __device__ bool next(int i, Unit& u) const {
        const long L = (long)i * G + c; if (L >= nwg) return false;
        int wgid = (int)L; { const int q = nwg / NXCD, r = nwg % NXCD, xcd = wgid % NXCD, off = wgid / NXCD; wgid = (xcd < r ? xcd * (q + 1) : r * (q + 1) + (xcd - r) * q) + off; }
        const int nig = WGM * nN, gid = wgid / nig, fm = gid * WGM, gsz = (nM - fm) < WGM ? (nM - fm) : WGM;
        u.pm = fm + ((wgid % nig) % gsz); u.pn = (wgid % nig) / gsz; return true;
    }
    __device__ __forceinline__ void a_ready(const Unit&) const {}
    __device__ __forceinline__ void done(const Unit&) const {}
};

__device__ __forceinline__ unsigned cvt_pk_bf16(float lo, float hi) { unsigned r; asm volatile("v_cvt_pk_bf16_f32 %0, %1, %2" : "=v"(r) : "v"(lo), "v"(hi)); return r; }
typedef float f32x2 __attribute__((ext_vector_type(2)));
template <class Epi, class Sched, bool ALIGN_EPI = false, bool SP2 = false>
__device__ __forceinline__ void gemm_phase(PG8_LAS unsigned char* lds, const Gemm g, const Sched& S, const Epi& E) {
    const int tid = threadIdx.x, wid = __builtin_amdgcn_readfirstlane(tid >> 6), lane = tid & 63, wr = wid >> 2, wc = wid & 3, fr = lane & 15, fq = lane >> 4;
    const int K = g.K, nt = K / BK;
    unsigned voffA[2], voffB[2];
#pragma unroll
    for (int i = 0; i < 2; ++i) { int R, C; stage_rc(tid * 16 + i * 8192, R, C); const int Rb = Epi::PERM ? ((R & ~31) + perm32(R & 31)) : R;
        voffA[i] = (unsigned)(R * K + C) * 2u; voffB[i] = (unsigned)(Rb * K + C) * 2u; }
    const size_t kstep = (size_t)(BK * 2);
    const size_t hstep = (size_t)HALF * K * 2;
    const size_t tstep = 2 * hstep;
    const unsigned ldsw = (unsigned)wid * 1024u;
    const int aoff = lds_byte(wr * 64 + fr, fq * 8), boff = lds_byte(wc * 32 + fr, fq * 8);
#define PG8_SA(b, h) (((b) * 2 + (h)) * HTB)
#define PG8_SB(b, h) ((4 + (b) * 2 + (h)) * HTB)
#define PG8_STAGE(bufoff, gbase, voff) do { _Pragma("unroll") for (int _i = 0; _i < 2; ++_i) \
        __builtin_amdgcn_global_load_lds((const unsigned*)((const char*)(gbase) + (voff)[_i]), (PG8_LAS unsigned*)(lds + (bufoff) + ldsw + _i * 8192), 16, 0, 0); } while (0)
#define PG8_LDA(dst, b, h) do { _Pragma("unroll") for (int m = 0; m < 4; ++m) _Pragma("unroll") for (int k = 0; k < 2; ++k) dst[m][k] = *(const PG8_LAS bf16x8*)(lds + PG8_SA(b, h) + aoff + m * 2048 + k * 1024); } while (0)
#define PG8_LDB(dst, b, h) do { _Pragma("unroll") for (int n = 0; n < 2; ++n) _Pragma("unroll") for (int k = 0; k < 2; ++k) dst[n][k] = *(const PG8_LAS bf16x8*)(lds + PG8_SB(b, h) + boff + n * 2048 + k * 1024); } while (0)
#define PG8_MMA(ai, bj, At, Bt) do { __builtin_amdgcn_s_setprio(1); _Pragma("unroll") for (int m = 0; m < 4; ++m) _Pragma("unroll") for (int n = 0; n < 2; ++n) _Pragma("unroll") for (int k = 0; k < 2; ++k) \
        acc[ai][bj][m][n] = __builtin_amdgcn_mfma_f32_16x16x32_bf16(Bt[n][k], At[m][k], acc[ai][bj][m][n], 0, 0, 0); __builtin_amdgcn_s_setprio(0); } while (0)
#define PG8_WAIT_V(n) asm volatile("s_waitcnt vmcnt(" #n ")" ::: "memory")
#define PG8_WAIT_L(n) asm volatile("s_waitcnt lgkmcnt(" #n ")" ::: "memory")
#define PG8_BAR __builtin_amdgcn_s_barrier()
#define PG8_SCHED __builtin_amdgcn_sched_barrier(0)
    Unit cur, nxt; int ui = 0;
    if (!S.next(0, cur)) return;
    f32x4 acc[2][2][4][2];
#pragma unroll
    for (int a = 0; a < 2; ++a)
#pragma unroll
        for (int b = 0; b < 2; ++b)
#pragma unroll
            for (int m = 0; m < 4; ++m)
#pragma unroll
                for (int n = 0; n < 2; ++n) acc[a][b][m][n] = (f32x4){0.f, 0.f, 0.f, 0.f};
    bf16x8 At[4][2], B0[2][2], B1[2][2];
    const char* cA = (const char*)g.A + (size_t)cur.pm * tstep; const char* cB = (const char*)g.Bt + (size_t)cur.pn * tstep;
    S.a_ready(cur);
    if constexpr (SP2) {
        PG8_STAGE(PG8_SB(0, 0), cB, voffB); PG8_STAGE(PG8_SB(0, 1), cB + hstep, voffB); PG8_STAGE(PG8_SA(0, 0), cA, voffA); PG8_STAGE(PG8_SA(0, 1), cA + hstep, voffA);
        if (wr == 1) PG8_BAR;
        PG8_WAIT_V(2); PG8_BAR;
        PG8_STAGE(PG8_SB(1, 0), cB + kstep, voffB); PG8_STAGE(PG8_SA(1, 0), cA + kstep, voffA); PG8_STAGE(PG8_SB(1, 1), cB + hstep + kstep, voffB);
        PG8_WAIT_V(6); PG8_BAR;
    } else {
        PG8_STAGE(PG8_SB(0, 0), cB, voffB); PG8_STAGE(PG8_SA(0, 0), cA, voffA); PG8_STAGE(PG8_SB(0, 1), cB + hstep, voffB); PG8_STAGE(PG8_SA(0, 1), cA + hstep, voffA);
        if (wr == 1) PG8_BAR;
        PG8_WAIT_V(4); PG8_BAR;
        PG8_STAGE(PG8_SB(1, 0), cB + kstep, voffB); PG8_STAGE(PG8_SA(1, 0), cA + kstep, voffA); PG8_STAGE(PG8_SB(1, 1), cB + hstep + kstep, voffB);
        PG8_WAIT_V(6); PG8_BAR;
    }
    for (;;) {
        const bool has_next = S.next(ui + 1, nxt);
        const char* nA = has_next ? (const char*)g.A + (size_t)nxt.pm * tstep : cA; const char* nB = has_next ? (const char*)g.Bt + (size_t)nxt.pn * tstep : cB;
        for (int t = 0; t < nt; t += 2) {
            const bool last = (t == nt - 2);
            const char* a1 = cA + (size_t)(t + 1) * kstep;
            const char* a2 = last ? nA : cA + (size_t)(t + 2) * kstep; const char* b2 = last ? nB : cB + (size_t)(t + 2) * kstep;
            const char* a3 = a2 + kstep; const char* b3 = b2 + kstep;
            if (last && has_next) S.a_ready(nxt);
            if constexpr (SP2) {
            PG8_LDB(B0, 0, 0); PG8_LDB(B1, 0, 1); PG8_SCHED; PG8_LDA(At, 0, 0); PG8_STAGE(PG8_SA(1, 1), a1 + hstep, voffA);
            PG8_WAIT_V(8); PG8_WAIT_L(0); PG8_BAR; PG8_MMA(0, 0, At, B0); PG8_MMA(0, 1, At, B1); PG8_BAR; PG8_SCHED;
            PG8_LDA(At, 0, 1); PG8_STAGE(PG8_SB(0, 0), b2, voffB); PG8_STAGE(PG8_SB(0, 1), b2 + hstep, voffB); PG8_STAGE(PG8_SA(0, 0), a2, voffA);
            PG8_WAIT_V(8); PG8_WAIT_L(0); PG8_BAR; PG8_MMA(1, 0, At, B0); PG8_MMA(1, 1, At, B1); PG8_BAR; PG8_SCHED;
            PG8_LDB(B0, 1, 0); PG8_LDB(B1, 1, 1); PG8_SCHED; PG8_LDA(At, 1, 0); PG8_STAGE(PG8_SA(0, 1), a2 + hstep, voffA);
            PG8_WAIT_V(8); PG8_WAIT_L(0); PG8_BAR; PG8_MMA(0, 0, At, B0); PG8_MMA(0, 1, At, B1); PG8_BAR; PG8_SCHED;
            PG8_LDA(At, 1, 1); PG8_STAGE(PG8_SB(1, 0), b3, voffB); PG8_STAGE(PG8_SB(1, 1), b3 + hstep, voffB); PG8_STAGE(PG8_SA(1, 0), a3, voffA);
            PG8_WAIT_V(8); PG8_WAIT_L(0); PG8_BAR; PG8_MMA(1, 0, At, B0); PG8_MMA(1, 1, At, B1); PG8_BAR; PG8_SCHED;
            } else {
            PG8_LDB(B0, 0, 0); PG8_SCHED; PG8_LDA(At, 0, 0); PG8_STAGE(PG8_SA(1, 1), a1 + hstep, voffA);
            PG8_WAIT_L(8); PG8_BAR; PG8_WAIT_L(0); PG8_MMA(0, 0, At, B0); PG8_BAR; PG8_SCHED;
            PG8_LDB(B1, 0, 1); PG8_STAGE(PG8_SB(0, 0), b2, voffB);
            PG8_BAR; PG8_WAIT_L(0); PG8_MMA(0, 1, At, B1); PG8_BAR;
            PG8_LDA(At, 0, 1); PG8_STAGE(PG8_SA(0, 0), a2, voffA);
            PG8_BAR; PG8_WAIT_L(0); PG8_MMA(1, 0, At, B0); PG8_BAR; PG8_SCHED;
            PG8_STAGE(PG8_SB(0, 1), b2 + hstep, voffB);
            PG8_WAIT_V(6); PG8_BAR; PG8_MMA(1, 1, At, B1); PG8_BAR;
            PG8_LDB(B0, 1, 0); PG8_SCHED; PG8_LDA(At, 1, 0); PG8_STAGE(PG8_SA(0, 1), a2 + hstep, voffA);
            PG8_WAIT_L(8); PG8_BAR; PG8_WAIT_L(0); PG8_MMA(0, 0, At, B0); PG8_BAR; PG8_SCHED;
            PG8_LDB(B1, 1, 1); PG8_STAGE(PG8_SB(1, 0), b3, voffB);
            PG8_BAR; PG8_WAIT_L(0); PG8_MMA(0, 1, At, B1); PG8_BAR;
            PG8_LDA(At, 1, 1); PG8_STAGE(PG8_SA(1, 0), a3, voffA);
            PG8_BAR; PG8_WAIT_L(0); PG8_MMA(1, 0, At, B0); PG8_BAR; PG8_SCHED;
            PG8_STAGE(PG8_SB(1, 1), b3 + hstep, voffB);
            PG8_WAIT_V(6); PG8_BAR; PG8_MMA(1, 1, At, B1); PG8_BAR;
            }
        }
        if constexpr (ALIGN_EPI) { if (wr == 0) PG8_BAR; }
        if constexpr (!Epi::AFTER_DRAIN) { E(acc, cur, wr, wc, fr, fq); S.done(cur); }
        if (!has_next) break;
#pragma unroll
        for (int a = 0; a < 2; ++a)
#pragma unroll
            for (int b = 0; b < 2; ++b)
#pragma unroll
                for (int m = 0; m < 4; ++m)
#pragma unroll
                    for (int n = 0; n < 2; ++n) acc[a][b][m][n] = (f32x4){0.f, 0.f, 0.f, 0.f};
        cur = nxt; cA = nA; cB = nB; ++ui;
        if constexpr (ALIGN_EPI) { if (wr == 1) PG8_BAR; }
    }
    PG8_WAIT_V(0);
    if constexpr (!ALIGN_EPI) { if (wr == 0) PG8_BAR; }
    PG8_BAR;
    if constexpr (Epi::AFTER_DRAIN) { E.fused(acc, cur, wr, wc, fr, fq, lds, wid, lane); S.done(cur); }
#undef PG8_SA
#undef PG8_SB
#undef PG8_STAGE
#undef PG8_LDA
#undef PG8_LDB
#undef PG8_MMA
#undef PG8_WAIT_V
#undef PG8_WAIT_L
#undef PG8_BAR
#undef PG8_SCHED
}
}

#ifndef PG8_SP2
#define PG8_SP2 true
#endif
#ifndef PG8_ALIGN
#define PG8_ALIGN true
#endif
#define GAS __attribute__((address_space(1)))
#define LAS __attribute__((address_space(3)))
typedef unsigned short bf16;
typedef unsigned v4u __attribute__((ext_vector_type(4)));
typedef float f32x4 __attribute__((ext_vector_type(4)));
typedef short bf16x8 __attribute__((ext_vector_type(8)));
typedef GAS unsigned gu32;
typedef GAS unsigned long long gu64;
#define RLX_AGENT __ATOMIC_RELAXED, __HIP_MEMORY_SCOPE_AGENT
#define LDS_WAIT() asm volatile("s_waitcnt lgkmcnt(0)" ::: "memory")
#define VM_WAIT() asm volatile("s_waitcnt vmcnt(0)" ::: "memory")
__device__ __forceinline__ unsigned long long rt() { return __builtin_amdgcn_s_memrealtime(); }
__device__ __forceinline__ unsigned f2bf(float f) { unsigned u = __builtin_bit_cast(unsigned, f); return (u + 0x7fffu + ((u >> 16) & 1u)) >> 16; }
__device__ __forceinline__ unsigned pk2(float lo, float hi) { return f2bf(lo) | (f2bf(hi) << 16); }

#define XB_TMO      128
#define XB_XCNT(j)  (256  + 64 * (j))
#define XB_XSUB(j)  (1280 + 64 * (j))
#define XB_XGEN(j)  (2304 + 64 * (j))
#define XB_TOP      3328
#define XB_TOPGEN   3392
#define XCD_BAR_WORDS 3456
#define XB_SPIN_CAP (1u << 18)

__device__ __forceinline__ unsigned xb_ld(unsigned* p)              { return __hip_atomic_load(p, __ATOMIC_RELAXED, __HIP_MEMORY_SCOPE_AGENT); }
__device__ __forceinline__ unsigned xb_add(unsigned* p, unsigned v) { return __hip_atomic_fetch_add(p, v, __ATOMIC_RELAXED, __HIP_MEMORY_SCOPE_AGENT); }
__device__ __forceinline__ unsigned xb_xcc_id() { return (unsigned)__builtin_amdgcn_s_getreg((3 << 11) | 20) & 0xFu; }
#define XB_SPIN(cond, bar) do { unsigned _sp = 0; while (cond) { __builtin_amdgcn_s_sleep(1); \
    if ((++_sp & 255u) == 0u) { if (xb_ld(&(bar)[XB_TMO])) break; if (_sp > XB_SPIN_CAP) { atomicAdd(&(bar)[XB_TMO], 1u); break; } } } } while (0)

struct XcdBarrier {
    unsigned* bar; unsigned x;
    volatile LAS unsigned* st;
};

__device__ __forceinline__ XcdBarrier xcd_barrier_post(unsigned* bar, volatile LAS unsigned* st) {
    XcdBarrier b; b.bar = bar; b.x = xb_xcc_id(); b.st = st;
    if (threadIdx.x == 0) (void)xb_add(&bar[XB_XCNT(b.x)], 1u);
    return b;
}
__device__ __forceinline__ void xcd_barrier_complete(unsigned* bar, unsigned x, unsigned& nloc, unsigned& nx) {
    const unsigned G = gridDim.x * gridDim.y * gridDim.z;
    unsigned sum, cnt, mine, sp = 0u;
    for (;;) {
        sum = 0u; cnt = 0u; mine = 0u;
#pragma unroll
        for (unsigned j = 0; j < 16; ++j) { const unsigned c = xb_ld(&bar[XB_XCNT(j)]); sum += c; cnt += (c > 0u) ? 1u : 0u; mine = (j == x) ? c : mine; }
        if (sum == G) break;
        __builtin_amdgcn_s_sleep(1);
        if ((++sp & 255u) == 0u) { if (xb_ld(&bar[XB_TMO])) break; if (sp > XB_SPIN_CAP) { atomicAdd(&bar[XB_TMO], 1u); break; } }
    }
    nloc = mine > 0u ? mine : 1u; nx = cnt > 0u ? cnt : 1u;
}

__device__ __forceinline__ void xcd_barrier(const XcdBarrier& b) {
    asm volatile("s_waitcnt vmcnt(0)" ::: "memory");
    __syncthreads();
    if (threadIdx.x == 0) {
        unsigned* bar = b.bar;
        __builtin_amdgcn_s_waitcnt(0);
        unsigned nloc = b.st[0], nx = b.st[1];
        if (nloc == 0u) { xcd_barrier_complete(bar, b.x, nloc, nx); b.st[0] = nloc; b.st[1] = nx; }
        const unsigned old = xb_add(&bar[XB_XSUB(b.x)], 1u);
        const unsigned gen = old / nloc;
        if (old + 1u == (gen + 1u) * nloc) {
            __builtin_amdgcn_fence(__ATOMIC_RELEASE, "agent");
            asm volatile("s_waitcnt vmcnt(0)" ::: "memory");
            const unsigned og = xb_add(&bar[XB_TOP], 1u);
            const unsigned tg = og / nx;
            if (og + 1u == (tg + 1u) * nx) xb_add(&bar[XB_TOPGEN], 1u);
            else XB_SPIN(xb_ld(&bar[XB_TOPGEN]) == tg, bar);
            __builtin_amdgcn_fence(__ATOMIC_ACQUIRE, "agent");
            xb_add(&bar[XB_XGEN(b.x)], 1u);
            asm volatile("s_waitcnt vmcnt(0)" ::: "memory");
        } else {
            XB_SPIN(xb_ld(&bar[XB_XGEN(b.x)]) == gen, bar);
            __builtin_amdgcn_fence(__ATOMIC_ACQUIRE, "agent");
            asm volatile("s_waitcnt vmcnt(0)" ::: "memory");
        }
    }
    __syncthreads();
}


constexpr int NWAVES = 8;
constexpr int DM = 1024, SEQ = 4096, NBP = 4, NBS = 32, TS = 8;
constexpr int MP = NBP * SEQ, MS = NBS * TS, MT = MP + MS;
constexpr int NH = 8, HD = 64, DSSM = 512, NST = 128, IN_LD = 3080, NIN = 3072;
constexpr int DFF = 2816, DFF2 = 5632, DPLE = 256, WBUF = 2048;
constexpr float EPS = 1e-6f, LOG2E = 1.4426950408889634f, C2 = 0.125f * 1.4426950408889634f;
constexpr int PC_K = 512, PC_V = 1024, PC_Z = 1536, PC_X = 2048;
constexpr size_t O_Y = 0, O_YS = 16777216, O_KP = 17039360, O_VP = 21233664, O_KS = 25427968, O_VS = 25559040, O_SP = 25690112, O_SS = 25952256,
                 O_CP = 28049408, O_CS = 28061696, O_FP = 28160000, O_FS = 28205056, O_END = 28565504;
constexpr size_t MiB = 1u << 20;
constexpr size_t WS_CTL = 0, CTL_ZERO_BYTES = 1 * MiB;
constexpr size_t WS_RS1 = 256 * 1024, WS_RSE = 384 * 1024, WS_RS3 = 512 * 1024;
constexpr size_t WS_WIN = 2 * MiB, WS_WOUT = 8 * MiB, WS_WUP = 10 * MiB, WS_WDOWN = 21 * MiB, WS_WPLE = 27 * MiB, WS_WGATE = 28 * MiB;
constexpr size_t WS_DT = 30 * MiB, WS_PB = 31 * MiB, WS_XN = 40 * MiB, WS_MIX = 73 * MiB, WS_H1 = 106 * MiB, WS_E = 171 * MiB;
constexpr size_t WS_PROJ = 236 * MiB, WS_OBR = 334 * MiB, WS_LSE = 382 * MiB, WS_XBCC = 384 * MiB, WS_YS = 449 * MiB;
constexpr size_t WS_U = 236 * MiB, WS_ACT = 415 * MiB, WS_END = 505 * MiB;
static_assert(WS_PROJ + (size_t)MT * NIN * 2 <= WS_OBR && WS_OBR + (size_t)3 * MP * 512 * 2 <= WS_LSE && WS_LSE + (size_t)3 * MP * 8 * 4 <= WS_XBCC, "ws map A");
static_assert(WS_XBCC + (size_t)MT * 1024 * 4 <= WS_YS && WS_YS + (size_t)MT * 512 * 4 <= WS_END, "ws map B");
static_assert(WS_U + (size_t)MT * DFF2 * 2 <= WS_ACT && WS_ACT + (size_t)MT * DFF * 2 <= WS_END, "ws map C");
static_assert(WS_XN + (size_t)MT * DM * 2 <= WS_MIX && WS_MIX + (size_t)MT * DM * 2 <= WS_H1 && WS_H1 + (size_t)MT * DM * 4 <= WS_E && WS_E + (size_t)MT * DM * 4 <= WS_PROJ, "ws map D");
static_assert(WS_PB + (size_t)MT * DPLE * 2 <= WS_XN && WS_DT + (size_t)MT * 8 * 4 <= WS_PB, "ws map E");
constexpr int CW_TMO = 0, CW_BAR = 4096;
constexpr int RING_BYTES = 131072, LDSCTL_OFF = RING_BYTES, MISC_OFF = LDSCTL_OFF + 320, LDS_BYTES = 147456;

typedef float f32x16 __attribute__((ext_vector_type(16)));
typedef short v4i16_t __attribute__((ext_vector_type(4)));
typedef unsigned u32x2 __attribute__((ext_vector_type(2)));

__device__ const unsigned char BUCKET_TAB[3][132] = {
 {0,1,2,3,4,5,6,7,8,9,10,11,12,13,14,15,16,16,16,16,16,16,17,17,17,17,17,17,17,17,18,18,18,18,18,18,18,18,18,18,19,19,19,19,19,19,19,19,19,19,19,19,19,19,20,20,20,20,20,20,20,20,20,20,20,20,20,20,20,20,20,20,20,21,21,21,21,21,21,21,21,21,21,21,21,21,21,21,21,21,21,21,21,21,21,21,21,21,21,22,22,22,22,22,22,22,22,22,22,22,22,22,22,22,22,22,22,22,22,22,22,22,22,22,22,22,22,22,22,0,0,0},
 {0,4,8,12,16,16,17,17,18,18,19,19,19,19,20,20,20,20,20,21,21,21,21,21,21,22,22,22,22,22,22,22,22,22,23,23,23,23,23,23,23,23,23,23,23,23,24,24,24,24,24,24,24,24,24,24,24,24,24,24,24,24,25,25,25,25,25,25,25,25,25,25,25,25,25,25,25,25,25,25,25,25,25,26,26,26,26,26,26,26,26,26,26,26,26,26,26,26,26,26,26,26,26,26,26,26,26,26,26,26,26,26,26,27,27,27,27,27,27,27,27,27,27,27,27,27,27,27,27,0,0,0},
 {0,16,18,19,20,21,21,22,22,23,23,23,24,24,24,24,25,25,25,25,25,26,26,26,26,26,26,26,26,27,27,27,27,27,27,27,27,27,27,28,28,28,28,28,28,28,28,28,28,28,28,28,29,29,29,29,29,29,29,29,29,29,29,29,29,29,29,29,29,29,30,30,30,30,30,30,30,30,30,30,30,30,30,30,30,30,30,30,30,30,30,30,30,30,30,31,31,31,31,31,31,31,31,31,31,31,31,31,31,31,31,31,31,31,31,31,31,31,31,31,31,31,31,31,31,31,31,31,31,0,0,0}};

__device__ __forceinline__ float wave_sum(float v) {
#pragma unroll
    for (int o = 1; o < 64; o <<= 1) v += __shfl_xor(v, o);
    return v;
}
__device__ __forceinline__ float wave_max(float v) {
#pragma unroll
    for (int o = 1; o < 64; o <<= 1) v = fmaxf(v, __shfl_xor(v, o));
    return v;
}
__device__ __forceinline__ float bf2f(unsigned short b) { return __uint_as_float((unsigned)b << 16); }
__device__ __forceinline__ float bflo(unsigned w) { return __uint_as_float(w << 16); }
__device__ __forceinline__ float bfhi(unsigned w) { return __uint_as_float(w & 0xffff0000u); }
__device__ __forceinline__ float siluf(float x) { return x / (1.f + __expf(-x)); }
__device__ __forceinline__ float softplusf(float x) { return fmaxf(x, 0.f) + log1pf(__expf(-fabsf(x))); }
__device__ __forceinline__ int crow(int r, int hi) { return (r & 3) + 8 * (r >> 2) + 4 * hi; }

struct Args { const float* in[28]; float* out; unsigned char* ws; int ph_lo, ph_hi, li, pad; };

struct EpiIn {
    static constexpr bool PERM = true, AFTER_DRAIN = false;
    pg8::bf16_t* PROJ; float* out;
    __device__ __forceinline__ void operator()(const pg8::f32x4 (&acc)[2][2][4][2], const pg8::Unit& u, int wr, int wc, int fr, int fq) const {
        const int pn = u.pn; const float sc = (pn < 2) ? C2 : 1.f;
        const int colb = pn * 256 + wc * 32 + 8 * fq;
#pragma unroll
        for (int ai = 0; ai < 2; ++ai)
#pragma unroll
            for (int m = 0; m < 4; ++m) {
                const int row = u.pm * 256 + ai * 128 + wr * 64 + m * 16 + fr;
#pragma unroll
                for (int bj = 0; bj < 2; ++bj) {
                    const int col = colb + bj * 128; const pg8::f32x4 v0 = acc[ai][bj][m][0], v1 = acc[ai][bj][m][1];
                    pg8::u32x4 w; w.x = pg8::cvt_pk_bf16(v0[0] * sc, v0[1] * sc); w.y = pg8::cvt_pk_bf16(v0[2] * sc, v0[3] * sc); w.z = pg8::cvt_pk_bf16(v1[0] * sc, v1[1] * sc); w.w = pg8::cvt_pk_bf16(v1[2] * sc, v1[3] * sc);
                    *(pg8::u32x4*)(PROJ + (size_t)row * NIN + col) = w;
                    float* dst = nullptr;
                    if (pn >= 2 && pn < 6) {
                        const bool isk = pn < 4; const int c = col - (isk ? PC_K : PC_V);
                        if (row < MP) { const int t = row & (SEQ - 1), b = row >> 12; if (t >= SEQ - WBUF) dst = out + (isk ? O_KP : O_VP) + ((size_t)(b * WBUF + t - (SEQ - WBUF))) * 512 + c; }
                        else dst = out + (isk ? O_KS : O_VS) + (size_t)(row - MP) * 512 + c;
                    } else if (pn >= 8) {
                        const int c = col - PC_X;
                        if (row < MP) { const int t = row & (SEQ - 1), b = row >> 12; if (t >= SEQ - 3) dst = out + O_CP + (size_t)(b * 3 + t - (SEQ - 3)) * 1024 + c; }
                        else { const int r = row - MP, t = r & 7, b = r >> 3; if (t >= TS - 3) dst = out + O_CS + (size_t)(b * 3 + t - (TS - 3)) * 1024 + c; }
                    }
                    if (dst) { *(pg8::f32x4*)dst = v0; *(pg8::f32x4*)(dst + 4) = v1; }
                }
            }
    }
};
struct EpiOut {
    static constexpr bool PERM = false, AFTER_DRAIN = false;
    const float* xp; const float* xs; float* H1; pg8::bf16_t* H1b; float* RS;
    __device__ __forceinline__ void operator()(const pg8::f32x4 (&acc)[2][2][4][2], const pg8::Unit& u, int wr, int wc, int fr, int fq) const {
        const int col0 = u.pn * 256 + wc * 32 + 4 * fq;
#pragma unroll
        for (int ai = 0; ai < 2; ++ai)
#pragma unroll
            for (int m = 0; m < 4; ++m) {
                const int row = u.pm * 256 + ai * 128 + wr * 64 + m * 16 + fr;
                const float* xrow = (row < MP) ? xp + (size_t)row * DM : xs + (size_t)(row - MP) * DM;
                float ss = 0.f;
#pragma unroll
                for (int bj = 0; bj < 2; ++bj)
#pragma unroll
                    for (int n = 0; n < 2; ++n) {
                        const int c = col0 + bj * 128 + n * 16;
                        const pg8::f32x4 h = *(const pg8::f32x4*)(xrow + c) + acc[ai][bj][m][n];
                        *(pg8::f32x4*)(H1 + (size_t)row * DM + c) = h;
                        u32x2 w; w.x = pg8::cvt_pk_bf16(h[0], h[1]); w.y = pg8::cvt_pk_bf16(h[2], h[3]);
                        *(u32x2*)(H1b + (size_t)row * DM + c) = w;
                        ss += (h[0] * h[0] + h[1] * h[1]) + (h[2] * h[2] + h[3] * h[3]);
                    }
                ss += __shfl_xor(ss, 16); ss += __shfl_xor(ss, 32);
                if (fq == 0) atomicAdd(RS + row, ss);
                asm volatile("" ::: "memory");
            }
    }
};
struct EpiUp {
    static constexpr bool PERM = true, AFTER_DRAIN = false;
    pg8::bf16_t* U; const float* RS; float* out;
    __device__ __forceinline__ void operator()(const pg8::f32x4 (&acc)[2][2][4][2], const pg8::Unit& u, int wr, int wc, int fr, int fq) const {
        const int colb = u.pn * 256 + wc * 32 + 8 * fq;
#pragma unroll
        for (int ai = 0; ai < 2; ++ai)
#pragma unroll
            for (int m = 0; m < 4; ++m) {
                const int row = u.pm * 256 + ai * 128 + wr * 64 + m * 16 + fr;
                const float rs = 1.0f / sqrtf(RS[row] * (1.f / DM) + EPS);
                float* dstb = nullptr;
                if (row < MP) { const int t = row & (SEQ - 1), b = row >> 12; if (t >= SEQ - 2) dstb = out + O_FP + (size_t)(b * 2 + t - (SEQ - 2)) * DFF2; }
                else { const int r = row - MP, t = r & 7, b = r >> 3; if (t >= TS - 2) dstb = out + O_FS + (size_t)(b * 2 + t - (TS - 2)) * DFF2; }
#pragma unroll
                for (int bj = 0; bj < 2; ++bj) {
                    const int col = colb + bj * 128; const pg8::f32x4 v0 = acc[ai][bj][m][0] * rs, v1 = acc[ai][bj][m][1] * rs;
                    pg8::u32x4 w; w.x = pg8::cvt_pk_bf16(v0[0], v0[1]); w.y = pg8::cvt_pk_bf16(v0[2], v0[3]); w.z = pg8::cvt_pk_bf16(v1[0], v1[1]); w.w = pg8::cvt_pk_bf16(v1[2], v1[3]);
                    *(pg8::u32x4*)(U + (size_t)row * DFF2 + col) = w;
                    if (dstb) { *(pg8::f32x4*)(dstb + col) = v0; *(pg8::f32x4*)(dstb + col + 4) = v1; }
                }
            }
    }
};
struct EpiDown {
    static constexpr bool PERM = false, AFTER_DRAIN = false;
    float* H1; pg8::bf16_t* H2b;
    __device__ __forceinline__ void operator()(const pg8::f32x4 (&acc)[2][2][4][2], const pg8::Unit& u, int wr, int wc, int fr, int fq) const {
        const int col0 = u.pn * 256 + wc * 32 + 4 * fq;
#pragma unroll
        for (int ai = 0; ai < 2; ++ai)
#pragma unroll
            for (int m = 0; m < 4; ++m) {
                const int row = u.pm * 256 + ai * 128 + wr * 64 + m * 16 + fr;
#pragma unroll
                for (int bj = 0; bj < 2; ++bj)
#pragma unroll
                    for (int n = 0; n < 2; ++n) {
                        const int c = col0 + bj * 128 + n * 16; float* hp = H1 + (size_t)row * DM + c;
                        const pg8::f32x4 h = *(const pg8::f32x4*)hp + acc[ai][bj][m][n];
                        *(pg8::f32x4*)hp = h;
                        u32x2 w; w.x = pg8::cvt_pk_bf16(h[0], h[1]); w.y = pg8::cvt_pk_bf16(h[2], h[3]);
                        *(u32x2*)(H2b + (size_t)row * DM + c) = w;
                    }
                asm volatile("" ::: "memory");
            }
    }
};
struct EpiPle {
    static constexpr bool PERM = false, AFTER_DRAIN = false;
    float* E; float* RS;
    __device__ __forceinline__ void operator()(const pg8::f32x4 (&acc)[2][2][4][2], const pg8::Unit& u, int wr, int wc, int fr, int fq) const {
        const int col0 = u.pn * 256 + wc * 32 + 4 * fq;
#pragma unroll
        for (int ai = 0; ai < 2; ++ai)
#pragma unroll
            for (int m = 0; m < 4; ++m) {
                const int row = u.pm * 256 + ai * 128 + wr * 64 + m * 16 + fr; float ss = 0.f;
#pragma unroll
                for (int bj = 0; bj < 2; ++bj)
#pragma unroll
                    for (int n = 0; n < 2; ++n) {
                        const int c = col0 + bj * 128 + n * 16; const pg8::f32x4 h = acc[ai][bj][m][n];
                        *(pg8::f32x4*)(E + (size_t)row * DM + c) = h;
                        ss += (h[0] * h[0] + h[1] * h[1]) + (h[2] * h[2] + h[3] * h[3]);
                    }
                ss += __shfl_xor(ss, 16); ss += __shfl_xor(ss, 32);
                if (fq == 0) atomicAdd(RS + row, ss);
            }
    }
};
struct EpiGate {
    static constexpr bool PERM = false, AFTER_DRAIN = false;
    const float* H2; const float* E; const float* RSE; const float* gple; float* out; float* RS3;
    __device__ __forceinline__ void operator()(const pg8::f32x4 (&acc)[2][2][4][2], const pg8::Unit& u, int wr, int wc, int fr, int fq) const {
        const int col0 = u.pn * 256 + wc * 32 + 4 * fq;
        pg8::f32x4 gp[2][2];
#pragma unroll
        for (int bj = 0; bj < 2; ++bj)
#pragma unroll
            for (int n = 0; n < 2; ++n) gp[bj][n] = *(const pg8::f32x4*)(gple + col0 + bj * 128 + n * 16);
#pragma unroll
        for (int ai = 0; ai < 2; ++ai)
#pragma unroll
            for (int m = 0; m < 4; ++m) {
                const int row = u.pm * 256 + ai * 128 + wr * 64 + m * 16 + fr;
                const float rse = 1.0f / sqrtf(RSE[row] * (1.f / DM) + EPS);
                float* orow = (row < MP) ? out + O_Y + (size_t)row * DM : out + O_YS + (size_t)(row - MP) * DM;
                float ss = 0.f;
#pragma unroll
                for (int bj = 0; bj < 2; ++bj)
#pragma unroll
                    for (int n = 0; n < 2; ++n) {
                        const int c = col0 + bj * 128 + n * 16;
                        const pg8::f32x4 a = acc[ai][bj][m][n], e = *(const pg8::f32x4*)(E + (size_t)row * DM + c), h2 = *(const pg8::f32x4*)(H2 + (size_t)row * DM + c);
                        pg8::f32x4 h;
#pragma unroll
                        for (int k = 0; k < 4; ++k) { const float g = 1.f / (1.f + __expf(-a[k])); h[k] = h2[k] + g * (e[k] * rse * gp[bj][n][k]); }
                        *(pg8::f32x4*)(orow + c) = h;
                        ss += (h[0] * h[0] + h[1] * h[1]) + (h[2] * h[2] + h[3] * h[3]);
                    }
                ss += __shfl_xor(ss, 16); ss += __shfl_xor(ss, 32);
                if (fq == 0) atomicAdd(RS3 + row, ss);
                asm volatile("" ::: "memory");
            }
    }
};

__device__ __forceinline__ void p0_transpose_item(const float* W, int ldn, int K, int N, bf16* WT, const float* gk, LAS float* scr, int item, int lane) {
    const int nblk = N / 32, kb = item / nblk, nb = item % nblk, k0 = 64 * kb, n0 = 32 * nb;
#pragma unroll 8
    for (int i = 0; i < 32; ++i) { const int kk = 2 * i + (lane >> 5); float w = W[(size_t)(k0 + kk) * ldn + n0 + (lane & 31)]; if (gk) w *= gk[k0 + kk]; scr[kk * 33 + (lane & 31)] = w; }
    LDS_WAIT(); asm volatile("" ::: "memory");
    const int c = lane & 7;
#pragma unroll
    for (int j = 0; j < 4; ++j) { const int n = (lane >> 3) + 8 * j; const LAS float* s = scr + (8 * c) * 33 + n;
        v4u o; o.x = pk2(s[0 * 33], s[1 * 33]); o.y = pk2(s[2 * 33], s[3 * 33]); o.z = pk2(s[4 * 33], s[5 * 33]); o.w = pk2(s[6 * 33], s[7 * 33]);
        *(GAS v4u*)(WT + (size_t)(n0 + n) * K + k0 + 8 * c) = o; }
    LDS_WAIT(); asm volatile("" ::: "memory");
}
__device__ __forceinline__ void p0_prologue(const Args& a, LAS unsigned char* lds, int gw, int NGW, int wave, int lane) {
    unsigned char* ws = a.ws;
    LAS float* scr = (LAS float*)(lds + wave * 16384);
    constexpr int I_IN = (DM / 64) * (NIN / 32), I_OUT = (DM / 64) * (DM / 32), I_UP = (DM / 64) * (DFF2 / 32), I_DN = (DFF / 64) * (DM / 32), I_PLE = (DPLE / 64) * (DM / 32), I_G = I_OUT;
    constexpr int NITEMS = I_IN + I_OUT + I_UP + I_DN + I_PLE + I_G;
    for (int it = gw; it < NITEMS; it += NGW) {
        int r = it;
        if (r < I_IN)  { p0_transpose_item(a.in[11], IN_LD, DM, NIN, (bf16*)(ws + WS_WIN), a.in[10], scr, r, lane); continue; } r -= I_IN;
        if (r < I_OUT) { p0_transpose_item(a.in[18], DM, DM, DM, (bf16*)(ws + WS_WOUT), nullptr, scr, r, lane); continue; } r -= I_OUT;
        if (r < I_UP)  { p0_transpose_item(a.in[20], DFF2, DM, DFF2, (bf16*)(ws + WS_WUP), a.in[19], scr, r, lane); continue; } r -= I_UP;
        if (r < I_DN)  { p0_transpose_item(a.in[23], DM, DFF, DM, (bf16*)(ws + WS_WDOWN), nullptr, scr, r, lane); continue; } r -= I_DN;
        if (r < I_PLE) { p0_transpose_item(a.in[24], DM, DPLE, DM, (bf16*)(ws + WS_WPLE), nullptr, scr, r, lane); continue; } r -= I_PLE;
        p0_transpose_item(a.in[26], DM, DM, DM, (bf16*)(ws + WS_WGATE), nullptr, scr, r, lane);
    }
    const float* gmix = a.in[10]; const float* win = a.in[11]; const float* dtb = a.in[14];
    bf16* XN = (bf16*)(ws + WS_XN); bf16* PB = (bf16*)(ws + WS_PB); float* DT = (float*)(ws + WS_DT);
    for (int m = gw; m < MT; m += NGW) {
        const float* xrow = (m < MP) ? a.in[0] + (size_t)m * DM : a.in[1] + (size_t)(m - MP) * DM;
        const GAS f32x4* xr = (const GAS f32x4*)xrow + lane;
        f32x4 v[4]; float s = 0.f;
#pragma unroll
        for (int j = 0; j < 4; ++j) { v[j] = xr[64 * j]; s += (v[j].x * v[j].x + v[j].y * v[j].y) + (v[j].z * v[j].z + v[j].w * v[j].w); }
        const float rstd = 1.0f / sqrtf(wave_sum(s) * (1.f / DM) + EPS);
        GAS unsigned long long* o8 = (GAS unsigned long long*)(XN + (size_t)m * DM) + lane;
        float dacc[8];
#pragma unroll
        for (int h = 0; h < 8; ++h) dacc[h] = 0.f;
#pragma unroll
        for (int j = 0; j < 4; ++j) {
            v[j] = v[j] * rstd;
            o8[64 * j] = (unsigned long long)pk2(v[j].x, v[j].y) | ((unsigned long long)pk2(v[j].z, v[j].w) << 32);
#pragma unroll
            for (int e = 0; e < 4; ++e) {
                const int k = 256 * j + 4 * lane + e; const float xv = v[j][e] * gmix[k];
                const f32x4 w0 = *(const f32x4*)(win + (size_t)k * IN_LD + NIN), w1 = *(const f32x4*)(win + (size_t)k * IN_LD + NIN + 4);
                dacc[0] += xv * w0.x; dacc[1] += xv * w0.y; dacc[2] += xv * w0.z; dacc[3] += xv * w0.w;
                dacc[4] += xv * w1.x; dacc[5] += xv * w1.y; dacc[6] += xv * w1.z; dacc[7] += xv * w1.w;
            }
        }
#pragma unroll
        for (int h = 0; h < 8; ++h) dacc[h] = softplusf(wave_sum(dacc[h]) + dtb[h]);
        if (lane == 0) { *(f32x4*)(DT + (size_t)m * 8) = (f32x4){dacc[0], dacc[1], dacc[2], dacc[3]}; *(f32x4*)(DT + (size_t)m * 8 + 4) = (f32x4){dacc[4], dacc[5], dacc[6], dacc[7]}; }
        const float* prow = (m < MP) ? a.in[2] + (size_t)m * DPLE : a.in[3] + (size_t)(m - MP) * DPLE;
        const f32x4 pv = *((const f32x4*)prow + lane);
        *((GAS unsigned long long*)(PB + (size_t)m * DPLE) + lane) = (unsigned long long)pk2(pv.x, pv.y) | ((unsigned long long)pk2(pv.z, pv.w) << 32);
    }
}

__device__ __forceinline__ void load8bf(const bf16* p, float (&o)[8]) {
    const v4u w = *(const v4u*)p;
    o[0] = bflo(w.x); o[1] = bfhi(w.x); o[2] = bflo(w.y); o[3] = bfhi(w.y); o[4] = bflo(w.z); o[5] = bfhi(w.z); o[6] = bflo(w.w); o[7] = bfhi(w.w);
}
__device__ __forceinline__ void load8f(const float* p, float (&o)[8]) {
    const f32x4 a = *(const f32x4*)p, b = *(const f32x4*)(p + 4);
    o[0] = a.x; o[1] = a.y; o[2] = a.z; o[3] = a.w; o[4] = b.x; o[5] = b.y; o[6] = b.z; o[7] = b.w;
}
__device__ __forceinline__ void conv_xbc_pass(const Args& a, int gtid, int NT) {
    const bf16* PROJ = (const bf16*)(a.ws + WS_PROJ); float* XB = (float*)(a.ws + WS_XBCC);
    const float* cw = a.in[12]; const float* cb = a.in[13]; const float* sconv = a.in[7];
    for (int it = gtid; it < (MT / 8) * 128; it += NT) {
        const int rb = it >> 7, c = (it & 127) * 8, m0 = rb * 8;
        float w0[8], w1[8], w2[8], w3[8], bb[8], x3[8], x2[8], x1[8];
        load8f(cw + c, w0); load8f(cw + 1024 + c, w1); load8f(cw + 2048 + c, w2); load8f(cw + 3072 + c, w3); load8f(cb + c, bb);
        if (m0 < MP) {
            if ((m0 & (SEQ - 1)) == 0) {
#pragma unroll
                for (int k = 0; k < 8; ++k) { x3[k] = 0.f; x2[k] = 0.f; x1[k] = 0.f; }
            } else { load8bf(PROJ + (size_t)(m0 - 3) * NIN + PC_X + c, x3); load8bf(PROJ + (size_t)(m0 - 2) * NIN + PC_X + c, x2); load8bf(PROJ + (size_t)(m0 - 1) * NIN + PC_X + c, x1); }
        } else { const int b = (m0 - MP) >> 3; load8f(sconv + (size_t)(b * 3 + 0) * 1024 + c, x3); load8f(sconv + (size_t)(b * 3 + 1) * 1024 + c, x2); load8f(sconv + (size_t)(b * 3 + 2) * 1024 + c, x1); }
#pragma unroll
        for (int r = 0; r < 8; ++r) {
            float cur[8], y[8]; load8bf(PROJ + (size_t)(m0 + r) * NIN + PC_X + c, cur);
#pragma unroll
            for (int k = 0; k < 8; ++k) { y[k] = siluf(bb[k] + w0[k] * x3[k] + w1[k] * x2[k] + w2[k] * x1[k] + w3[k] * cur[k]); x3[k] = x2[k]; x2[k] = x1[k]; x1[k] = cur[k]; }
            float* o = XB + (size_t)(m0 + r) * 1024 + c;
            *(f32x4*)o = (f32x4){y[0], y[1], y[2], y[3]}; *(f32x4*)(o + 4) = (f32x4){y[4], y[5], y[6], y[7]};
        }
    }
}

constexpr int ATT_WAVE_BYTES = 8704, ATT_VB = 0, ATT_STG = 4096, ATT_WSF = 8192, ATT_BTAB_OFF = 8 * ATT_WAVE_BYTES  , ATT_BT_LD = 132;
__device__ __forceinline__ v4i16_t vtr(const LAS unsigned char* p) { return __builtin_amdgcn_ds_read_tr16_b64_v4i16((LAS v4i16_t*)p); }
__device__ __forceinline__ unsigned cvtpk_s(float lo, float hi) { typedef float f2 __attribute__((ext_vector_type(2))); typedef __bf16 b2 __attribute__((ext_vector_type(2))); f2 v = {lo, hi}; b2 b = __builtin_convertvector(v, b2); return __builtin_bit_cast(unsigned, b); }

__device__ __forceinline__ void attn_build_btab(const Args& a, LAS unsigned char* lds, int tid) {
    LAS float* bt = (LAS float*)(lds + ATT_BTAB_OFF); const float* rb = a.in[9];
    for (int i = tid; i < 3 * 8 * 129; i += NWAVES * 64) { const int br = i / (8 * 129), rem = i % (8 * 129), h = rem / 129, j = rem % 129; bt[(br * 8 + h) * ATT_BT_LD + j] = rb[BUCKET_TAB[br][j] * 8 + h] * LOG2E; }
}
__device__ __forceinline__ void attn_prompt_unit(const Args& a, LAS unsigned char* lds, int unit, int wave, int lane) {
    const bf16* PROJ = (const bf16*)(a.ws + WS_PROJ);
    const int r32 = lane & 31, hi = lane >> 5;
    const int rq = unit & 127, bhb = unit >> 7, br = bhb % 3, bh = bhb / 3, h = bh & 7, b = bh >> 3;
    const int sh = 2 * br, dil = 1 << sh, nqb = 128 >> sh, r = rq / nqb, qb = rq % nqb, l0 = qb * 32;
    const size_t rowb = (size_t)b * SEQ;
    LAS unsigned char* wl = lds + wave * ATT_WAVE_BYTES;
    const LAS float* bt = (const LAS float*)(lds + ATT_BTAB_OFF) + (br * 8 + h) * ATT_BT_LD;
    bf16x8 qr[4];
    { const bf16* qp = PROJ + (rowb + (size_t)(l0 + r32) * dil + r) * NIN + h * 64 + hi * 8;
#pragma unroll
      for (int d0 = 0; d0 < 4; ++d0) qr[d0] = *(const bf16x8*)(qp + d0 * 16); }
    const int kb0 = (l0 >= 128) ? 0 : (4 - (l0 >> 5));
    f32x16 s[5];
#pragma unroll
    for (int kb = 0; kb < 5; ++kb) {
#pragma unroll
        for (int i = 0; i < 16; ++i) s[kb][i] = 0.f;
        if (kb >= kb0) {
            int kk = l0 - 128 + 32 * kb + r32; kk = kk < 0 ? 0 : kk;
            const bf16* kp = PROJ + (rowb + (size_t)kk * dil + r) * NIN + PC_K + h * 64 + hi * 8;
            bf16x8 kf[4];
#pragma unroll
            for (int d0 = 0; d0 < 4; ++d0) kf[d0] = *(const bf16x8*)(kp + d0 * 16);
#pragma unroll
            for (int d0 = 0; d0 < 4; ++d0) s[kb] = __builtin_amdgcn_mfma_f32_32x32x16_bf16(kf[d0], qr[d0], s[kb], 0, 0, 0);
        }
    }
    float mx = -INFINITY;
#pragma unroll
    for (int kb = 0; kb < 5; ++kb)
#pragma unroll
        for (int i = 0; i < 16; ++i) {
            const int c = crow(i, hi), j = r32 - c + 128 - 32 * kb, kk = l0 - 128 + 32 * kb + c;
            const bool valid = (j >= 0) && (j <= 128) && (kk >= 0) && (kb >= kb0);
            const int jc = j < 0 ? 0 : (j > 128 ? 128 : j);
            const float v = valid ? s[kb][i] + bt[jc] : -INFINITY;
            s[kb][i] = v; mx = fmaxf(mx, v);
        }
    mx = fmaxf(mx, __shfl_xor(mx, 32));
    float l = 0.f;
#pragma unroll
    for (int kb = 0; kb < 5; ++kb)
#pragma unroll
        for (int i = 0; i < 16; ++i) { const float p = __builtin_amdgcn_exp2f(s[kb][i] - mx); s[kb][i] = p; l += p; }
    l += __shfl_xor(l, 32);
    f32x16 o[2];
#pragma unroll
    for (int i = 0; i < 16; ++i) { o[0][i] = 0.f; o[1][i] = 0.f; }
    const LAS unsigned char* vrd = wl + ATT_VB + ((lane >> 4) & 1) * 32 + (lane & 3) * 8 + (4 * hi + ((lane & 15) >> 2)) * 64;
#pragma unroll
    for (int kb = 0; kb < 5; ++kb) {
        if (kb >= kb0) {
#pragma unroll
            for (int i = 0; i < 4; ++i) {
                const int idx = i * 64 + lane, key = idx >> 3, ch = idx & 7;
                int kk = l0 - 128 + 32 * kb + key; kk = kk < 0 ? 0 : kk;
                const v4u vv = *(const v4u*)(PROJ + (rowb + (size_t)kk * dil + r) * NIN + PC_V + h * 64 + ch * 8);
                *(LAS v4u*)(wl + ATT_VB + (ch >> 2) * 2048 + (key >> 4) * 1024 + (key & 15) * 64 + (ch & 3) * 16) = vv;
            }
            LDS_WAIT();
#pragma unroll
            for (int ks = 0; ks < 2; ++ks) {
                v4u pw;
                pw.x = cvtpk_s(s[kb][8 * ks + 0], s[kb][8 * ks + 1]); pw.y = cvtpk_s(s[kb][8 * ks + 2], s[kb][8 * ks + 3]);
                pw.z = cvtpk_s(s[kb][8 * ks + 4], s[kb][8 * ks + 5]); pw.w = cvtpk_s(s[kb][8 * ks + 6], s[kb][8 * ks + 7]);
                const bf16x8 pa = __builtin_bit_cast(bf16x8, pw);
#pragma unroll
                for (int d0 = 0; d0 < 2; ++d0) {
                    const v4i16_t lo = vtr(vrd + d0 * 2048 + ks * 1024), hh = vtr(vrd + d0 * 2048 + ks * 1024 + 512);
                    const bf16x8 vb = (bf16x8){lo[0], lo[1], lo[2], lo[3], hh[0], hh[1], hh[2], hh[3]};
                    o[d0] = __builtin_amdgcn_mfma_f32_32x32x16_bf16(pa, vb, o[d0], 0, 0, 0);
                }
            }
            LDS_WAIT();
        }
    }
    LAS float* wsf = (LAS float*)(wl + ATT_WSF);
    if (hi == 0) wsf[r32] = l;
    LDS_WAIT();
    LAS bf16* stg = (LAS bf16*)(wl + ATT_STG);
#pragma unroll
    for (int i = 0; i < 16; ++i) {
        const int orow = crow(i, hi); const float rl = 1.0f / wsf[orow];
        stg[orow * 64 + r32] = (bf16)f2bf(o[0][i] * rl); stg[orow * 64 + 32 + r32] = (bf16)f2bf(o[1][i] * rl);
    }
    LDS_WAIT();
    bf16* OBR = (bf16*)(a.ws + WS_OBR) + (size_t)br * MP * 512;
#pragma unroll
    for (int i = 0; i < 4; ++i) {
        const int row = i * 8 + (lane >> 3), ch = lane & 7;
        const v4u v = *(const LAS v4u*)(stg + row * 64 + ch * 8);
        *(v4u*)(OBR + (rowb + (size_t)(l0 + row) * dil + r) * 512 + h * 64 + ch * 8) = v;
    }
    if (hi == 0) { float* LSE = (float*)(a.ws + WS_LSE) + (size_t)br * MP * 8; LSE[(rowb + (size_t)(l0 + r32) * dil + r) * 8 + h] = mx + __builtin_amdgcn_logf(l); }
    LDS_WAIT();
}

__device__ __forceinline__ void attn_sample_task(const Args& a, LAS unsigned char* lds, int task, int wave, int lane) {
    const int h = task & 7, t = (task >> 3) & 7, b = task >> 6;
    const bf16* PROJ = (const bf16*)(a.ws + WS_PROJ);
    const float* ck = a.in[4]; const float* cv = a.in[5]; const float* kn = a.out + O_KS; const float* vn = a.out + O_VS;
    LAS float* pl = (LAS float*)(lds + wave * ATT_WAVE_BYTES + ATT_STG);
    float q[64];
    { const bf16* qp = PROJ + (size_t)(MP + b * 8 + t) * NIN + h * 64;
#pragma unroll
      for (int i = 0; i < 8; ++i) { float tmp[8]; load8bf(qp + i * 8, tmp);
#pragma unroll
          for (int k = 0; k < 8; ++k) q[i * 8 + k] = tmp[k]; } }
    float mx = -INFINITY;
#pragma unroll 1
    for (int br = 0; br < 3; ++br) {
        const int dil = 1 << (2 * br);
        const LAS float* bt = (const LAS float*)(lds + ATT_BTAB_OFF) + (br * 8 + h) * ATT_BT_LD;
#pragma unroll 1
        for (int jj = 0; jj < 3; ++jj) {
            const int j = jj * 64 + lane;
            if (j <= 128) {
                const int idx = WBUF + t - j * dil;
                const float* kp = (idx < WBUF) ? ck + ((size_t)(b * WBUF + idx) * 8 + h) * 64 : kn + ((size_t)(b * 8 + (idx - WBUF)) * 8 + h) * 64;
                float d = 0.f;
#pragma unroll
                for (int i = 0; i < 16; ++i) { const f32x4 kv = *(const f32x4*)(kp + i * 4); d += q[4 * i] * kv.x + q[4 * i + 1] * kv.y + q[4 * i + 2] * kv.z + q[4 * i + 3] * kv.w; }
                const float v = d + bt[j];
                pl[br * ATT_BT_LD + j] = v; mx = fmaxf(mx, v);
            }
        }
    }
    mx = wave_max(mx);
    LDS_WAIT(); asm volatile("" ::: "memory");
    float l = 0.f;
#pragma unroll 1
    for (int i = lane; i < 3 * ATT_BT_LD; i += 64) { const int j = i % ATT_BT_LD; if (j <= 128) { const float p = __builtin_amdgcn_exp2f(pl[i] - mx); pl[i] = p; l += p; } }
    l = wave_sum(l);
    LDS_WAIT(); asm volatile("" ::: "memory");
    float o = 0.f;
#pragma unroll
    for (int br = 0; br < 3; ++br) {
        const int dil = 1 << (2 * br);
#pragma unroll 4
        for (int j = 0; j <= 128; ++j) {
            const int idx = WBUF + t - j * dil;
            const float* vp = (idx < WBUF) ? cv + ((size_t)(b * WBUF + idx) * 8 + h) * 64 : vn + ((size_t)(b * 8 + (idx - WBUF)) * 8 + h) * 64;
            o += pl[br * ATT_BT_LD + j] * vp[lane];
        }
    }
    bf16* MIX = (bf16*)(a.ws + WS_MIX);
    MIX[(size_t)(MP + b * 8 + t) * DM + h * 64 + lane] = (bf16)f2bf(o / l);
    LDS_WAIT(); asm volatile("" ::: "memory");
}

__device__ __forceinline__ void ssd_task(const Args& a, int task, int lane) {
    const float* XB = (const float*)(a.ws + WS_XBCC); const float* DT = (const float*)(a.ws + WS_DT); float* YS = (float*)(a.ws + WS_YS);
    int b, h, p, T, row0; float s0, s1; float* sout;
    if (task < NBP * 512) { b = task >> 9; h = (task >> 6) & 7; p = task & 63; T = SEQ; row0 = b * SEQ; s0 = 0.f; s1 = 0.f; sout = a.out + O_SP + ((size_t)((b * 8 + h) * 64 + p)) * 128; }
    else { const int k = task - NBP * 512; b = k >> 9; h = (k >> 6) & 7; p = k & 63; T = TS; row0 = MP + b * TS; const float* si = a.in[6] + ((size_t)((b * 8 + h) * 64 + p)) * 128; s0 = si[lane]; s1 = si[lane + 64]; sout = a.out + O_SS + ((size_t)((b * 8 + h) * 64 + p)) * 128; }
    const int g = h >> 2; const float A = -__expf(a.in[15][h]);
    for (int t = 0; t < T; t += 4) {
        float dtv[4], xv[4], B0[4], B1[4], C0[4], C1[4];
#pragma unroll
        for (int k = 0; k < 4; ++k) { const size_t m = (size_t)(row0 + t + k); dtv[k] = DT[m * 8 + h]; const float* xr = XB + m * 1024; xv[k] = xr[h * 64 + p]; B0[k] = xr[512 + g * 128 + lane]; B1[k] = xr[512 + g * 128 + 64 + lane]; C0[k] = xr[768 + g * 128 + lane]; C1[k] = xr[768 + g * 128 + 64 + lane]; }
        float y[4];
#pragma unroll
        for (int k = 0; k < 4; ++k) { const float da = __expf(dtv[k] * A), xd = dtv[k] * xv[k]; s0 = da * s0 + xd * B0[k]; s1 = da * s1 + xd * B1[k]; y[k] = C0[k] * s0 + C1[k] * s1; }
#pragma unroll
        for (int k = 0; k < 4; ++k) y[k] = wave_sum(y[k]);
        if (lane == 0) {
#pragma unroll
            for (int k = 0; k < 4; ++k) YS[(size_t)(row0 + t + k) * 512 + h * 64 + p] = y[k];
        }
    }
    sout[lane] = s0; sout[lane + 64] = s1;
}
__device__ __forceinline__ void attn_combine_pass(const Args& a, int gtid, int NT) {
    const bf16* OBR = (const bf16*)(a.ws + WS_OBR); const float* LSE = (const float*)(a.ws + WS_LSE); bf16* MIX = (bf16*)(a.ws + WS_MIX);
    for (int it = gtid; it < MP * 64; it += NT) {
        const int row = it >> 6, c8 = it & 63, h = c8 >> 3;
        const float l0 = LSE[(size_t)row * 8 + h], l1 = LSE[(size_t)(MP + row) * 8 + h], l2 = LSE[(size_t)(2 * MP + row) * 8 + h];
        const float mx = fmaxf(l0, fmaxf(l1, l2));
        float w0 = __builtin_amdgcn_exp2f(l0 - mx), w1 = __builtin_amdgcn_exp2f(l1 - mx), w2 = __builtin_amdgcn_exp2f(l2 - mx);
        const float inv = 1.f / (w0 + w1 + w2); w0 *= inv; w1 *= inv; w2 *= inv;
        float o0[8], o1[8], o2[8];
        load8bf(OBR + (size_t)row * 512 + c8 * 8, o0); load8bf(OBR + ((size_t)MP + row) * 512 + c8 * 8, o1); load8bf(OBR + ((size_t)2 * MP + row) * 512 + c8 * 8, o2);
        float r[8];
#pragma unroll
        for (int k = 0; k < 8; ++k) r[k] = w0 * o0[k] + w1 * o1[k] + w2 * o2[k];
        v4u w; w.x = pk2(r[0], r[1]); w.y = pk2(r[2], r[3]); w.z = pk2(r[4], r[5]); w.w = pk2(r[6], r[7]);
        *(v4u*)(MIX + (size_t)row * DM + c8 * 8) = w;
    }
}
__device__ __forceinline__ void ssd_finish_pass(const Args& a, int gw, int NGW, int lane) {
    const float* XB = (const float*)(a.ws + WS_XBCC); const float* YS = (const float*)(a.ws + WS_YS); const bf16* PROJ = (const bf16*)(a.ws + WS_PROJ); bf16* MIX = (bf16*)(a.ws + WS_MIX);
    const float* dsk = a.in[16]; const float* gs = a.in[17];
    const int c = lane * 8; const float dh = dsk[c >> 6];
    float g8[8]; load8f(gs + c, g8);
    for (int m = gw; m < MT; m += NGW) {
        float y[8], x[8], z[8], v[8]; load8f(YS + (size_t)m * 512 + c, y); load8f(XB + (size_t)m * 1024 + c, x); load8bf(PROJ + (size_t)m * NIN + PC_Z + c, z);
        float ss = 0.f;
#pragma unroll
        for (int k = 0; k < 8; ++k) { v[k] = (y[k] + dh * x[k]) * siluf(z[k]); ss += v[k] * v[k]; }
#pragma unroll
        for (int o = 1; o < 32; o <<= 1) ss += __shfl_xor(ss, o);
        const float rs = 1.0f / sqrtf(ss * (1.f / 256.f) + EPS);
        v4u w; w.x = pk2(v[0] * rs * g8[0], v[1] * rs * g8[1]); w.y = pk2(v[2] * rs * g8[2], v[3] * rs * g8[3]); w.z = pk2(v[4] * rs * g8[4], v[5] * rs * g8[5]); w.w = pk2(v[6] * rs * g8[6], v[7] * rs * g8[7]);
        *(v4u*)(MIX + (size_t)m * DM + 512 + c) = w;
    }
}
__device__ __forceinline__ void ffn_conv_pass(const Args& a, int gtid, int NT) {
    const bf16* U = (const bf16*)(a.ws + WS_U); bf16* ACT = (bf16*)(a.ws + WS_ACT);
    const float* fw = a.in[21]; const float* fb = a.in[22]; const float* sf = a.in[8];
    constexpr int NC8 = DFF / 8, NPB = MP / 16, NITEMS = (NPB + NBS) * NC8;
    for (int it = gtid; it < NITEMS; it += NT) {
        const int blk = it / NC8, c = (it % NC8) * 8;
        float wa0[8], wa1[8], wa2[8], wb0[8], wb1[8], wb2[8], ba[8], bb[8], a2[8], a1[8], b2[8], b1[8];
        load8f(fw + c, wa0); load8f(fw + DFF2 + c, wa1); load8f(fw + 2 * DFF2 + c, wa2); load8f(fb + c, ba);
        load8f(fw + DFF + c, wb0); load8f(fw + DFF2 + DFF + c, wb1); load8f(fw + 2 * DFF2 + DFF + c, wb2); load8f(fb + DFF + c, bb);
        int m0, nr;
        if (blk < NPB) { m0 = blk * 16; nr = 16;
            if ((m0 & (SEQ - 1)) == 0) {
#pragma unroll
                for (int k = 0; k < 8; ++k) { a2[k] = 0.f; a1[k] = 0.f; b2[k] = 0.f; b1[k] = 0.f; }
            } else { load8bf(U + (size_t)(m0 - 2) * DFF2 + c, a2); load8bf(U + (size_t)(m0 - 1) * DFF2 + c, a1); load8bf(U + (size_t)(m0 - 2) * DFF2 + DFF + c, b2); load8bf(U + (size_t)(m0 - 1) * DFF2 + DFF + c, b1); }
        } else { const int b = blk - NPB; m0 = MP + b * 8; nr = 8;
            load8f(sf + (size_t)(b * 2) * DFF2 + c, a2); load8f(sf + (size_t)(b * 2 + 1) * DFF2 + c, a1); load8f(sf + (size_t)(b * 2) * DFF2 + DFF + c, b2); load8f(sf + (size_t)(b * 2 + 1) * DFF2 + DFF + c, b1); }
        for (int r = 0; r < nr; ++r) {
            float ua[8], ub[8], o[8]; load8bf(U + (size_t)(m0 + r) * DFF2 + c, ua); load8bf(U + (size_t)(m0 + r) * DFF2 + DFF + c, ub);
#pragma unroll
            for (int k = 0; k < 8; ++k) {
                const float ya = ba[k] + wa0[k] * a2[k] + wa1[k] * a1[k] + wa2[k] * ua[k], yb = bb[k] + wb0[k] * b2[k] + wb1[k] * b1[k] + wb2[k] * ub[k];
                o[k] = siluf(ya) * yb; a2[k] = a1[k]; a1[k] = ua[k]; b2[k] = b1[k]; b1[k] = ub[k];
            }
            v4u w; w.x = pk2(o[0], o[1]); w.y = pk2(o[2], o[3]); w.z = pk2(o[4], o[5]); w.w = pk2(o[6], o[7]);
            *(v4u*)(ACT + (size_t)(m0 + r) * DFF + c) = w;
        }
    }
}
__device__ __forceinline__ void final_norm_pass(const Args& a, int gw, int NGW, int lane) {
    const float* RS3 = (const float*)(a.ws + WS_RS3); const float* gf = a.in[27];
    f32x4 g[4];
#pragma unroll
    for (int j = 0; j < 4; ++j) g[j] = *((const f32x4*)gf + lane + 64 * j);
    for (int m = gw; m < MT; m += NGW) {
        float* orow = (m < MP) ? a.out + O_Y + (size_t)m * DM : a.out + O_YS + (size_t)(m - MP) * DM;
        const float rs = 1.0f / sqrtf(RS3[m] * (1.f / DM) + EPS);
#pragma unroll
        for (int j = 0; j < 4; ++j) { f32x4* p = (f32x4*)orow + lane + 64 * j; *p = (*p) * rs * g[j]; }
    }
}

constexpr int NPH = 11;
#ifndef MK_N_LAUNCHES
#define MK_N_LAUNCHES 1
#endif
constexpr int N_LAUNCHES = MK_N_LAUNCHES;
__global__ void __launch_bounds__(NWAVES * 64, 2) mk_fwd(Args args) {
    extern __shared__ __attribute__((aligned(16))) unsigned char lds_raw[];
    LAS unsigned char* lds = (LAS unsigned char*)lds_raw;
    volatile LAS unsigned* MISC = (volatile LAS unsigned*)(lds + MISC_OFF);
    const int tid = threadIdx.x, lane = tid & 63, wave = __builtin_amdgcn_readfirstlane(tid >> 6);
    const int G = gridDim.x, bx = blockIdx.x, vcu = (G % 8 == 0) ? (bx % 8) * (G / 8) + bx / 8 : bx;
    const int gw = vcu * NWAVES + wave, NGW = G * NWAVES, gtid = vcu * (NWAVES * 64) + tid, NT = G * NWAVES * 64;
    unsigned char* ws = args.ws;
    gu32* ctl = (gu32*)(ws + WS_CTL);
    for (int u = tid; u < (LDS_BYTES - LDSCTL_OFF) / 4; u += NWAVES * 64) ((LAS unsigned*)(lds + LDSCTL_OFF))[u] = 0u;
    __syncthreads();
    XcdBarrier bar; bar.bar = (unsigned*)(ctl + CW_BAR); bar.x = 0; bar.st = nullptr;
    if (N_LAUNCHES == 1) bar = xcd_barrier_post((unsigned*)(ctl + CW_BAR), MISC + 8);
    const int lo = args.ph_lo, hi = args.ph_hi;
#ifndef PHMASK
#define PHMASK 0x7ff
#endif
#define IN(k) (((PHMASK >> (k)) & 1) && lo <= (k) && (k) < hi)
#define SEAM(k) do { if (IN(k) && IN((k) + 1)) xcd_barrier(bar); } while (0)

    if (IN(0)) { p0_prologue(args, lds, gw, NGW, wave, lane); VM_WAIT(); __syncthreads(); }
    SEAM(0);
    if (IN(1)) {
        pg8::Gemm g{(const pg8::bf16_t*)(ws + WS_XN), (const pg8::bf16_t*)(ws + WS_WIN), MT, NIN, DM}; pg8::StaticOrder S; S.init(MT, NIN, G, bx);
        EpiIn E{(pg8::bf16_t*)(ws + WS_PROJ), args.out};
        pg8::gemm_phase<EpiIn, pg8::StaticOrder, PG8_ALIGN, PG8_SP2>(lds, g, S, E);
    }
    SEAM(1);
    if (IN(2)) {
        attn_build_btab(args, lds, tid);
        __syncthreads();
#ifndef P2SUB
#define P2SUB 7
#endif
        if (P2SUB & 1) conv_xbc_pass(args, gtid, NT);
        if (P2SUB & 2) for (int task = gw; task < NBS * TS * NH; task += NGW) attn_sample_task(args, lds, task, wave, lane);
        if (P2SUB & 4) for (int unit = gw; unit < NBP * NH * 3 * 128; unit += NGW) attn_prompt_unit(args, lds, unit, wave, lane);
        VM_WAIT(); __syncthreads();
    }
    SEAM(2);
    if (IN(3)) {
        for (int task = gw; task < NBP * 512 + NBS * 512; task += NGW) ssd_task(args, task, lane);
        attn_combine_pass(args, gtid, NT);
        VM_WAIT(); __syncthreads();
    }
    SEAM(3);
    if (IN(4)) { ssd_finish_pass(args, gw, NGW, lane); VM_WAIT(); __syncthreads(); }
    SEAM(4);
    if (IN(5)) {
        { pg8::Gemm g{(const pg8::bf16_t*)(ws + WS_MIX), (const pg8::bf16_t*)(ws + WS_WOUT), MT, DM, DM}; pg8::StaticOrder S; S.init(MT, DM, G, bx);
          EpiOut E{args.in[0], args.in[1], (float*)(ws + WS_H1), (pg8::bf16_t*)(ws + WS_XN), (float*)(ws + WS_RS1)};
          pg8::gemm_phase<EpiOut, pg8::StaticOrder, PG8_ALIGN, PG8_SP2>(lds, g, S, E); }
        { pg8::Gemm g{(const pg8::bf16_t*)(ws + WS_PB), (const pg8::bf16_t*)(ws + WS_WPLE), MT, DM, DPLE}; pg8::StaticOrder S; S.init(MT, DM, G, bx);
          EpiPle E{(float*)(ws + WS_E), (float*)(ws + WS_RSE)};
          pg8::gemm_phase<EpiPle, pg8::StaticOrder, PG8_ALIGN, PG8_SP2>(lds, g, S, E); }
    }
    SEAM(5);
    if (IN(6)) {
        pg8::Gemm g{(const pg8::bf16_t*)(ws + WS_XN), (const pg8::bf16_t*)(ws + WS_WUP), MT, DFF2, DM}; pg8::StaticOrder S; S.init(MT, DFF2, G, bx);
        EpiUp E{(pg8::bf16_t*)(ws + WS_U), (const float*)(ws + WS_RS1), args.out};
        pg8::gemm_phase<EpiUp, pg8::StaticOrder, PG8_ALIGN, PG8_SP2>(lds, g, S, E);
    }
    SEAM(6);
    if (IN(7)) { ffn_conv_pass(args, gtid, NT); VM_WAIT(); __syncthreads(); }
    SEAM(7);
    if (IN(8)) {
        pg8::Gemm g{(const pg8::bf16_t*)(ws + WS_ACT), (const pg8::bf16_t*)(ws + WS_WDOWN), MT, DM, DFF}; pg8::StaticOrder S; S.init(MT, DM, G, bx);
        EpiDown E{(float*)(ws + WS_H1), (pg8::bf16_t*)(ws + WS_XN)};
        pg8::gemm_phase<EpiDown, pg8::StaticOrder, PG8_ALIGN, PG8_SP2>(lds, g, S, E);
    }
    SEAM(8);
    if (IN(9)) {
        pg8::Gemm g{(const pg8::bf16_t*)(ws + WS_XN), (const pg8::bf16_t*)(ws + WS_WGATE), MT, DM, DM}; pg8::StaticOrder S; S.init(MT, DM, G, bx);
        EpiGate E{(const float*)(ws + WS_H1), (const float*)(ws + WS_E), (const float*)(ws + WS_RSE), args.in[25], args.out, (float*)(ws + WS_RS3)};
        pg8::gemm_phase<EpiGate, pg8::StaticOrder, PG8_ALIGN, PG8_SP2>(lds, g, S, E);
    }
    SEAM(9);
    if (IN(10)) { final_norm_pass(args, gw, NGW, lane); }
#undef IN
#undef SEAM
}

extern "C" void kernel_launch(void* const* d_in, const int* in_sizes, int n_in, void* d_out, int out_size, void* d_ws, size_t ws_size, hipStream_t stream) {
    static int grid = 0;
    if (grid == 0) {
        if (n_in != 28 || out_size != (int)O_END || ws_size < WS_END) { fprintf(stderr, "kernel_launch: unexpected shapes: n_in %d out %d ws %zu\n", n_in, out_size, ws_size); grid = -1; return; }
        int dev = 0, cus = 0, per_cu = 0;
        if (hipGetDevice(&dev) != hipSuccess || hipDeviceGetAttribute(&cus, hipDeviceAttributeMultiprocessorCount, dev) != hipSuccess) { grid = -1; return; }
        if (hipFuncSetAttribute((const void*)mk_fwd, hipFuncAttributeMaxDynamicSharedMemorySize, LDS_BYTES) != hipSuccess) { fprintf(stderr, "kernel_launch: hipFuncSetAttribute failed\n"); grid = -1; return; }
        if (hipOccupancyMaxActiveBlocksPerMultiprocessor(&per_cu, (const void*)mk_fwd, NWAVES * 64, LDS_BYTES) != hipSuccess || per_cu < 1) fprintf(stderr, "kernel_launch: occupancy query says %d\n", per_cu);
        (void)hipGetLastError();
        grid = cus;
    }
    if (grid < 0) return;
    if (hipMemsetAsync((char*)d_ws + WS_CTL, 0, CTL_ZERO_BYTES, stream) != hipSuccess) { fprintf(stderr, "kernel_launch: memset failed\n"); return; }
    Args a{};
    for (int i = 0; i < 28; ++i) a.in[i] = (const float*)d_in[i];
    a.out = (float*)d_out; a.ws = (unsigned char*)d_ws;
    for (int li = 0; li < N_LAUNCHES; ++li) {
        if (N_LAUNCHES == 1) { a.ph_lo = 0; a.ph_hi = NPH; } else { a.ph_lo = li; a.ph_hi = li + 1; }
        a.li = li;
        hipLaunchKernelGGL(mk_fwd, dim3(grid), dim3(NWAVES * 64), LDS_BYTES, stream, a);
        const hipError_t le = hipPeekAtLastError();
        if (le != hipSuccess) { fprintf(stderr, "kernel_launch: launch %d failed: %s\n", li, hipGetErrorName(le)); break; }
    }
}
```

```cpp
#include <hip/hip_runtime.h>
#include <cstdio>
#include <cstdint>
namespace pg8 {
#define PG8_LAS __attribute__((address_space(3)))
typedef unsigned short bf16_t;
typedef short bf16x8 __attribute__((ext_vector_type(8)));
typedef float f32x4 __attribute__((ext_vector_type(4)));
typedef unsigned u32x4 __attribute__((ext_vector_type(4)));
constexpr int BM = 256, BK = 64, HALF = 128, HTB = HALF * BK * 2  , STAGE_BYTES = 8 * HTB, NXCD = 8, WGM = 8;

__host__ __device__ __forceinline__ int lds_byte(int r, int c) { const int st = (r >> 4) * 2 + (c >> 5), rr = r & 15, cc = c & 31, ob = rr * 64 + cc * 2; return st * 1024 + (ob ^ (((ob >> 9) & 1) << 5)); }
__host__ __device__ __forceinline__ void stage_rc(int b, int& R, int& C) { const int st = b / 1024, sb = b % 1024, swz = sb ^ (((sb >> 9) & 1) << 5); R = (st >> 1) * 16 + swz / 64; C = (st & 1) * 32 + (swz % 64) / 2; }
__host__ __device__ __forceinline__ int perm32(int rho) { const int n = rho >> 4, i = rho & 15; return 8 * (i >> 2) + 4 * n + (i & 3); }

struct Unit { int pm, pn; };
struct Gemm { const bf16_t* A; const bf16_t* Bt; int M, N, K; };

struct StaticOrder {
    int nM, nN, nwg, G, c;
    __host__ __device__ void init(int M, int N, int G_, int c_) { nM = M / BM; nN = N / BM; nwg = nM * nN; G = G_; c = c_; }
    __host__ __device__ bool next(int i, Unit& u) const {
        const long L = (long)i * G + c; if (L >= nwg) return false;
        int wgid = (int)L; { const int q = nwg / NXCD, r = nwg % NXCD, xcd = wgid % NXCD, off = wgid / NXCD; wgid = (xcd < r ? xcd * (q + 1) : r * (q + 1) + (xcd - r) * q) + off; }
        const int nig = WGM * nN, gid = wgid / nig, fm = gid * WGM, gsz = (nM - fm) < WGM ? (nM - fm) : WGM;
        u.pm = fm + ((wgid % nig) % gsz); u.pn = (wgid % nig) / gsz; return true;
    }
    __device__ __forceinline__ void a_ready(const Unit&) const {}
    __device__ __forceinline__ void done(const Unit&) const {}
};

__device__ __forceinline__ unsigned cvt_pk_bf16(float lo, float hi) { unsigned r; asm volatile("v_cvt_pk_bf16_f32 %0, %1, %2" : "=v"(r) : "v"(lo), "v"(hi)); return r; }
typedef float f32x2 __attribute__((ext_vector_type(2)));
template <class Epi, class Sched, bool ALIGN_EPI = false, bool SP2 = false>
__device__ __forceinline__ void gemm_phase(PG8_LAS unsigned char* lds, const Gemm g, const Sched& S, const Epi& E) {
    const int tid = threadIdx.x, wid = __builtin_amdgcn_readfirstlane(tid >> 6), lane = tid & 63, wr = wid >> 2, wc = wid & 3, fr = lane & 15, fq = lane >> 4;
    const int K = g.K, nt = K / BK;
    unsigned voffA[2], voffB[2];
#pragma unroll
    for (int i = 0; i < 2; ++i) { int R, C; stage_rc(tid * 16 + i * 8192, R, C); const int Rb = Epi::PERM ? ((R & ~31) + perm32(R & 31)) : R;
        voffA[i] = (unsigned)(R * K + C) * 2u; voffB[i] = (unsigned)(Rb * K + C) * 2u; }
    const size_t kstep = (size_t)(BK * 2);
    const size_t hstep = (size_t)HALF * K * 2;
    const size_t tstep = 2 * hstep;
    const unsigned ldsw = (unsigned)wid * 1024u;
    const int aoff = lds_byte(wr * 64 + fr, fq * 8), boff = lds_byte(wc * 32 + fr, fq * 8);
#define PG8_SA(b, h) (((b) * 2 + (h)) * HTB)
#define PG8_SB(b, h) ((4 + (b) * 2 + (h)) * HTB)
#define PG8_STAGE(bufoff, gbase, voff) do { _Pragma("unroll") for (int _i = 0; _i < 2; ++_i) \
        __builtin_amdgcn_global_load_lds((const unsigned*)((const char*)(gbase) + (voff)[_i]), (PG8_LAS unsigned*)(lds + (bufoff) + ldsw + _i * 8192), 16, 0, 0); } while (0)
#define PG8_LDA(dst, b, h) do { _Pragma("unroll") for (int m = 0; m < 4; ++m) _Pragma("unroll") for (int k = 0; k < 2; ++k) dst[m][k] = *(const PG8_LAS bf16x8*)(lds + PG8_SA(b, h) + aoff + m * 2048 + k * 1024); } while (0)
#define PG8_LDB(dst, b, h) do { _Pragma("unroll") for (int n = 0; n < 2; ++n) _Pragma("unroll") for (int k = 0; k < 2; ++k) dst[n][k] = *(const PG8_LAS bf16x8*)(lds + PG8_SB(b, h) + boff + n * 2048 + k * 1024); } while (0)
#define PG8_MMA(ai, bj, At, Bt) do { __builtin_amdgcn_s_setprio(1); _Pragma("unroll") for (int m = 0; m < 4; ++m) _Pragma("unroll") for (int n = 0; n < 2; ++n) _Pragma("unroll") for (int k = 0; k < 2; ++k) \
        acc[ai][bj][m][n] = __builtin_amdgcn_mfma_f32_16x16x32_bf16(Bt[n][k], At[m][k], acc[ai][bj][m][n], 0, 0, 0); __builtin_amdgcn_s_setprio(0); } while (0)
#define PG8_WAIT_V(n) asm volatile("s_waitcnt vmcnt(" #n ")" ::: "memory")
#define PG8_WAIT_L(n) asm volatile("s_waitcnt lgkmcnt(" #n ")" ::: "memory")
#define PG8_BAR __builtin_amdgcn_s_barrier()
#define PG8_SCHED __builtin_amdgcn_sched_barrier(0)
    Unit cur, nxt; int ui = 0;
    if (!S.next(0, cur)) return;
    f32x4 acc[2][2][4][2];
#pragma unroll
    for (int a = 0; a < 2; ++a)
#pragma unroll
        for (int b = 0; b < 2; ++b)
#pragma unroll
            for (int m = 0; m < 4; ++m)
#pragma unroll
                for (int n = 0; n < 2; ++n) acc[a][b][m][n] = (f32x4){0.f, 0.f, 0.f, 0.f};
    bf16x8 At[4][2], B0[2][2], B1[2][2];
    const char* cA = (const char*)g.A + (size_t)cur.pm * tstep; const char* cB = (const char*)g.Bt + (size_t)cur.pn * tstep;
    S.a_ready(cur);
    if constexpr (SP2) {
        PG8_STAGE(PG8_SB(0, 0), cB, voffB); PG8_STAGE(PG8_SB(0, 1), cB + hstep, voffB); PG8_STAGE(PG8_SA(0, 0), cA, voffA); PG8_STAGE(PG8_SA(0, 1), cA + hstep, voffA);
        if (wr == 1) PG8_BAR;
        PG8_WAIT_V(2); PG8_BAR;
        PG8_STAGE(PG8_SB(1, 0), cB + kstep, voffB); PG8_STAGE(PG8_SA(1, 0), cA + kstep, voffA); PG8_STAGE(PG8_SB(1, 1), cB + hstep + kstep, voffB);
        PG8_WAIT_V(6); PG8_BAR;
    } else {
        PG8_STAGE(PG8_SB(0, 0), cB, voffB); PG8_STAGE(PG8_SA(0, 0), cA, voffA); PG8_STAGE(PG8_SB(0, 1), cB + hstep, voffB); PG8_STAGE(PG8_SA(0, 1), cA + hstep, voffA);
        if (wr == 1) PG8_BAR;
        PG8_WAIT_V(4); PG8_BAR;
        PG8_STAGE(PG8_SB(1, 0), cB + kstep, voffB); PG8_STAGE(PG8_SA(1, 0), cA + kstep, voffA); PG8_STAGE(PG8_SB(1, 1), cB + hstep + kstep, voffB);
        PG8_WAIT_V(6); PG8_BAR;
    }
    for (;;) {
        const bool has_next = S.next(ui + 1, nxt);
        const char* nA = has_next ? (const char*)g.A + (size_t)nxt.pm * tstep : cA; const char* nB = has_next ? (const char*)g.Bt + (size_t)nxt.pn * tstep : cB;
        for (int t = 0; t < nt; t += 2) {
            const bool last = (t == nt - 2);
            const char* a1 = cA + (size_t)(t + 1) * kstep;
            const char* a2 = last ? nA : cA + (size_t)(t + 2) * kstep; const char* b2 = last ? nB : cB + (size_t)(t + 2) * kstep;
            const char* a3 = a2 + kstep; const char* b3 = b2 + kstep;
            if (last && has_next) S.a_ready(nxt);
            if constexpr (SP2) {
            PG8_LDB(B0, 0, 0); PG8_LDB(B1, 0, 1); PG8_SCHED; PG8_LDA(At, 0, 0); PG8_STAGE(PG8_SA(1, 1), a1 + hstep, voffA);
            PG8_WAIT_V(8); PG8_WAIT_L(0); PG8_BAR; PG8_MMA(0, 0, At, B0); PG8_MMA(0, 1, At, B1); PG8_BAR; PG8_SCHED;
            PG8_LDA(At, 0, 1); PG8_STAGE(PG8_SB(0, 0), b2, voffB); PG8_STAGE(PG8_SB(0, 1), b2 + hstep, voffB); PG8_STAGE(PG8_SA(0, 0), a2, voffA);
            PG8_WAIT_V(8); PG8_WAIT_L(0); PG8_BAR; PG8_MMA(1, 0, At, B0); PG8_MMA(1, 1, At, B1); PG8_BAR; PG8_SCHED;
            PG8_LDB(B0, 1, 0); PG8_LDB(B1, 1, 1); PG8_SCHED; PG8_LDA(At, 1, 0); PG8_STAGE(PG8_SA(0, 1), a2 + hstep, voffA);
            PG8_WAIT_V(8); PG8_WAIT_L(0); PG8_BAR; PG8_MMA(0, 0, At, B0); PG8_MMA(0, 1, At, B1); PG8_BAR; PG8_SCHED;
            PG8_LDA(At, 1, 1); PG8_STAGE(PG8_SB(1, 0), b3, voffB); PG8_STAGE(PG8_SB(1, 1), b3 + hstep, voffB); PG8_STAGE(PG8_SA(1, 0), a3, voffA);
            PG8_WAIT_V(8); PG8_WAIT_L(0); PG8_BAR; PG8_MMA(1, 0, At, B0); PG8_MMA(1, 1, At, B1); PG8_BAR; PG8_SCHED;
            } else {
            PG8_LDB(B0, 0, 0); PG8_SCHED; PG8_LDA(At, 0, 0); PG8_STAGE(PG8_SA(1, 1), a1 + hstep, voffA);
            PG8_WAIT_L(8); PG8_BAR; PG8_WAIT_L(0); PG8_MMA(0, 0, At, B0); PG8_BAR; PG8_SCHED;
            PG8_LDB(B1, 0, 1); PG8_STAGE(PG8_SB(0, 0), b2, voffB);
            PG8_BAR; PG8_WAIT_L(0); PG8_MMA(0, 1, At, B1); PG8_BAR;
            PG8_LDA(At, 0, 1); PG8_STAGE(PG8_SA(0, 0), a2, voffA);
            PG8_BAR; PG8_WAIT_L(0); PG8_MMA(1, 0, At, B0); PG8_BAR; PG8_SCHED;
            PG8_STAGE(PG8_SB(0, 1), b2 + hstep, voffB);
            PG8_WAIT_V(6); PG8_BAR; PG8_MMA(1, 1, At, B1); PG8_BAR;
            PG8_LDB(B0, 1, 0); PG8_SCHED; PG8_LDA(At, 1, 0); PG8_STAGE(PG8_SA(0, 1), a2 + hstep, voffA);
            PG8_WAIT_L(8); PG8_BAR; PG8_WAIT_L(0); PG8_MMA(0, 0, At, B0); PG8_BAR; PG8_SCHED;
            PG8_LDB(B1, 1, 1); PG8_STAGE(PG8_SB(1, 0), b3, voffB);
            PG8_BAR; PG8_WAIT_L(0); PG8_MMA(0, 1, At, B1); PG8_BAR;
            PG8_LDA(At, 1, 1); PG8_STAGE(PG8_SA(1, 0), a3, voffA);
            PG8_BAR; PG8_WAIT_L(0); PG8_MMA(1, 0, At, B0); PG8_BAR; PG8_SCHED;
            PG8_STAGE(PG8_SB(1, 1), b3 + hstep, voffB);
            PG8_WAIT_V(6); PG8_BAR; PG8_MMA(1, 1, At, B1); PG8_BAR;
            }
        }
        if constexpr (ALIGN_EPI) { if (wr == 0) PG8_BAR; }
        if constexpr (!Epi::AFTER_DRAIN) { E(acc, cur, wr, wc, fr, fq); S.done(cur); }
        if (!has_next) break;
#pragma unroll
        for (int a = 0; a < 2; ++a)
#pragma unroll
            for (int b = 0; b < 2; ++b)
#pragma unroll
                for (int m = 0; m < 4; ++m)
#pragma unroll
                    for (int n = 0; n < 2; ++n) acc[a][b][m][n] = (f32x4){0.f, 0.f, 0.f, 0.f};
        cur = nxt; cA = nA; cB = nB; ++ui;
        if constexpr (ALIGN_EPI) { if (wr == 1) PG8_BAR; }
    }
    PG8_WAIT_V(0);
    if constexpr (!ALIGN_EPI) { if (wr == 0) PG8_BAR; }
    PG8_BAR;
    if constexpr (Epi::AFTER_DRAIN) { E.fused(acc, cur, wr, wc, fr, fq, lds, wid, lane); S.done(cur); }
#undef PG8_SA
#undef PG8_SB
#undef PG8_STAGE
#undef PG8_LDA
#undef PG8_LDB
#undef PG8_MMA
#undef PG8_WAIT_V
#undef PG8_WAIT_L
#undef PG8_BAR
#undef PG8_SCHED
}
}

#ifndef PG8_SP2
#define PG8_SP2 true
#endif
#ifndef PG8_ALIGN
#define PG8_ALIGN true
#endif
#define GAS __attribute__((address_space(1)))
#define LAS __attribute__((address_space(3)))
typedef unsigned short bf16;
typedef unsigned v4u __attribute__((ext_vector_type(4)));
typedef float f32x4 __attribute__((ext_vector_type(4)));
typedef short bf16x8 __attribute__((ext_vector_type(8)));
typedef GAS unsigned gu32;
typedef GAS unsigned long long gu64;
#define RLX_AGENT __ATOMIC_RELAXED, __HIP_MEMORY_SCOPE_AGENT
#define LDS_WAIT() asm volatile("s_waitcnt lgkmcnt(0)" ::: "memory")
#define VM_WAIT() asm volatile("s_waitcnt vmcnt(0)" ::: "memory")
__device__ __forceinline__ unsigned long long rt() { return __builtin_amdgcn_s_memrealtime(); }
__device__ __forceinline__ unsigned f2bf(float f) { unsigned u = __builtin_bit_cast(unsigned, f); return (u + 0x7fffu + ((u >> 16) & 1u)) >> 16; }
__device__ __forceinline__ unsigned pk2(float lo, float hi) { return f2bf(lo) | (f2bf(hi) << 16); }

#define XB_TMO      128
#define XB_XCNT(j)  (256  + 64 * (j))
#define XB_XSUB(j)  (1280 + 64 * (j))
#define XB_XGEN(j)  (2304 + 64 * (j))
#define XB_TOP      3328
#define XB_TOPGEN   3392
#define XCD_BAR_WORDS 3456
#define XB_SPIN_CAP (1u << 18)

__device__ __forceinline__ unsigned xb_ld(unsigned* p)              { return __hip_atomic_load(p, __ATOMIC_RELAXED, __HIP_MEMORY_SCOPE_AGENT); }
__device__ __forceinline__ unsigned xb_add(unsigned* p, unsigned v) { return __hip_atomic_fetch_add(p, v, __ATOMIC_RELAXED, __HIP_MEMORY_SCOPE_AGENT); }
__device__ __forceinline__ unsigned xb_xcc_id() { return (unsigned)__builtin_amdgcn_s_getreg((3 << 11) | 20) & 0xFu; }
#define XB_SPIN(cond, bar) do { unsigned _sp = 0; while (cond) { __builtin_amdgcn_s_sleep(1); \
    if ((++_sp & 255u) == 0u) { if (xb_ld(&(bar)[XB_TMO])) break; if (_sp > XB_SPIN_CAP) { atomicAdd(&(bar)[XB_TMO], 1u); break; } } } } while (0)

struct XcdBarrier {
    unsigned* bar; unsigned x;
    volatile LAS unsigned* st;
};

__device__ __forceinline__ XcdBarrier xcd_barrier_post(unsigned* bar, volatile LAS unsigned* st) {
    XcdBarrier b; b.bar = bar; b.x = xb_xcc_id(); b.st = st;
    if (threadIdx.x == 0) (void)xb_add(&bar[XB_XCNT(b.x)], 1u);
    return b;
}
__device__ __forceinline__ void xcd_barrier_complete(unsigned* bar, unsigned x, unsigned& nloc, unsigned& nx) {
    const unsigned G = gridDim.x * gridDim.y * gridDim.z;
    unsigned sum, cnt, mine, sp = 0u;
    for (;;) {
        sum = 0u; cnt = 0u; mine = 0u;
#pragma unroll
        for (unsigned j = 0; j < 16; ++j) { const unsigned c = xb_ld(&bar[XB_XCNT(j)]); sum += c; cnt += (c > 0u) ? 1u : 0u; mine = (j == x) ? c : mine; }
        if (sum == G) break;
        __builtin_amdgcn_s_sleep(1);
        if ((++sp & 255u) == 0u) { if (xb_ld(&bar[XB_TMO])) break; if (sp > XB_SPIN_CAP) { atomicAdd(&bar[XB_TMO], 1u); break; } }
    }
    nloc = mine > 0u ? mine : 1u; nx = cnt > 0u ? cnt : 1u;
}

__device__ __forceinline__ void xcd_barrier(const XcdBarrier& b) {
    asm volatile("s_waitcnt vmcnt(0)" ::: "memory");
    __syncthreads();
    if (threadIdx.x == 0) {
        unsigned* bar = b.bar;
        __builtin_amdgcn_s_waitcnt(0);
        unsigned nloc = b.st[0], nx = b.st[1];
        if (nloc == 0u) { xcd_barrier_complete(bar, b.x, nloc, nx); b.st[0] = nloc; b.st[1] = nx; }
        const unsigned old = xb_add(&bar[XB_XSUB(b.x)], 1u);
        const unsigned gen = old / nloc;
        if (old + 1u == (gen + 1u) * nloc) {
            __builtin_amdgcn_fence(__ATOMIC_RELEASE, "agent");
            asm volatile("s_waitcnt vmcnt(0)" ::: "memory");
            const unsigned og = xb_add(&bar[XB_TOP], 1u);
            const unsigned tg = og / nx;
            if (og + 1u == (tg + 1u) * nx) xb_add(&bar[XB_TOPGEN], 1u);
            else XB_SPIN(xb_ld(&bar[XB_TOPGEN]) == tg, bar);
            __builtin_amdgcn_fence(__ATOMIC_ACQUIRE, "agent");
            xb_add(&bar[XB_XGEN(b.x)], 1u);
            asm volatile("s_waitcnt vmcnt(0)" ::: "memory");
        } else {
            XB_SPIN(xb_ld(&bar[XB_XGEN(b.x)]) == gen, bar);
            __builtin_amdgcn_fence(__ATOMIC_ACQUIRE, "agent");
            asm volatile("s_waitcnt vmcnt(0)" ::: "memory");
        }
    }
    __syncthreads();
}


constexpr int NWAVES = 8;
constexpr int DM = 1024, SEQ = 4096, NBP = 4, NBS = 32, TS = 8;
constexpr int MP = NBP * SEQ, MS = NBS * TS, MT = MP + MS;
constexpr int NH = 8, HD = 64, DSSM = 512, NST = 128, IN_LD = 3080, NIN = 3072;
constexpr int DFF = 2816, DFF2 = 5632, DPLE = 256, WBUF = 2048;
constexpr float EPS = 1e-6f, LOG2E = 1.4426950408889634f, C2 = 0.125f * 1.4426950408889634f;
constexpr int PC_K = 512, PC_V = 1024, PC_Z = 1536, PC_X = 2048;
constexpr size_t O_Y = 0, O_YS = 16777216, O_KP = 17039360, O_VP = 21233664, O_KS = 25427968, O_VS = 25559040, O_SP = 25690112, O_SS = 25952256,
                 O_CP = 28049408, O_CS = 28061696, O_FP = 28160000, O_FS = 28205056, O_END = 28565504;
constexpr size_t MiB = 1u << 20;
constexpr size_t WS_CTL = 0, CTL_ZERO_BYTES = 1 * MiB;
constexpr size_t WS_RS1 = 256 * 1024, WS_RSE = 384 * 1024, WS_RS3 = 512 * 1024;
constexpr size_t WS_WIN = 2 * MiB, WS_WOUT = 8 * MiB, WS_WUP = 10 * MiB, WS_WDOWN = 21 * MiB, WS_WPLE = 27 * MiB, WS_WGATE = 28 * MiB;
constexpr size_t WS_DT = 30 * MiB, WS_PB = 31 * MiB, WS_XN = 40 * MiB, WS_MIX = 73 * MiB, WS_H1 = 106 * MiB, WS_E = 171 * MiB;
constexpr size_t WS_PROJ = 236 * MiB, WS_OBR = 334 * MiB, WS_LSE = 382 * MiB, WS_XBS = 384 * MiB, WS_XC = 385 * MiB, WS_CC = 402 * MiB, WS_CS = 410 * MiB, WS_PREV = 442 * MiB,
                 WS_ACUM = 458 * MiB, WS_ACL = 458 * MiB + 768 * 1024, WS_YS = 459 * MiB;
constexpr size_t WS_U = 236 * MiB, WS_ACT = 415 * MiB, WS_END = 505 * MiB;
static_assert(WS_PROJ + (size_t)MT * NIN * 2 <= WS_OBR && WS_OBR + (size_t)3 * MP * 512 * 2 <= WS_LSE && WS_LSE + (size_t)3 * MP * 8 * 4 <= WS_XBS, "ws map A");
static_assert(WS_XBS + (size_t)MS * 1024 * 4 <= WS_XC && WS_XC + (size_t)MT * 512 * 2 <= WS_CC && WS_CC + (size_t)MP * 256 * 2 <= WS_CS && WS_CS + (size_t)MP / 128 * 8 * 64 * 128 * 4 <= WS_PREV && WS_PREV + (size_t)MP / 128 * 8 * 64 * 128 * 2 <= WS_ACUM && WS_ACUM + (size_t)MP * 8 * 4 <= WS_ACL && WS_ACL + 4096 <= WS_YS && WS_YS + (size_t)MT * 512 * 4 <= WS_END, "ws map B");
static_assert(WS_U + (size_t)MT * DFF2 * 2 <= WS_ACT && WS_ACT + (size_t)MT * DFF * 2 <= WS_END, "ws map C");
static_assert(WS_XN + (size_t)MT * DM * 2 <= WS_MIX && WS_MIX + (size_t)MT * DM * 2 <= WS_H1 && WS_H1 + (size_t)MT * DM * 4 <= WS_E && WS_E + (size_t)MT * DM * 4 <= WS_PROJ, "ws map D");
static_assert(WS_PB + (size_t)MT * DPLE * 2 <= WS_XN && WS_DT + (size_t)MT * 8 * 4 <= WS_PB, "ws map E");
constexpr int CW_TMO = 0, CW_BAR = 4096;
constexpr int RING_BYTES = 131072, LDSCTL_OFF = RING_BYTES, MISC_OFF = LDSCTL_OFF + 320, LDS_BYTES = 147456;

typedef float f32x16 __attribute__((ext_vector_type(16)));
typedef short v4i16_t __attribute__((ext_vector_type(4)));
typedef unsigned u32x2 __attribute__((ext_vector_type(2)));

__device__ const unsigned char BUCKET_TAB[3][132] = {
 {0,1,2,3,4,5,6,7,8,9,10,11,12,13,14,15,16,16,16,16,16,16,17,17,17,17,17,17,17,17,18,18,18,18,18,18,18,18,18,18,19,19,19,19,19,19,19,19,19,19,19,19,19,19,20,20,20,20,20,20,20,20,20,20,20,20,20,20,20,20,20,20,20,21,21,21,21,21,21,21,21,21,21,21,21,21,21,21,21,21,21,21,21,21,21,21,21,21,21,22,22,22,22,22,22,22,22,22,22,22,22,22,22,22,22,22,22,22,22,22,22,22,22,22,22,22,22,22,22,0,0,0},
 {0,4,8,12,16,16,17,17,18,18,19,19,19,19,20,20,20,20,20,21,21,21,21,21,21,22,22,22,22,22,22,22,22,22,23,23,23,23,23,23,23,23,23,23,23,23,24,24,24,24,24,24,24,24,24,24,24,24,24,24,24,24,25,25,25,25,25,25,25,25,25,25,25,25,25,25,25,25,25,25,25,25,25,26,26,26,26,26,26,26,26,26,26,26,26,26,26,26,26,26,26,26,26,26,26,26,26,26,26,26,26,26,26,27,27,27,27,27,27,27,27,27,27,27,27,27,27,27,27,0,0,0},
 {0,16,18,19,20,21,21,22,22,23,23,23,24,24,24,24,25,25,25,25,25,26,26,26,26,26,26,26,26,27,27,27,27,27,27,27,27,27,27,28,28,28,28,28,28,28,28,28,28,28,28,28,29,29,29,29,29,29,29,29,29,29,29,29,29,29,29,29,29,29,30,30,30,30,30,30,30,30,30,30,30,30,30,30,30,30,30,30,30,30,30,30,30,30,30,31,31,31,31,31,31,31,31,31,31,31,31,31,31,31,31,31,31,31,31,31,31,31,31,31,31,31,31,31,31,31,31,31,31,0,0,0}};

__device__ __forceinline__ float wave_sum(float v) {
#pragma unroll
    for (int o = 1; o < 64; o <<= 1) v += __shfl_xor(v, o);
    return v;
}
__device__ __forceinline__ float wave_max(float v) {
#pragma unroll
    for (int o = 1; o < 64; o <<= 1) v = fmaxf(v, __shfl_xor(v, o));
    return v;
}
__device__ __forceinline__ float bf2f(unsigned short b) { return __uint_as_float((unsigned)b << 16); }
__device__ __forceinline__ float bflo(unsigned w) { return __uint_as_float(w << 16); }
__device__ __forceinline__ float bfhi(unsigned w) { return __uint_as_float(w & 0xffff0000u); }
__device__ __forceinline__ float siluf(float x) { return x / (1.f + __expf(-x)); }
__device__ __forceinline__ float softplusf(float x) { return fmaxf(x, 0.f) + log1pf(__expf(-fabsf(x))); }
__device__ __forceinline__ int crow(int r, int hi) { return (r & 3) + 8 * (r >> 2) + 4 * hi; }

__device__ __forceinline__ v4i16_t vtr(const LAS unsigned char* p) { return __builtin_amdgcn_ds_read_tr16_b64_v4i16((LAS v4i16_t*)p); }
__device__ __forceinline__ unsigned cvtpk_s(float lo, float hi) { typedef float f2 __attribute__((ext_vector_type(2))); typedef __bf16 b2 __attribute__((ext_vector_type(2))); f2 v = {lo, hi}; b2 b = __builtin_convertvector(v, b2); return __builtin_bit_cast(unsigned, b); }
struct Args { const float* in[28]; float* out; unsigned char* ws; int ph_lo, ph_hi, li, pad; };

struct EpiIn {
    static constexpr bool PERM = true, AFTER_DRAIN = false;
    pg8::bf16_t* PROJ; float* out;
    __device__ __forceinline__ void operator()(const pg8::f32x4 (&acc)[2][2][4][2], const pg8::Unit& u, int wr, int wc, int fr, int fq) const {
        const int pn = u.pn; const float sc = (pn < 2) ? C2 : 1.f;
        const int colb = pn * 256 + wc * 32 + 8 * fq;
#pragma unroll
        for (int ai = 0; ai < 2; ++ai)
#pragma unroll
            for (int m = 0; m < 4; ++m) {
                const int row = u.pm * 256 + ai * 128 + wr * 64 + m * 16 + fr;
#pragma unroll
                for (int bj = 0; bj < 2; ++bj) {
                    const int col = colb + bj * 128; const pg8::f32x4 v0 = acc[ai][bj][m][0], v1 = acc[ai][bj][m][1];
                    pg8::u32x4 w; w.x = pg8::cvt_pk_bf16(v0[0] * sc, v0[1] * sc); w.y = pg8::cvt_pk_bf16(v0[2] * sc, v0[3] * sc); w.z = pg8::cvt_pk_bf16(v1[0] * sc, v1[1] * sc); w.w = pg8::cvt_pk_bf16(v1[2] * sc, v1[3] * sc);
                    *(pg8::u32x4*)(PROJ + (size_t)row * NIN + col) = w;
                    float* dst = nullptr;
                    if (pn >= 2 && pn < 6) {
                        const bool isk = pn < 4; const int c = col - (isk ? PC_K : PC_V);
                        if (row < MP) { const int t = row & (SEQ - 1), b = row >> 12; if (t >= SEQ - WBUF) dst = out + (isk ? O_KP : O_VP) + ((size_t)(b * WBUF + t - (SEQ - WBUF))) * 512 + c; }
                        else dst = out + (isk ? O_KS : O_VS) + (size_t)(row - MP) * 512 + c;
                    } else if (pn >= 8) {
                        const int c = col - PC_X;
                        if (row < MP) { const int t = row & (SEQ - 1), b = row >> 12; if (t >= SEQ - 3) dst = out + O_CP + (size_t)(b * 3 + t - (SEQ - 3)) * 1024 + c; }
                        else { const int r = row - MP, t = r & 7, b = r >> 3; if (t >= TS - 3) dst = out + O_CS + (size_t)(b * 3 + t - (TS - 3)) * 1024 + c; }
                    }
                    if (dst) { *(pg8::f32x4*)dst = v0; *(pg8::f32x4*)(dst + 4) = v1; }
                }
            }
    }
};
struct EpiOut {
    static constexpr bool PERM = false, AFTER_DRAIN = false;
    const float* xp; const float* xs; float* H1; pg8::bf16_t* H1b; float* RS;
    __device__ __forceinline__ void operator()(const pg8::f32x4 (&acc)[2][2][4][2], const pg8::Unit& u, int wr, int wc, int fr, int fq) const {
        const int col0 = u.pn * 256 + wc * 32 + 4 * fq;
#pragma unroll
        for (int ai = 0; ai < 2; ++ai)
#pragma unroll
            for (int m = 0; m < 4; ++m) {
                const int row = u.pm * 256 + ai * 128 + wr * 64 + m * 16 + fr;
                const float* xrow = (row < MP) ? xp + (size_t)row * DM : xs + (size_t)(row - MP) * DM;
                float ss = 0.f;
#pragma unroll
                for (int bj = 0; bj < 2; ++bj)
#pragma unroll
                    for (int n = 0; n < 2; ++n) {
                        const int c = col0 + bj * 128 + n * 16;
                        const pg8::f32x4 h = *(const pg8::f32x4*)(xrow + c) + acc[ai][bj][m][n];
                        *(pg8::f32x4*)(H1 + (size_t)row * DM + c) = h;
                        u32x2 w; w.x = pg8::cvt_pk_bf16(h[0], h[1]); w.y = pg8::cvt_pk_bf16(h[2], h[3]);
                        *(u32x2*)(H1b + (size_t)row * DM + c) = w;
                        ss += (h[0] * h[0] + h[1] * h[1]) + (h[2] * h[2] + h[3] * h[3]);
                    }
                ss += __shfl_xor(ss, 16); ss += __shfl_xor(ss, 32);
                if (fq == 0) atomicAdd(RS + row, ss);
                asm volatile("" ::: "memory");
            }
    }
};
struct EpiUp {
    static constexpr bool PERM = true, AFTER_DRAIN = false;
    pg8::bf16_t* U; const float* RS; float* out;
    __device__ __forceinline__ void operator()(const pg8::f32x4 (&acc)[2][2][4][2], const pg8::Unit& u, int wr, int wc, int fr, int fq) const {
        const int colb = u.pn * 256 + wc * 32 + 8 * fq;
#pragma unroll
        for (int ai = 0; ai < 2; ++ai)
#pragma unroll
            for (int m = 0; m < 4; ++m) {
                const int row = u.pm * 256 + ai * 128 + wr * 64 + m * 16 + fr;
                const float rs = 1.0f / sqrtf(RS[row] * (1.f / DM) + EPS);
                float* dstb = nullptr;
                if (row < MP) { const int t = row & (SEQ - 1), b = row >> 12; if (t >= SEQ - 2) dstb = out + O_FP + (size_t)(b * 2 + t - (SEQ - 2)) * DFF2; }
                else { const int r = row - MP, t = r & 7, b = r >> 3; if (t >= TS - 2) dstb = out + O_FS + (size_t)(b * 2 + t - (TS - 2)) * DFF2; }
#pragma unroll
                for (int bj = 0; bj < 2; ++bj) {
                    const int col = colb + bj * 128; const pg8::f32x4 v0 = acc[ai][bj][m][0] * rs, v1 = acc[ai][bj][m][1] * rs;
                    pg8::u32x4 w; w.x = pg8::cvt_pk_bf16(v0[0], v0[1]); w.y = pg8::cvt_pk_bf16(v0[2], v0[3]); w.z = pg8::cvt_pk_bf16(v1[0], v1[1]); w.w = pg8::cvt_pk_bf16(v1[2], v1[3]);
                    *(pg8::u32x4*)(U + (size_t)row * DFF2 + col) = w;
                    if (dstb) { *(pg8::f32x4*)(dstb + col) = v0; *(pg8::f32x4*)(dstb + col + 4) = v1; }
                }
            }
    }
};
struct EpiDown {
    static constexpr bool PERM = false, AFTER_DRAIN = false;
    float* H1; pg8::bf16_t* H2b;
    __device__ __forceinline__ void operator()(const pg8::f32x4 (&acc)[2][2][4][2], const pg8::Unit& u, int wr, int wc, int fr, int fq) const {
        const int col0 = u.pn * 256 + wc * 32 + 4 * fq;
#pragma unroll
        for (int ai = 0; ai < 2; ++ai)
#pragma unroll
            for (int m = 0; m < 4; ++m) {
                const int row = u.pm * 256 + ai * 128 + wr * 64 + m * 16 + fr;
#pragma unroll
                for (int bj = 0; bj < 2; ++bj)
#pragma unroll
                    for (int n = 0; n < 2; ++n) {
                        const int c = col0 + bj * 128 + n * 16; float* hp = H1 + (size_t)row * DM + c;
                        const pg8::f32x4 h = *(const pg8::f32x4*)hp + acc[ai][bj][m][n];
                        *(pg8::f32x4*)hp = h;
                        u32x2 w; w.x = pg8::cvt_pk_bf16(h[0], h[1]); w.y = pg8::cvt_pk_bf16(h[2], h[3]);
                        *(u32x2*)(H2b + (size_t)row * DM + c) = w;
                    }
                asm volatile("" ::: "memory");
            }
    }
};
struct EpiPle {
    static constexpr bool PERM = false, AFTER_DRAIN = false;
    float* E; float* RS;
    __device__ __forceinline__ void operator()(const pg8::f32x4 (&acc)[2][2][4][2], const pg8::Unit& u, int wr, int wc, int fr, int fq) const {
        const int col0 = u.pn * 256 + wc * 32 + 4 * fq;
#pragma unroll
        for (int ai = 0; ai < 2; ++ai)
#pragma unroll
            for (int m = 0; m < 4; ++m) {
                const int row = u.pm * 256 + ai * 128 + wr * 64 + m * 16 + fr; float ss = 0.f;
#pragma unroll
                for (int bj = 0; bj < 2; ++bj)
#pragma unroll
                    for (int n = 0; n < 2; ++n) {
                        const int c = col0 + bj * 128 + n * 16; const pg8::f32x4 h = acc[ai][bj][m][n];
                        *(pg8::f32x4*)(E + (size_t)row * DM + c) = h;
                        ss += (h[0] * h[0] + h[1] * h[1]) + (h[2] * h[2] + h[3] * h[3]);
                    }
                ss += __shfl_xor(ss, 16); ss += __shfl_xor(ss, 32);
                if (fq == 0) atomicAdd(RS + row, ss);
            }
    }
};
struct EpiGate {
    static constexpr bool PERM = false, AFTER_DRAIN = false;
    const float* H2; const float* E; const float* RSE; const float* gple; float* out; float* RS3;
    __device__ __forceinline__ void operator()(const pg8::f32x4 (&acc)[2][2][4][2], const pg8::Unit& u, int wr, int wc, int fr, int fq) const {
        const int col0 = u.pn * 256 + wc * 32 + 4 * fq;
        pg8::f32x4 gp[2][2];
#pragma unroll
        for (int bj = 0; bj < 2; ++bj)
#pragma unroll
            for (int n = 0; n < 2; ++n) gp[bj][n] = *(const pg8::f32x4*)(gple + col0 + bj * 128 + n * 16);
#pragma unroll
        for (int ai = 0; ai < 2; ++ai)
#pragma unroll
            for (int m = 0; m < 4; ++m) {
                const int row = u.pm * 256 + ai * 128 + wr * 64 + m * 16 + fr;
                const float rse = 1.0f / sqrtf(RSE[row] * (1.f / DM) + EPS);
                float* orow = (row < MP) ? out + O_Y + (size_t)row * DM : out + O_YS + (size_t)(row - MP) * DM;
                float ss = 0.f;
#pragma unroll
                for (int bj = 0; bj < 2; ++bj)
#pragma unroll
                    for (int n = 0; n < 2; ++n) {
                        const int c = col0 + bj * 128 + n * 16;
                        const pg8::f32x4 a = acc[ai][bj][m][n], e = *(const pg8::f32x4*)(E + (size_t)row * DM + c), h2 = *(const pg8::f32x4*)(H2 + (size_t)row * DM + c);
                        pg8::f32x4 h;
#pragma unroll
                        for (int k = 0; k < 4; ++k) { const float g = 1.f / (1.f + __expf(-a[k])); h[k] = h2[k] + g * (e[k] * rse * gp[bj][n][k]); }
                        *(pg8::f32x4*)(orow + c) = h;
                        ss += (h[0] * h[0] + h[1] * h[1]) + (h[2] * h[2] + h[3] * h[3]);
                    }
                ss += __shfl_xor(ss, 16); ss += __shfl_xor(ss, 32);
                if (fq == 0) atomicAdd(RS3 + row, ss);
                asm volatile("" ::: "memory");
            }
    }
};

__device__ __forceinline__ void p0_transpose_item(const float* W, int ldn, int K, int N, bf16* WT, const float* gk, LAS float* scr, int item, int lane) {
    const int nblk = N / 32, kb = item / nblk, nb = item % nblk, k0 = 64 * kb, n0 = 32 * nb;
#pragma unroll 8
    for (int i = 0; i < 32; ++i) { const int kk = 2 * i + (lane >> 5); float w = W[(size_t)(k0 + kk) * ldn + n0 + (lane & 31)]; if (gk) w *= gk[k0 + kk]; scr[kk * 33 + (lane & 31)] = w; }
    LDS_WAIT(); asm volatile("" ::: "memory");
    const int c = lane & 7;
#pragma unroll
    for (int j = 0; j < 4; ++j) { const int n = (lane >> 3) + 8 * j; const LAS float* s = scr + (8 * c) * 33 + n;
        v4u o; o.x = pk2(s[0 * 33], s[1 * 33]); o.y = pk2(s[2 * 33], s[3 * 33]); o.z = pk2(s[4 * 33], s[5 * 33]); o.w = pk2(s[6 * 33], s[7 * 33]);
        *(GAS v4u*)(WT + (size_t)(n0 + n) * K + k0 + 8 * c) = o; }
    LDS_WAIT(); asm volatile("" ::: "memory");
}
__device__ __forceinline__ void p0_prologue(const Args& a, LAS unsigned char* lds, int gw, int NGW, int wave, int lane) {
    unsigned char* ws = a.ws;
    LAS float* scr = (LAS float*)(lds + wave * 16384);
    constexpr int I_IN = (DM / 64) * (NIN / 32), I_OUT = (DM / 64) * (DM / 32), I_UP = (DM / 64) * (DFF2 / 32), I_DN = (DFF / 64) * (DM / 32), I_PLE = (DPLE / 64) * (DM / 32), I_G = I_OUT;
    constexpr int NITEMS = I_IN + I_OUT + I_UP + I_DN + I_PLE + I_G;
    for (int it = gw; it < NITEMS; it += NGW) {
        int r = it;
        if (r < I_IN)  { p0_transpose_item(a.in[11], IN_LD, DM, NIN, (bf16*)(ws + WS_WIN), a.in[10], scr, r, lane); continue; } r -= I_IN;
        if (r < I_OUT) { p0_transpose_item(a.in[18], DM, DM, DM, (bf16*)(ws + WS_WOUT), nullptr, scr, r, lane); continue; } r -= I_OUT;
        if (r < I_UP)  { p0_transpose_item(a.in[20], DFF2, DM, DFF2, (bf16*)(ws + WS_WUP), a.in[19], scr, r, lane); continue; } r -= I_UP;
        if (r < I_DN)  { p0_transpose_item(a.in[23], DM, DFF, DM, (bf16*)(ws + WS_WDOWN), nullptr, scr, r, lane); continue; } r -= I_DN;
        if (r < I_PLE) { p0_transpose_item(a.in[24], DM, DPLE, DM, (bf16*)(ws + WS_WPLE), nullptr, scr, r, lane); continue; } r -= I_PLE;
        p0_transpose_item(a.in[26], DM, DM, DM, (bf16*)(ws + WS_WGATE), nullptr, scr, r, lane);
    }
    const float* gmix = a.in[10]; const float* win = a.in[11]; const float* dtb = a.in[14];
    bf16* XN = (bf16*)(ws + WS_XN); bf16* PB = (bf16*)(ws + WS_PB); float* DT = (float*)(ws + WS_DT);
    for (int m = gw; m < MT; m += NGW) {
        const float* xrow = (m < MP) ? a.in[0] + (size_t)m * DM : a.in[1] + (size_t)(m - MP) * DM;
        const GAS f32x4* xr = (const GAS f32x4*)xrow + lane;
        f32x4 v[4]; float s = 0.f;
#pragma unroll
        for (int j = 0; j < 4; ++j) { v[j] = xr[64 * j]; s += (v[j].x * v[j].x + v[j].y * v[j].y) + (v[j].z * v[j].z + v[j].w * v[j].w); }
        const float rstd = 1.0f / sqrtf(wave_sum(s) * (1.f / DM) + EPS);
        GAS unsigned long long* o8 = (GAS unsigned long long*)(XN + (size_t)m * DM) + lane;
        float dacc[8];
#pragma unroll
        for (int h = 0; h < 8; ++h) dacc[h] = 0.f;
#pragma unroll
        for (int j = 0; j < 4; ++j) {
            v[j] = v[j] * rstd;
            o8[64 * j] = (unsigned long long)pk2(v[j].x, v[j].y) | ((unsigned long long)pk2(v[j].z, v[j].w) << 32);
#pragma unroll
            for (int e = 0; e < 4; ++e) {
                const int k = 256 * j + 4 * lane + e; const float xv = v[j][e] * gmix[k];
                const f32x4 w0 = *(const f32x4*)(win + (size_t)k * IN_LD + NIN), w1 = *(const f32x4*)(win + (size_t)k * IN_LD + NIN + 4);
                dacc[0] += xv * w0.x; dacc[1] += xv * w0.y; dacc[2] += xv * w0.z; dacc[3] += xv * w0.w;
                dacc[4] += xv * w1.x; dacc[5] += xv * w1.y; dacc[6] += xv * w1.z; dacc[7] += xv * w1.w;
            }
        }
#pragma unroll
        for (int h = 0; h < 8; ++h) dacc[h] = softplusf(wave_sum(dacc[h]) + dtb[h]);
        if (lane == 0) { *(f32x4*)(DT + (size_t)m * 8) = (f32x4){dacc[0], dacc[1], dacc[2], dacc[3]}; *(f32x4*)(DT + (size_t)m * 8 + 4) = (f32x4){dacc[4], dacc[5], dacc[6], dacc[7]}; }
        const float* prow = (m < MP) ? a.in[2] + (size_t)m * DPLE : a.in[3] + (size_t)(m - MP) * DPLE;
        const f32x4 pv = *((const f32x4*)prow + lane);
        *((GAS unsigned long long*)(PB + (size_t)m * DPLE) + lane) = (unsigned long long)pk2(pv.x, pv.y) | ((unsigned long long)pk2(pv.z, pv.w) << 32);
    }
}

__device__ __forceinline__ void load8bf(const bf16* p, float (&o)[8]) {
    const v4u w = *(const v4u*)p;
    o[0] = bflo(w.x); o[1] = bfhi(w.x); o[2] = bflo(w.y); o[3] = bfhi(w.y); o[4] = bflo(w.z); o[5] = bfhi(w.z); o[6] = bflo(w.w); o[7] = bfhi(w.w);
}
__device__ __forceinline__ void load8f(const float* p, float (&o)[8]) {
    const f32x4 a = *(const f32x4*)p, b = *(const f32x4*)(p + 4);
    o[0] = a.x; o[1] = a.y; o[2] = a.z; o[3] = a.w; o[4] = b.x; o[5] = b.y; o[6] = b.z; o[7] = b.w;
}
__device__ __forceinline__ void conv_sample_pass(const Args& a, int gtid, int NT) {
    const bf16* PROJ = (const bf16*)(a.ws + WS_PROJ); float* XB = (float*)(a.ws + WS_XBS); bf16* XC = (bf16*)(a.ws + WS_XC);
    const float* cw = a.in[12]; const float* cb = a.in[13]; const float* sconv = a.in[7];
    for (int it = gtid; it < NBS * 128; it += NT) {
        const int b = it >> 7, c = (it & 127) * 8, m0 = MP + b * 8;
        float w0[8], w1[8], w2[8], w3[8], bb[8], x3[8], x2[8], x1[8];
        load8f(cw + c, w0); load8f(cw + 1024 + c, w1); load8f(cw + 2048 + c, w2); load8f(cw + 3072 + c, w3); load8f(cb + c, bb);
        load8f(sconv + (size_t)(b * 3 + 0) * 1024 + c, x3); load8f(sconv + (size_t)(b * 3 + 1) * 1024 + c, x2); load8f(sconv + (size_t)(b * 3 + 2) * 1024 + c, x1);
#pragma unroll
        for (int r = 0; r < 8; ++r) {
            float cur[8], y[8]; load8bf(PROJ + (size_t)(m0 + r) * NIN + PC_X + c, cur);
#pragma unroll
            for (int k = 0; k < 8; ++k) { y[k] = siluf(bb[k] + w0[k] * x3[k] + w1[k] * x2[k] + w2[k] * x1[k] + w3[k] * cur[k]); x3[k] = x2[k]; x2[k] = x1[k]; x1[k] = cur[k]; }
            float* o = XB + (size_t)(b * 8 + r) * 1024 + c;
            *(f32x4*)o = (f32x4){y[0], y[1], y[2], y[3]}; *(f32x4*)(o + 4) = (f32x4){y[4], y[5], y[6], y[7]};
            if (c < 512) { v4u w; w.x = pk2(y[0], y[1]); w.y = pk2(y[2], y[3]); w.z = pk2(y[4], y[5]); w.w = pk2(y[6], y[7]); *(v4u*)(XC + (size_t)(m0 + r) * 512 + c) = w; }
        }
    }
}

constexpr int S1_BR = 0, S1_CR = 32768, S1_BT = 65536, S1_XT = 98304, S1_XW = 114688, S1_AC = 133120;
__device__ __forceinline__ void ssd_s1_unit(const Args& a, LAS unsigned char* lds, int unit, int tid, int wave, int lane) {
    const int h = unit & 7, c = (unit >> 3) & 31, b = unit >> 8, g = h >> 2, m0 = b * SEQ + c * 128;
    const bf16* PROJ = (const bf16*)(a.ws + WS_PROJ); const float* DT = (const float*)(a.ws + WS_DT);
    LAS float* ac = (LAS float*)(lds + S1_AC); LAS float* dts = ac + 128;
    const int r32 = lane & 31, hh = lane >> 5;
    if (wave == 0) {
        const float A = -__expf(a.in[15][h]);
        const float d0 = DT[(size_t)(m0 + 2 * lane) * 8 + h], d1 = DT[(size_t)(m0 + 2 * lane + 1) * 8 + h];
        const float a0 = d0 * A, a1 = d1 * A; float v = a0 + a1;
#pragma unroll
        for (int d = 1; d < 64; d <<= 1) { const float n = __shfl_up(v, d); if (lane >= d) v += n; }
        const float e0 = v - a1, e1 = v;
        ac[2 * lane] = e0; ac[2 * lane + 1] = e1; dts[2 * lane] = d0; dts[2 * lane + 1] = d1;
        float* ACUM = (float*)(a.ws + WS_ACUM); ACUM[(size_t)(m0 + 2 * lane) * 8 + h] = e0; ACUM[(size_t)(m0 + 2 * lane + 1) * 8 + h] = e1;
        if (lane == 63) ((float*)(a.ws + WS_ACL))[(b * 32 + c) * 8 + h] = e1;
    }
    __syncthreads();
#ifndef S1SUB
#define S1SUB 7
#endif
    if ((S1SUB & 1) && tid < 320) {
        const int o = tid % 40, rc = tid / 40, s0 = rc * 16;
        const int xcol = (o < 8) ? h * 64 + 8 * o : (o < 24) ? 512 + g * 128 + 8 * (o - 8) : 768 + g * 128 + 8 * (o - 24);
        const float* cw = a.in[12]; const float* cb = a.in[13];
        float w0[8], w1[8], w2[8], w3[8], bb[8], x3[8], x2[8], x1[8];
        load8f(cw + xcol, w0); load8f(cw + 1024 + xcol, w1); load8f(cw + 2048 + xcol, w2); load8f(cw + 3072 + xcol, w3); load8f(cb + xcol, bb);
        const bf16* src = PROJ + (size_t)(m0 + s0) * NIN + PC_X + xcol;
        if (c == 0 && rc == 0) {
#pragma unroll
            for (int k = 0; k < 8; ++k) { x3[k] = 0.f; x2[k] = 0.f; x1[k] = 0.f; }
        } else { load8bf(src - 3 * NIN, x3); load8bf(src - 2 * NIN, x2); load8bf(src - NIN, x1); }
        const float aL = ac[127];
        bf16* XC = (bf16*)(a.ws + WS_XC); bf16* CC = (bf16*)(a.ws + WS_CC);
#pragma unroll 1
        for (int r = 0; r < 16; ++r) {
            const int sr = s0 + r; float cur[8], y[8]; load8bf(src + (size_t)r * NIN, cur);
#pragma unroll
            for (int k = 0; k < 8; ++k) { y[k] = siluf(bb[k] + w0[k] * x3[k] + w1[k] * x2[k] + w2[k] * x1[k] + w3[k] * cur[k]); x3[k] = x2[k]; x2[k] = x1[k]; x1[k] = cur[k]; }
            v4u w; w.x = pk2(y[0], y[1]); w.y = pk2(y[2], y[3]); w.z = pk2(y[4], y[5]); w.w = pk2(y[6], y[7]);
            if (o < 8) {
                const int off = (o >> 2) * 8192 + (sr >> 4) * 1024 + (sr & 15) * 64 + (o & 3) * 16;
                *(LAS v4u*)(lds + S1_XT + off) = w;
                const float de = __expf(aL - ac[sr]) * dts[sr];
                v4u ww; ww.x = pk2(y[0] * de, y[1] * de); ww.y = pk2(y[2] * de, y[3] * de); ww.z = pk2(y[4] * de, y[5] * de); ww.w = pk2(y[6] * de, y[7] * de);
                *(LAS v4u*)(lds + S1_XW + off) = ww;
                *(v4u*)(XC + (size_t)(m0 + sr) * 512 + h * 64 + 8 * o) = w;
            } else if (o < 24) {
                const int ch = o - 8;
                *(LAS v4u*)(lds + S1_BR + sr * 256 + ((ch ^ (sr & 15)) << 4)) = w;
                *(LAS v4u*)(lds + S1_BT + (ch >> 2) * 8192 + (sr >> 4) * 1024 + (sr & 15) * 64 + (ch & 3) * 16) = w;
            } else {
                const int ch = o - 24;
                *(LAS v4u*)(lds + S1_CR + sr * 256 + ((ch ^ (sr & 15)) << 4)) = w;
                if ((h & 3) == 0) *(v4u*)(CC + (size_t)(m0 + sr) * 256 + g * 128 + 8 * ch) = w;
            }
        }
    }
    __syncthreads();
    const int laneoff = ((lane >> 4) & 1) * 32 + (lane & 3) * 8 + (4 * hh + ((lane & 15) >> 2)) * 64;
    if (S1SUB & 2) {
        const int tb = wave >> 1, ph = wave & 1, tq = 32 * tb + r32;
        bf16x8 cq[8];
#pragma unroll
        for (int k = 0; k < 8; ++k) cq[k] = *(const LAS bf16x8*)(lds + S1_CR + tq * 256 + (((2 * k + hh) ^ (tq & 15)) << 4));
        const float act = ac[tq] * LOG2E;
        f32x16 o;
#pragma unroll
        for (int i = 0; i < 16; ++i) o[i] = 0.f;
#pragma unroll 1
        for (int sb = 0; sb <= tb; ++sb) {
            {
                f32x16 S;
#pragma unroll
                for (int i = 0; i < 16; ++i) S[i] = 0.f;
                const int sq = 32 * sb + r32;
#pragma unroll
                for (int k = 0; k < 8; ++k) { const bf16x8 bf = *(const LAS bf16x8*)(lds + S1_BR + sq * 256 + (((2 * k + hh) ^ (sq & 15)) << 4)); S = __builtin_amdgcn_mfma_f32_32x32x16_bf16(bf, cq[k], S, 0, 0, 0); }
#pragma unroll
                for (int i = 0; i < 16; ++i) { const int si = 32 * sb + crow(i, hh); const float e = __builtin_amdgcn_exp2f(act - ac[si] * LOG2E) * dts[si]; S[i] = (si <= tq) ? S[i] * e : 0.f; }
#pragma unroll
                for (int ks = 0; ks < 2; ++ks) {
                    v4u pw; pw.x = cvtpk_s(S[8 * ks + 0], S[8 * ks + 1]); pw.y = cvtpk_s(S[8 * ks + 2], S[8 * ks + 3]); pw.z = cvtpk_s(S[8 * ks + 4], S[8 * ks + 5]); pw.w = cvtpk_s(S[8 * ks + 6], S[8 * ks + 7]);
                    const bf16x8 pa = __builtin_bit_cast(bf16x8, pw);
                    const LAS unsigned char* xp = lds + S1_XT + ph * 8192 + (2 * sb + ks) * 1024 + laneoff;
                    const v4i16_t lo = vtr(xp), hi2 = vtr(xp + 512);
                    const bf16x8 xb = (bf16x8){lo[0], lo[1], lo[2], lo[3], hi2[0], hi2[1], hi2[2], hi2[3]};
                    o = __builtin_amdgcn_mfma_f32_32x32x16_bf16(pa, xb, o, 0, 0, 0);
                }
            }
        }
        float* YS = (float*)(a.ws + WS_YS);
#pragma unroll
        for (int i = 0; i < 16; ++i) YS[(size_t)(m0 + 32 * tb + crow(i, hh)) * 512 + h * 64 + 32 * ph + r32] = o[i];
    }
    if (S1SUB & 4) {
        const int pb = wave & 1, nb = wave >> 1;
        f32x16 st;
#pragma unroll
        for (int i = 0; i < 16; ++i) st[i] = 0.f;
#pragma unroll
        for (int k = 0; k < 8; ++k) {
            const LAS unsigned char* ap = lds + S1_XW + pb * 8192 + k * 1024 + laneoff; const LAS unsigned char* bp = lds + S1_BT + nb * 8192 + k * 1024 + laneoff;
            const v4i16_t al = vtr(ap), ah = vtr(ap + 512), bl = vtr(bp), bh = vtr(bp + 512);
            const bf16x8 af = (bf16x8){al[0], al[1], al[2], al[3], ah[0], ah[1], ah[2], ah[3]}, bf = (bf16x8){bl[0], bl[1], bl[2], bl[3], bh[0], bh[1], bh[2], bh[3]};
            st = __builtin_amdgcn_mfma_f32_32x32x16_bf16(af, bf, st, 0, 0, 0);
        }
        float* CS = (float*)(a.ws + WS_CS) + (size_t)((b * 32 + c) * 8 + h) * 64 * 128;
#pragma unroll
        for (int i = 0; i < 16; ++i) CS[(size_t)(32 * pb + crow(i, hh)) * 128 + 32 * nb + r32] = st[i];
    }
    LDS_WAIT(); __syncthreads();
}
__device__ __forceinline__ void ssd_s2_pass(const Args& a, int gtid, int NT) {
    typedef float f32x2t __attribute__((ext_vector_type(2)));
    const float* CS = (const float*)(a.ws + WS_CS); const float* ACL = (const float*)(a.ws + WS_ACL); bf16* PREV = (bf16*)(a.ws + WS_PREV);
    for (int it = gtid; it < NBP * 8 * 64 * 64; it += NT) {
        const int n2 = it & 63, p = (it >> 6) & 63, h = (it >> 12) & 7, b = it >> 15;
        f32x2t s = {0.f, 0.f};
#pragma unroll 8
        for (int c = 0; c < 32; ++c) {
            const size_t idx = ((size_t)((b * 32 + c) * 8 + h) * 64 + p) * 128 + 2 * n2;
            const f32x2t cs = *(const f32x2t*)(CS + idx); const float dec = __expf(ACL[(b * 32 + c) * 8 + h]);
            *(unsigned*)(PREV + idx) = pk2(s.x, s.y);
            s = s * dec + cs;
        }
        *(f32x2t*)(a.out + O_SP + ((size_t)((b * 8 + h) * 64 + p)) * 128 + 2 * n2) = s;
    }
}
__device__ __forceinline__ void ssd_s3_unit(const Args& a, int unit, int wave, int lane) {
    const int h = unit & 7, c = (unit >> 3) & 31, b = unit >> 8, g = h >> 2, m0 = b * SEQ + c * 128;
    const int r32 = lane & 31, hh = lane >> 5, tb = wave >> 1, ph = wave & 1;
    const bf16* cp = (const bf16*)(a.ws + WS_CC) + (size_t)(m0 + 32 * tb + r32) * 256 + g * 128 + 8 * hh;
    const bf16* pp = (const bf16*)(a.ws + WS_PREV) + ((size_t)((b * 32 + c) * 8 + h) * 64 + 32 * ph + r32) * 128 + 8 * hh;
    bf16x8 cf[8], pf[8];
#pragma unroll
    for (int k = 0; k < 8; ++k) { cf[k] = *(const bf16x8*)(cp + 16 * k); pf[k] = *(const bf16x8*)(pp + 16 * k); }
    f32x16 acc;
#pragma unroll
    for (int i = 0; i < 16; ++i) acc[i] = 0.f;
#pragma unroll
    for (int k = 0; k < 8; ++k) acc = __builtin_amdgcn_mfma_f32_32x32x16_bf16(cf[k], pf[k], acc, 0, 0, 0);
    float* YS = (float*)(a.ws + WS_YS); const float* ACUM = (const float*)(a.ws + WS_ACUM);
#pragma unroll
    for (int i = 0; i < 16; ++i) { const size_t t = (size_t)(m0 + 32 * tb + crow(i, hh)); float* yp = YS + t * 512 + h * 64 + 32 * ph + r32; *yp = *yp + __expf(ACUM[t * 8 + h]) * acc[i]; }
}

constexpr int ATT_WAVE_BYTES = 8704, ATT_VB = 0, ATT_STG = 4096, ATT_WSF = 8192, ATT_BTAB_OFF = 8 * ATT_WAVE_BYTES  , ATT_BT_LD = 132;

__device__ __forceinline__ void attn_build_btab(const Args& a, LAS unsigned char* lds, int tid) {
    LAS float* bt = (LAS float*)(lds + ATT_BTAB_OFF); const float* rb = a.in[9];
    for (int i = tid; i < 3 * 8 * 129; i += NWAVES * 64) { const int br = i / (8 * 129), rem = i % (8 * 129), h = rem / 129, j = rem % 129; bt[(br * 8 + h) * ATT_BT_LD + j] = rb[BUCKET_TAB[br][j] * 8 + h] * LOG2E; }
}
__device__ __forceinline__ void attn_prompt_unit(const Args& a, LAS unsigned char* lds, int unit, int wave, int lane) {
    const bf16* PROJ = (const bf16*)(a.ws + WS_PROJ);
    const int r32 = lane & 31, hi = lane >> 5;
    const int rq = unit & 127, bhb = unit >> 7, br = bhb % 3, bh = bhb / 3, h = bh & 7, b = bh >> 3;
    const int sh = 2 * br, dil = 1 << sh, nqb = 128 >> sh, r = rq / nqb, qb = rq % nqb, l0 = qb * 32;
    const size_t rowb = (size_t)b * SEQ;
    LAS unsigned char* wl = lds + wave * ATT_WAVE_BYTES;
    const LAS float* bt = (const LAS float*)(lds + ATT_BTAB_OFF) + (br * 8 + h) * ATT_BT_LD;
    bf16x8 qr[4];
    { const bf16* qp = PROJ + (rowb + (size_t)(l0 + r32) * dil + r) * NIN + h * 64 + hi * 8;
#pragma unroll
      for (int d0 = 0; d0 < 4; ++d0) qr[d0] = *(const bf16x8*)(qp + d0 * 16); }
    const int kb0 = (l0 >= 128) ? 0 : (4 - (l0 >> 5));
    f32x16 s[5];
#pragma unroll
    for (int kb = 0; kb < 5; ++kb) {
#pragma unroll
        for (int i = 0; i < 16; ++i) s[kb][i] = 0.f;
        if (kb >= kb0) {
            int kk = l0 - 128 + 32 * kb + r32; kk = kk < 0 ? 0 : kk;
            const bf16* kp = PROJ + (rowb + (size_t)kk * dil + r) * NIN + PC_K + h * 64 + hi * 8;
            bf16x8 kf[4];
#pragma unroll
            for (int d0 = 0; d0 < 4; ++d0) kf[d0] = *(const bf16x8*)(kp + d0 * 16);
#pragma unroll
            for (int d0 = 0; d0 < 4; ++d0) s[kb] = __builtin_amdgcn_mfma_f32_32x32x16_bf16(kf[d0], qr[d0], s[kb], 0, 0, 0);
        }
    }
    float mx = -INFINITY;
#pragma unroll
    for (int kb = 0; kb < 5; ++kb)
#pragma unroll
        for (int i = 0; i < 16; ++i) {
            const int c = crow(i, hi), j = r32 - c + 128 - 32 * kb, kk = l0 - 128 + 32 * kb + c;
            const bool valid = (j >= 0) && (j <= 128) && (kk >= 0) && (kb >= kb0);
            const int jc = j < 0 ? 0 : (j > 128 ? 128 : j);
            const float v = valid ? s[kb][i] + bt[jc] : -INFINITY;
            s[kb][i] = v; mx = fmaxf(mx, v);
        }
    mx = fmaxf(mx, __shfl_xor(mx, 32));
    float l = 0.f;
#pragma unroll
    for (int kb = 0; kb < 5; ++kb)
#pragma unroll
        for (int i = 0; i < 16; ++i) { const float p = __builtin_amdgcn_exp2f(s[kb][i] - mx); s[kb][i] = p; l += p; }
    l += __shfl_xor(l, 32);
    f32x16 o[2];
#pragma unroll
    for (int i = 0; i < 16; ++i) { o[0][i] = 0.f; o[1][i] = 0.f; }
    const LAS unsigned char* vrd = wl + ATT_VB + ((lane >> 4) & 1) * 32 + (lane & 3) * 8 + (4 * hi + ((lane & 15) >> 2)) * 64;
#pragma unroll
    for (int kb = 0; kb < 5; ++kb) {
        if (kb >= kb0) {
#pragma unroll
            for (int i = 0; i < 4; ++i) {
                const int idx = i * 64 + lane, key = idx >> 3, ch = idx & 7;
                int kk = l0 - 128 + 32 * kb + key; kk = kk < 0 ? 0 : kk;
                const v4u vv = *(const v4u*)(PROJ + (rowb + (size_t)kk * dil + r) * NIN + PC_V + h * 64 + ch * 8);
                *(LAS v4u*)(wl + ATT_VB + (ch >> 2) * 2048 + (key >> 4) * 1024 + (key & 15) * 64 + (ch & 3) * 16) = vv;
            }
            LDS_WAIT();
#pragma unroll
            for (int ks = 0; ks < 2; ++ks) {
                v4u pw;
                pw.x = cvtpk_s(s[kb][8 * ks + 0], s[kb][8 * ks + 1]); pw.y = cvtpk_s(s[kb][8 * ks + 2], s[kb][8 * ks + 3]);
                pw.z = cvtpk_s(s[kb][8 * ks + 4], s[kb][8 * ks + 5]); pw.w = cvtpk_s(s[kb][8 * ks + 6], s[kb][8 * ks + 7]);
                const bf16x8 pa = __builtin_bit_cast(bf16x8, pw);
#pragma unroll
                for (int d0 = 0; d0 < 2; ++d0) {
                    const v4i16_t lo = vtr(vrd + d0 * 2048 + ks * 1024), hh = vtr(vrd + d0 * 2048 + ks * 1024 + 512);
                    const bf16x8 vb = (bf16x8){lo[0], lo[1], lo[2], lo[3], hh[0], hh[1], hh[2], hh[3]};
                    o[d0] = __builtin_amdgcn_mfma_f32_32x32x16_bf16(pa, vb, o[d0], 0, 0, 0);
                }
            }
            LDS_WAIT();
        }
    }
    LAS float* wsf = (LAS float*)(wl + ATT_WSF);
    if (hi == 0) wsf[r32] = l;
    LDS_WAIT();
    LAS bf16* stg = (LAS bf16*)(wl + ATT_STG);
#pragma unroll
    for (int i = 0; i < 16; ++i) {
        const int orow = crow(i, hi); const float rl = 1.0f / wsf[orow];
        stg[orow * 64 + r32] = (bf16)f2bf(o[0][i] * rl); stg[orow * 64 + 32 + r32] = (bf16)f2bf(o[1][i] * rl);
    }
    LDS_WAIT();
    bf16* OBR = (bf16*)(a.ws + WS_OBR) + (size_t)br * MP * 512;
#pragma unroll
    for (int i = 0; i < 4; ++i) {
        const int row = i * 8 + (lane >> 3), ch = lane & 7;
        const v4u v = *(const LAS v4u*)(stg + row * 64 + ch * 8);
        *(v4u*)(OBR + (rowb + (size_t)(l0 + row) * dil + r) * 512 + h * 64 + ch * 8) = v;
    }
    if (hi == 0) { float* LSE = (float*)(a.ws + WS_LSE) + (size_t)br * MP * 8; LSE[(rowb + (size_t)(l0 + r32) * dil + r) * 8 + h] = mx + __builtin_amdgcn_logf(l); }
    LDS_WAIT();
}

__device__ __forceinline__ void attn_sample_task(const Args& a, LAS unsigned char* lds, int task, int wave, int lane) {
    const int h = task & 7, t = (task >> 3) & 7, b = task >> 6;
    const bf16* PROJ = (const bf16*)(a.ws + WS_PROJ);
    const float* ck = a.in[4]; const float* cv = a.in[5]; const float* kn = a.out + O_KS; const float* vn = a.out + O_VS;
    LAS float* pl = (LAS float*)(lds + wave * ATT_WAVE_BYTES + ATT_STG);
    float q[64];
    { const bf16* qp = PROJ + (size_t)(MP + b * 8 + t) * NIN + h * 64;
#pragma unroll
      for (int i = 0; i < 8; ++i) { float tmp[8]; load8bf(qp + i * 8, tmp);
#pragma unroll
          for (int k = 0; k < 8; ++k) q[i * 8 + k] = tmp[k]; } }
    float mx = -INFINITY;
#pragma unroll 1
    for (int br = 0; br < 3; ++br) {
        const int dil = 1 << (2 * br);
        const LAS float* bt = (const LAS float*)(lds + ATT_BTAB_OFF) + (br * 8 + h) * ATT_BT_LD;
#pragma unroll 1
        for (int jj = 0; jj < 3; ++jj) {
            const int j = jj * 64 + lane;
            if (j <= 128) {
                const int idx = WBUF + t - j * dil;
                const float* kp = (idx < WBUF) ? ck + ((size_t)(b * WBUF + idx) * 8 + h) * 64 : kn + ((size_t)(b * 8 + (idx - WBUF)) * 8 + h) * 64;
                float d = 0.f;
#pragma unroll
                for (int i = 0; i < 16; ++i) { const f32x4 kv = *(const f32x4*)(kp + i * 4); d += q[4 * i] * kv.x + q[4 * i + 1] * kv.y + q[4 * i + 2] * kv.z + q[4 * i + 3] * kv.w; }
                const float v = d + bt[j];
                pl[br * ATT_BT_LD + j] = v; mx = fmaxf(mx, v);
            }
        }
    }
    mx = wave_max(mx);
    LDS_WAIT(); asm volatile("" ::: "memory");
    float l = 0.f;
#pragma unroll 1
    for (int i = lane; i < 3 * ATT_BT_LD; i += 64) { const int j = i % ATT_BT_LD; if (j <= 128) { const float p = __builtin_amdgcn_exp2f(pl[i] - mx); pl[i] = p; l += p; } }
    l = wave_sum(l);
    LDS_WAIT(); asm volatile("" ::: "memory");
    float o = 0.f;
#pragma unroll
    for (int br = 0; br < 3; ++br) {
        const int dil = 1 << (2 * br);
#pragma unroll 4
        for (int j = 0; j <= 128; ++j) {
            const int idx = WBUF + t - j * dil;
            const float* vp = (idx < WBUF) ? cv + ((size_t)(b * WBUF + idx) * 8 + h) * 64 : vn + ((size_t)(b * 8 + (idx - WBUF)) * 8 + h) * 64;
            o += pl[br * ATT_BT_LD + j] * vp[lane];
        }
    }
    bf16* MIX = (bf16*)(a.ws + WS_MIX);
    MIX[(size_t)(MP + b * 8 + t) * DM + h * 64 + lane] = (bf16)f2bf(o / l);
    LDS_WAIT(); asm volatile("" ::: "memory");
}

__device__ __forceinline__ void ssd_sample_task(const Args& a, int k, int lane) {
    const float* XB = (const float*)(a.ws + WS_XBS); const float* DT = (const float*)(a.ws + WS_DT); float* YS = (float*)(a.ws + WS_YS);
    const int b = k >> 9, h = (k >> 6) & 7, p = k & 63, g = h >> 2;
    const float* si = a.in[6] + ((size_t)((b * 8 + h) * 64 + p)) * 128; float s0 = si[lane], s1 = si[lane + 64];
    float* sout = a.out + O_SS + ((size_t)((b * 8 + h) * 64 + p)) * 128;
    const float A = -__expf(a.in[15][h]);
    for (int t = 0; t < TS; t += 4) {
        float dtv[4], xv[4], B0[4], B1[4], C0[4], C1[4];
#pragma unroll
        for (int q = 0; q < 4; ++q) { const int r = b * TS + t + q; dtv[q] = DT[(size_t)(MP + r) * 8 + h]; const float* xr = XB + (size_t)r * 1024; xv[q] = xr[h * 64 + p]; B0[q] = xr[512 + g * 128 + lane]; B1[q] = xr[512 + g * 128 + 64 + lane]; C0[q] = xr[768 + g * 128 + lane]; C1[q] = xr[768 + g * 128 + 64 + lane]; }
        float y[4];
#pragma unroll
        for (int q = 0; q < 4; ++q) { const float da = __expf(dtv[q] * A), xd = dtv[q] * xv[q]; s0 = da * s0 + xd * B0[q]; s1 = da * s1 + xd * B1[q]; y[q] = C0[q] * s0 + C1[q] * s1; }
#pragma unroll
        for (int q = 0; q < 4; ++q) y[q] = wave_sum(y[q]);
        if (lane == 0) {
#pragma unroll
            for (int q = 0; q < 4; ++q) YS[(size_t)(MP + b * TS + t + q) * 512 + h * 64 + p] = y[q];
        }
    }
    sout[lane] = s0; sout[lane + 64] = s1;
}
__device__ __forceinline__ void attn_combine_pass(const Args& a, int gtid, int NT) {
    const bf16* OBR = (const bf16*)(a.ws + WS_OBR); const float* LSE = (const float*)(a.ws + WS_LSE); bf16* MIX = (bf16*)(a.ws + WS_MIX);
    for (int it = gtid; it < MP * 64; it += NT) {
        const int row = it >> 6, c8 = it & 63, h = c8 >> 3;
        const float l0 = LSE[(size_t)row * 8 + h], l1 = LSE[(size_t)(MP + row) * 8 + h], l2 = LSE[(size_t)(2 * MP + row) * 8 + h];
        const float mx = fmaxf(l0, fmaxf(l1, l2));
        float w0 = __builtin_amdgcn_exp2f(l0 - mx), w1 = __builtin_amdgcn_exp2f(l1 - mx), w2 = __builtin_amdgcn_exp2f(l2 - mx);
        const float inv = 1.f / (w0 + w1 + w2); w0 *= inv; w1 *= inv; w2 *= inv;
        float o0[8], o1[8], o2[8];
        load8bf(OBR + (size_t)row * 512 + c8 * 8, o0); load8bf(OBR + ((size_t)MP + row) * 512 + c8 * 8, o1); load8bf(OBR + ((size_t)2 * MP + row) * 512 + c8 * 8, o2);
        float r[8];
#pragma unroll
        for (int k = 0; k < 8; ++k) r[k] = w0 * o0[k] + w1 * o1[k] + w2 * o2[k];
        v4u w; w.x = pk2(r[0], r[1]); w.y = pk2(r[2], r[3]); w.z = pk2(r[4], r[5]); w.w = pk2(r[6], r[7]);
        *(v4u*)(MIX + (size_t)row * DM + c8 * 8) = w;
    }
}
__device__ __forceinline__ void ssd_finish_pass(const Args& a, int gw, int NGW, int lane) {
    const bf16* XC = (const bf16*)(a.ws + WS_XC); const float* YS = (const float*)(a.ws + WS_YS); const bf16* PROJ = (const bf16*)(a.ws + WS_PROJ); bf16* MIX = (bf16*)(a.ws + WS_MIX);
    const float* dsk = a.in[16]; const float* gs = a.in[17];
    const int c = lane * 8; const float dh = dsk[c >> 6];
    float g8[8]; load8f(gs + c, g8);
    for (int m = gw; m < MT; m += NGW) {
        float y[8], x[8], z[8], v[8]; load8f(YS + (size_t)m * 512 + c, y); load8bf(XC + (size_t)m * 512 + c, x); load8bf(PROJ + (size_t)m * NIN + PC_Z + c, z);
        float ss = 0.f;
#pragma unroll
        for (int k = 0; k < 8; ++k) { v[k] = (y[k] + dh * x[k]) * siluf(z[k]); ss += v[k] * v[k]; }
#pragma unroll
        for (int o = 1; o < 32; o <<= 1) ss += __shfl_xor(ss, o);
        const float rs = 1.0f / sqrtf(ss * (1.f / 256.f) + EPS);
        v4u w; w.x = pk2(v[0] * rs * g8[0], v[1] * rs * g8[1]); w.y = pk2(v[2] * rs * g8[2], v[3] * rs * g8[3]); w.z = pk2(v[4] * rs * g8[4], v[5] * rs * g8[5]); w.w = pk2(v[6] * rs * g8[6], v[7] * rs * g8[7]);
        *(v4u*)(MIX + (size_t)m * DM + 512 + c) = w;
    }
}
__device__ __forceinline__ void ffn_conv_pass(const Args& a, int gtid, int NT) {
    const bf16* U = (const bf16*)(a.ws + WS_U); bf16* ACT = (bf16*)(a.ws + WS_ACT);
    const float* fw = a.in[21]; const float* fb = a.in[22]; const float* sf = a.in[8];
    constexpr int NC8 = DFF / 8, NPB = MP / 16, NITEMS = (NPB + NBS) * NC8;
    for (int it = gtid; it < NITEMS; it += NT) {
        const int blk = it / NC8, c = (it % NC8) * 8;
        float wa0[8], wa1[8], wa2[8], wb0[8], wb1[8], wb2[8], ba[8], bb[8], a2[8], a1[8], b2[8], b1[8];
        load8f(fw + c, wa0); load8f(fw + DFF2 + c, wa1); load8f(fw + 2 * DFF2 + c, wa2); load8f(fb + c, ba);
        load8f(fw + DFF + c, wb0); load8f(fw + DFF2 + DFF + c, wb1); load8f(fw + 2 * DFF2 + DFF + c, wb2); load8f(fb + DFF + c, bb);
        int m0, nr;
        if (blk < NPB) { m0 = blk * 16; nr = 16;
            if ((m0 & (SEQ - 1)) == 0) {
#pragma unroll
                for (int k = 0; k < 8; ++k) { a2[k] = 0.f; a1[k] = 0.f; b2[k] = 0.f; b1[k] = 0.f; }
            } else { load8bf(U + (size_t)(m0 - 2) * DFF2 + c, a2); load8bf(U + (size_t)(m0 - 1) * DFF2 + c, a1); load8bf(U + (size_t)(m0 - 2) * DFF2 + DFF + c, b2); load8bf(U + (size_t)(m0 - 1) * DFF2 + DFF + c, b1); }
        } else { const int b = blk - NPB; m0 = MP + b * 8; nr = 8;
            load8f(sf + (size_t)(b * 2) * DFF2 + c, a2); load8f(sf + (size_t)(b * 2 + 1) * DFF2 + c, a1); load8f(sf + (size_t)(b * 2) * DFF2 + DFF + c, b2); load8f(sf + (size_t)(b * 2 + 1) * DFF2 + DFF + c, b1); }
        for (int r = 0; r < nr; ++r) {
            float ua[8], ub[8], o[8]; load8bf(U + (size_t)(m0 + r) * DFF2 + c, ua); load8bf(U + (size_t)(m0 + r) * DFF2 + DFF + c, ub);
#pragma unroll
            for (int k = 0; k < 8; ++k) {
                const float ya = ba[k] + wa0[k] * a2[k] + wa1[k] * a1[k] + wa2[k] * ua[k], yb = bb[k] + wb0[k] * b2[k] + wb1[k] * b1[k] + wb2[k] * ub[k];
                o[k] = siluf(ya) * yb; a2[k] = a1[k]; a1[k] = ua[k]; b2[k] = b1[k]; b1[k] = ub[k];
            }
            v4u w; w.x = pk2(o[0], o[1]); w.y = pk2(o[2], o[3]); w.z = pk2(o[4], o[5]); w.w = pk2(o[6], o[7]);
            *(v4u*)(ACT + (size_t)(m0 + r) * DFF + c) = w;
        }
    }
}
__device__ __forceinline__ void final_norm_pass(const Args& a, int gw, int NGW, int lane) {
    const float* RS3 = (const float*)(a.ws + WS_RS3); const float* gf = a.in[27];
    f32x4 g[4];
#pragma unroll
    for (int j = 0; j < 4; ++j) g[j] = *((const f32x4*)gf + lane + 64 * j);
    for (int m = gw; m < MT; m += NGW) {
        float* orow = (m < MP) ? a.out + O_Y + (size_t)m * DM : a.out + O_YS + (size_t)(m - MP) * DM;
        const float rs = 1.0f / sqrtf(RS3[m] * (1.f / DM) + EPS);
#pragma unroll
        for (int j = 0; j < 4; ++j) { f32x4* p = (f32x4*)orow + lane + 64 * j; *p = (*p) * rs * g[j]; }
    }
}

constexpr int NPH = 12;
#ifndef MK_N_LAUNCHES
#define MK_N_LAUNCHES 1
#endif
constexpr int N_LAUNCHES = MK_N_LAUNCHES;
__global__ void __launch_bounds__(NWAVES * 64, 2) mk_fwd(Args args) {
    extern __shared__ __attribute__((aligned(16))) unsigned char lds_raw[];
    LAS unsigned char* lds = (LAS unsigned char*)lds_raw;
    volatile LAS unsigned* MISC = (volatile LAS unsigned*)(lds + MISC_OFF);
    const int tid = threadIdx.x, lane = tid & 63, wave = __builtin_amdgcn_readfirstlane(tid >> 6);
    const int G = gridDim.x, bx = blockIdx.x, vcu = (G % 8 == 0) ? (bx % 8) * (G / 8) + bx / 8 : bx;
    const int gw = vcu * NWAVES + wave, NGW = G * NWAVES, gtid = vcu * (NWAVES * 64) + tid, NT = G * NWAVES * 64;
    unsigned char* ws = args.ws;
    gu32* ctl = (gu32*)(ws + WS_CTL);
    for (int u = tid; u < (LDS_BYTES - LDSCTL_OFF) / 4; u += NWAVES * 64) ((LAS unsigned*)(lds + LDSCTL_OFF))[u] = 0u;
    __syncthreads();
    XcdBarrier bar; bar.bar = (unsigned*)(ctl + CW_BAR); bar.x = 0; bar.st = nullptr;
    if (N_LAUNCHES == 1) bar = xcd_barrier_post((unsigned*)(ctl + CW_BAR), MISC + 8);
    const int lo = args.ph_lo, hi = args.ph_hi;
#ifndef PHMASK
#define PHMASK 0xfff
#endif
#define IN(k) (((PHMASK >> (k)) & 1) && lo <= (k) && (k) < hi)
#define SEAM(k) do { if (IN(k) && IN((k) + 1)) xcd_barrier(bar); } while (0)

    if (IN(0)) { p0_prologue(args, lds, gw, NGW, wave, lane); VM_WAIT(); __syncthreads(); }
    SEAM(0);
    if (IN(1)) {
        pg8::Gemm g{(const pg8::bf16_t*)(ws + WS_XN), (const pg8::bf16_t*)(ws + WS_WIN), MT, NIN, DM}; pg8::StaticOrder S; S.init(MT, NIN, G, bx);
        EpiIn E{(pg8::bf16_t*)(ws + WS_PROJ), args.out};
        pg8::gemm_phase<EpiIn, pg8::StaticOrder, PG8_ALIGN, PG8_SP2>(lds, g, S, E);
    }
    SEAM(1);
    if (IN(2)) {
        attn_build_btab(args, lds, tid);
        conv_sample_pass(args, gtid, NT);
        __syncthreads();
#ifndef P2SUB
#define P2SUB 7
#endif
        if (P2SUB & 1) for (int task = gw; task < NBS * TS * NH; task += NGW) attn_sample_task(args, lds, task, wave, lane);
        __syncthreads();
        if (P2SUB & 2) for (int unit = gw; unit < NBP * NH * 3 * 128; unit += NGW) attn_prompt_unit(args, lds, unit, wave, lane);
        __syncthreads();
        if (P2SUB & 4) for (int unit = vcu; unit < NBP * 32 * 8; unit += G) ssd_s1_unit(args, lds, unit, tid, wave, lane);
        VM_WAIT(); __syncthreads();
    }
    SEAM(2);
    if (IN(3)) {
        ssd_s2_pass(args, gtid, NT);
        for (int task = gw; task < NBS * 512; task += NGW) ssd_sample_task(args, task, lane);
        attn_combine_pass(args, gtid, NT);
        VM_WAIT(); __syncthreads();
    }
    SEAM(3);
    if (IN(4)) {
        for (int unit = vcu; unit < NBP * 32 * 8; unit += G) ssd_s3_unit(args, unit, wave, lane);
        VM_WAIT(); __syncthreads();
    }
    SEAM(4);
    if (IN(5)) { ssd_finish_pass(args, gw, NGW, lane); VM_WAIT(); __syncthreads(); }
    SEAM(5);
    if (IN(6)) {
        { pg8::Gemm g{(const pg8::bf16_t*)(ws + WS_MIX), (const pg8::bf16_t*)(ws + WS_WOUT), MT, DM, DM}; pg8::StaticOrder S; S.init(MT, DM, G, bx);
          EpiOut E{args.in[0], args.in[1], (float*)(ws + WS_H1), (pg8::bf16_t*)(ws + WS_XN), (float*)(ws + WS_RS1)};
          pg8::gemm_phase<EpiOut, pg8::StaticOrder, PG8_ALIGN, PG8_SP2>(lds, g, S, E); }
        { pg8::Gemm g{(const pg8::bf16_t*)(ws + WS_PB), (const pg8::bf16_t*)(ws + WS_WPLE), MT, DM, DPLE}; pg8::StaticOrder S; S.init(MT, DM, G, bx);
          EpiPle E{(float*)(ws + WS_E), (float*)(ws + WS_RSE)};
          pg8::gemm_phase<EpiPle, pg8::StaticOrder, PG8_ALIGN, PG8_SP2>(lds, g, S, E); }
    }
    SEAM(6);
    if (IN(7)) {
        pg8::Gemm g{(const pg8::bf16_t*)(ws + WS_XN), (const pg8::bf16_t*)(ws + WS_WUP), MT, DFF2, DM}; pg8::StaticOrder S; S.init(MT, DFF2, G, bx);
        EpiUp E{(pg8::bf16_t*)(ws + WS_U), (const float*)(ws + WS_RS1), args.out};
        pg8::gemm_phase<EpiUp, pg8::StaticOrder, PG8_ALIGN, PG8_SP2>(lds, g, S, E);
    }
    SEAM(7);
    if (IN(8)) { ffn_conv_pass(args, gtid, NT); VM_WAIT(); __syncthreads(); }
    SEAM(8);
    if (IN(9)) {
        pg8::Gemm g{(const pg8::bf16_t*)(ws + WS_ACT), (const pg8::bf16_t*)(ws + WS_WDOWN), MT, DM, DFF}; pg8::StaticOrder S; S.init(MT, DM, G, bx);
        EpiDown E{(float*)(ws + WS_H1), (pg8::bf16_t*)(ws + WS_XN)};
        pg8::gemm_phase<EpiDown, pg8::StaticOrder, PG8_ALIGN, PG8_SP2>(lds, g, S, E);
    }
    SEAM(9);
    if (IN(10)) {
        pg8::Gemm g{(const pg8::bf16_t*)(ws + WS_XN), (const pg8::bf16_t*)(ws + WS_WGATE), MT, DM, DM}; pg8::StaticOrder S; S.init(MT, DM, G, bx);
        EpiGate E{(const float*)(ws + WS_H1), (const float*)(ws + WS_E), (const float*)(ws + WS_RSE), args.in[25], args.out, (float*)(ws + WS_RS3)};
        pg8::gemm_phase<EpiGate, pg8::StaticOrder, PG8_ALIGN, PG8_SP2>(lds, g, S, E);
    }
    SEAM(10);
    if (IN(11)) { final_norm_pass(args, gw, NGW, lane); }
#undef IN
#undef SEAM
}

extern "C" void kernel_launch(void* const* d_in, const int* in_sizes, int n_in, void* d_out, int out_size, void* d_ws, size_t ws_size, hipStream_t stream) {
    static int grid = 0;
    if (grid == 0) {
        if (n_in != 28 || out_size != (int)O_END || ws_size < WS_END) { fprintf(stderr, "kernel_launch: unexpected shapes: n_in %d out %d ws %zu\n", n_in, out_size, ws_size); grid = -1; return; }
        int dev = 0, cus = 0, per_cu = 0;
        if (hipGetDevice(&dev) != hipSuccess || hipDeviceGetAttribute(&cus, hipDeviceAttributeMultiprocessorCount, dev) != hipSuccess) { grid = -1; return; }
        if (hipFuncSetAttribute((const void*)mk_fwd, hipFuncAttributeMaxDynamicSharedMemorySize, LDS_BYTES) != hipSuccess) { fprintf(stderr, "kernel_launch: hipFuncSetAttribute failed\n"); grid = -1; return; }
        if (hipOccupancyMaxActiveBlocksPerMultiprocessor(&per_cu, (const void*)mk_fwd, NWAVES * 64, LDS_BYTES) != hipSuccess || per_cu < 1) fprintf(stderr, "kernel_launch: occupancy query says %d\n", per_cu);
        (void)hipGetLastError();
        grid = cus;
    }
    if (grid < 0) return;
    if (hipMemsetAsync((char*)d_ws + WS_CTL, 0, CTL_ZERO_BYTES, stream) != hipSuccess) { fprintf(stderr, "kernel_launch: memset failed\n"); return; }
    Args a{};
    for (int i = 0; i < 28; ++i) a.in[i] = (const float*)d_in[i];
    a.out = (float*)d_out; a.ws = (unsigned char*)d_ws;
    for (int li = 0; li < N_LAUNCHES; ++li) {
        if (N_LAUNCHES == 1) { a.ph_lo = 0; a.ph_hi = NPH; } else { a.ph_lo = li; a.ph_hi = li + 1; }
        a.li = li;
        hipLaunchKernelGGL(mk_fwd, dim3(grid), dim3(NWAVES * 64), LDS_BYTES, stream, a);
        const hipError_t le = hipPeekAtLastError();
        if (le != hipSuccess) { fprintf(stderr, "kernel_launch: launch %d failed: %s\n", li, hipGetErrorName(le)); break; }
    }
}
```

```cpp
#include <hip/hip_runtime.h>
#include <cstdio>
#include <cstdint>
namespace pg8 {
#define PG8_LAS __attribute__((address_space(3)))
typedef unsigned short bf16_t;
typedef short bf16x8 __attribute__((ext_vector_type(8)));
typedef float f32x4 __attribute__((ext_vector_type(4)));
typedef unsigned u32x4 __attribute__((ext_vector_type(4)));
constexpr int BM = 256, BK = 64, HALF = 128, HTB = HALF * BK * 2  , STAGE_BYTES = 8 * HTB, NXCD = 8, WGM = 8;

__host__ __device__ __forceinline__ int lds_byte(int r, int c) { const int st = (r >> 4) * 2 + (c >> 5), rr = r & 15, cc = c & 31, ob = rr * 64 + cc * 2; return st * 1024 + (ob ^ (((ob >> 9) & 1) << 5)); }
__host__ __device__ __forceinline__ void stage_rc(int b, int& R, int& C) { const int st = b / 1024, sb = b % 1024, swz = sb ^ (((sb >> 9) & 1) << 5); R = (st >> 1) * 16 + swz / 64; C = (st & 1) * 32 + (swz % 64) / 2; }
__host__ __device__ __forceinline__ int perm32(int rho) { const int n = rho >> 4, i = rho & 15; return 8 * (i >> 2) + 4 * n + (i & 3); }

struct Unit { int pm, pn; };
struct Gemm { const bf16_t* A; const bf16_t* Bt; int M, N, K; };

struct StaticOrder {
    int nM, nN, nwg, G, c;
    __host__ __device__ void init(int M, int N, int G_, int c_) { nM = M / BM; nN = N / BM; nwg = nM * nN; G = G_; c = c_; }
    __host__ __device__ bool next(int i, Unit& u) const {
        const long L = (long)i * G + c; if (L >= nwg) return false;
        int wgid = (int)L; { const int q = nwg / NXCD, r = nwg % NXCD, xcd = wgid % NXCD, off = wgid / NXCD; wgid = (xcd < r ? xcd * (q + 1) : r * (q + 1) + (xcd - r) * q) + off; }
        const int nig = WGM * nN, gid = wgid / nig, fm = gid * WGM, gsz = (nM - fm) < WGM ? (nM - fm) : WGM;
        u.pm = fm + ((wgid % nig) % gsz); u.pn = (wgid % nig) / gsz; return true;
    }
    __device__ __forceinline__ void a_ready(const Unit&) const {}
    __device__ __forceinline__ void done(const Unit&) const {}
};

__device__ __forceinline__ unsigned cvt_pk_bf16(float lo, float hi) { unsigned r; asm volatile("v_cvt_pk_bf16_f32 %0, %1, %2" : "=v"(r) : "v"(lo), "v"(hi)); return r; }
typedef float f32x2 __attribute__((ext_vector_type(2)));
template <class Epi, class Sched, bool ALIGN_EPI = false, bool SP2 = false>
__device__ __forceinline__ void gemm_phase(PG8_LAS unsigned char* lds, const Gemm g, const Sched& S, const Epi& E) {
    const int tid = threadIdx.x, wid = __builtin_amdgcn_readfirstlane(tid >> 6), lane = tid & 63, wr = wid >> 2, wc = wid & 3, fr = lane & 15, fq = lane >> 4;
    const int K = g.K, nt = K / BK;
    unsigned voffA[2], voffB[2];
#pragma unroll
    for (int i = 0; i < 2; ++i) { int R, C; stage_rc(tid * 16 + i * 8192, R, C); const int Rb = Epi::PERM ? ((R & ~31) + perm32(R & 31)) : R;
        voffA[i] = (unsigned)(R * K + C) * 2u; voffB[i] = (unsigned)(Rb * K + C) * 2u; }
    const size_t kstep = (size_t)(BK * 2);
    const size_t hstep = (size_t)HALF * K * 2;
    const size_t tstep = 2 * hstep;
    const unsigned ldsw = (unsigned)wid * 1024u;
    const int aoff = lds_byte(wr * 64 + fr, fq * 8), boff = lds_byte(wc * 32 + fr, fq * 8);
#define PG8_SA(b, h) (((b) * 2 + (h)) * HTB)
#define PG8_SB(b, h) ((4 + (b) * 2 + (h)) * HTB)
#define PG8_STAGE(bufoff, gbase, voff) do { _Pragma("unroll") for (int _i = 0; _i < 2; ++_i) \
        __builtin_amdgcn_global_load_lds((const unsigned*)((const char*)(gbase) + (voff)[_i]), (PG8_LAS unsigned*)(lds + (bufoff) + ldsw + _i * 8192), 16, 0, 0); } while (0)
#define PG8_LDA(dst, b, h) do { _Pragma("unroll") for (int m = 0; m < 4; ++m) _Pragma("unroll") for (int k = 0; k < 2; ++k) dst[m][k] = *(const PG8_LAS bf16x8*)(lds + PG8_SA(b, h) + aoff + m * 2048 + k * 1024); } while (0)
#define PG8_LDB(dst, b, h) do { _Pragma("unroll") for (int n = 0; n < 2; ++n) _Pragma("unroll") for (int k = 0; k < 2; ++k) dst[n][k] = *(const PG8_LAS bf16x8*)(lds + PG8_SB(b, h) + boff + n * 2048 + k * 1024); } while (0)
#define PG8_MMA(ai, bj, At, Bt) do { __builtin_amdgcn_s_setprio(1); _Pragma("unroll") for (int m = 0; m < 4; ++m) _Pragma("unroll") for (int n = 0; n < 2; ++n) _Pragma("unroll") for (int k = 0; k < 2; ++k) \
        acc[ai][bj][m][n] = __builtin_amdgcn_mfma_f32_16x16x32_bf16(Bt[n][k], At[m][k], acc[ai][bj][m][n], 0, 0, 0); __builtin_amdgcn_s_setprio(0); } while (0)
#define PG8_WAIT_V(n) asm volatile("s_waitcnt vmcnt(" #n ")" ::: "memory")
#define PG8_WAIT_L(n) asm volatile("s_waitcnt lgkmcnt(" #n ")" ::: "memory")
#define PG8_BAR __builtin_amdgcn_s_barrier()
#define PG8_SCHED __builtin_amdgcn_sched_barrier(0)
    Unit cur, nxt; int ui = 0;
    if (!S.next(0, cur)) return;
    f32x4 acc[2][2][4][2];
#pragma unroll
    for (int a = 0; a < 2; ++a)
#pragma unroll
        for (int b = 0; b < 2; ++b)
#pragma unroll
            for (int m = 0; m < 4; ++m)
#pragma unroll
                for (int n = 0; n < 2; ++n) acc[a][b][m][n] = (f32x4){0.f, 0.f, 0.f, 0.f};
    bf16x8 At[4][2], B0[2][2], B1[2][2];
    const char* cA = (const char*)g.A + (size_t)cur.pm * tstep; const char* cB = (const char*)g.Bt + (size_t)cur.pn * tstep;
    S.a_ready(cur);
    if constexpr (SP2) {
        PG8_STAGE(PG8_SB(0, 0), cB, voffB); PG8_STAGE(PG8_SB(0, 1), cB + hstep, voffB); PG8_STAGE(PG8_SA(0, 0), cA, voffA); PG8_STAGE(PG8_SA(0, 1), cA + hstep, voffA);
        if (wr == 1) PG8_BAR;
        PG8_WAIT_V(2); PG8_BAR;
        PG8_STAGE(PG8_SB(1, 0), cB + kstep, voffB); PG8_STAGE(PG8_SA(1, 0), cA + kstep, voffA); PG8_STAGE(PG8_SB(1, 1), cB + hstep + kstep, voffB);
        PG8_WAIT_V(6); PG8_BAR;
    } else {
        PG8_STAGE(PG8_SB(0, 0), cB, voffB); PG8_STAGE(PG8_SA(0, 0), cA, voffA); PG8_STAGE(PG8_SB(0, 1), cB + hstep, voffB); PG8_STAGE(PG8_SA(0, 1), cA + hstep, voffA);
        if (wr == 1) PG8_BAR;
        PG8_WAIT_V(4); PG8_BAR;
        PG8_STAGE(PG8_SB(1, 0), cB + kstep, voffB); PG8_STAGE(PG8_SA(1, 0), cA + kstep, voffA); PG8_STAGE(PG8_SB(1, 1), cB + hstep + kstep, voffB);
        PG8_WAIT_V(6); PG8_BAR;
    }
    for (;;) {
        const bool has_next = S.next(ui + 1, nxt);
        const char* nA = has_next ? (const char*)g.A + (size_t)nxt.pm * tstep : cA; const char* nB = has_next ? (const char*)g.Bt + (size_t)nxt.pn * tstep : cB;
        for (int t = 0; t < nt; t += 2) {
            const bool last = (t == nt - 2);
            const char* a1 = cA + (size_t)(t + 1) * kstep;
            const char* a2 = last ? nA : cA + (size_t)(t + 2) * kstep; const char* b2 = last ? nB : cB + (size_t)(t + 2) * kstep;
            const char* a3 = a2 + kstep; const char* b3 = b2 + kstep;
            if (last && has_next) S.a_ready(nxt);
            if constexpr (SP2) {
            PG8_LDB(B0, 0, 0); PG8_LDB(B1, 0, 1); PG8_SCHED; PG8_LDA(At, 0, 0); PG8_STAGE(PG8_SA(1, 1), a1 + hstep, voffA);
            PG8_WAIT_V(8); PG8_WAIT_L(0); PG8_BAR; PG8_MMA(0, 0, At, B0); PG8_MMA(0, 1, At, B1); PG8_BAR; PG8_SCHED;
            PG8_LDA(At, 0, 1); PG8_STAGE(PG8_SB(0, 0), b2, voffB); PG8_STAGE(PG8_SB(0, 1), b2 + hstep, voffB); PG8_STAGE(PG8_SA(0, 0), a2, voffA);
            PG8_WAIT_V(8); PG8_WAIT_L(0); PG8_BAR; PG8_MMA(1, 0, At, B0); PG8_MMA(1, 1, At, B1); PG8_BAR; PG8_SCHED;
            PG8_LDB(B0, 1, 0); PG8_LDB(B1, 1, 1); PG8_SCHED; PG8_LDA(At, 1, 0); PG8_STAGE(PG8_SA(0, 1), a2 + hstep, voffA);
            PG8_WAIT_V(8); PG8_WAIT_L(0); PG8_BAR; PG8_MMA(0, 0, At, B0); PG8_MMA(0, 1, At, B1); PG8_BAR; PG8_SCHED;
            PG8_LDA(At, 1, 1); PG8_STAGE(PG8_SB(1, 0), b3, voffB); PG8_STAGE(PG8_SB(1, 1), b3 + hstep, voffB); PG8_STAGE(PG8_SA(1, 0), a3, voffA);
            PG8_WAIT_V(8); PG8_WAIT_L(0); PG8_BAR; PG8_MMA(1, 0, At, B0); PG8_MMA(1, 1, At, B1); PG8_BAR; PG8_SCHED;
            } else {
            PG8_LDB(B0, 0, 0); PG8_SCHED; PG8_LDA(At, 0, 0); PG8_STAGE(PG8_SA(1, 1), a1 + hstep, voffA);
            PG8_WAIT_L(8); PG8_BAR; PG8_WAIT_L(0); PG8_MMA(0, 0, At, B0); PG8_BAR; PG8_SCHED;
            PG8_LDB(B1, 0, 1); PG8_STAGE(PG8_SB(0, 0), b2, voffB);
            PG8_BAR; PG8_WAIT_L(0); PG8_MMA(0, 1, At, B1); PG8_BAR;
            PG8_LDA(At, 0, 1); PG8_STAGE(PG8_SA(0, 0), a2, voffA);
            PG8_BAR; PG8_WAIT_L(0); PG8_MMA(1, 0, At, B0); PG8_BAR; PG8_SCHED;
            PG8_STAGE(PG8_SB(0, 1), b2 + hstep, voffB);
            PG8_WAIT_V(6); PG8_BAR; PG8_MMA(1, 1, At, B1); PG8_BAR;
            PG8_LDB(B0, 1, 0); PG8_SCHED; PG8_LDA(At, 1, 0); PG8_STAGE(PG8_SA(0, 1), a2 + hstep, voffA);
            PG8_WAIT_L(8); PG8_BAR; PG8_WAIT_L(0); PG8_MMA(0, 0, At, B0); PG8_BAR; PG8_SCHED;
            PG8_LDB(B1, 1, 1); PG8_STAGE(PG8_SB(1, 0), b3, voffB);
            PG8_BAR; PG8_WAIT_L(0); PG8_MMA(0, 1, At, B1); PG8_BAR;
            PG8_LDA(At, 1, 1); PG8_STAGE(PG8_SA(1, 0), a3, voffA);
            PG8_BAR; PG8_WAIT_L(0); PG8_MMA(1, 0, At, B0); PG8_BAR; PG8_SCHED;
            PG8_STAGE(PG8_SB(1, 1), b3 + hstep, voffB);
            PG8_WAIT_V(6); PG8_BAR; PG8_MMA(1, 1, At, B1); PG8_BAR;
            }
        }
        if constexpr (ALIGN_EPI) { if (wr == 0) PG8_BAR; }
        if constexpr (!Epi::AFTER_DRAIN) { E(acc, cur, wr, wc, fr, fq); S.done(cur); }
        if (!has_next) break;
#pragma unroll
        for (int a = 0; a < 2; ++a)
#pragma unroll
            for (int b = 0; b < 2; ++b)
#pragma unroll
                for (int m = 0; m < 4; ++m)
#pragma unroll
                    for (int n = 0; n < 2; ++n) acc[a][b][m][n] = (f32x4){0.f, 0.f, 0.f, 0.f};
        cur = nxt; cA = nA; cB = nB; ++ui;
        if constexpr (ALIGN_EPI) { if (wr == 1) PG8_BAR; }
    }
    PG8_WAIT_V(0);
    if constexpr (!ALIGN_EPI) { if (wr == 0) PG8_BAR; }
    PG8_BAR;
    if constexpr (Epi::AFTER_DRAIN) { E.fused(acc, cur, wr, wc, fr, fq, lds, wid, lane); S.done(cur); }
#undef PG8_SA
#undef PG8_SB
#undef PG8_STAGE
#undef PG8_LDA
#undef PG8_LDB
#undef PG8_MMA
#undef PG8_WAIT_V
#undef PG8_WAIT_L
#undef PG8_BAR
#undef PG8_SCHED
}
}

#ifndef PG8_SP2
#define PG8_SP2 true
#endif
#ifndef PG8_ALIGN
#define PG8_ALIGN true
#endif
#define GAS __attribute__((address_space(1)))
#define LAS __attribute__((address_space(3)))
typedef unsigned short bf16;
typedef unsigned v4u __attribute__((ext_vector_type(4)));
typedef float f32x4 __attribute__((ext_vector_type(4)));
typedef short bf16x8 __attribute__((ext_vector_type(8)));
typedef GAS unsigned gu32;
typedef GAS unsigned long long gu64;
#define RLX_AGENT __ATOMIC_RELAXED, __HIP_MEMORY_SCOPE_AGENT
#define LDS_WAIT() asm volatile("s_waitcnt lgkmcnt(0)" ::: "memory")
#define VM_WAIT() asm volatile("s_waitcnt vmcnt(0)" ::: "memory")
__device__ __forceinline__ unsigned long long rt() { return __builtin_amdgcn_s_memrealtime(); }
__device__ __forceinline__ unsigned f2bf(float f) { unsigned u = __builtin_bit_cast(unsigned, f); return (u + 0x7fffu + ((u >> 16) & 1u)) >> 16; }
__device__ __forceinline__ unsigned pk2(float lo, float hi) { return f2bf(lo) | (f2bf(hi) << 16); }

#define XB_TMO      128
#define XB_XCNT(j)  (256  + 64 * (j))
#define XB_XSUB(j)  (1280 + 64 * (j))
#define XB_XGEN(j)  (2304 + 64 * (j))
#define XB_TOP      3328
#define XB_TOPGEN   3392
#define XCD_BAR_WORDS 3456
#define XB_SPIN_CAP (1u << 18)

__device__ __forceinline__ unsigned xb_ld(unsigned* p)              { return __hip_atomic_load(p, __ATOMIC_RELAXED, __HIP_MEMORY_SCOPE_AGENT); }
__device__ __forceinline__ unsigned xb_add(unsigned* p, unsigned v) { return __hip_atomic_fetch_add(p, v, __ATOMIC_RELAXED, __HIP_MEMORY_SCOPE_AGENT); }
__device__ __forceinline__ unsigned xb_xcc_id() { return (unsigned)__builtin_amdgcn_s_getreg((3 << 11) | 20) & 0xFu; }
#define XB_SPIN(cond, bar) do { unsigned _sp = 0; while (cond) { __builtin_amdgcn_s_sleep(1); \
    if ((++_sp & 255u) == 0u) { if (xb_ld(&(bar)[XB_TMO])) break; if (_sp > XB_SPIN_CAP) { atomicAdd(&(bar)[XB_TMO], 1u); break; } } } } while (0)

struct XcdBarrier {
    unsigned* bar; unsigned x;
    volatile LAS unsigned* st;
};

__device__ __forceinline__ XcdBarrier xcd_barrier_post(unsigned* bar, volatile LAS unsigned* st) {
    XcdBarrier b; b.bar = bar; b.x = xb_xcc_id(); b.st = st;
    if (threadIdx.x == 0) (void)xb_add(&bar[XB_XCNT(b.x)], 1u);
    return b;
}
__device__ __forceinline__ void xcd_barrier_complete(unsigned* bar, unsigned x, unsigned& nloc, unsigned& nx) {
    const unsigned G = gridDim.x * gridDim.y * gridDim.z;
    unsigned sum, cnt, mine, sp = 0u;
    for (;;) {
        sum = 0u; cnt = 0u; mine = 0u;
#pragma unroll
        for (unsigned j = 0; j < 16; ++j) { const unsigned c = xb_ld(&bar[XB_XCNT(j)]); sum += c; cnt += (c > 0u) ? 1u : 0u; mine = (j == x) ? c : mine; }
        if (sum == G) break;
        __builtin_amdgcn_s_sleep(1);
        if ((++sp & 255u) == 0u) { if (xb_ld(&bar[XB_TMO])) break; if (sp > XB_SPIN_CAP) { atomicAdd(&bar[XB_TMO], 1u); break; } }
    }
    nloc = mine > 0u ? mine : 1u; nx = cnt > 0u ? cnt : 1u;
}

__device__ __forceinline__ void xcd_barrier(const XcdBarrier& b) {
    asm volatile("s_waitcnt vmcnt(0)" ::: "memory");
    __syncthreads();
    if (threadIdx.x == 0) {
        unsigned* bar = b.bar;
        __builtin_amdgcn_s_waitcnt(0);
        unsigned nloc = b.st[0], nx = b.st[1];
        if (nloc == 0u) { xcd_barrier_complete(bar, b.x, nloc, nx); b.st[0] = nloc; b.st[1] = nx; }
        const unsigned old = xb_add(&bar[XB_XSUB(b.x)], 1u);
        const unsigned gen = old / nloc;
        if (old + 1u == (gen + 1u) * nloc) {
            __builtin_amdgcn_fence(__ATOMIC_RELEASE, "agent");
            asm volatile("s_waitcnt vmcnt(0)" ::: "memory");
            const unsigned og = xb_add(&bar[XB_TOP], 1u);
            const unsigned tg = og / nx;
            if (og + 1u == (tg + 1u) * nx) xb_add(&bar[XB_TOPGEN], 1u);
            else XB_SPIN(xb_ld(&bar[XB_TOPGEN]) == tg, bar);
            __builtin_amdgcn_fence(__ATOMIC_ACQUIRE, "agent");
            xb_add(&bar[XB_XGEN(b.x)], 1u);
            asm volatile("s_waitcnt vmcnt(0)" ::: "memory");
        } else {
            XB_SPIN(xb_ld(&bar[XB_XGEN(b.x)]) == gen, bar);
            __builtin_amdgcn_fence(__ATOMIC_ACQUIRE, "agent");
            asm volatile("s_waitcnt vmcnt(0)" ::: "memory");
        }
    }
    __syncthreads();
}


constexpr int NWAVES = 8;
constexpr int DM = 1024, SEQ = 4096, NBP = 4, NBS = 32, TS = 8;
constexpr int MP = NBP * SEQ, MS = NBS * TS, MT = MP + MS;
constexpr int NH = 8, HD = 64, DSSM = 512, NST = 128, IN_LD = 3080, NIN = 3072;
constexpr int DFF = 2816, DFF2 = 5632, DPLE = 256, WBUF = 2048;
constexpr float EPS = 1e-6f, LOG2E = 1.4426950408889634f, C2 = 0.125f * 1.4426950408889634f;
constexpr int PC_K = 512, PC_V = 1024, PC_Z = 1536, PC_X = 2048;
constexpr size_t O_Y = 0, O_YS = 16777216, O_KP = 17039360, O_VP = 21233664, O_KS = 25427968, O_VS = 25559040, O_SP = 25690112, O_SS = 25952256,
                 O_CP = 28049408, O_CS = 28061696, O_FP = 28160000, O_FS = 28205056, O_END = 28565504;
constexpr size_t MiB = 1u << 20;
constexpr size_t WS_CTL = 0, CTL_ZERO_BYTES = 1 * MiB;
constexpr size_t WS_RS1 = 256 * 1024, WS_RSE = 384 * 1024, WS_RS3 = 512 * 1024;
constexpr size_t WS_WIN = 2 * MiB, WS_WOUT = 8 * MiB, WS_WUP = 10 * MiB, WS_WDOWN = 21 * MiB, WS_WPLE = 27 * MiB, WS_WGATE = 28 * MiB;
constexpr size_t WS_DT = 30 * MiB, WS_PB = 31 * MiB, WS_XN = 40 * MiB, WS_MIX = 73 * MiB, WS_H1 = 106 * MiB, WS_E = 171 * MiB;
constexpr size_t WS_PROJ = 236 * MiB, WS_OBR = 334 * MiB, WS_LSE = 382 * MiB, WS_XBS = 384 * MiB, WS_XC = 385 * MiB, WS_CC = 402 * MiB, WS_CS = 410 * MiB, WS_PREV = 442 * MiB,
                 WS_ACUM = 458 * MiB, WS_ACL = 458 * MiB + 768 * 1024, WS_YS = 459 * MiB;
constexpr size_t WS_U = 236 * MiB, WS_ACT = 415 * MiB, WS_END = 505 * MiB;
static_assert(WS_PROJ + (size_t)MT * NIN * 2 <= WS_OBR && WS_OBR + (size_t)3 * MP * 512 * 2 <= WS_LSE && WS_LSE + (size_t)3 * MP * 8 * 4 <= WS_XBS, "ws map A");
static_assert(WS_XBS + (size_t)MS * 1024 * 4 <= WS_XC && WS_XC + (size_t)MT * 512 * 2 <= WS_CC && WS_CC + (size_t)MP * 256 * 2 <= WS_CS && WS_CS + (size_t)MP / 128 * 8 * 64 * 128 * 4 <= WS_PREV && WS_PREV + (size_t)MP / 128 * 8 * 64 * 128 * 2 <= WS_ACUM && WS_ACUM + (size_t)MP * 8 * 4 <= WS_ACL && WS_ACL + 4096 <= WS_YS && WS_YS + (size_t)MT * 512 * 4 <= WS_END, "ws map B");
static_assert(WS_U + (size_t)MT * DFF2 * 2 <= WS_ACT && WS_ACT + (size_t)MT * DFF * 2 <= WS_END, "ws map C");
static_assert(WS_XN + (size_t)MT * DM * 2 <= WS_MIX && WS_MIX + (size_t)MT * DM * 2 <= WS_H1 && WS_H1 + (size_t)MT * DM * 4 <= WS_E && WS_E + (size_t)MT * DM * 4 <= WS_PROJ, "ws map D");
static_assert(WS_PB + (size_t)MT * DPLE * 2 <= WS_XN && WS_DT + (size_t)MT * 8 * 4 <= WS_PB, "ws map E");
constexpr int CW_TMO = 0, CW_BAR = 4096;
constexpr int RING_BYTES = 131072, LDSCTL_OFF = RING_BYTES, MISC_OFF = LDSCTL_OFF + 320, LDS_BYTES = 147456;

typedef float f32x16 __attribute__((ext_vector_type(16)));
typedef short v4i16_t __attribute__((ext_vector_type(4)));
typedef unsigned u32x2 __attribute__((ext_vector_type(2)));

__device__ const unsigned char BUCKET_TAB[3][132] = {
 {0,1,2,3,4,5,6,7,8,9,10,11,12,13,14,15,16,16,16,16,16,16,17,17,17,17,17,17,17,17,18,18,18,18,18,18,18,18,18,18,19,19,19,19,19,19,19,19,19,19,19,19,19,19,20,20,20,20,20,20,20,20,20,20,20,20,20,20,20,20,20,20,20,21,21,21,21,21,21,21,21,21,21,21,21,21,21,21,21,21,21,21,21,21,21,21,21,21,21,22,22,22,22,22,22,22,22,22,22,22,22,22,22,22,22,22,22,22,22,22,22,22,22,22,22,22,22,22,22,0,0,0},
 {0,4,8,12,16,16,17,17,18,18,19,19,19,19,20,20,20,20,20,21,21,21,21,21,21,22,22,22,22,22,22,22,22,22,23,23,23,23,23,23,23,23,23,23,23,23,24,24,24,24,24,24,24,24,24,24,24,24,24,24,24,24,25,25,25,25,25,25,25,25,25,25,25,25,25,25,25,25,25,25,25,25,25,26,26,26,26,26,26,26,26,26,26,26,26,26,26,26,26,26,26,26,26,26,26,26,26,26,26,26,26,26,26,27,27,27,27,27,27,27,27,27,27,27,27,27,27,27,27,0,0,0},
 {0,16,18,19,20,21,21,22,22,23,23,23,24,24,24,24,25,25,25,25,25,26,26,26,26,26,26,26,26,27,27,27,27,27,27,27,27,27,27,28,28,28,28,28,28,28,28,28,28,28,28,28,29,29,29,29,29,29,29,29,29,29,29,29,29,29,29,29,29,29,30,30,30,30,30,30,30,30,30,30,30,30,30,30,30,30,30,30,30,30,30,30,30,30,30,31,31,31,31,31,31,31,31,31,31,31,31,31,31,31,31,31,31,31,31,31,31,31,31,31,31,31,31,31,31,31,31,31,31,0,0,0}};

__device__ __forceinline__ float wave_sum(float v) {
#pragma unroll
    for (int o = 1; o < 64; o <<= 1) v += __shfl_xor(v, o);
    return v;
}
__device__ __forceinline__ float wave_max(float v) {
#pragma unroll
    for (int o = 1; o < 64; o <<= 1) v = fmaxf(v, __shfl_xor(v, o));
    return v;
}
__device__ __forceinline__ float bf2f(unsigned short b) { return __uint_as_float((unsigned)b << 16); }
__device__ __forceinline__ float bflo(unsigned w) { return __uint_as_float(w << 16); }
__device__ __forceinline__ float bfhi(unsigned w) { return __uint_as_float(w & 0xffff0000u); }
__device__ __forceinline__ float siluf(float x) { return x / (1.f + __expf(-x)); }
__device__ __forceinline__ float softplusf(float x) { return fmaxf(x, 0.f) + log1pf(__expf(-fabsf(x))); }
__device__ __forceinline__ int crow(int r, int hi) { return (r & 3) + 8 * (r >> 2) + 4 * hi; }

__device__ __forceinline__ v4i16_t vtr(const LAS unsigned char* p) { return __builtin_amdgcn_ds_read_tr16_b64_v4i16((LAS v4i16_t*)p); }
__device__ __forceinline__ unsigned cvtpk_s(float lo, float hi) { typedef float f2 __attribute__((ext_vector_type(2))); typedef __bf16 b2 __attribute__((ext_vector_type(2))); f2 v = {lo, hi}; b2 b = __builtin_convertvector(v, b2); return __builtin_bit_cast(unsigned, b); }
struct Args { const float* in[28]; float* out; unsigned char* ws; int ph_lo, ph_hi, li, pad; };

struct EpiIn {
    static constexpr bool PERM = true, AFTER_DRAIN = false;
    pg8::bf16_t* PROJ; float* out;
    __device__ __forceinline__ void operator()(const pg8::f32x4 (&acc)[2][2][4][2], const pg8::Unit& u, int wr, int wc, int fr, int fq) const {
        const int pn = u.pn; const float sc = (pn < 2) ? C2 : 1.f;
        const int colb = pn * 256 + wc * 32 + 8 * fq;
#pragma unroll
        for (int ai = 0; ai < 2; ++ai)
#pragma unroll
            for (int m = 0; m < 4; ++m) {
                const int row = u.pm * 256 + ai * 128 + wr * 64 + m * 16 + fr;
#pragma unroll
                for (int bj = 0; bj < 2; ++bj) {
                    const int col = colb + bj * 128; const pg8::f32x4 v0 = acc[ai][bj][m][0], v1 = acc[ai][bj][m][1];
                    pg8::u32x4 w; w.x = pg8::cvt_pk_bf16(v0[0] * sc, v0[1] * sc); w.y = pg8::cvt_pk_bf16(v0[2] * sc, v0[3] * sc); w.z = pg8::cvt_pk_bf16(v1[0] * sc, v1[1] * sc); w.w = pg8::cvt_pk_bf16(v1[2] * sc, v1[3] * sc);
                    *(pg8::u32x4*)(PROJ + (size_t)row * NIN + col) = w;
                    float* dst = nullptr;
                    if (pn >= 2 && pn < 6) {
                        const bool isk = pn < 4; const int c = col - (isk ? PC_K : PC_V);
                        if (row < MP) { const int t = row & (SEQ - 1), b = row >> 12; if (t >= SEQ - WBUF) dst = out + (isk ? O_KP : O_VP) + ((size_t)(b * WBUF + t - (SEQ - WBUF))) * 512 + c; }
                        else dst = out + (isk ? O_KS : O_VS) + (size_t)(row - MP) * 512 + c;
                    } else if (pn >= 8) {
                        const int c = col - PC_X;
                        if (row < MP) { const int t = row & (SEQ - 1), b = row >> 12; if (t >= SEQ - 3) dst = out + O_CP + (size_t)(b * 3 + t - (SEQ - 3)) * 1024 + c; }
                        else { const int r = row - MP, t = r & 7, b = r >> 3; if (t >= TS - 3) dst = out + O_CS + (size_t)(b * 3 + t - (TS - 3)) * 1024 + c; }
                    }
                    if (dst) { *(pg8::f32x4*)dst = v0; *(pg8::f32x4*)(dst + 4) = v1; }
                }
            }
    }
};
struct EpiOut {
    static constexpr bool PERM = false, AFTER_DRAIN = false;
    const float* xp; const float* xs; float* H1; pg8::bf16_t* H1b; float* RS;
    __device__ __forceinline__ void operator()(const pg8::f32x4 (&acc)[2][2][4][2], const pg8::Unit& u, int wr, int wc, int fr, int fq) const {
        const int col0 = u.pn * 256 + wc * 32 + 4 * fq;
#pragma unroll
        for (int ai = 0; ai < 2; ++ai)
#pragma unroll
            for (int m = 0; m < 4; ++m) {
                const int row = u.pm * 256 + ai * 128 + wr * 64 + m * 16 + fr;
                const float* xrow = (row < MP) ? xp + (size_t)row * DM : xs + (size_t)(row - MP) * DM;
                float ss = 0.f;
#pragma unroll
                for (int bj = 0; bj < 2; ++bj)
#pragma unroll
                    for (int n = 0; n < 2; ++n) {
                        const int c = col0 + bj * 128 + n * 16;
                        const pg8::f32x4 h = *(const pg8::f32x4*)(xrow + c) + acc[ai][bj][m][n];
                        *(pg8::f32x4*)(H1 + (size_t)row * DM + c) = h;
                        u32x2 w; w.x = pg8::cvt_pk_bf16(h[0], h[1]); w.y = pg8::cvt_pk_bf16(h[2], h[3]);
                        *(u32x2*)(H1b + (size_t)row * DM + c) = w;
                        ss += (h[0] * h[0] + h[1] * h[1]) + (h[2] * h[2] + h[3] * h[3]);
                    }
                ss += __shfl_xor(ss, 16); ss += __shfl_xor(ss, 32);
                if (fq == 0) atomicAdd(RS + row, ss);
                asm volatile("" ::: "memory");
            }
    }
};
struct EpiUp {
    static constexpr bool PERM = true, AFTER_DRAIN = false;
    pg8::bf16_t* U; const float* RS; float* out;
    __device__ __forceinline__ void operator()(const pg8::f32x4 (&acc)[2][2][4][2], const pg8::Unit& u, int wr, int wc, int fr, int fq) const {
        const int colb = u.pn * 256 + wc * 32 + 8 * fq;
#pragma unroll
        for (int ai = 0; ai < 2; ++ai)
#pragma unroll
            for (int m = 0; m < 4; ++m) {
                const int row = u.pm * 256 + ai * 128 + wr * 64 + m * 16 + fr;
                const float rs = 1.0f / sqrtf(RS[row] * (1.f / DM) + EPS);
                float* dstb = nullptr;
                if (row < MP) { const int t = row & (SEQ - 1), b = row >> 12; if (t >= SEQ - 2) dstb = out + O_FP + (size_t)(b * 2 + t - (SEQ - 2)) * DFF2; }
                else { const int r = row - MP, t = r & 7, b = r >> 3; if (t >= TS - 2) dstb = out + O_FS + (size_t)(b * 2 + t - (TS - 2)) * DFF2; }
#pragma unroll
                for (int bj = 0; bj < 2; ++bj) {
                    const int col = colb + bj * 128; const pg8::f32x4 v0 = acc[ai][bj][m][0] * rs, v1 = acc[ai][bj][m][1] * rs;
                    pg8::u32x4 w; w.x = pg8::cvt_pk_bf16(v0[0], v0[1]); w.y = pg8::cvt_pk_bf16(v0[2], v0[3]); w.z = pg8::cvt_pk_bf16(v1[0], v1[1]); w.w = pg8::cvt_pk_bf16(v1[2], v1[3]);
                    *(pg8::u32x4*)(U + (size_t)row * DFF2 + col) = w;
                    if (dstb) { *(pg8::f32x4*)(dstb + col) = v0; *(pg8::f32x4*)(dstb + col + 4) = v1; }
                }
            }
    }
};
struct EpiDown {
    static constexpr bool PERM = false, AFTER_DRAIN = false;
    float* H1; pg8::bf16_t* H2b;
    __device__ __forceinline__ void operator()(const pg8::f32x4 (&acc)[2][2][4][2], const pg8::Unit& u, int wr, int wc, int fr, int fq) const {
        const int col0 = u.pn * 256 + wc * 32 + 4 * fq;
#pragma unroll
        for (int ai = 0; ai < 2; ++ai)
#pragma unroll
            for (int m = 0; m < 4; ++m) {
                const int row = u.pm * 256 + ai * 128 + wr * 64 + m * 16 + fr;
#pragma unroll
                for (int bj = 0; bj < 2; ++bj)
#pragma unroll
                    for (int n = 0; n < 2; ++n) {
                        const int c = col0 + bj * 128 + n * 16; float* hp = H1 + (size_t)row * DM + c;
                        const pg8::f32x4 h = *(const pg8::f32x4*)hp + acc[ai][bj][m][n];
                        *(pg8::f32x4*)hp = h;
                        u32x2 w; w.x = pg8::cvt_pk_bf16(h[0], h[1]); w.y = pg8::cvt_pk_bf16(h[2], h[3]);
                        *(u32x2*)(H2b + (size_t)row * DM + c) = w;
                    }
                asm volatile("" ::: "memory");
            }
    }
};
struct EpiPle {
    static constexpr bool PERM = false, AFTER_DRAIN = false;
    float* E; float* RS;
    __device__ __forceinline__ void operator()(const pg8::f32x4 (&acc)[2][2][4][2], const pg8::Unit& u, int wr, int wc, int fr, int fq) const {
        const int col0 = u.pn * 256 + wc * 32 + 4 * fq;
#pragma unroll
        for (int ai = 0; ai < 2; ++ai)
#pragma unroll
            for (int m = 0; m < 4; ++m) {
                const int row = u.pm * 256 + ai * 128 + wr * 64 + m * 16 + fr; float ss = 0.f;
#pragma unroll
                for (int bj = 0; bj < 2; ++bj)
#pragma unroll
                    for (int n = 0; n < 2; ++n) {
                        const int c = col0 + bj * 128 + n * 16; const pg8::f32x4 h = acc[ai][bj][m][n];
                        *(pg8::f32x4*)(E + (size_t)row * DM + c) = h;
                        ss += (h[0] * h[0] + h[1] * h[1]) + (h[2] * h[2] + h[3] * h[3]);
                    }
                ss += __shfl_xor(ss, 16); ss += __shfl_xor(ss, 32);
                if (fq == 0) atomicAdd(RS + row, ss);
            }
    }
};
struct EpiGate {
    static constexpr bool PERM = false, AFTER_DRAIN = false;
    const float* H2; const float* E; const float* RSE; const float* gple; float* out; float* RS3;
    __device__ __forceinline__ void operator()(const pg8::f32x4 (&acc)[2][2][4][2], const pg8::Unit& u, int wr, int wc, int fr, int fq) const {
        const int col0 = u.pn * 256 + wc * 32 + 4 * fq;
        pg8::f32x4 gp[2][2];
#pragma unroll
        for (int bj = 0; bj < 2; ++bj)
#pragma unroll
            for (int n = 0; n < 2; ++n) gp[bj][n] = *(const pg8::f32x4*)(gple + col0 + bj * 128 + n * 16);
#pragma unroll
        for (int ai = 0; ai < 2; ++ai)
#pragma unroll
            for (int m = 0; m < 4; ++m) {
                const int row = u.pm * 256 + ai * 128 + wr * 64 + m * 16 + fr;
                const float rse = 1.0f / sqrtf(RSE[row] * (1.f / DM) + EPS);
                float* orow = (row < MP) ? out + O_Y + (size_t)row * DM : out + O_YS + (size_t)(row - MP) * DM;
                float ss = 0.f;
#pragma unroll
                for (int bj = 0; bj < 2; ++bj)
#pragma unroll
                    for (int n = 0; n < 2; ++n) {
                        const int c = col0 + bj * 128 + n * 16;
                        const pg8::f32x4 a = acc[ai][bj][m][n], e = *(const pg8::f32x4*)(E + (size_t)row * DM + c), h2 = *(const pg8::f32x4*)(H2 + (size_t)row * DM + c);
                        pg8::f32x4 h;
#pragma unroll
                        for (int k = 0; k < 4; ++k) { const float g = 1.f / (1.f + __expf(-a[k])); h[k] = h2[k] + g * (e[k] * rse * gp[bj][n][k]); }
                        *(pg8::f32x4*)(orow + c) = h;
                        ss += (h[0] * h[0] + h[1] * h[1]) + (h[2] * h[2] + h[3] * h[3]);
                    }
                ss += __shfl_xor(ss, 16); ss += __shfl_xor(ss, 32);
                if (fq == 0) atomicAdd(RS3 + row, ss);
                asm volatile("" ::: "memory");
            }
    }
};

__device__ __forceinline__ void p0_transpose_item(const float* W, int ldn, int K, int N, bf16* WT, const float* gk, LAS float* scr, int item, int lane) {
    const int nblk = N / 32, kb = item / nblk, nb = item % nblk, k0 = 64 * kb, n0 = 32 * nb;
#pragma unroll 8
    for (int i = 0; i < 32; ++i) { const int kk = 2 * i + (lane >> 5); float w = W[(size_t)(k0 + kk) * ldn + n0 + (lane & 31)]; if (gk) w *= gk[k0 + kk]; scr[kk * 33 + (lane & 31)] = w; }
    LDS_WAIT(); asm volatile("" ::: "memory");
    const int c = lane & 7;
#pragma unroll
    for (int j = 0; j < 4; ++j) { const int n = (lane >> 3) + 8 * j; const LAS float* s = scr + (8 * c) * 33 + n;
        v4u o; o.x = pk2(s[0 * 33], s[1 * 33]); o.y = pk2(s[2 * 33], s[3 * 33]); o.z = pk2(s[4 * 33], s[5 * 33]); o.w = pk2(s[6 * 33], s[7 * 33]);
        *(GAS v4u*)(WT + (size_t)(n0 + n) * K + k0 + 8 * c) = o; }
    LDS_WAIT(); asm volatile("" ::: "memory");
}
__device__ __forceinline__ void p0_prologue(const Args& a, LAS unsigned char* lds, int gw, int NGW, int wave, int lane) {
    unsigned char* ws = a.ws;
    LAS float* scr = (LAS float*)(lds + wave * 8704);
    constexpr int I_IN = (DM / 64) * (NIN / 32), I_OUT = (DM / 64) * (DM / 32), I_UP = (DM / 64) * (DFF2 / 32), I_DN = (DFF / 64) * (DM / 32), I_PLE = (DPLE / 64) * (DM / 32), I_G = I_OUT;
    constexpr int NITEMS = I_IN + I_OUT + I_UP + I_DN + I_PLE + I_G;
    for (int it = gw; it < NITEMS; it += NGW) {
        int r = it;
        if (r < I_IN)  { p0_transpose_item(a.in[11], IN_LD, DM, NIN, (bf16*)(ws + WS_WIN), a.in[10], scr, r, lane); continue; } r -= I_IN;
        if (r < I_OUT) { p0_transpose_item(a.in[18], DM, DM, DM, (bf16*)(ws + WS_WOUT), nullptr, scr, r, lane); continue; } r -= I_OUT;
        if (r < I_UP)  { p0_transpose_item(a.in[20], DFF2, DM, DFF2, (bf16*)(ws + WS_WUP), a.in[19], scr, r, lane); continue; } r -= I_UP;
        if (r < I_DN)  { p0_transpose_item(a.in[23], DM, DFF, DM, (bf16*)(ws + WS_WDOWN), nullptr, scr, r, lane); continue; } r -= I_DN;
        if (r < I_PLE) { p0_transpose_item(a.in[24], DM, DPLE, DM, (bf16*)(ws + WS_WPLE), nullptr, scr, r, lane); continue; } r -= I_PLE;
        p0_transpose_item(a.in[26], DM, DM, DM, (bf16*)(ws + WS_WGATE), nullptr, scr, r, lane);
    }
    const float* gmix = a.in[10]; const float* win = a.in[11]; const float* dtb = a.in[14];
    bf16* XN = (bf16*)(ws + WS_XN); bf16* PB = (bf16*)(ws + WS_PB); float* DT = (float*)(ws + WS_DT);
    LAS unsigned char* dtw = lds + 81920;
    for (int k = threadIdx.x; k < DM; k += NWAVES * 64) {
        const float gk = gmix[k]; const f32x4 w0 = *(const f32x4*)(win + (size_t)k * IN_LD + NIN) * gk, w1 = *(const f32x4*)(win + (size_t)k * IN_LD + NIN + 4) * gk;
        LAS f32x4* d = (LAS f32x4*)(dtw + (k >> 2) * 144 + (k & 3) * 32); d[0] = w0; d[1] = w1;
    }
    LDS_WAIT(); __syncthreads();
    for (int m = gw; m < MT; m += NGW) {
        const float* xrow = (m < MP) ? a.in[0] + (size_t)m * DM : a.in[1] + (size_t)(m - MP) * DM;
        const GAS f32x4* xr = (const GAS f32x4*)xrow + lane;
        f32x4 v[4]; float s = 0.f;
#pragma unroll
        for (int j = 0; j < 4; ++j) { v[j] = xr[64 * j]; s += (v[j].x * v[j].x + v[j].y * v[j].y) + (v[j].z * v[j].z + v[j].w * v[j].w); }
        const float rstd = 1.0f / sqrtf(wave_sum(s) * (1.f / DM) + EPS);
        GAS unsigned long long* o8 = (GAS unsigned long long*)(XN + (size_t)m * DM) + lane;
        float dacc[8];
#pragma unroll
        for (int h = 0; h < 8; ++h) dacc[h] = 0.f;
#pragma unroll
        for (int j = 0; j < 4; ++j) {
            v[j] = v[j] * rstd;
            o8[64 * j] = (unsigned long long)pk2(v[j].x, v[j].y) | ((unsigned long long)pk2(v[j].z, v[j].w) << 32);
#pragma unroll
            for (int e = 0; e < 4; ++e) {
                const float xv = v[j][e];
                const LAS f32x4* d = (const LAS f32x4*)(dtw + (64 * j + lane) * 144 + e * 32);
                const f32x4 w0 = d[0], w1 = d[1];
                dacc[0] += xv * w0.x; dacc[1] += xv * w0.y; dacc[2] += xv * w0.z; dacc[3] += xv * w0.w;
                dacc[4] += xv * w1.x; dacc[5] += xv * w1.y; dacc[6] += xv * w1.z; dacc[7] += xv * w1.w;
            }
        }
#pragma unroll
        for (int h = 0; h < 8; ++h) dacc[h] = softplusf(wave_sum(dacc[h]) + dtb[h]);
        if (lane == 0) { *(f32x4*)(DT + (size_t)m * 8) = (f32x4){dacc[0], dacc[1], dacc[2], dacc[3]}; *(f32x4*)(DT + (size_t)m * 8 + 4) = (f32x4){dacc[4], dacc[5], dacc[6], dacc[7]}; }
        const float* prow = (m < MP) ? a.in[2] + (size_t)m * DPLE : a.in[3] + (size_t)(m - MP) * DPLE;
        const f32x4 pv = *((const f32x4*)prow + lane);
        *((GAS unsigned long long*)(PB + (size_t)m * DPLE) + lane) = (unsigned long long)pk2(pv.x, pv.y) | ((unsigned long long)pk2(pv.z, pv.w) << 32);
    }
}

__device__ __forceinline__ void load8bf(const bf16* p, float (&o)[8]) {
    const v4u w = *(const v4u*)p;
    o[0] = bflo(w.x); o[1] = bfhi(w.x); o[2] = bflo(w.y); o[3] = bfhi(w.y); o[4] = bflo(w.z); o[5] = bfhi(w.z); o[6] = bflo(w.w); o[7] = bfhi(w.w);
}
__device__ __forceinline__ void load8f(const float* p, float (&o)[8]) {
    const f32x4 a = *(const f32x4*)p, b = *(const f32x4*)(p + 4);
    o[0] = a.x; o[1] = a.y; o[2] = a.z; o[3] = a.w; o[4] = b.x; o[5] = b.y; o[6] = b.z; o[7] = b.w;
}
__device__ __forceinline__ void conv_sample_pass(const Args& a, int gtid, int NT) {
    const bf16* PROJ = (const bf16*)(a.ws + WS_PROJ); float* XB = (float*)(a.ws + WS_XBS); bf16* XC = (bf16*)(a.ws + WS_XC);
    const float* cw = a.in[12]; const float* cb = a.in[13]; const float* sconv = a.in[7];
    for (int it = gtid; it < NBS * 128; it += NT) {
        const int b = it >> 7, c = (it & 127) * 8, m0 = MP + b * 8;
        float w0[8], w1[8], w2[8], w3[8], bb[8], x3[8], x2[8], x1[8];
        load8f(cw + c, w0); load8f(cw + 1024 + c, w1); load8f(cw + 2048 + c, w2); load8f(cw + 3072 + c, w3); load8f(cb + c, bb);
        load8f(sconv + (size_t)(b * 3 + 0) * 1024 + c, x3); load8f(sconv + (size_t)(b * 3 + 1) * 1024 + c, x2); load8f(sconv + (size_t)(b * 3 + 2) * 1024 + c, x1);
#pragma unroll
        for (int r = 0; r < 8; ++r) {
            float cur[8], y[8]; load8bf(PROJ + (size_t)(m0 + r) * NIN + PC_X + c, cur);
#pragma unroll
            for (int k = 0; k < 8; ++k) { y[k] = siluf(bb[k] + w0[k] * x3[k] + w1[k] * x2[k] + w2[k] * x1[k] + w3[k] * cur[k]); x3[k] = x2[k]; x2[k] = x1[k]; x1[k] = cur[k]; }
            float* o = XB + (size_t)(b * 8 + r) * 1024 + c;
            *(f32x4*)o = (f32x4){y[0], y[1], y[2], y[3]}; *(f32x4*)(o + 4) = (f32x4){y[4], y[5], y[6], y[7]};
            if (c < 512) { v4u w; w.x = pk2(y[0], y[1]); w.y = pk2(y[2], y[3]); w.z = pk2(y[4], y[5]); w.w = pk2(y[6], y[7]); *(v4u*)(XC + (size_t)(m0 + r) * 512 + c) = w; }
        }
    }
}

constexpr int S1_BR = 0, S1_CR = 32768, S1_BT = 65536, S1_XT = 98304, S1_XW = 114688, S1_AC = 133120;
__device__ __forceinline__ void ssd_s1_unit(const Args& a, LAS unsigned char* lds, int unit, int tid, int wave, int lane) {
    const int h = unit & 7, c = (unit >> 3) & 31, b = unit >> 8, g = h >> 2, m0 = b * SEQ + c * 128;
    const bf16* PROJ = (const bf16*)(a.ws + WS_PROJ); const float* DT = (const float*)(a.ws + WS_DT);
    LAS float* ac = (LAS float*)(lds + S1_AC); LAS float* dts = ac + 128;
    const int r32 = lane & 31, hh = lane >> 5;
    if (wave == 0) {
        const float A = -__expf(a.in[15][h]);
        const float d0 = DT[(size_t)(m0 + 2 * lane) * 8 + h], d1 = DT[(size_t)(m0 + 2 * lane + 1) * 8 + h];
        const float a0 = d0 * A, a1 = d1 * A; float v = a0 + a1;
#pragma unroll
        for (int d = 1; d < 64; d <<= 1) { const float n = __shfl_up(v, d); if (lane >= d) v += n; }
        const float e0 = v - a1, e1 = v;
        ac[2 * lane] = e0; ac[2 * lane + 1] = e1; dts[2 * lane] = d0; dts[2 * lane + 1] = d1;
        float* ACUM = (float*)(a.ws + WS_ACUM); ACUM[(size_t)(m0 + 2 * lane) * 8 + h] = e0; ACUM[(size_t)(m0 + 2 * lane + 1) * 8 + h] = e1;
        if (lane == 63) ((float*)(a.ws + WS_ACL))[(b * 32 + c) * 8 + h] = e1;
    }
    __syncthreads();
#ifndef S1SUB
#define S1SUB 7
#endif
    if ((S1SUB & 1) && tid < 320) {
        const int o = tid % 40, rc = tid / 40, s0 = rc * 16;
        const int xcol = (o < 8) ? h * 64 + 8 * o : (o < 24) ? 512 + g * 128 + 8 * (o - 8) : 768 + g * 128 + 8 * (o - 24);
        const float* cw = a.in[12]; const float* cb = a.in[13];
        float w0[8], w1[8], w2[8], w3[8], bb[8], x3[8], x2[8], x1[8];
        load8f(cw + xcol, w0); load8f(cw + 1024 + xcol, w1); load8f(cw + 2048 + xcol, w2); load8f(cw + 3072 + xcol, w3); load8f(cb + xcol, bb);
        const bf16* src = PROJ + (size_t)(m0 + s0) * NIN + PC_X + xcol;
        if (c == 0 && rc == 0) {
#pragma unroll
            for (int k = 0; k < 8; ++k) { x3[k] = 0.f; x2[k] = 0.f; x1[k] = 0.f; }
        } else { load8bf(src - 3 * NIN, x3); load8bf(src - 2 * NIN, x2); load8bf(src - NIN, x1); }
        const float aL = ac[127];
        bf16* XC = (bf16*)(a.ws + WS_XC); bf16* CC = (bf16*)(a.ws + WS_CC);
#pragma unroll 1
        for (int r = 0; r < 16; ++r) {
            const int sr = s0 + r; float cur[8], y[8]; load8bf(src + (size_t)r * NIN, cur);
#pragma unroll
            for (int k = 0; k < 8; ++k) { y[k] = siluf(bb[k] + w0[k] * x3[k] + w1[k] * x2[k] + w2[k] * x1[k] + w3[k] * cur[k]); x3[k] = x2[k]; x2[k] = x1[k]; x1[k] = cur[k]; }
            v4u w; w.x = pk2(y[0], y[1]); w.y = pk2(y[2], y[3]); w.z = pk2(y[4], y[5]); w.w = pk2(y[6], y[7]);
            if (o < 8) {
                const int off = (o >> 2) * 8192 + (sr >> 4) * 1024 + (sr & 15) * 64 + (o & 3) * 16;
                *(LAS v4u*)(lds + S1_XT + off) = w;
                const float de = __expf(aL - ac[sr]) * dts[sr];
                v4u ww; ww.x = pk2(y[0] * de, y[1] * de); ww.y = pk2(y[2] * de, y[3] * de); ww.z = pk2(y[4] * de, y[5] * de); ww.w = pk2(y[6] * de, y[7] * de);
                *(LAS v4u*)(lds + S1_XW + off) = ww;
                *(v4u*)(XC + (size_t)(m0 + sr) * 512 + h * 64 + 8 * o) = w;
            } else if (o < 24) {
                const int ch = o - 8;
                *(LAS v4u*)(lds + S1_BR + sr * 256 + ((ch ^ (sr & 15)) << 4)) = w;
                *(LAS v4u*)(lds + S1_BT + (ch >> 2) * 8192 + (sr >> 4) * 1024 + (sr & 15) * 64 + (ch & 3) * 16) = w;
            } else {
                const int ch = o - 24;
                *(LAS v4u*)(lds + S1_CR + sr * 256 + ((ch ^ (sr & 15)) << 4)) = w;
                if ((h & 3) == 0) *(v4u*)(CC + (size_t)(m0 + sr) * 256 + g * 128 + 8 * ch) = w;
            }
        }
    }
    __syncthreads();
    const int laneoff = ((lane >> 4) & 1) * 32 + (lane & 3) * 8 + (4 * hh + ((lane & 15) >> 2)) * 64;
    if (S1SUB & 2) {
        const int tb = wave >> 1, ph = wave & 1, tq = 32 * tb + r32;
        bf16x8 cq[8];
#pragma unroll
        for (int k = 0; k < 8; ++k) cq[k] = *(const LAS bf16x8*)(lds + S1_CR + tq * 256 + (((2 * k + hh) ^ (tq & 15)) << 4));
        const float act = ac[tq] * LOG2E;
        f32x16 o;
#pragma unroll
        for (int i = 0; i < 16; ++i) o[i] = 0.f;
#pragma unroll 1
        for (int sb = 0; sb <= tb; ++sb) {
            {
                f32x16 S;
#pragma unroll
                for (int i = 0; i < 16; ++i) S[i] = 0.f;
                const int sq = 32 * sb + r32;
#pragma unroll
                for (int k = 0; k < 8; ++k) { const bf16x8 bf = *(const LAS bf16x8*)(lds + S1_BR + sq * 256 + (((2 * k + hh) ^ (sq & 15)) << 4)); S = __builtin_amdgcn_mfma_f32_32x32x16_bf16(bf, cq[k], S, 0, 0, 0); }
#pragma unroll
                for (int i = 0; i < 16; ++i) { const int si = 32 * sb + crow(i, hh); const float e = __builtin_amdgcn_exp2f(act - ac[si] * LOG2E) * dts[si]; S[i] = (si <= tq) ? S[i] * e : 0.f; }
#pragma unroll
                for (int ks = 0; ks < 2; ++ks) {
                    v4u pw; pw.x = cvtpk_s(S[8 * ks + 0], S[8 * ks + 1]); pw.y = cvtpk_s(S[8 * ks + 2], S[8 * ks + 3]); pw.z = cvtpk_s(S[8 * ks + 4], S[8 * ks + 5]); pw.w = cvtpk_s(S[8 * ks + 6], S[8 * ks + 7]);
                    const bf16x8 pa = __builtin_bit_cast(bf16x8, pw);
                    const LAS unsigned char* xp = lds + S1_XT + ph * 8192 + (2 * sb + ks) * 1024 + laneoff;
                    const v4i16_t lo = vtr(xp), hi2 = vtr(xp + 512);
                    const bf16x8 xb = (bf16x8){lo[0], lo[1], lo[2], lo[3], hi2[0], hi2[1], hi2[2], hi2[3]};
                    o = __builtin_amdgcn_mfma_f32_32x32x16_bf16(pa, xb, o, 0, 0, 0);
                }
            }
        }
        float* YS = (float*)(a.ws + WS_YS);
#pragma unroll
        for (int i = 0; i < 16; ++i) YS[(size_t)(m0 + 32 * tb + crow(i, hh)) * 512 + h * 64 + 32 * ph + r32] = o[i];
    }
    if (S1SUB & 4) {
        const int pb = wave & 1, nb = wave >> 1;
        f32x16 st;
#pragma unroll
        for (int i = 0; i < 16; ++i) st[i] = 0.f;
#pragma unroll
        for (int k = 0; k < 8; ++k) {
            const LAS unsigned char* ap = lds + S1_XW + pb * 8192 + k * 1024 + laneoff; const LAS unsigned char* bp = lds + S1_BT + nb * 8192 + k * 1024 + laneoff;
            const v4i16_t al = vtr(ap), ah = vtr(ap + 512), bl = vtr(bp), bh = vtr(bp + 512);
            const bf16x8 af = (bf16x8){al[0], al[1], al[2], al[3], ah[0], ah[1], ah[2], ah[3]}, bf = (bf16x8){bl[0], bl[1], bl[2], bl[3], bh[0], bh[1], bh[2], bh[3]};
            st = __builtin_amdgcn_mfma_f32_32x32x16_bf16(af, bf, st, 0, 0, 0);
        }
        float* CS = (float*)(a.ws + WS_CS) + (size_t)((b * 32 + c) * 8 + h) * 64 * 128;
#pragma unroll
        for (int i = 0; i < 16; ++i) CS[(size_t)(32 * pb + crow(i, hh)) * 128 + 32 * nb + r32] = st[i];
    }
    LDS_WAIT(); __syncthreads();
}
__device__ __forceinline__ void ssd_s2_pass(const Args& a, int gtid, int NT) {
    typedef float f32x2t __attribute__((ext_vector_type(2)));
    const float* CS = (const float*)(a.ws + WS_CS); const float* ACL = (const float*)(a.ws + WS_ACL); bf16* PREV = (bf16*)(a.ws + WS_PREV);
    for (int it = gtid; it < NBP * 8 * 64 * 64; it += NT) {
        const int n2 = it & 63, p = (it >> 6) & 63, h = (it >> 12) & 7, b = it >> 15;
        f32x2t s = {0.f, 0.f};
#pragma unroll 8
        for (int c = 0; c < 32; ++c) {
            const size_t idx = ((size_t)((b * 32 + c) * 8 + h) * 64 + p) * 128 + 2 * n2;
            const f32x2t cs = *(const f32x2t*)(CS + idx); const float dec = __expf(ACL[(b * 32 + c) * 8 + h]);
            *(unsigned*)(PREV + idx) = pk2(s.x, s.y);
            s = s * dec + cs;
        }
        *(f32x2t*)(a.out + O_SP + ((size_t)((b * 8 + h) * 64 + p)) * 128 + 2 * n2) = s;
    }
}
__device__ __forceinline__ void ssd_s3_unit(const Args& a, int unit, int wave, int lane) {
    const int h = unit & 7, c = (unit >> 3) & 31, b = unit >> 8, g = h >> 2, m0 = b * SEQ + c * 128;
    const int r32 = lane & 31, hh = lane >> 5, tb = wave >> 1, ph = wave & 1;
    const bf16* cp = (const bf16*)(a.ws + WS_CC) + (size_t)(m0 + 32 * tb + r32) * 256 + g * 128 + 8 * hh;
    const bf16* pp = (const bf16*)(a.ws + WS_PREV) + ((size_t)((b * 32 + c) * 8 + h) * 64 + 32 * ph + r32) * 128 + 8 * hh;
    bf16x8 cf[8], pf[8];
#pragma unroll
    for (int k = 0; k < 8; ++k) { cf[k] = *(const bf16x8*)(cp + 16 * k); pf[k] = *(const bf16x8*)(pp + 16 * k); }
    f32x16 acc;
#pragma unroll
    for (int i = 0; i < 16; ++i) acc[i] = 0.f;
#pragma unroll
    for (int k = 0; k < 8; ++k) acc = __builtin_amdgcn_mfma_f32_32x32x16_bf16(cf[k], pf[k], acc, 0, 0, 0);
    float* YS = (float*)(a.ws + WS_YS); const float* ACUM = (const float*)(a.ws + WS_ACUM);
#pragma unroll
    for (int i = 0; i < 16; ++i) { const size_t t = (size_t)(m0 + 32 * tb + crow(i, hh)); float* yp = YS + t * 512 + h * 64 + 32 * ph + r32; *yp = *yp + __expf(ACUM[t * 8 + h]) * acc[i]; }
}

constexpr int ATT_WAVE_BYTES = 8704, ATT_VB = 0, ATT_STG = 4096, ATT_WSF = 8192, ATT_BTAB_OFF = 8 * ATT_WAVE_BYTES  , ATT_BT_LD = 132;

__device__ __forceinline__ void attn_build_btab(const Args& a, LAS unsigned char* lds, int tid) {
    LAS float* bt = (LAS float*)(lds + ATT_BTAB_OFF); const float* rb = a.in[9];
    for (int i = tid; i < 3 * 8 * 129; i += NWAVES * 64) { const int br = i / (8 * 129), rem = i % (8 * 129), h = rem / 129, j = rem % 129; bt[(br * 8 + h) * ATT_BT_LD + j] = rb[BUCKET_TAB[br][j] * 8 + h] * LOG2E; }
}
__device__ __forceinline__ void attn_prompt_unit(const Args& a, LAS unsigned char* lds, int unit, int wave, int lane) {
    const bf16* PROJ = (const bf16*)(a.ws + WS_PROJ);
    const int r32 = lane & 31, hi = lane >> 5;
    const int rq = unit & 127, bhb = unit >> 7, br = bhb % 3, bh = bhb / 3, h = bh & 7, b = bh >> 3;
    const int sh = 2 * br, dil = 1 << sh, nqb = 128 >> sh, r = rq / nqb, qb = rq % nqb, l0 = qb * 32;
    const size_t rowb = (size_t)b * SEQ;
    LAS unsigned char* wl = lds + wave * ATT_WAVE_BYTES;
    const LAS float* bt = (const LAS float*)(lds + ATT_BTAB_OFF) + (br * 8 + h) * ATT_BT_LD;
    bf16x8 qr[4];
    { const bf16* qp = PROJ + (rowb + (size_t)(l0 + r32) * dil + r) * NIN + h * 64 + hi * 8;
#pragma unroll
      for (int d0 = 0; d0 < 4; ++d0) qr[d0] = *(const bf16x8*)(qp + d0 * 16); }
    const int kb0 = (l0 >= 128) ? 0 : (4 - (l0 >> 5));
    f32x16 s[5];
#pragma unroll
    for (int kb = 0; kb < 5; ++kb) {
#pragma unroll
        for (int i = 0; i < 16; ++i) s[kb][i] = 0.f;
        if (kb >= kb0) {
            int kk = l0 - 128 + 32 * kb + r32; kk = kk < 0 ? 0 : kk;
            const bf16* kp = PROJ + (rowb + (size_t)kk * dil + r) * NIN + PC_K + h * 64 + hi * 8;
            bf16x8 kf[4];
#pragma unroll
            for (int d0 = 0; d0 < 4; ++d0) kf[d0] = *(const bf16x8*)(kp + d0 * 16);
#pragma unroll
            for (int d0 = 0; d0 < 4; ++d0) s[kb] = __builtin_amdgcn_mfma_f32_32x32x16_bf16(kf[d0], qr[d0], s[kb], 0, 0, 0);
        }
    }
    float mx = -INFINITY;
#pragma unroll
    for (int kb = 0; kb < 5; ++kb)
#pragma unroll
        for (int i = 0; i < 16; ++i) {
            const int c = crow(i, hi), j = r32 - c + 128 - 32 * kb, kk = l0 - 128 + 32 * kb + c;
            const bool valid = (j >= 0) && (j <= 128) && (kk >= 0) && (kb >= kb0);
            const int jc = j < 0 ? 0 : (j > 128 ? 128 : j);
            const float v = valid ? s[kb][i] + bt[jc] : -INFINITY;
            s[kb][i] = v; mx = fmaxf(mx, v);
        }
    mx = fmaxf(mx, __shfl_xor(mx, 32));
    float l = 0.f;
#pragma unroll
    for (int kb = 0; kb < 5; ++kb)
#pragma unroll
        for (int i = 0; i < 16; ++i) { const float p = __builtin_amdgcn_exp2f(s[kb][i] - mx); s[kb][i] = p; l += p; }
    l += __shfl_xor(l, 32);
    f32x16 o[2];
#pragma unroll
    for (int i = 0; i < 16; ++i) { o[0][i] = 0.f; o[1][i] = 0.f; }
    const LAS unsigned char* vrd = wl + ATT_VB + ((lane >> 4) & 1) * 32 + (lane & 3) * 8 + (4 * hi + ((lane & 15) >> 2)) * 64;
#pragma unroll
    for (int kb = 0; kb < 5; ++kb) {
        if (kb >= kb0) {
#pragma unroll
            for (int i = 0; i < 4; ++i) {
                const int idx = i * 64 + lane, key = idx >> 3, ch = idx & 7;
                int kk = l0 - 128 + 32 * kb + key; kk = kk < 0 ? 0 : kk;
                const v4u vv = *(const v4u*)(PROJ + (rowb + (size_t)kk * dil + r) * NIN + PC_V + h * 64 + ch * 8);
                *(LAS v4u*)(wl + ATT_VB + (ch >> 2) * 2048 + (key >> 4) * 1024 + (key & 15) * 64 + (ch & 3) * 16) = vv;
            }
            LDS_WAIT();
#pragma unroll
            for (int ks = 0; ks < 2; ++ks) {
                v4u pw;
                pw.x = cvtpk_s(s[kb][8 * ks + 0], s[kb][8 * ks + 1]); pw.y = cvtpk_s(s[kb][8 * ks + 2], s[kb][8 * ks + 3]);
                pw.z = cvtpk_s(s[kb][8 * ks + 4], s[kb][8 * ks + 5]); pw.w = cvtpk_s(s[kb][8 * ks + 6], s[kb][8 * ks + 7]);
                const bf16x8 pa = __builtin_bit_cast(bf16x8, pw);
#pragma unroll
                for (int d0 = 0; d0 < 2; ++d0) {
                    const v4i16_t lo = vtr(vrd + d0 * 2048 + ks * 1024), hh = vtr(vrd + d0 * 2048 + ks * 1024 + 512);
                    const bf16x8 vb = (bf16x8){lo[0], lo[1], lo[2], lo[3], hh[0], hh[1], hh[2], hh[3]};
                    o[d0] = __builtin_amdgcn_mfma_f32_32x32x16_bf16(pa, vb, o[d0], 0, 0, 0);
                }
            }
            LDS_WAIT();
        }
    }
    LAS float* wsf = (LAS float*)(wl + ATT_WSF);
    if (hi == 0) wsf[r32] = l;
    LDS_WAIT();
    LAS bf16* stg = (LAS bf16*)(wl + ATT_STG);
#pragma unroll
    for (int i = 0; i < 16; ++i) {
        const int orow = crow(i, hi); const float rl = 1.0f / wsf[orow];
        stg[orow * 64 + r32] = (bf16)f2bf(o[0][i] * rl); stg[orow * 64 + 32 + r32] = (bf16)f2bf(o[1][i] * rl);
    }
    LDS_WAIT();
    bf16* OBR = (bf16*)(a.ws + WS_OBR) + (size_t)br * MP * 512;
#pragma unroll
    for (int i = 0; i < 4; ++i) {
        const int row = i * 8 + (lane >> 3), ch = lane & 7;
        const v4u v = *(const LAS v4u*)(stg + row * 64 + ch * 8);
        *(v4u*)(OBR + (rowb + (size_t)(l0 + row) * dil + r) * 512 + h * 64 + ch * 8) = v;
    }
    if (hi == 0) { float* LSE = (float*)(a.ws + WS_LSE) + (size_t)br * MP * 8; LSE[(rowb + (size_t)(l0 + r32) * dil + r) * 8 + h] = mx + __builtin_amdgcn_logf(l); }
    LDS_WAIT();
}

__device__ __forceinline__ float row16_sum(float v) {
    v += __builtin_bit_cast(float, __builtin_amdgcn_update_dpp(0, __builtin_bit_cast(int, v), 0xB1, 0xf, 0xf, true));
    v += __builtin_bit_cast(float, __builtin_amdgcn_update_dpp(0, __builtin_bit_cast(int, v), 0x4E, 0xf, 0xf, true));
    v += __builtin_bit_cast(float, __builtin_amdgcn_update_dpp(0, __builtin_bit_cast(int, v), 0x141, 0xf, 0xf, true));
    v += __builtin_bit_cast(float, __builtin_amdgcn_update_dpp(0, __builtin_bit_cast(int, v), 0x140, 0xf, 0xf, true));
    return v;
}
__device__ __forceinline__ void attn_sample_task(const Args& a, LAS unsigned char* lds, int task, int wave, int lane) {
    const int h = task & 7, t = (task >> 3) & 7, b = task >> 6;
    const bf16* PROJ = (const bf16*)(a.ws + WS_PROJ);
    const float* ck = a.in[4]; const float* cv = a.in[5]; const float* kn = a.out + O_KS; const float* vn = a.out + O_VS;
    LAS float* pl = (LAS float*)(lds + wave * ATT_WAVE_BYTES + ATT_STG);
    const int ks = lane >> 4, dq = lane & 15;
    f32x4 q4;
    { const u32x2 w = *(const u32x2*)(PROJ + (size_t)(MP + b * 8 + t) * NIN + h * 64 + 4 * dq); q4 = (f32x4){bflo(w.x), bfhi(w.x), bflo(w.y), bfhi(w.y)}; }
    const size_t cbase = ((size_t)b * WBUF * 8 + h) * 64 + 4 * dq, nbase = ((size_t)b * 8 * 8 + h) * 64 + 4 * dq;
#pragma unroll 1
    for (int br = 0; br < 3; ++br) {
        const int dil = 1 << (2 * br);
        const LAS float* bt = (const LAS float*)(lds + ATT_BTAB_OFF) + (br * 8 + h) * ATT_BT_LD;
#pragma unroll 1
        for (int it0 = 0; it0 < 33; it0 += 11) {
            f32x4 kv[11];
#pragma unroll
            for (int u = 0; u < 11; ++u) { int j = 4 * (it0 + u) + ks; j = j > 128 ? 128 : j; const int idx = WBUF + t - j * dil;
                kv[u] = (idx < WBUF) ? *(const f32x4*)(ck + cbase + (size_t)idx * 512) : *(const f32x4*)(kn + nbase + (size_t)(idx - WBUF) * 512); }
#pragma unroll
            for (int u = 0; u < 11; ++u) { const int j = 4 * (it0 + u) + ks; float d = q4.x * kv[u].x + q4.y * kv[u].y + q4.z * kv[u].z + q4.w * kv[u].w; d = row16_sum(d);
                if (dq == 0 && j <= 128) pl[br * ATT_BT_LD + j] = d + bt[j]; }
        }
    }
    LDS_WAIT(); asm volatile("" ::: "memory");
    float mx = -INFINITY;
#pragma unroll 1
    for (int i = lane; i < 3 * ATT_BT_LD; i += 64) { const int j = i % ATT_BT_LD; if (j <= 128) mx = fmaxf(mx, pl[i]); }
    mx = wave_max(mx);
    float l = 0.f;
#pragma unroll 1
    for (int i = lane; i < 3 * ATT_BT_LD; i += 64) { const int j = i % ATT_BT_LD; if (j <= 128) { const float p = __builtin_amdgcn_exp2f(pl[i] - mx); pl[i] = p; l += p; } }
    l = wave_sum(l);
    LDS_WAIT(); asm volatile("" ::: "memory");
    f32x4 o4 = {0.f, 0.f, 0.f, 0.f};
#pragma unroll 1
    for (int br = 0; br < 3; ++br) {
        const int dil = 1 << (2 * br);
#pragma unroll 1
        for (int it0 = 0; it0 < 33; it0 += 11) {
            f32x4 vv[11]; float pp[11];
#pragma unroll
            for (int u = 0; u < 11; ++u) { const int j0 = 4 * (it0 + u) + ks, j = j0 > 128 ? 128 : j0; const int idx = WBUF + t - j * dil;
                vv[u] = (idx < WBUF) ? *(const f32x4*)(cv + cbase + (size_t)idx * 512) : *(const f32x4*)(vn + nbase + (size_t)(idx - WBUF) * 512);
                pp[u] = (j0 <= 128) ? pl[br * ATT_BT_LD + j] : 0.f; }
#pragma unroll
            for (int u = 0; u < 11; ++u) o4 += vv[u] * pp[u];
        }
    }
#pragma unroll
    for (int e = 0; e < 4; ++e) { o4[e] += __shfl_xor(o4[e], 16); o4[e] += __shfl_xor(o4[e], 32); }
    if (lane < 16) { const float il = 1.f / l; u32x2 w; w.x = pk2(o4.x * il, o4.y * il); w.y = pk2(o4.z * il, o4.w * il);
        *(u32x2*)((bf16*)(a.ws + WS_MIX) + (size_t)(MP + b * 8 + t) * DM + h * 64 + 4 * dq) = w; }
    LDS_WAIT(); asm volatile("" ::: "memory");
}

__device__ __forceinline__ void ssd_sample_task(const Args& a, int k, int lane) {
    const float* XB = (const float*)(a.ws + WS_XBS); const float* DT = (const float*)(a.ws + WS_DT); float* YS = (float*)(a.ws + WS_YS);
    const int b = k >> 9, h = (k >> 6) & 7, p = k & 63, g = h >> 2;
    const float* si = a.in[6] + ((size_t)((b * 8 + h) * 64 + p)) * 128; float s0 = si[lane], s1 = si[lane + 64];
    float* sout = a.out + O_SS + ((size_t)((b * 8 + h) * 64 + p)) * 128;
    const float A = -__expf(a.in[15][h]);
    for (int t = 0; t < TS; t += 4) {
        float dtv[4], xv[4], B0[4], B1[4], C0[4], C1[4];
#pragma unroll
        for (int q = 0; q < 4; ++q) { const int r = b * TS + t + q; dtv[q] = DT[(size_t)(MP + r) * 8 + h]; const float* xr = XB + (size_t)r * 1024; xv[q] = xr[h * 64 + p]; B0[q] = xr[512 + g * 128 + lane]; B1[q] = xr[512 + g * 128 + 64 + lane]; C0[q] = xr[768 + g * 128 + lane]; C1[q] = xr[768 + g * 128 + 64 + lane]; }
        float y[4];
#pragma unroll
        for (int q = 0; q < 4; ++q) { const float da = __expf(dtv[q] * A), xd = dtv[q] * xv[q]; s0 = da * s0 + xd * B0[q]; s1 = da * s1 + xd * B1[q]; y[q] = C0[q] * s0 + C1[q] * s1; }
#pragma unroll
        for (int q = 0; q < 4; ++q) y[q] = wave_sum(y[q]);
        if (lane == 0) {
#pragma unroll
            for (int q = 0; q < 4; ++q) YS[(size_t)(MP + b * TS + t + q) * 512 + h * 64 + p] = y[q];
        }
    }
    sout[lane] = s0; sout[lane + 64] = s1;
}
__device__ __forceinline__ void attn_combine_pass(const Args& a, int gtid, int NT) {
    const bf16* OBR = (const bf16*)(a.ws + WS_OBR); const float* LSE = (const float*)(a.ws + WS_LSE); bf16* MIX = (bf16*)(a.ws + WS_MIX);
    for (int it = gtid; it < MP * 64; it += NT) {
        const int row = it >> 6, c8 = it & 63, h = c8 >> 3;
        const float l0 = LSE[(size_t)row * 8 + h], l1 = LSE[(size_t)(MP + row) * 8 + h], l2 = LSE[(size_t)(2 * MP + row) * 8 + h];
        const float mx = fmaxf(l0, fmaxf(l1, l2));
        float w0 = __builtin_amdgcn_exp2f(l0 - mx), w1 = __builtin_amdgcn_exp2f(l1 - mx), w2 = __builtin_amdgcn_exp2f(l2 - mx);
        const float inv = 1.f / (w0 + w1 + w2); w0 *= inv; w1 *= inv; w2 *= inv;
        float o0[8], o1[8], o2[8];
        load8bf(OBR + (size_t)row * 512 + c8 * 8, o0); load8bf(OBR + ((size_t)MP + row) * 512 + c8 * 8, o1); load8bf(OBR + ((size_t)2 * MP + row) * 512 + c8 * 8, o2);
        float r[8];
#pragma unroll
        for (int k = 0; k < 8; ++k) r[k] = w0 * o0[k] + w1 * o1[k] + w2 * o2[k];
        v4u w; w.x = pk2(r[0], r[1]); w.y = pk2(r[2], r[3]); w.z = pk2(r[4], r[5]); w.w = pk2(r[6], r[7]);
        *(v4u*)(MIX + (size_t)row * DM + c8 * 8) = w;
    }
}
__device__ __forceinline__ void ssd_finish_pass(const Args& a, int gw, int NGW, int lane) {
    const bf16* XC = (const bf16*)(a.ws + WS_XC); const float* YS = (const float*)(a.ws + WS_YS); const bf16* PROJ = (const bf16*)(a.ws + WS_PROJ); bf16* MIX = (bf16*)(a.ws + WS_MIX);
    const float* dsk = a.in[16]; const float* gs = a.in[17];
    const int c = lane * 8; const float dh = dsk[c >> 6];
    float g8[8]; load8f(gs + c, g8);
    for (int m = gw; m < MT; m += NGW) {
        float y[8], x[8], z[8], v[8]; load8f(YS + (size_t)m * 512 + c, y); load8bf(XC + (size_t)m * 512 + c, x); load8bf(PROJ + (size_t)m * NIN + PC_Z + c, z);
        float ss = 0.f;
#pragma unroll
        for (int k = 0; k < 8; ++k) { v[k] = (y[k] + dh * x[k]) * siluf(z[k]); ss += v[k] * v[k]; }
#pragma unroll
        for (int o = 1; o < 32; o <<= 1) ss += __shfl_xor(ss, o);
        const float rs = 1.0f / sqrtf(ss * (1.f / 256.f) + EPS);
        v4u w; w.x = pk2(v[0] * rs * g8[0], v[1] * rs * g8[1]); w.y = pk2(v[2] * rs * g8[2], v[3] * rs * g8[3]); w.z = pk2(v[4] * rs * g8[4], v[5] * rs * g8[5]); w.w = pk2(v[6] * rs * g8[6], v[7] * rs * g8[7]);
        *(v4u*)(MIX + (size_t)m * DM + 512 + c) = w;
    }
}
__device__ __forceinline__ void ffn_conv_pass(const Args& a, int gtid, int NT) {
    const bf16* U = (const bf16*)(a.ws + WS_U); bf16* ACT = (bf16*)(a.ws + WS_ACT);
    const float* fw = a.in[21]; const float* fb = a.in[22]; const float* sf = a.in[8];
    constexpr int NC8 = DFF / 8, NPB = MP / 16, NITEMS = (NPB + NBS) * NC8;
    for (int it = gtid; it < NITEMS; it += NT) {
        const int blk = it / NC8, c = (it % NC8) * 8;
        float wa0[8], wa1[8], wa2[8], wb0[8], wb1[8], wb2[8], ba[8], bb[8], a2[8], a1[8], b2[8], b1[8];
        load8f(fw + c, wa0); load8f(fw + DFF2 + c, wa1); load8f(fw + 2 * DFF2 + c, wa2); load8f(fb + c, ba);
        load8f(fw + DFF + c, wb0); load8f(fw + DFF2 + DFF + c, wb1); load8f(fw + 2 * DFF2 + DFF + c, wb2); load8f(fb + DFF + c, bb);
        int m0, nr;
        if (blk < NPB) { m0 = blk * 16; nr = 16;
            if ((m0 & (SEQ - 1)) == 0) {
#pragma unroll
                for (int k = 0; k < 8; ++k) { a2[k] = 0.f; a1[k] = 0.f; b2[k] = 0.f; b1[k] = 0.f; }
            } else { load8bf(U + (size_t)(m0 - 2) * DFF2 + c, a2); load8bf(U + (size_t)(m0 - 1) * DFF2 + c, a1); load8bf(U + (size_t)(m0 - 2) * DFF2 + DFF + c, b2); load8bf(U + (size_t)(m0 - 1) * DFF2 + DFF + c, b1); }
        } else { const int b = blk - NPB; m0 = MP + b * 8; nr = 8;
            load8f(sf + (size_t)(b * 2) * DFF2 + c, a2); load8f(sf + (size_t)(b * 2 + 1) * DFF2 + c, a1); load8f(sf + (size_t)(b * 2) * DFF2 + DFF + c, b2); load8f(sf + (size_t)(b * 2 + 1) * DFF2 + DFF + c, b1); }
        for (int r = 0; r < nr; ++r) {
            float ua[8], ub[8], o[8]; load8bf(U + (size_t)(m0 + r) * DFF2 + c, ua); load8bf(U + (size_t)(m0 + r) * DFF2 + DFF + c, ub);
#pragma unroll
            for (int k = 0; k < 8; ++k) {
                const float ya = ba[k] + wa0[k] * a2[k] + wa1[k] * a1[k] + wa2[k] * ua[k], yb = bb[k] + wb0[k] * b2[k] + wb1[k] * b1[k] + wb2[k] * ub[k];
                o[k] = siluf(ya) * yb; a2[k] = a1[k]; a1[k] = ua[k]; b2[k] = b1[k]; b1[k] = ub[k];
            }
            v4u w; w.x = pk2(o[0], o[1]); w.y = pk2(o[2], o[3]); w.z = pk2(o[4], o[5]); w.w = pk2(o[6], o[7]);
            *(v4u*)(ACT + (size_t)(m0 + r) * DFF + c) = w;
        }
    }
}
__device__ __forceinline__ void final_norm_pass(const Args& a, int gw, int NGW, int lane) {
    const float* RS3 = (const float*)(a.ws + WS_RS3); const float* gf = a.in[27];
    f32x4 g[4];
#pragma unroll
    for (int j = 0; j < 4; ++j) g[j] = *((const f32x4*)gf + lane + 64 * j);
    for (int m = gw; m < MT; m += NGW) {
        float* orow = (m < MP) ? a.out + O_Y + (size_t)m * DM : a.out + O_YS + (size_t)(m - MP) * DM;
        const float rs = 1.0f / sqrtf(RS3[m] * (1.f / DM) + EPS);
#pragma unroll
        for (int j = 0; j < 4; ++j) { f32x4* p = (f32x4*)orow + lane + 64 * j; *p = (*p) * rs * g[j]; }
    }
}


typedef float f32x4m __attribute__((ext_vector_type(4)));
template <class Epi>
__device__ __forceinline__ void skinny_gemm(LAS unsigned char* lds, const bf16* A, const bf16* Wt, int N, int K, const Epi& E, int vcu, int G, int tid, int wave, int lane) {
    const int npieces = (MS / 16) * (N / 64), kslice = K / 8, nsteps = kslice / 32;
    const int r16 = lane & 15, kg = lane >> 4;
    for (int piece = vcu; piece < npieces; piece += G) {
        const int mb = piece & 15, nb = piece >> 4, m0 = mb * 16, n0 = nb * 64;
        const bf16* ap = A + (size_t)(m0 + r16) * K + wave * kslice + 8 * kg;
        const bf16* wp = Wt + (size_t)(n0 + r16) * K + wave * kslice + 8 * kg;
        f32x4m acc[4];
#pragma unroll
        for (int j = 0; j < 4; ++j) acc[j] = (f32x4m){0.f, 0.f, 0.f, 0.f};
        for (int s0 = 0; s0 < nsteps; s0 += 4) {
            bf16x8 af[4], wf[4][4];
#pragma unroll
            for (int u = 0; u < 4; ++u) if (s0 + u < nsteps) {
                af[u] = *(const bf16x8*)(ap + (s0 + u) * 32);
#pragma unroll
                for (int j = 0; j < 4; ++j) wf[u][j] = *(const bf16x8*)(wp + (size_t)(16 * j) * K + (s0 + u) * 32);
            }
#pragma unroll
            for (int u = 0; u < 4; ++u) if (s0 + u < nsteps) {
#pragma unroll
                for (int j = 0; j < 4; ++j) acc[j] = __builtin_amdgcn_mfma_f32_16x16x32_bf16(wf[u][j], af[u], acc[j], 0, 0, 0);
            }
        }
#pragma unroll
        for (int j = 0; j < 4; ++j) *(LAS f32x4m*)(lds + ((wave * 4 + j) * 64 + lane) * 16) = acc[j];
        LDS_WAIT(); __syncthreads();
        if (tid < 256) {
            const int j = tid >> 6, l2 = tid & 63;
            f32x4m v = *(const LAS f32x4m*)(lds + (j * 64 + l2) * 16);
#pragma unroll
            for (int w = 1; w < 8; ++w) v += *(const LAS f32x4m*)(lds + ((w * 4 + j) * 64 + l2) * 16);
            E.apply(m0 + (l2 & 15), n0 + 16 * j + 4 * (l2 >> 4), v);
        }
        LDS_WAIT(); __syncthreads();
    }
}
struct SEpiIn { bf16* PROJ; float* out;
    __device__ __forceinline__ void apply(int r, int c, f32x4m v) const {
        const float sc = (c < PC_K) ? C2 : 1.f; u32x2 w; w.x = pk2(v.x * sc, v.y * sc); w.y = pk2(v.z * sc, v.w * sc);
        *(u32x2*)(PROJ + (size_t)(MP + r) * NIN + c) = w;
        if (c >= PC_K && c < PC_Z) { const bool isk = c < PC_V; *(f32x4m*)(out + (isk ? O_KS : O_VS) + (size_t)r * 512 + (c - (isk ? PC_K : PC_V))) = v; }
        else if (c >= PC_X) { const int t = r & 7, b = r >> 3; if (t >= TS - 3) *(f32x4m*)(out + O_CS + (size_t)(b * 3 + t - (TS - 3)) * 1024 + (c - PC_X)) = v; }
    } };
struct SEpiOut { const float* xs; float* H1; bf16* H1b; float* RS;
    __device__ __forceinline__ void apply(int r, int c, f32x4m v) const {
        const f32x4m h = *(const f32x4m*)(xs + (size_t)r * DM + c) + v; const size_t o = (size_t)(MP + r) * DM + c;
        *(f32x4m*)(H1 + o) = h; u32x2 w; w.x = pk2(h.x, h.y); w.y = pk2(h.z, h.w); *(u32x2*)(H1b + o) = w;
        atomicAdd(RS + MP + r, (h.x * h.x + h.y * h.y) + (h.z * h.z + h.w * h.w));
    } };
struct SEpiPle { float* E; float* RS;
    __device__ __forceinline__ void apply(int r, int c, f32x4m v) const {
        *(f32x4m*)(E + (size_t)(MP + r) * DM + c) = v; atomicAdd(RS + MP + r, (v.x * v.x + v.y * v.y) + (v.z * v.z + v.w * v.w));
    } };
struct SEpiDown { float* H1; bf16* H2b;
    __device__ __forceinline__ void apply(int r, int c, f32x4m v) const {
        const size_t o = (size_t)(MP + r) * DM + c; const f32x4m h = *(const f32x4m*)(H1 + o) + v;
        *(f32x4m*)(H1 + o) = h; u32x2 w; w.x = pk2(h.x, h.y); w.y = pk2(h.z, h.w); *(u32x2*)(H2b + o) = w;
    } };
struct SEpiGate { const float* H2; const float* E; const float* RSE; const float* gple; float* out; float* RS3;
    __device__ __forceinline__ void apply(int r, int c, f32x4m v) const {
        const size_t o = (size_t)(MP + r) * DM + c; const float rse = 1.0f / sqrtf(RSE[MP + r] * (1.f / DM) + EPS);
        const f32x4m e = *(const f32x4m*)(E + o), h2 = *(const f32x4m*)(H2 + o), gp = *(const f32x4m*)(gple + c); f32x4m h;
#pragma unroll
        for (int k = 0; k < 4; ++k) { const float g = 1.f / (1.f + __expf(-v[k])); h[k] = h2[k] + g * (e[k] * rse * gp[k]); }
        *(f32x4m*)(out + O_YS + (size_t)r * DM + c) = h; atomicAdd(RS3 + MP + r, (h.x * h.x + h.y * h.y) + (h.z * h.z + h.w * h.w));
    } };

constexpr int NPH = 12;
#ifndef MK_N_LAUNCHES
#define MK_N_LAUNCHES 1
#endif
constexpr int N_LAUNCHES = MK_N_LAUNCHES;
__global__ void __launch_bounds__(NWAVES * 64, 2) mk_fwd(Args args) {
    extern __shared__ __attribute__((aligned(16))) unsigned char lds_raw[];
    LAS unsigned char* lds = (LAS unsigned char*)lds_raw;
    volatile LAS unsigned* MISC = (volatile LAS unsigned*)(lds + MISC_OFF);
    const int tid = threadIdx.x, lane = tid & 63, wave = __builtin_amdgcn_readfirstlane(tid >> 6);
    const int G = gridDim.x, bx = blockIdx.x, vcu = (G % 8 == 0) ? (bx % 8) * (G / 8) + bx / 8 : bx;
    const int gw = vcu * NWAVES + wave, NGW = G * NWAVES, gtid = vcu * (NWAVES * 64) + tid, NT = G * NWAVES * 64;
    unsigned char* ws = args.ws;
    gu32* ctl = (gu32*)(ws + WS_CTL);
    for (int u = tid; u < (LDS_BYTES - LDSCTL_OFF) / 4; u += NWAVES * 64) ((LAS unsigned*)(lds + LDSCTL_OFF))[u] = 0u;
    __syncthreads();
    XcdBarrier bar; bar.bar = (unsigned*)(ctl + CW_BAR); bar.x = 0; bar.st = nullptr;
    if (N_LAUNCHES == 1) bar = xcd_barrier_post((unsigned*)(ctl + CW_BAR), MISC + 8);
    const int lo = args.ph_lo, hi = args.ph_hi;
#ifndef PHMASK
#define PHMASK 0xfff
#endif
#define IN(k) (((PHMASK >> (k)) & 1) && lo <= (k) && (k) < hi)
#define SEAM(k) do { if (IN(k) && IN((k) + 1)) xcd_barrier(bar); } while (0)

    if (IN(0)) { p0_prologue(args, lds, gw, NGW, wave, lane); VM_WAIT(); __syncthreads(); }
    SEAM(0);
    if (IN(1)) {
        pg8::Gemm g{(const pg8::bf16_t*)(ws + WS_XN), (const pg8::bf16_t*)(ws + WS_WIN), MP, NIN, DM}; pg8::StaticOrder S; S.init(MP, NIN, G, bx);
        EpiIn E{(pg8::bf16_t*)(ws + WS_PROJ), args.out};
        pg8::gemm_phase<EpiIn, pg8::StaticOrder, PG8_ALIGN, PG8_SP2>(lds, g, S, E);
        { SEpiIn SE{(bf16*)(ws + WS_PROJ), args.out}; skinny_gemm(lds, (const bf16*)(ws + WS_XN) + (size_t)MP * DM, (const bf16*)(ws + WS_WIN), NIN, DM, SE, vcu, G, tid, wave, lane); }
    }
    SEAM(1);
    if (IN(2)) {
        attn_build_btab(args, lds, tid);
        conv_sample_pass(args, gtid, NT);
        __syncthreads();
#ifndef P2SUB
#define P2SUB 7
#endif
        if (P2SUB & 1) for (int task = gw; task < NBS * TS * NH; task += NGW) attn_sample_task(args, lds, task, wave, lane);
        __syncthreads();
        if (P2SUB & 2) for (int unit = gw; unit < NBP * NH * 3 * 128; unit += NGW) attn_prompt_unit(args, lds, unit, wave, lane);
        __syncthreads();
        if (P2SUB & 4) for (int unit = vcu; unit < NBP * 32 * 8; unit += G) ssd_s1_unit(args, lds, unit, tid, wave, lane);
        VM_WAIT(); __syncthreads();
    }
    SEAM(2);
    if (IN(3)) {
        ssd_s2_pass(args, gtid, NT);
        for (int task = gw; task < NBS * 512; task += NGW) ssd_sample_task(args, task, lane);
        attn_combine_pass(args, gtid, NT);
        VM_WAIT(); __syncthreads();
    }
    SEAM(3);
    if (IN(4)) {
        for (int unit = vcu; unit < NBP * 32 * 8; unit += G) ssd_s3_unit(args, unit, wave, lane);
        VM_WAIT(); __syncthreads();
    }
    SEAM(4);
    if (IN(5)) { ssd_finish_pass(args, gw, NGW, lane); VM_WAIT(); __syncthreads(); }
    SEAM(5);
    if (IN(6)) {
        { pg8::Gemm g{(const pg8::bf16_t*)(ws + WS_MIX), (const pg8::bf16_t*)(ws + WS_WOUT), MP, DM, DM}; pg8::StaticOrder S; S.init(MP, DM, G, bx);
          EpiOut E{args.in[0], args.in[1], (float*)(ws + WS_H1), (pg8::bf16_t*)(ws + WS_XN), (float*)(ws + WS_RS1)};
          pg8::gemm_phase<EpiOut, pg8::StaticOrder, PG8_ALIGN, PG8_SP2>(lds, g, S, E); }
        { SEpiOut SE{args.in[1], (float*)(ws + WS_H1), (bf16*)(ws + WS_XN), (float*)(ws + WS_RS1)}; skinny_gemm(lds, (const bf16*)(ws + WS_MIX) + (size_t)MP * DM, (const bf16*)(ws + WS_WOUT), DM, DM, SE, vcu, G, tid, wave, lane); }
        { pg8::Gemm g{(const pg8::bf16_t*)(ws + WS_PB), (const pg8::bf16_t*)(ws + WS_WPLE), MP, DM, DPLE}; pg8::StaticOrder S; S.init(MP, DM, G, bx);
          EpiPle E{(float*)(ws + WS_E), (float*)(ws + WS_RSE)};
          pg8::gemm_phase<EpiPle, pg8::StaticOrder, PG8_ALIGN, PG8_SP2>(lds, g, S, E); }
        { SEpiPle SE{(float*)(ws + WS_E), (float*)(ws + WS_RSE)}; skinny_gemm(lds, (const bf16*)(ws + WS_PB) + (size_t)MP * DPLE, (const bf16*)(ws + WS_WPLE), DM, DPLE, SE, vcu, G, tid, wave, lane); }
    }
    SEAM(6);
    if (IN(7)) {
        pg8::Gemm g{(const pg8::bf16_t*)(ws + WS_XN), (const pg8::bf16_t*)(ws + WS_WUP), MT, DFF2, DM}; pg8::StaticOrder S; S.init(MT, DFF2, G, bx);
        EpiUp E{(pg8::bf16_t*)(ws + WS_U), (const float*)(ws + WS_RS1), args.out};
        pg8::gemm_phase<EpiUp, pg8::StaticOrder, PG8_ALIGN, PG8_SP2>(lds, g, S, E);
    }
    SEAM(7);
    if (IN(8)) { ffn_conv_pass(args, gtid, NT); VM_WAIT(); __syncthreads(); }
    SEAM(8);
    if (IN(9)) {
        pg8::Gemm g{(const pg8::bf16_t*)(ws + WS_ACT), (const pg8::bf16_t*)(ws + WS_WDOWN), MP, DM, DFF}; pg8::StaticOrder S; S.init(MP, DM, G, bx);
        EpiDown E{(float*)(ws + WS_H1), (pg8::bf16_t*)(ws + WS_XN)};
        pg8::gemm_phase<EpiDown, pg8::StaticOrder, PG8_ALIGN, PG8_SP2>(lds, g, S, E);
        { SEpiDown SE{(float*)(ws + WS_H1), (bf16*)(ws + WS_XN)}; skinny_gemm(lds, (const bf16*)(ws + WS_ACT) + (size_t)MP * DFF, (const bf16*)(ws + WS_WDOWN), DM, DFF, SE, vcu, G, tid, wave, lane); }
    }
    SEAM(9);
    if (IN(10)) {
        pg8::Gemm g{(const pg8::bf16_t*)(ws + WS_XN), (const pg8::bf16_t*)(ws + WS_WGATE), MP, DM, DM}; pg8::StaticOrder S; S.init(MP, DM, G, bx);
        EpiGate E{(const float*)(ws + WS_H1), (const float*)(ws + WS_E), (const float*)(ws + WS_RSE), args.in[25], args.out, (float*)(ws + WS_RS3)};
        pg8::gemm_phase<EpiGate, pg8::StaticOrder, PG8_ALIGN, PG8_SP2>(lds, g, S, E);
        { SEpiGate SE{(const float*)(ws + WS_H1), (const float*)(ws + WS_E), (const float*)(ws + WS_RSE), args.in[25], args.out, (float*)(ws + WS_RS3)}; skinny_gemm(lds, (const bf16*)(ws + WS_XN) + (size_t)MP * DM, (const bf16*)(ws + WS_WGATE), DM, DM, SE, vcu, G, tid, wave, lane); }
    }
    SEAM(10);
    if (IN(11)) { final_norm_pass(args, gw, NGW, lane); }
#undef IN
#undef SEAM
}

extern "C" void kernel_launch(void* const* d_in, const int* in_sizes, int n_in, void* d_out, int out_size, void* d_ws, size_t ws_size, hipStream_t stream) {
    static int grid = 0;
    if (grid == 0) {
        if (n_in != 28 || out_size != (int)O_END || ws_size < WS_END) { fprintf(stderr, "kernel_launch: unexpected shapes: n_in %d out %d ws %zu\n", n_in, out_size, ws_size); grid = -1; return; }
        int dev = 0, cus = 0, per_cu = 0;
        if (hipGetDevice(&dev) != hipSuccess || hipDeviceGetAttribute(&cus, hipDeviceAttributeMultiprocessorCount, dev) != hipSuccess) { grid = -1; return; }
        if (hipFuncSetAttribute((const void*)mk_fwd, hipFuncAttributeMaxDynamicSharedMemorySize, LDS_BYTES) != hipSuccess) { fprintf(stderr, "kernel_launch: hipFuncSetAttribute failed\n"); grid = -1; return; }
        if (hipOccupancyMaxActiveBlocksPerMultiprocessor(&per_cu, (const void*)mk_fwd, NWAVES * 64, LDS_BYTES) != hipSuccess || per_cu < 1) fprintf(stderr, "kernel_launch: occupancy query says %d\n", per_cu);
        (void)hipGetLastError();
        grid = cus;
    }
    if (grid < 0) return;
    if (hipMemsetAsync((char*)d_ws + WS_CTL, 0, CTL_ZERO_BYTES, stream) != hipSuccess) { fprintf(stderr, "kernel_launch: memset failed\n"); return; }
    Args a{};
    for (int i = 0; i < 28; ++i) a.in[i] = (const float*)d_in[i];
    a.out = (float*)d_out; a.ws = (unsigned char*)d_ws;
    for (int li = 0; li < N_LAUNCHES; ++li) {
        if (N_LAUNCHES == 1) { a.ph_lo = 0; a.ph_hi = NPH; } else { a.ph_lo = li; a.ph_hi = li + 1; }
        a.li = li;
        hipLaunchKernelGGL(mk_fwd, dim3(grid), dim3(NWAVES * 64), LDS_BYTES, stream, a);
        const hipError_t le = hipPeekAtLastError();
        if (le != hipSuccess) { fprintf(stderr, "kernel_launch: launch %d failed: %s\n", li, hipGetErrorName(le)); break; }
    }
}
```

```cpp
#include <hip/hip_runtime.h>
#include <cstdio>
#include <cstdint>
namespace pg8 {
#define PG8_LAS __attribute__((address_space(3)))
typedef unsigned short bf16_t;
typedef short bf16x8 __attribute__((ext_vector_type(8)));
typedef float f32x4 __attribute__((ext_vector_type(4)));
typedef unsigned u32x4 __attribute__((ext_vector_type(4)));
constexpr int BM = 256, BK = 64, HALF = 128, HTB = HALF * BK * 2  , STAGE_BYTES = 8 * HTB, NXCD = 8, WGM = 8;

__host__ __device__ __forceinline__ int lds_byte(int r, int c) { const int st = (r >> 4) * 2 + (c >> 5), rr = r & 15, cc = c & 31, ob = rr * 64 + cc * 2; return st * 1024 + (ob ^ (((ob >> 9) & 1) << 5)); }
__host__ __device__ __forceinline__ void stage_rc(int b, int& R, int& C) { const int st = b / 1024, sb = b % 1024, swz = sb ^ (((sb >> 9) & 1) << 5); R = (st >> 1) * 16 + swz / 64; C = (st & 1) * 32 + (swz % 64) / 2; }
__host__ __device__ __forceinline__ int perm32(int rho) { const int n = rho >> 4, i = rho & 15; return 8 * (i >> 2) + 4 * n + (i & 3); }

struct Unit { int pm, pn; };
struct Gemm { const bf16_t* A; const bf16_t* Bt; int M, N, K; };

struct StaticOrder {
    int nM, nN, nwg, G, c;
    __host__ __device__ void init(int M, int N, int G_, int c_) { nM = M / BM; nN = N / BM; nwg = nM * nN; G = G_; c = c_; }
    __host__ __device__ bool next(int i, Unit& u) const {
        const long L = (long)i * G + c; if (L >= nwg) return false;
        int wgid = (int)L; { const int q = nwg / NXCD, r = nwg % NXCD, xcd = wgid % NXCD, off = wgid / NXCD; wgid = (xcd < r ? xcd * (q + 1) : r * (q + 1) + (xcd - r) * q) + off; }
        const int nig = WGM * nN, gid = wgid / nig, fm = gid * WGM, gsz = (nM - fm) < WGM ? (nM - fm) : WGM;
        u.pm = fm + ((wgid % nig) % gsz); u.pn = (wgid % nig) / gsz; return true;
    }
    __device__ __forceinline__ void a_ready(const Unit&) const {}
    __device__ __forceinline__ void done(const Unit&) const {}
};

__device__ __forceinline__ unsigned cvt_pk_bf16(float lo, float hi) { unsigned r; asm volatile("v_cvt_pk_bf16_f32 %0, %1, %2" : "=v"(r) : "v"(lo), "v"(hi)); return r; }
typedef float f32x2 __attribute__((ext_vector_type(2)));
template <class Epi, class Sched, bool ALIGN_EPI = false, bool SP2 = false>
__device__ __forceinline__ void gemm_phase(PG8_LAS unsigned char* lds, const Gemm g, const Sched& S, const Epi& E) {
    const int tid = threadIdx.x, wid = __builtin_amdgcn_readfirstlane(tid >> 6), lane = tid & 63, wr = wid >> 2, wc = wid & 3, fr = lane & 15, fq = lane >> 4;
    const int K = g.K, nt = K / BK;
    unsigned voffA[2], voffB[2];
#pragma unroll
    for (int i = 0; i < 2; ++i) { int R, C; stage_rc(tid * 16 + i * 8192, R, C); const int Rb = Epi::PERM ? ((R & ~31) + perm32(R & 31)) : R;
        voffA[i] = (unsigned)(R * K + C) * 2u; voffB[i] = (unsigned)(Rb * K + C) * 2u; }
    const size_t kstep = (size_t)(BK * 2);
    const size_t hstep = (size_t)HALF * K * 2;
    const size_t tstep = 2 * hstep;
    const unsigned ldsw = (unsigned)wid * 1024u;
    const int aoff = lds_byte(wr * 64 + fr, fq * 8), boff = lds_byte(wc * 32 + fr, fq * 8);
#define PG8_SA(b, h) (((b) * 2 + (h)) * HTB)
#define PG8_SB(b, h) ((4 + (b) * 2 + (h)) * HTB)
#define PG8_STAGE(bufoff, gbase, voff) do { _Pragma("unroll") for (int _i = 0; _i < 2; ++_i) \
        __builtin_amdgcn_global_load_lds((const unsigned*)((const char*)(gbase) + (voff)[_i]), (PG8_LAS unsigned*)(lds + (bufoff) + ldsw + _i * 8192), 16, 0, 0); } while (0)
#define PG8_LDA(dst, b, h) do { _Pragma("unroll") for (int m = 0; m < 4; ++m) _Pragma("unroll") for (int k = 0; k < 2; ++k) dst[m][k] = *(const PG8_LAS bf16x8*)(lds + PG8_SA(b, h) + aoff + m * 2048 + k * 1024); } while (0)
#define PG8_LDB(dst, b, h) do { _Pragma("unroll") for (int n = 0; n < 2; ++n) _Pragma("unroll") for (int k = 0; k < 2; ++k) dst[n][k] = *(const PG8_LAS bf16x8*)(lds + PG8_SB(b, h) + boff + n * 2048 + k * 1024); } while (0)
#define PG8_MMA(ai, bj, At, Bt) do { __builtin_amdgcn_s_setprio(1); _Pragma("unroll") for (int m = 0; m < 4; ++m) _Pragma("unroll") for (int n = 0; n < 2; ++n) _Pragma("unroll") for (int k = 0; k < 2; ++k) \
        acc[ai][bj][m][n] = __builtin_amdgcn_mfma_f32_16x16x32_bf16(Bt[n][k], At[m][k], acc[ai][bj][m][n], 0, 0, 0); __builtin_amdgcn_s_setprio(0); } while (0)
#define PG8_WAIT_V(n) asm volatile("s_waitcnt vmcnt(" #n ")" ::: "memory")
#define PG8_WAIT_L(n) asm volatile("s_waitcnt lgkmcnt(" #n ")" ::: "memory")
#define PG8_BAR __builtin_amdgcn_s_barrier()
#define PG8_SCHED __builtin_amdgcn_sched_barrier(0)
    Unit cur, nxt; int ui = 0;
    if (!S.next(0, cur)) return;
    f32x4 acc[2][2][4][2];
#pragma unroll
    for (int a = 0; a < 2; ++a)
#pragma unroll
        for (int b = 0; b < 2; ++b)
#pragma unroll
            for (int m = 0; m < 4; ++m)
#pragma unroll
                for (int n = 0; n < 2; ++n) acc[a][b][m][n] = (f32x4){0.f, 0.f, 0.f, 0.f};
    bf16x8 At[4][2], B0[2][2], B1[2][2];
    const char* cA = (const char*)g.A + (size_t)cur.pm * tstep; const char* cB = (const char*)g.Bt + (size_t)cur.pn * tstep;
    S.a_ready(cur);
    if constexpr (SP2) {
        PG8_STAGE(PG8_SB(0, 0), cB, voffB); PG8_STAGE(PG8_SB(0, 1), cB + hstep, voffB); PG8_STAGE(PG8_SA(0, 0), cA, voffA); PG8_STAGE(PG8_SA(0, 1), cA + hstep, voffA);
        if (wr == 1) PG8_BAR;
        PG8_WAIT_V(2); PG8_BAR;
        PG8_STAGE(PG8_SB(1, 0), cB + kstep, voffB); PG8_STAGE(PG8_SA(1, 0), cA + kstep, voffA); PG8_STAGE(PG8_SB(1, 1), cB + hstep + kstep, voffB);
        PG8_WAIT_V(6); PG8_BAR;
    } else {
        PG8_STAGE(PG8_SB(0, 0), cB, voffB); PG8_STAGE(PG8_SA(0, 0), cA, voffA); PG8_STAGE(PG8_SB(0, 1), cB + hstep, voffB); PG8_STAGE(PG8_SA(0, 1), cA + hstep, voffA);
        if (wr == 1) PG8_BAR;
        PG8_WAIT_V(4); PG8_BAR;
        PG8_STAGE(PG8_SB(1, 0), cB + kstep, voffB); PG8_STAGE(PG8_SA(1, 0), cA + kstep, voffA); PG8_STAGE(PG8_SB(1, 1), cB + hstep + kstep, voffB);
        PG8_WAIT_V(6); PG8_BAR;
    }
    for (;;) {
        const bool has_next = S.next(ui + 1, nxt);
        const char* nA = has_next ? (const char*)g.A + (size_t)nxt.pm * tstep : cA; const char* nB = has_next ? (const char*)g.Bt + (size_t)nxt.pn * tstep : cB;
        for (int t = 0; t < nt; t += 2) {
            const bool last = (t == nt - 2);
            const char* a1 = cA + (size_t)(t + 1) * kstep;
            const char* a2 = last ? nA : cA + (size_t)(t + 2) * kstep; const char* b2 = last ? nB : cB + (size_t)(t + 2) * kstep;
            const char* a3 = a2 + kstep; const char* b3 = b2 + kstep;
            if (last && has_next) S.a_ready(nxt);
            if constexpr (SP2) {
            PG8_LDB(B0, 0, 0); PG8_LDB(B1, 0, 1); PG8_SCHED; PG8_LDA(At, 0, 0); PG8_STAGE(PG8_SA(1, 1), a1 + hstep, voffA);
            PG8_WAIT_V(8); PG8_WAIT_L(0); PG8_BAR; PG8_MMA(0, 0, At, B0); PG8_MMA(0, 1, At, B1); PG8_BAR; PG8_SCHED;
            PG8_LDA(At, 0, 1); PG8_STAGE(PG8_SB(0, 0), b2, voffB); PG8_STAGE(PG8_SB(0, 1), b2 + hstep, voffB); PG8_STAGE(PG8_SA(0, 0), a2, voffA);
            PG8_WAIT_V(8); PG8_WAIT_L(0); PG8_BAR; PG8_MMA(1, 0, At, B0); PG8_MMA(1, 1, At, B1); PG8_BAR; PG8_SCHED;
            PG8_LDB(B0, 1, 0); PG8_LDB(B1, 1, 1); PG8_SCHED; PG8_LDA(At, 1, 0); PG8_STAGE(PG8_SA(0, 1), a2 + hstep, voffA);
            PG8_WAIT_V(8); PG8_WAIT_L(0); PG8_BAR; PG8_MMA(0, 0, At, B0); PG8_MMA(0, 1, At, B1); PG8_BAR; PG8_SCHED;
            PG8_LDA(At, 1, 1); PG8_STAGE(PG8_SB(1, 0), b3, voffB); PG8_STAGE(PG8_SB(1, 1), b3 + hstep, voffB); PG8_STAGE(PG8_SA(1, 0), a3, voffA);
            PG8_WAIT_V(8); PG8_WAIT_L(0); PG8_BAR; PG8_MMA(1, 0, At, B0); PG8_MMA(1, 1, At, B1); PG8_BAR; PG8_SCHED;
            } else {
            PG8_LDB(B0, 0, 0); PG8_SCHED; PG8_LDA(At, 0, 0); PG8_STAGE(PG8_SA(1, 1), a1 + hstep, voffA);
            PG8_WAIT_L(8); PG8_BAR; PG8_WAIT_L(0); PG8_MMA(0, 0, At, B0); PG8_BAR; PG8_SCHED;
            PG8_LDB(B1, 0, 1); PG8_STAGE(PG8_SB(0, 0), b2, voffB);
            PG8_BAR; PG8_WAIT_L(0); PG8_MMA(0, 1, At, B1); PG8_BAR;
            PG8_LDA(At, 0, 1); PG8_STAGE(PG8_SA(0, 0), a2, voffA);
            PG8_BAR; PG8_WAIT_L(0); PG8_MMA(1, 0, At, B0); PG8_BAR; PG8_SCHED;
            PG8_STAGE(PG8_SB(0, 1), b2 + hstep, voffB);
            PG8_WAIT_V(6); PG8_BAR; PG8_MMA(1, 1, At, B1); PG8_BAR;
            PG8_LDB(B0, 1, 0); PG8_SCHED; PG8_LDA(At, 1, 0); PG8_STAGE(PG8_SA(0, 1), a2 + hstep, voffA);
            PG8_WAIT_L(8); PG8_BAR; PG8_WAIT_L(0); PG8_MMA(0, 0, At, B0); PG8_BAR; PG8_SCHED;
            PG8_LDB(B1, 1, 1); PG8_STAGE(PG8_SB(1, 0), b3, voffB);
            PG8_BAR; PG8_WAIT_L(0); PG8_MMA(0, 1, At, B1); PG8_BAR;
            PG8_LDA(At, 1, 1); PG8_STAGE(PG8_SA(1, 0), a3, voffA);
            PG8_BAR; PG8_WAIT_L(0); PG8_MMA(1, 0, At, B0); PG8_BAR; PG8_SCHED;
            PG8_STAGE(PG8_SB(1, 1), b3 + hstep, voffB);
            PG8_WAIT_V(6); PG8_BAR; PG8_MMA(1, 1, At, B1); PG8_BAR;
            }
        }
        if constexpr (ALIGN_EPI) { if (wr == 0) PG8_BAR; }
        if constexpr (!Epi::AFTER_DRAIN) { E(acc, cur, wr, wc, fr, fq); S.done(cur); }
        if (!has_next) break;
#pragma unroll
        for (int a = 0; a < 2; ++a)
#pragma unroll
            for (int b = 0; b < 2; ++b)
#pragma unroll
                for (int m = 0; m < 4; ++m)
#pragma unroll
                    for (int n = 0; n < 2; ++n) acc[a][b][m][n] = (f32x4){0.f, 0.f, 0.f, 0.f};
        cur = nxt; cA = nA; cB = nB; ++ui;
        if constexpr (ALIGN_EPI) { if (wr == 1) PG8_BAR; }
    }
    PG8_WAIT_V(0);
    if constexpr (!ALIGN_EPI) { if (wr == 0) PG8_BAR; }
    PG8_BAR;
    if constexpr (Epi::AFTER_DRAIN) { E.fused(acc, cur, wr, wc, fr, fq, lds, wid, lane); S.done(cur); }
#undef PG8_SA
#undef PG8_SB
#undef PG8_STAGE
#undef PG8_LDA
#undef PG8_LDB
#undef PG8_MMA
#undef PG8_WAIT_V
#undef PG8_WAIT_L
#undef PG8_BAR
#undef PG8_SCHED
}
}

#ifndef PG8_SP2
#define PG8_SP2 true
#endif
#ifndef PG8_ALIGN
#define PG8_ALIGN true
#endif
#define GAS __attribute__((address_space(1)))
#define LAS __attribute__((address_space(3)))
typedef unsigned short bf16;
typedef unsigned v4u __attribute__((ext_vector_type(4)));
typedef float f32x4 __attribute__((ext_vector_type(4)));
typedef short bf16x8 __attribute__((ext_vector_type(8)));
typedef GAS unsigned gu32;
typedef GAS unsigned long long gu64;
#define RLX_AGENT __ATOMIC_RELAXED, __HIP_MEMORY_SCOPE_AGENT
#define LDS_WAIT() asm volatile("s_waitcnt lgkmcnt(0)" ::: "memory")
#define VM_WAIT() asm volatile("s_waitcnt vmcnt(0)" ::: "memory")
__device__ __forceinline__ unsigned long long rt() { return __builtin_amdgcn_s_memrealtime(); }
__device__ __forceinline__ unsigned f2bf(float f) { unsigned u = __builtin_bit_cast(unsigned, f); return (u + 0x7fffu + ((u >> 16) & 1u)) >> 16; }
__device__ __forceinline__ unsigned pk2(float lo, float hi) { return f2bf(lo) | (f2bf(hi) << 16); }

#define XB_TMO      128
#define XB_XCNT(j)  (256  + 64 * (j))
#define XB_XSUB(j)  (1280 + 64 * (j))
#define XB_XGEN(j)  (2304 + 64 * (j))
#define XB_TOP      3328
#define XB_TOPGEN   3392
#define XCD_BAR_WORDS 3456
#define XB_SPIN_CAP (1u << 18)

__device__ __forceinline__ unsigned xb_ld(unsigned* p)              { return __hip_atomic_load(p, __ATOMIC_RELAXED, __HIP_MEMORY_SCOPE_AGENT); }
__device__ __forceinline__ unsigned xb_add(unsigned* p, unsigned v) { return __hip_atomic_fetch_add(p, v, __ATOMIC_RELAXED, __HIP_MEMORY_SCOPE_AGENT); }
__device__ __forceinline__ unsigned xb_xcc_id() { return (unsigned)__builtin_amdgcn_s_getreg((3 << 11) | 20) & 0xFu; }
#define XB_SPIN(cond, bar) do { unsigned _sp = 0; while (cond) { __builtin_amdgcn_s_sleep(1); \
    if ((++_sp & 255u) == 0u) { if (xb_ld(&(bar)[XB_TMO])) break; if (_sp > XB_SPIN_CAP) { atomicAdd(&(bar)[XB_TMO], 1u); break; } } } } while (0)

struct XcdBarrier {
    unsigned* bar; unsigned x;
    volatile LAS unsigned* st;
};

__device__ __forceinline__ XcdBarrier xcd_barrier_post(unsigned* bar, volatile LAS unsigned* st) {
    XcdBarrier b; b.bar = bar; b.x = xb_xcc_id(); b.st = st;
    if (threadIdx.x == 0) (void)xb_add(&bar[XB_XCNT(b.x)], 1u);
    return b;
}
__device__ __forceinline__ void xcd_barrier_complete(unsigned* bar, unsigned x, unsigned& nloc, unsigned& nx) {
    const unsigned G = gridDim.x * gridDim.y * gridDim.z;
    unsigned sum, cnt, mine, sp = 0u;
    for (;;) {
        sum = 0u; cnt = 0u; mine = 0u;
#pragma unroll
        for (unsigned j = 0; j < 16; ++j) { const unsigned c = xb_ld(&bar[XB_XCNT(j)]); sum += c; cnt += (c > 0u) ? 1u : 0u; mine = (j == x) ? c : mine; }
        if (sum == G) break;
        __builtin_amdgcn_s_sleep(1);
        if ((++sp & 255u) == 0u) { if (xb_ld(&bar[XB_TMO])) break; if (sp > XB_SPIN_CAP) { atomicAdd(&bar[XB_TMO], 1u); break; } }
    }
    nloc = mine > 0u ? mine : 1u; nx = cnt > 0u ? cnt : 1u;
}

__device__ __forceinline__ void xcd_barrier(const XcdBarrier& b) {
    asm volatile("s_waitcnt vmcnt(0)" ::: "memory");
    __syncthreads();
    if (threadIdx.x == 0) {
        unsigned* bar = b.bar;
        __builtin_amdgcn_s_waitcnt(0);
        unsigned nloc = b.st[0], nx = b.st[1];
        if (nloc == 0u) { xcd_barrier_complete(bar, b.x, nloc, nx); b.st[0] = nloc; b.st[1] = nx; }
        const unsigned old = xb_add(&bar[XB_XSUB(b.x)], 1u);
        const unsigned gen = old / nloc;
        if (old + 1u == (gen + 1u) * nloc) {
            __builtin_amdgcn_fence(__ATOMIC_RELEASE, "agent");
            asm volatile("s_waitcnt vmcnt(0)" ::: "memory");
            const unsigned og = xb_add(&bar[XB_TOP], 1u);
            const unsigned tg = og / nx;
            if (og + 1u == (tg + 1u) * nx) xb_add(&bar[XB_TOPGEN], 1u);
            else XB_SPIN(xb_ld(&bar[XB_TOPGEN]) == tg, bar);
            __builtin_amdgcn_fence(__ATOMIC_ACQUIRE, "agent");
            xb_add(&bar[XB_XGEN(b.x)], 1u);
            asm volatile("s_waitcnt vmcnt(0)" ::: "memory");
        } else {
            XB_SPIN(xb_ld(&bar[XB_XGEN(b.x)]) == gen, bar);
            __builtin_amdgcn_fence(__ATOMIC_ACQUIRE, "agent");
            asm volatile("s_waitcnt vmcnt(0)" ::: "memory");
        }
    }
    __syncthreads();
}


constexpr int NWAVES = 8;
constexpr int DM = 1024, SEQ = 4096, NBP = 4, NBS = 32, TS = 8;
constexpr int MP = NBP * SEQ, MS = NBS * TS, MT = MP + MS;
constexpr int NH = 8, HD = 64, DSSM = 512, NST = 128, IN_LD = 3080, NIN = 3072;
constexpr int DFF = 2816, DFF2 = 5632, DPLE = 256, WBUF = 2048;
constexpr float EPS = 1e-6f, LOG2E = 1.4426950408889634f, C2 = 0.125f * 1.4426950408889634f;
constexpr int PC_K = 512, PC_V = 1024, PC_Z = 1536, PC_X = 2048;
constexpr size_t O_Y = 0, O_YS = 16777216, O_KP = 17039360, O_VP = 21233664, O_KS = 25427968, O_VS = 25559040, O_SP = 25690112, O_SS = 25952256,
                 O_CP = 28049408, O_CS = 28061696, O_FP = 28160000, O_FS = 28205056, O_END = 28565504;
constexpr size_t MiB = 1u << 20;
constexpr size_t WS_CTL = 0, CTL_ZERO_BYTES = 1 * MiB;
constexpr size_t WS_RS1 = 256 * 1024, WS_RSE = 384 * 1024, WS_RS3 = 512 * 1024;
constexpr size_t WS_WIN = 2 * MiB, WS_WOUT = 8 * MiB, WS_WUP = 10 * MiB, WS_WDOWN = 21 * MiB, WS_WPLE = 27 * MiB, WS_WGATE = 28 * MiB;
constexpr size_t WS_DT = 30 * MiB, WS_PB = 31 * MiB, WS_XN = 40 * MiB, WS_MIX = 73 * MiB, WS_H1 = 106 * MiB, WS_E = 171 * MiB;
constexpr size_t WS_PROJ = 236 * MiB, WS_OBR = 334 * MiB, WS_LSE = 382 * MiB, WS_XBS = 384 * MiB, WS_XC = 385 * MiB, WS_CC = 402 * MiB, WS_CS = 410 * MiB, WS_PREV = 442 * MiB,
                 WS_ACUM = 458 * MiB, WS_ACL = 458 * MiB + 768 * 1024, WS_YS = 459 * MiB;
constexpr size_t WS_U = 236 * MiB, WS_ACT = 415 * MiB, WS_END = 505 * MiB;
static_assert(WS_PROJ + (size_t)MT * NIN * 2 <= WS_OBR && WS_OBR + (size_t)3 * MP * 512 * 2 <= WS_LSE && WS_LSE + (size_t)3 * MP * 8 * 4 <= WS_XBS, "ws map A");
static_assert(WS_XBS + (size_t)MS * 1024 * 4 <= WS_XC && WS_XC + (size_t)MT * 512 * 2 <= WS_CC && WS_CC + (size_t)MP * 256 * 2 <= WS_CS && WS_CS + (size_t)MP / 128 * 8 * 64 * 128 * 4 <= WS_PREV && WS_PREV + (size_t)MP / 128 * 8 * 64 * 128 * 2 <= WS_ACUM && WS_ACUM + (size_t)MP * 8 * 4 <= WS_ACL && WS_ACL + 4096 <= WS_YS && WS_YS + (size_t)MT * 512 * 4 <= WS_END, "ws map B");
static_assert(WS_U + (size_t)MT * DFF2 * 2 <= WS_ACT && WS_ACT + (size_t)MT * DFF * 2 <= WS_END, "ws map C");
static_assert(WS_XN + (size_t)MT * DM * 2 <= WS_MIX && WS_MIX + (size_t)MT * DM * 2 <= WS_H1 && WS_H1 + (size_t)MT * DM * 4 <= WS_E && WS_E + (size_t)MT * DM * 4 <= WS_PROJ, "ws map D");
static_assert(WS_PB + (size_t)MT * DPLE * 2 <= WS_XN && WS_DT + (size_t)MT * 8 * 4 <= WS_PB, "ws map E");
constexpr int CW_TMO = 0, CW_BAR = 4096;
constexpr int RING_BYTES = 131072, LDSCTL_OFF = RING_BYTES, MISC_OFF = LDSCTL_OFF + 320, LDS_BYTES = 147456;

typedef float f32x16 __attribute__((ext_vector_type(16)));
typedef short v4i16_t __attribute__((ext_vector_type(4)));
typedef unsigned u32x2 __attribute__((ext_vector_type(2)));

__device__ const unsigned char BUCKET_TAB[3][132] = {
 {0,1,2,3,4,5,6,7,8,9,10,11,12,13,14,15,16,16,16,16,16,16,17,17,17,17,17,17,17,17,18,18,18,18,18,18,18,18,18,18,19,19,19,19,19,19,19,19,19,19,19,19,19,19,20,20,20,20,20,20,20,20,20,20,20,20,20,20,20,20,20,20,20,21,21,21,21,21,21,21,21,21,21,21,21,21,21,21,21,21,21,21,21,21,21,21,21,21,21,22,22,22,22,22,22,22,22,22,22,22,22,22,22,22,22,22,22,22,22,22,22,22,22,22,22,22,22,22,22,0,0,0},
 {0,4,8,12,16,16,17,17,18,18,19,19,19,19,20,20,20,20,20,21,21,21,21,21,21,22,22,22,22,22,22,22,22,22,23,23,23,23,23,23,23,23,23,23,23,23,24,24,24,24,24,24,24,24,24,24,24,24,24,24,24,24,25,25,25,25,25,25,25,25,25,25,25,25,25,25,25,25,25,25,25,25,25,26,26,26,26,26,26,26,26,26,26,26,26,26,26,26,26,26,26,26,26,26,26,26,26,26,26,26,26,26,26,27,27,27,27,27,27,27,27,27,27,27,27,27,27,27,27,0,0,0},
 {0,16,18,19,20,21,21,22,22,23,23,23,24,24,24,24,25,25,25,25,25,26,26,26,26,26,26,26,26,27,27,27,27,27,27,27,27,27,27,28,28,28,28,28,28,28,28,28,28,28,28,28,29,29,29,29,29,29,29,29,29,29,29,29,29,29,29,29,29,29,30,30,30,30,30,30,30,30,30,30,30,30,30,30,30,30,30,30,30,30,30,30,30,30,30,31,31,31,31,31,31,31,31,31,31,31,31,31,31,31,31,31,31,31,31,31,31,31,31,31,31,31,31,31,31,31,31,31,31,0,0,0}};

__device__ __forceinline__ float wave_sum(float v) {
#pragma unroll
    for (int o = 1; o < 64; o <<= 1) v += __shfl_xor(v, o);
    return v;
}
__device__ __forceinline__ float wave_max(float v) {
#pragma unroll
    for (int o = 1; o < 64; o <<= 1) v = fmaxf(v, __shfl_xor(v, o));
    return v;
}
__device__ __forceinline__ float row16_sum(float v) {
    v += __builtin_bit_cast(float, __builtin_amdgcn_update_dpp(0, __builtin_bit_cast(int, v), 0xB1, 0xf, 0xf, true));
    v += __builtin_bit_cast(float, __builtin_amdgcn_update_dpp(0, __builtin_bit_cast(int, v), 0x4E, 0xf, 0xf, true));
    v += __builtin_bit_cast(float, __builtin_amdgcn_update_dpp(0, __builtin_bit_cast(int, v), 0x141, 0xf, 0xf, true));
    v += __builtin_bit_cast(float, __builtin_amdgcn_update_dpp(0, __builtin_bit_cast(int, v), 0x140, 0xf, 0xf, true));
    return v;
}
__device__ __forceinline__ float bf2f(unsigned short b) { return __uint_as_float((unsigned)b << 16); }
__device__ __forceinline__ float bflo(unsigned w) { return __uint_as_float(w << 16); }
__device__ __forceinline__ float bfhi(unsigned w) { return __uint_as_float(w & 0xffff0000u); }
__device__ __forceinline__ float siluf(float x) { return x / (1.f + __expf(-x)); }
__device__ __forceinline__ float softplusf(float x) { return fmaxf(x, 0.f) + log1pf(__expf(-fabsf(x))); }
__device__ __forceinline__ int crow(int r, int hi) { return (r & 3) + 8 * (r >> 2) + 4 * hi; }

__device__ __forceinline__ v4i16_t vtr(const LAS unsigned char* p) { return __builtin_amdgcn_ds_read_tr16_b64_v4i16((LAS v4i16_t*)p); }
__device__ __forceinline__ unsigned cvtpk_s(float lo, float hi) { typedef float f2 __attribute__((ext_vector_type(2))); typedef __bf16 b2 __attribute__((ext_vector_type(2))); f2 v = {lo, hi}; b2 b = __builtin_convertvector(v, b2); return __builtin_bit_cast(unsigned, b); }
struct Args { const float* in[28]; float* out; unsigned char* ws; int ph_lo, ph_hi, li, pad; };

struct EpiIn {
    static constexpr bool PERM = true, AFTER_DRAIN = false;
    pg8::bf16_t* PROJ; float* out;
    __device__ __forceinline__ void operator()(const pg8::f32x4 (&acc)[2][2][4][2], const pg8::Unit& u, int wr, int wc, int fr, int fq) const {
        const int pn = u.pn; const float sc = (pn < 2) ? C2 : 1.f;
        const int colb = pn * 256 + wc * 32 + 8 * fq;
#pragma unroll
        for (int ai = 0; ai < 2; ++ai)
#pragma unroll
            for (int m = 0; m < 4; ++m) {
                const int row = u.pm * 256 + ai * 128 + wr * 64 + m * 16 + fr;
#pragma unroll
                for (int bj = 0; bj < 2; ++bj) {
                    const int col = colb + bj * 128; const pg8::f32x4 v0 = acc[ai][bj][m][0], v1 = acc[ai][bj][m][1];
                    pg8::u32x4 w; w.x = pg8::cvt_pk_bf16(v0[0] * sc, v0[1] * sc); w.y = pg8::cvt_pk_bf16(v0[2] * sc, v0[3] * sc); w.z = pg8::cvt_pk_bf16(v1[0] * sc, v1[1] * sc); w.w = pg8::cvt_pk_bf16(v1[2] * sc, v1[3] * sc);
                    *(pg8::u32x4*)(PROJ + (unsigned)(row * NIN + col)) = w;
                    float* dst = nullptr;
                    if (pn >= 2 && pn < 6) {
                        const bool isk = pn < 4; const int c = col - (isk ? PC_K : PC_V);
                        if (row < MP) { const int t = row & (SEQ - 1), b = row >> 12; if (t >= SEQ - WBUF) dst = out + (isk ? O_KP : O_VP) + ((size_t)(b * WBUF + t - (SEQ - WBUF))) * 512 + c; }
                        else dst = out + (isk ? O_KS : O_VS) + (size_t)(row - MP) * 512 + c;
                    } else if (pn >= 8) {
                        const int c = col - PC_X;
                        if (row < MP) { const int t = row & (SEQ - 1), b = row >> 12; if (t >= SEQ - 3) dst = out + O_CP + (size_t)(b * 3 + t - (SEQ - 3)) * 1024 + c; }
                        else { const int r = row - MP, t = r & 7, b = r >> 3; if (t >= TS - 3) dst = out + O_CS + (size_t)(b * 3 + t - (TS - 3)) * 1024 + c; }
                    }
                    if (dst) { *(pg8::f32x4*)dst = v0; *(pg8::f32x4*)(dst + 4) = v1; }
                }
            }
    }
};
struct EpiOut {
    static constexpr bool PERM = false, AFTER_DRAIN = false;
    const float* xp; pg8::bf16_t* H1b; float* RS;
    __device__ __forceinline__ void operator()(const pg8::f32x4 (&acc)[2][2][4][2], const pg8::Unit& u, int wr, int wc, int fr, int fq) const {
        const int col0 = u.pn * 256 + wc * 32 + 4 * fq;
#pragma unroll
        for (int ai = 0; ai < 2; ++ai)
#pragma unroll
            for (int m = 0; m < 4; ++m) {
                const int row = u.pm * 256 + ai * 128 + wr * 64 + m * 16 + fr;
                const float* xrow = xp + (unsigned)(row * DM);
                float ss = 0.f;
#pragma unroll
                for (int bj = 0; bj < 2; ++bj)
#pragma unroll
                    for (int n = 0; n < 2; ++n) {
                        const int c = col0 + bj * 128 + n * 16;
                        const pg8::f32x4 h = *(const pg8::f32x4*)(xrow + c) + acc[ai][bj][m][n];
                        u32x2 w; w.x = pg8::cvt_pk_bf16(h[0], h[1]); w.y = pg8::cvt_pk_bf16(h[2], h[3]);
                        *(u32x2*)(H1b + (unsigned)(row * DM + c)) = w;
                        ss += (h[0] * h[0] + h[1] * h[1]) + (h[2] * h[2] + h[3] * h[3]);
                    }
                ss += __shfl_xor(ss, 16); ss += __shfl_xor(ss, 32);
                if (fq == 0) atomicAdd(RS + row, ss);
                asm volatile("" ::: "memory");
            }
    }
};
struct EpiUp {
    static constexpr bool PERM = true, AFTER_DRAIN = false;
    pg8::bf16_t* U; const float* RS; float* out;
    __device__ __forceinline__ void operator()(const pg8::f32x4 (&acc)[2][2][4][2], const pg8::Unit& u, int wr, int wc, int fr, int fq) const {
        const int colb = u.pn * 256 + wc * 32 + 8 * fq;
#pragma unroll
        for (int ai = 0; ai < 2; ++ai)
#pragma unroll
            for (int m = 0; m < 4; ++m) {
                const int row = u.pm * 256 + ai * 128 + wr * 64 + m * 16 + fr;
                const float rs = 1.0f / sqrtf(RS[row] * (1.f / DM) + EPS);
                float* dstb = nullptr;
                if (row < MP) { const int t = row & (SEQ - 1), b = row >> 12; if (t >= SEQ - 2) dstb = out + O_FP + (size_t)(b * 2 + t - (SEQ - 2)) * DFF2; }
                else { const int r = row - MP, t = r & 7, b = r >> 3; if (t >= TS - 2) dstb = out + O_FS + (size_t)(b * 2 + t - (TS - 2)) * DFF2; }
#pragma unroll
                for (int bj = 0; bj < 2; ++bj) {
                    const int col = colb + bj * 128; const pg8::f32x4 v0 = acc[ai][bj][m][0] * rs, v1 = acc[ai][bj][m][1] * rs;
                    pg8::u32x4 w; w.x = pg8::cvt_pk_bf16(v0[0], v0[1]); w.y = pg8::cvt_pk_bf16(v0[2], v0[3]); w.z = pg8::cvt_pk_bf16(v1[0], v1[1]); w.w = pg8::cvt_pk_bf16(v1[2], v1[3]);
                    *(pg8::u32x4*)(U + (unsigned)(row * DFF2 + col)) = w;
                    if (dstb) { *(pg8::f32x4*)(dstb + col) = v0; *(pg8::f32x4*)(dstb + col + 4) = v1; }
                }
            }
    }
};
struct EpiDown {
    static constexpr bool PERM = false, AFTER_DRAIN = false;
    pg8::bf16_t* Hb;
    __device__ __forceinline__ void operator()(const pg8::f32x4 (&acc)[2][2][4][2], const pg8::Unit& u, int wr, int wc, int fr, int fq) const {
        const int col0 = u.pn * 256 + wc * 32 + 4 * fq;
#pragma unroll
        for (int ai = 0; ai < 2; ++ai)
#pragma unroll
            for (int m = 0; m < 4; ++m) {
                const int row = u.pm * 256 + ai * 128 + wr * 64 + m * 16 + fr;
#pragma unroll
                for (int bj = 0; bj < 2; ++bj)
#pragma unroll
                    for (int n = 0; n < 2; ++n) {
                        const int c = col0 + bj * 128 + n * 16; u32x2* hp = (u32x2*)(Hb + (unsigned)(row * DM + c));
                        const u32x2 o = *hp; const pg8::f32x4 a = acc[ai][bj][m][n];
                        u32x2 w; w.x = pg8::cvt_pk_bf16(bflo(o.x) + a[0], bfhi(o.x) + a[1]); w.y = pg8::cvt_pk_bf16(bflo(o.y) + a[2], bfhi(o.y) + a[3]);
                        *hp = w;
                    }
                asm volatile("" ::: "memory");
            }
    }
};
struct EpiPle {
    static constexpr bool PERM = false, AFTER_DRAIN = false;
    pg8::bf16_t* E; float* RS;
    __device__ __forceinline__ void operator()(const pg8::f32x4 (&acc)[2][2][4][2], const pg8::Unit& u, int wr, int wc, int fr, int fq) const {
        const int col0 = u.pn * 256 + wc * 32 + 4 * fq;
#pragma unroll
        for (int ai = 0; ai < 2; ++ai)
#pragma unroll
            for (int m = 0; m < 4; ++m) {
                const int row = u.pm * 256 + ai * 128 + wr * 64 + m * 16 + fr; float ss = 0.f;
#pragma unroll
                for (int bj = 0; bj < 2; ++bj)
#pragma unroll
                    for (int n = 0; n < 2; ++n) {
                        const int c = col0 + bj * 128 + n * 16; const pg8::f32x4 h = acc[ai][bj][m][n];
                        u32x2 w; w.x = pg8::cvt_pk_bf16(h[0], h[1]); w.y = pg8::cvt_pk_bf16(h[2], h[3]);
                        *(u32x2*)(E + (unsigned)(row * DM + c)) = w;
                        ss += (h[0] * h[0] + h[1] * h[1]) + (h[2] * h[2] + h[3] * h[3]);
                    }
                ss += __shfl_xor(ss, 16); ss += __shfl_xor(ss, 32);
                if (fq == 0) atomicAdd(RS + row, ss);
            }
    }
};
struct EpiGate {
    static constexpr bool PERM = false, AFTER_DRAIN = false;
    const pg8::bf16_t* H2b; const pg8::bf16_t* E; const float* RSE; const float* gple; pg8::bf16_t* H3b; float* RS3;
    __device__ __forceinline__ void operator()(const pg8::f32x4 (&acc)[2][2][4][2], const pg8::Unit& u, int wr, int wc, int fr, int fq) const {
        const int col0 = u.pn * 256 + wc * 32 + 4 * fq;
        pg8::f32x4 gp[2][2];
#pragma unroll
        for (int bj = 0; bj < 2; ++bj)
#pragma unroll
            for (int n = 0; n < 2; ++n) gp[bj][n] = *(const pg8::f32x4*)(gple + col0 + bj * 128 + n * 16);
#pragma unroll
        for (int ai = 0; ai < 2; ++ai)
#pragma unroll
            for (int m = 0; m < 4; ++m) {
                const int row = u.pm * 256 + ai * 128 + wr * 64 + m * 16 + fr;
                const float rse = 1.0f / sqrtf(RSE[row] * (1.f / DM) + EPS);
                float ss = 0.f;
#pragma unroll
                for (int bj = 0; bj < 2; ++bj)
#pragma unroll
                    for (int n = 0; n < 2; ++n) {
                        const int c = col0 + bj * 128 + n * 16; const unsigned o = (unsigned)(row * DM + c);
                        const pg8::f32x4 a = acc[ai][bj][m][n]; const u32x2 eb = *(const u32x2*)(E + o), hb = *(const u32x2*)(H2b + o);
                        const float e4[4] = {bflo(eb.x), bfhi(eb.x), bflo(eb.y), bfhi(eb.y)}, h4[4] = {bflo(hb.x), bfhi(hb.x), bflo(hb.y), bfhi(hb.y)};
                        float h[4];
#pragma unroll
                        for (int k = 0; k < 4; ++k) { const float g = 1.f / (1.f + __expf(-a[k])); h[k] = h4[k] + g * (e4[k] * rse * gp[bj][n][k]); }
                        u32x2 w; w.x = pg8::cvt_pk_bf16(h[0], h[1]); w.y = pg8::cvt_pk_bf16(h[2], h[3]);
                        *(u32x2*)(H3b + o) = w;
                        ss += (h[0] * h[0] + h[1] * h[1]) + (h[2] * h[2] + h[3] * h[3]);
                    }
                ss += __shfl_xor(ss, 16); ss += __shfl_xor(ss, 32);
                if (fq == 0) atomicAdd(RS3 + row, ss);
                asm volatile("" ::: "memory");
            }
    }
};

__device__ __forceinline__ void p0_transpose_item(const float* W, int ldn, int K, int N, bf16* WT, const float* gk, LAS float* scr, int item, int lane) {
    const int nblk = N / 32, kb = item / nblk, nb = item % nblk, k0 = 64 * kb, n0 = 32 * nb;
#pragma unroll 8
    for (int i = 0; i < 32; ++i) { const int kk = 2 * i + (lane >> 5); float w = W[(size_t)(k0 + kk) * ldn + n0 + (lane & 31)]; if (gk) w *= gk[k0 + kk]; scr[kk * 33 + (lane & 31)] = w; }
    LDS_WAIT(); asm volatile("" ::: "memory");
    const int c = lane & 7;
#pragma unroll
    for (int j = 0; j < 4; ++j) { const int n = (lane >> 3) + 8 * j; const LAS float* s = scr + (8 * c) * 33 + n;
        v4u o; o.x = pk2(s[0 * 33], s[1 * 33]); o.y = pk2(s[2 * 33], s[3 * 33]); o.z = pk2(s[4 * 33], s[5 * 33]); o.w = pk2(s[6 * 33], s[7 * 33]);
        *(GAS v4u*)(WT + (size_t)(n0 + n) * K + k0 + 8 * c) = o; }
    LDS_WAIT(); asm volatile("" ::: "memory");
}
__device__ __forceinline__ void p0_prologue(const Args& a, LAS unsigned char* lds, int gw, int NGW, int wave, int lane) {
    unsigned char* ws = a.ws;
    LAS float* scr = (LAS float*)(lds + wave * 8704);
    constexpr int I_IN = (DM / 64) * (NIN / 32), I_OUT = (DM / 64) * (DM / 32), I_UP = (DM / 64) * (DFF2 / 32), I_DN = (DFF / 64) * (DM / 32), I_PLE = (DPLE / 64) * (DM / 32), I_G = I_OUT;
    constexpr int NITEMS = I_IN + I_OUT + I_UP + I_DN + I_PLE + I_G;
    for (int it = gw; it < NITEMS; it += NGW) {
        int r = it;
        if (r < I_IN)  { p0_transpose_item(a.in[11], IN_LD, DM, NIN, (bf16*)(ws + WS_WIN), a.in[10], scr, r, lane); continue; } r -= I_IN;
        if (r < I_OUT) { p0_transpose_item(a.in[18], DM, DM, DM, (bf16*)(ws + WS_WOUT), nullptr, scr, r, lane); continue; } r -= I_OUT;
        if (r < I_UP)  { p0_transpose_item(a.in[20], DFF2, DM, DFF2, (bf16*)(ws + WS_WUP), a.in[19], scr, r, lane); continue; } r -= I_UP;
        if (r < I_DN)  { p0_transpose_item(a.in[23], DM, DFF, DM, (bf16*)(ws + WS_WDOWN), nullptr, scr, r, lane); continue; } r -= I_DN;
        if (r < I_PLE) { p0_transpose_item(a.in[24], DM, DPLE, DM, (bf16*)(ws + WS_WPLE), nullptr, scr, r, lane); continue; } r -= I_PLE;
        p0_transpose_item(a.in[26], DM, DM, DM, (bf16*)(ws + WS_WGATE), nullptr, scr, r, lane);
    }
    const float* gmix = a.in[10]; const float* win = a.in[11]; const float* dtb = a.in[14];
    bf16* XN = (bf16*)(ws + WS_XN); bf16* PB = (bf16*)(ws + WS_PB); float* DT = (float*)(ws + WS_DT);
    LAS unsigned char* dtw = lds + 81920;
    for (int k = threadIdx.x; k < DM; k += NWAVES * 64) {
        const float gk = gmix[k]; const f32x4 w0 = *(const f32x4*)(win + (size_t)k * IN_LD + NIN) * gk, w1 = *(const f32x4*)(win + (size_t)k * IN_LD + NIN + 4) * gk;
        LAS f32x4* d = (LAS f32x4*)(dtw + (k >> 2) * 144 + (k & 3) * 32); d[0] = w0; d[1] = w1;
    }
    LDS_WAIT(); __syncthreads();
    for (int m = gw; m < MT; m += NGW) {
        const float* xrow = (m < MP) ? a.in[0] + (size_t)m * DM : a.in[1] + (size_t)(m - MP) * DM;
        const GAS f32x4* xr = (const GAS f32x4*)xrow + lane;
        f32x4 v[4]; float s = 0.f;
#pragma unroll
        for (int j = 0; j < 4; ++j) { v[j] = xr[64 * j]; s += (v[j].x * v[j].x + v[j].y * v[j].y) + (v[j].z * v[j].z + v[j].w * v[j].w); }
        const float rstd = 1.0f / sqrtf(wave_sum(s) * (1.f / DM) + EPS);
        GAS unsigned long long* o8 = (GAS unsigned long long*)(XN + (size_t)m * DM) + lane;
        float dacc[8];
#pragma unroll
        for (int h = 0; h < 8; ++h) dacc[h] = 0.f;
#pragma unroll
        for (int j = 0; j < 4; ++j) {
            v[j] = v[j] * rstd;
            o8[64 * j] = (unsigned long long)pk2(v[j].x, v[j].y) | ((unsigned long long)pk2(v[j].z, v[j].w) << 32);
#pragma unroll
            for (int e = 0; e < 4; ++e) {
                const float xv = v[j][e];
                const LAS f32x4* d = (const LAS f32x4*)(dtw + (64 * j + lane) * 144 + e * 32);
                const f32x4 w0 = d[0], w1 = d[1];
                dacc[0] += xv * w0.x; dacc[1] += xv * w0.y; dacc[2] += xv * w0.z; dacc[3] += xv * w0.w;
                dacc[4] += xv * w1.x; dacc[5] += xv * w1.y; dacc[6] += xv * w1.z; dacc[7] += xv * w1.w;
            }
        }
#pragma unroll
        for (int h = 0; h < 8; ++h) dacc[h] = softplusf(wave_sum(dacc[h]) + dtb[h]);
        if (lane == 0) { *(f32x4*)(DT + (size_t)m * 8) = (f32x4){dacc[0], dacc[1], dacc[2], dacc[3]}; *(f32x4*)(DT + (size_t)m * 8 + 4) = (f32x4){dacc[4], dacc[5], dacc[6], dacc[7]}; }
        const float* prow = (m < MP) ? a.in[2] + (size_t)m * DPLE : a.in[3] + (size_t)(m - MP) * DPLE;
        const f32x4 pv = *((const f32x4*)prow + lane);
        *((GAS unsigned long long*)(PB + (size_t)m * DPLE) + lane) = (unsigned long long)pk2(pv.x, pv.y) | ((unsigned long long)pk2(pv.z, pv.w) << 32);
    }
}

__device__ __forceinline__ void load8bf(const bf16* p, float (&o)[8]) {
    const v4u w = *(const v4u*)p;
    o[0] = bflo(w.x); o[1] = bfhi(w.x); o[2] = bflo(w.y); o[3] = bfhi(w.y); o[4] = bflo(w.z); o[5] = bfhi(w.z); o[6] = bflo(w.w); o[7] = bfhi(w.w);
}
__device__ __forceinline__ void load8f(const float* p, float (&o)[8]) {
    const f32x4 a = *(const f32x4*)p, b = *(const f32x4*)(p + 4);
    o[0] = a.x; o[1] = a.y; o[2] = a.z; o[3] = a.w; o[4] = b.x; o[5] = b.y; o[6] = b.z; o[7] = b.w;
}
__device__ __forceinline__ void conv_sample_pass(const Args& a, int gtid, int NT) {
    const bf16* PROJ = (const bf16*)(a.ws + WS_PROJ); float* XB = (float*)(a.ws + WS_XBS); bf16* XC = (bf16*)(a.ws + WS_XC);
    const float* cw = a.in[12]; const float* cb = a.in[13]; const float* sconv = a.in[7];
    for (int it = gtid; it < NBS * 128; it += NT) {
        const int b = it >> 7, c = (it & 127) * 8, m0 = MP + b * 8;
        float w0[8], w1[8], w2[8], w3[8], bb[8], x3[8], x2[8], x1[8];
        load8f(cw + c, w0); load8f(cw + 1024 + c, w1); load8f(cw + 2048 + c, w2); load8f(cw + 3072 + c, w3); load8f(cb + c, bb);
        load8f(sconv + (size_t)(b * 3 + 0) * 1024 + c, x3); load8f(sconv + (size_t)(b * 3 + 1) * 1024 + c, x2); load8f(sconv + (size_t)(b * 3 + 2) * 1024 + c, x1);
#pragma unroll
        for (int r = 0; r < 8; ++r) {
            float cur[8], y[8]; load8bf(PROJ + (size_t)(m0 + r) * NIN + PC_X + c, cur);
#pragma unroll
            for (int k = 0; k < 8; ++k) { y[k] = siluf(bb[k] + w0[k] * x3[k] + w1[k] * x2[k] + w2[k] * x1[k] + w3[k] * cur[k]); x3[k] = x2[k]; x2[k] = x1[k]; x1[k] = cur[k]; }
            float* o = XB + (size_t)(b * 8 + r) * 1024 + c;
            *(f32x4*)o = (f32x4){y[0], y[1], y[2], y[3]}; *(f32x4*)(o + 4) = (f32x4){y[4], y[5], y[6], y[7]};
            if (c < 512) { v4u w; w.x = pk2(y[0], y[1]); w.y = pk2(y[2], y[3]); w.z = pk2(y[4], y[5]); w.w = pk2(y[6], y[7]); *(v4u*)(XC + (size_t)(m0 + r) * 512 + c) = w; }
        }
    }
}

#ifndef S1SUB
#define S1SUB 7
#endif
constexpr int S1_BR = 0, S1_CR = 32768, S1_BT = 65536, S1_XT = 98304, S1_XW = 114688, S1_AC = 133120;
__device__ __forceinline__ void ssd_s1_unit(const Args& a, LAS unsigned char* lds, int unit, int tid, int wave, int lane) {
    asm volatile("" : "+v"(tid), "+v"(lane));
    const int h = unit & 7, c = (unit >> 3) & 31, b = unit >> 8, g = h >> 2, m0 = b * SEQ + c * 128;
    const bf16* PROJ = (const bf16*)(a.ws + WS_PROJ); const float* DT = (const float*)(a.ws + WS_DT);
    LAS float* ac = (LAS float*)(lds + S1_AC); LAS float* dts = ac + 128;
    const int r32 = lane & 31, hh = lane >> 5;
    const int o = tid % 40, rc = tid / 40, s0 = rc * 11;
    const int xcol = (o < 8) ? h * 64 + 8 * o : (o < 24) ? 512 + g * 128 + 8 * (o - 8) : 768 + g * 128 + 8 * (o - 24);
    const bool cact = tid < 480;
    v4u raw[14];
    if (cact) {
#pragma unroll
        for (int i = 0; i < 14; ++i) { int sr = s0 - 3 + i; sr = sr > 127 ? 127 : sr; if (c == 0 && sr < 0) sr = 0; raw[i] = *(const v4u*)(PROJ + (size_t)(m0 + sr) * NIN + PC_X + xcol); }
    }
    if (wave == 0) {
        const float A = -__expf(a.in[15][h]);
        const float d0 = DT[(size_t)(m0 + 2 * lane) * 8 + h], d1 = DT[(size_t)(m0 + 2 * lane + 1) * 8 + h];
        const float a0 = d0 * A, a1 = d1 * A; float v = a0 + a1;
#pragma unroll
        for (int d = 1; d < 64; d <<= 1) { const float n = __shfl_up(v, d); if (lane >= d) v += n; }
        const float e0 = v - a1, e1 = v;
        ac[2 * lane] = e0; ac[2 * lane + 1] = e1; dts[2 * lane] = d0; dts[2 * lane + 1] = d1;
        float* ACUM = (float*)(a.ws + WS_ACUM); ACUM[(size_t)(m0 + 2 * lane) * 8 + h] = e0; ACUM[(size_t)(m0 + 2 * lane + 1) * 8 + h] = e1;
        if (lane == 63) ((float*)(a.ws + WS_ACL))[(b * 32 + c) * 8 + h] = e1;
    }
    __syncthreads();
    if ((S1SUB & 1) && cact) {
        const float* cw = a.in[12]; const float* cb = a.in[13];
        float w0[8], w1[8], w2[8], w3[8], bb[8], x3[8], x2[8], x1[8];
        load8f(cw + xcol, w0); load8f(cw + 1024 + xcol, w1); load8f(cw + 2048 + xcol, w2); load8f(cw + 3072 + xcol, w3); load8f(cb + xcol, bb);
        const bool z0 = (c == 0 && rc == 0);
        { const v4u r3 = raw[0], r2 = raw[1], r1 = raw[2];
          x3[0] = bflo(r3.x); x3[1] = bfhi(r3.x); x3[2] = bflo(r3.y); x3[3] = bfhi(r3.y); x3[4] = bflo(r3.z); x3[5] = bfhi(r3.z); x3[6] = bflo(r3.w); x3[7] = bfhi(r3.w);
          x2[0] = bflo(r2.x); x2[1] = bfhi(r2.x); x2[2] = bflo(r2.y); x2[3] = bfhi(r2.y); x2[4] = bflo(r2.z); x2[5] = bfhi(r2.z); x2[6] = bflo(r2.w); x2[7] = bfhi(r2.w);
          x1[0] = bflo(r1.x); x1[1] = bfhi(r1.x); x1[2] = bflo(r1.y); x1[3] = bfhi(r1.y); x1[4] = bflo(r1.z); x1[5] = bfhi(r1.z); x1[6] = bflo(r1.w); x1[7] = bfhi(r1.w);
          if (z0) {
#pragma unroll
              for (int k = 0; k < 8; ++k) { x3[k] = 0.f; x2[k] = 0.f; x1[k] = 0.f; } } }
        const float aL = ac[127];
        bf16* XC = (bf16*)(a.ws + WS_XC); bf16* CC = (bf16*)(a.ws + WS_CC);
#pragma unroll
        for (int r = 0; r < 11; ++r) {
            const int sr = s0 + r;
            if (sr < 128) {
                const v4u rw = raw[3 + r]; float cur[8], y[8];
                cur[0] = bflo(rw.x); cur[1] = bfhi(rw.x); cur[2] = bflo(rw.y); cur[3] = bfhi(rw.y); cur[4] = bflo(rw.z); cur[5] = bfhi(rw.z); cur[6] = bflo(rw.w); cur[7] = bfhi(rw.w);
#pragma unroll
                for (int k = 0; k < 8; ++k) { y[k] = siluf(bb[k] + w0[k] * x3[k] + w1[k] * x2[k] + w2[k] * x1[k] + w3[k] * cur[k]); x3[k] = x2[k]; x2[k] = x1[k]; x1[k] = cur[k]; }
                v4u w; w.x = pk2(y[0], y[1]); w.y = pk2(y[2], y[3]); w.z = pk2(y[4], y[5]); w.w = pk2(y[6], y[7]);
                if (o < 8) {
                    const int off = (o >> 2) * 8192 + (sr >> 4) * 1024 + (sr & 15) * 64 + (o & 3) * 16;
                    *(LAS v4u*)(lds + S1_XT + off) = w;
                    const float de = __expf(aL - ac[sr]) * dts[sr];
                    v4u ww; ww.x = pk2(y[0] * de, y[1] * de); ww.y = pk2(y[2] * de, y[3] * de); ww.z = pk2(y[4] * de, y[5] * de); ww.w = pk2(y[6] * de, y[7] * de);
                    *(LAS v4u*)(lds + S1_XW + off) = ww;
                    *(v4u*)(XC + (size_t)(m0 + sr) * 512 + h * 64 + 8 * o) = w;
                } else if (o < 24) {
                    const int ch = o - 8;
                    *(LAS v4u*)(lds + S1_BR + sr * 256 + ((ch ^ (sr & 15)) << 4)) = w;
                    *(LAS v4u*)(lds + S1_BT + (ch >> 2) * 8192 + (sr >> 4) * 1024 + (sr & 15) * 64 + (ch & 3) * 16) = w;
                } else {
                    const int ch = o - 24;
                    *(LAS v4u*)(lds + S1_CR + sr * 256 + ((ch ^ (sr & 15)) << 4)) = w;
                    if ((h & 3) == 0) *(v4u*)(CC + (size_t)(m0 + sr) * 256 + g * 128 + 8 * ch) = w;
                }
            }
        }
    }
    __syncthreads();
    const int laneoff = ((lane >> 4) & 1) * 32 + (lane & 3) * 8 + (4 * hh + ((lane & 15) >> 2)) * 64;
    if (S1SUB & 2) {
        const int tb = wave >> 1, ph = wave & 1, tq = 32 * tb + r32;
        bf16x8 cq[8];
#pragma unroll
        for (int k = 0; k < 8; ++k) cq[k] = *(const LAS bf16x8*)(lds + S1_CR + tq * 256 + (((2 * k + hh) ^ (tq & 15)) << 4));
        const float act = ac[tq] * LOG2E;
        f32x16 o;
#pragma unroll
        for (int i = 0; i < 16; ++i) o[i] = 0.f;
#pragma unroll 1
        for (int sb = 0; sb <= tb; ++sb) {
            {
                f32x16 S;
#pragma unroll
                for (int i = 0; i < 16; ++i) S[i] = 0.f;
                const int sq = 32 * sb + r32;
#pragma unroll
                for (int k = 0; k < 8; ++k) { const bf16x8 bf = *(const LAS bf16x8*)(lds + S1_BR + sq * 256 + (((2 * k + hh) ^ (sq & 15)) << 4)); S = __builtin_amdgcn_mfma_f32_32x32x16_bf16(bf, cq[k], S, 0, 0, 0); }
#pragma unroll
                for (int i = 0; i < 16; ++i) { const int si = 32 * sb + crow(i, hh); const float e = __builtin_amdgcn_exp2f(act - ac[si] * LOG2E) * dts[si]; S[i] = (si <= tq) ? S[i] * e : 0.f; }
#pragma unroll
                for (int ks = 0; ks < 2; ++ks) {
                    v4u pw; pw.x = cvtpk_s(S[8 * ks + 0], S[8 * ks + 1]); pw.y = cvtpk_s(S[8 * ks + 2], S[8 * ks + 3]); pw.z = cvtpk_s(S[8 * ks + 4], S[8 * ks + 5]); pw.w = cvtpk_s(S[8 * ks + 6], S[8 * ks + 7]);
                    const bf16x8 pa = __builtin_bit_cast(bf16x8, pw);
                    const LAS unsigned char* xp = lds + S1_XT + ph * 8192 + (2 * sb + ks) * 1024 + laneoff;
                    const v4i16_t lo = vtr(xp), hi2 = vtr(xp + 512);
                    const bf16x8 xb = (bf16x8){lo[0], lo[1], lo[2], lo[3], hi2[0], hi2[1], hi2[2], hi2[3]};
                    o = __builtin_amdgcn_mfma_f32_32x32x16_bf16(pa, xb, o, 0, 0, 0);
                }
            }
        }
        float* YS = (float*)(a.ws + WS_YS);
#pragma unroll
        for (int i = 0; i < 16; ++i) YS[(size_t)(m0 + 32 * tb + crow(i, hh)) * 512 + h * 64 + 32 * ph + r32] = o[i];
    }
    if (S1SUB & 4) {
        const int pb = wave & 1, nb = wave >> 1;
        f32x16 st;
#pragma unroll
        for (int i = 0; i < 16; ++i) st[i] = 0.f;
#pragma unroll
        for (int k = 0; k < 8; ++k) {
            const LAS unsigned char* ap = lds + S1_XW + pb * 8192 + k * 1024 + laneoff; const LAS unsigned char* bp = lds + S1_BT + nb * 8192 + k * 1024 + laneoff;
            const v4i16_t al = vtr(ap), ah = vtr(ap + 512), bl = vtr(bp), bh = vtr(bp + 512);
            const bf16x8 af = (bf16x8){al[0], al[1], al[2], al[3], ah[0], ah[1], ah[2], ah[3]}, bf = (bf16x8){bl[0], bl[1], bl[2], bl[3], bh[0], bh[1], bh[2], bh[3]};
            st = __builtin_amdgcn_mfma_f32_32x32x16_bf16(af, bf, st, 0, 0, 0);
        }
        float* CS = (float*)(a.ws + WS_CS) + (size_t)((b * 32 + c) * 8 + h) * 64 * 128;
#pragma unroll
        for (int i = 0; i < 16; ++i) CS[(size_t)(32 * pb + crow(i, hh)) * 128 + 32 * nb + r32] = st[i];
    }
    LDS_WAIT(); __syncthreads();
}
__device__ __forceinline__ void ssd_s2_pass(const Args& a, int gtid, int NT) {
    typedef float f32x2t __attribute__((ext_vector_type(2)));
    const float* CS = (const float*)(a.ws + WS_CS); const float* ACL = (const float*)(a.ws + WS_ACL); bf16* PREV = (bf16*)(a.ws + WS_PREV);
    for (int it = gtid; it < NBP * 8 * 64 * 64; it += NT) {
        const int n2 = it & 63, p = (it >> 6) & 63, h = (it >> 12) & 7, b = it >> 15;
        f32x2t s = {0.f, 0.f};
#pragma unroll 8
        for (int c = 0; c < 32; ++c) {
            const size_t idx = ((size_t)((b * 32 + c) * 8 + h) * 64 + p) * 128 + 2 * n2;
            const f32x2t cs = *(const f32x2t*)(CS + idx); const float dec = __expf(ACL[(b * 32 + c) * 8 + h]);
            *(unsigned*)(PREV + idx) = pk2(s.x, s.y);
            s = s * dec + cs;
        }
        *(f32x2t*)(a.out + O_SP + ((size_t)((b * 8 + h) * 64 + p)) * 128 + 2 * n2) = s;
    }
}
__device__ __forceinline__ void ssd_s3_unit(const Args& a, int unit, int wave, int lane) {
    asm volatile("" : "+v"(lane));
    const int h = unit & 7, c = (unit >> 3) & 31, b = unit >> 8, g = h >> 2, m0 = b * SEQ + c * 128;
    const int r32 = lane & 31, hh = lane >> 5, tb = wave >> 1, ph = wave & 1;
    const bf16* cp = (const bf16*)(a.ws + WS_CC) + (size_t)(m0 + 32 * tb + r32) * 256 + g * 128 + 8 * hh;
    const bf16* pp = (const bf16*)(a.ws + WS_PREV) + ((size_t)((b * 32 + c) * 8 + h) * 64 + 32 * ph + r32) * 128 + 8 * hh;
    bf16x8 cf[8], pf[8];
#pragma unroll
    for (int k = 0; k < 8; ++k) { cf[k] = *(const bf16x8*)(cp + 16 * k); pf[k] = *(const bf16x8*)(pp + 16 * k); }
    f32x16 acc;
#pragma unroll
    for (int i = 0; i < 16; ++i) acc[i] = 0.f;
#pragma unroll
    for (int k = 0; k < 8; ++k) acc = __builtin_amdgcn_mfma_f32_32x32x16_bf16(cf[k], pf[k], acc, 0, 0, 0);
    float* YS = (float*)(a.ws + WS_YS); const float* ACUM = (const float*)(a.ws + WS_ACUM);
#pragma unroll
    for (int i = 0; i < 16; ++i) { const size_t t = (size_t)(m0 + 32 * tb + crow(i, hh)); float* yp = YS + t * 512 + h * 64 + 32 * ph + r32; *yp = *yp + __expf(ACUM[t * 8 + h]) * acc[i]; }
}

constexpr int ATT_WAVE_BYTES = 8704, ATT_VB = 0, ATT_STG = 4096, ATT_WSF = 8192, ATT_BTAB_OFF = 8 * ATT_WAVE_BYTES  , ATT_BT_LD = 132;

__device__ __forceinline__ void attn_build_btab(const Args& a, LAS unsigned char* lds, int tid) {
    LAS float* bt = (LAS float*)(lds + ATT_BTAB_OFF); const float* rb = a.in[9];
    for (int i = tid; i < 3 * 8 * 129; i += NWAVES * 64) { const int br = i / (8 * 129), rem = i % (8 * 129), h = rem / 129, j = rem % 129; bt[(br * 8 + h) * ATT_BT_LD + j] = rb[BUCKET_TAB[br][j] * 8 + h] * LOG2E; }
}
__device__ __forceinline__ void attn_prompt_unit(const Args& a, LAS unsigned char* lds, int unit, int wave, int lane) {
    asm volatile("" : "+v"(lane));
    const bf16* PROJ = (const bf16*)(a.ws + WS_PROJ);
    const int r32 = lane & 31, hi = lane >> 5;
    const int rq = unit & 127, bhb = unit >> 7, br = bhb % 3, bh = bhb / 3, h = bh & 7, b = bh >> 3;
    const int sh = 2 * br, dil = 1 << sh, nqb = 128 >> sh, r = rq / nqb, qb = rq % nqb, l0 = qb * 32;
    const size_t rowb = (size_t)b * SEQ;
    LAS unsigned char* wl = lds + wave * ATT_WAVE_BYTES;
    const LAS float* bt = (const LAS float*)(lds + ATT_BTAB_OFF) + (br * 8 + h) * ATT_BT_LD;
    bf16x8 qr[4];
    { const bf16* qp = PROJ + (rowb + (size_t)(l0 + r32) * dil + r) * NIN + h * 64 + hi * 8;
#pragma unroll
      for (int d0 = 0; d0 < 4; ++d0) qr[d0] = *(const bf16x8*)(qp + d0 * 16); }
    const int kb0 = (l0 >= 128) ? 0 : (4 - (l0 >> 5));
    f32x16 s[5];
    bf16x8 kfa[4], kfb[4];
#define ATT_KLOAD(dst, kb_) do { int kk_ = l0 - 128 + 32 * (kb_) + r32; kk_ = kk_ < 0 ? 0 : kk_; const bf16* kp_ = PROJ + (rowb + (size_t)kk_ * dil + r) * NIN + PC_K + h * 64 + hi * 8; \
        _Pragma("unroll") for (int d0 = 0; d0 < 4; ++d0) dst[d0] = *(const bf16x8*)(kp_ + d0 * 16); } while (0)
#define ATT_QK(src, kb_) do { _Pragma("unroll") for (int i = 0; i < 16; ++i) s[kb_][i] = 0.f; \
        if ((kb_) >= kb0) { _Pragma("unroll") for (int d0 = 0; d0 < 4; ++d0) s[kb_] = __builtin_amdgcn_mfma_f32_32x32x16_bf16(src[d0], qr[d0], s[kb_], 0, 0, 0); } } while (0)
    ATT_KLOAD(kfa, 0); ATT_KLOAD(kfb, 1);
    __builtin_amdgcn_sched_barrier(0);
    ATT_QK(kfa, 0); ATT_KLOAD(kfa, 2);
    __builtin_amdgcn_sched_barrier(0);
    ATT_QK(kfb, 1); ATT_KLOAD(kfb, 3);
    __builtin_amdgcn_sched_barrier(0);
    ATT_QK(kfa, 2); ATT_KLOAD(kfa, 4);
    __builtin_amdgcn_sched_barrier(0);
    ATT_QK(kfb, 3);
    __builtin_amdgcn_sched_barrier(0);
    ATT_QK(kfa, 4);
#undef ATT_KLOAD
#undef ATT_QK
    __builtin_amdgcn_sched_barrier(0);
    v4u vpre[5][4];
#pragma unroll
    for (int kb = 0; kb < 3; ++kb)
#pragma unroll
        for (int i = 0; i < 4; ++i) {
            const int idx = i * 64 + lane, key = idx >> 3, ch = idx & 7;
            int kk = l0 - 128 + 32 * kb + key; kk = kk < 0 ? 0 : kk;
            vpre[kb][i] = *(const v4u*)(PROJ + (rowb + (size_t)kk * dil + r) * NIN + PC_V + h * 64 + ch * 8);
        }
    __builtin_amdgcn_sched_barrier(0);
    float mx = -INFINITY;
    int J0 = r32 - 4 * hi + 128, T0 = 128 - l0 - 4 * hi;
    asm volatile("" : "+v"(J0), "+v"(T0));
#pragma unroll
    for (int kb = 0; kb < 5; ++kb)
#pragma unroll
        for (int i = 0; i < 16; ++i) {
            const int cst = (i & 3) + 8 * (i >> 2) + 32 * kb, j = J0 - cst;
            const bool valid = ((unsigned)j <= 128u) && (cst >= T0) && (kb >= kb0);
            const int jc = j < 0 ? 0 : (j > 128 ? 128 : j);
            const float v = valid ? s[kb][i] + bt[jc] : -INFINITY;
            s[kb][i] = v; mx = fmaxf(mx, v);
        }
    mx = fmaxf(mx, __shfl_xor(mx, 32));
    float l = 0.f;
#pragma unroll
    for (int kb = 0; kb < 5; ++kb)
#pragma unroll
        for (int i = 0; i < 16; ++i) { const float p = __builtin_amdgcn_exp2f(s[kb][i] - mx); s[kb][i] = p; l += p; }
    l += __shfl_xor(l, 32);
    __builtin_amdgcn_sched_barrier(0);
#pragma unroll
    for (int kb = 3; kb < 5; ++kb)
#pragma unroll
        for (int i = 0; i < 4; ++i) {
            const int idx = i * 64 + lane, key = idx >> 3, ch = idx & 7;
            int kk = l0 - 128 + 32 * kb + key; kk = kk < 0 ? 0 : kk;
            vpre[kb][i] = *(const v4u*)(PROJ + (rowb + (size_t)kk * dil + r) * NIN + PC_V + h * 64 + ch * 8);
        }
    f32x16 o[2];
#pragma unroll
    for (int i = 0; i < 16; ++i) { o[0][i] = 0.f; o[1][i] = 0.f; }
    const LAS unsigned char* vrd = wl + ATT_VB + ((lane >> 4) & 1) * 32 + (lane & 3) * 8 + (4 * hi + ((lane & 15) >> 2)) * 64;
#pragma unroll
    for (int kb = 0; kb < 5; ++kb) {
        if (kb >= kb0) {
#pragma unroll
            for (int i = 0; i < 4; ++i) {
                const int idx = i * 64 + lane, key = idx >> 3, ch = idx & 7;
                *(LAS v4u*)(wl + ATT_VB + (ch >> 2) * 2048 + (key >> 4) * 1024 + (key & 15) * 64 + (ch & 3) * 16) = vpre[kb][i];
            }
            LDS_WAIT();
#pragma unroll
            for (int ks = 0; ks < 2; ++ks) {
                v4u pw;
                pw.x = cvtpk_s(s[kb][8 * ks + 0], s[kb][8 * ks + 1]); pw.y = cvtpk_s(s[kb][8 * ks + 2], s[kb][8 * ks + 3]);
                pw.z = cvtpk_s(s[kb][8 * ks + 4], s[kb][8 * ks + 5]); pw.w = cvtpk_s(s[kb][8 * ks + 6], s[kb][8 * ks + 7]);
                const bf16x8 pa = __builtin_bit_cast(bf16x8, pw);
#pragma unroll
                for (int d0 = 0; d0 < 2; ++d0) {
                    const v4i16_t lo = vtr(vrd + d0 * 2048 + ks * 1024), hh = vtr(vrd + d0 * 2048 + ks * 1024 + 512);
                    const bf16x8 vb = (bf16x8){lo[0], lo[1], lo[2], lo[3], hh[0], hh[1], hh[2], hh[3]};
                    o[d0] = __builtin_amdgcn_mfma_f32_32x32x16_bf16(pa, vb, o[d0], 0, 0, 0);
                }
            }
            LDS_WAIT();
        }
    }
    LAS float* wsf = (LAS float*)(wl + ATT_WSF);
    if (hi == 0) wsf[r32] = l;
    LDS_WAIT();
    LAS bf16* stg = (LAS bf16*)(wl + ATT_STG);
#pragma unroll
    for (int i = 0; i < 16; ++i) {
        const int orow = crow(i, hi); const float rl = 1.0f / wsf[orow];
        stg[orow * 64 + r32] = (bf16)f2bf(o[0][i] * rl); stg[orow * 64 + 32 + r32] = (bf16)f2bf(o[1][i] * rl);
    }
    LDS_WAIT();
    bf16* OBR = (bf16*)(a.ws + WS_OBR) + (size_t)br * MP * 512;
#pragma unroll
    for (int i = 0; i < 4; ++i) {
        const int row = i * 8 + (lane >> 3), ch = lane & 7;
        const v4u v = *(const LAS v4u*)(stg + row * 64 + ch * 8);
        *(v4u*)(OBR + (rowb + (size_t)(l0 + row) * dil + r) * 512 + h * 64 + ch * 8) = v;
    }
    if (hi == 0) { float* LSE = (float*)(a.ws + WS_LSE) + (size_t)br * MP * 8; LSE[(rowb + (size_t)(l0 + r32) * dil + r) * 8 + h] = mx + __builtin_amdgcn_logf(l); }
    LDS_WAIT();
}

__device__ __forceinline__ void attn_sample_task(const Args& a, LAS unsigned char* lds, int task, int wave, int lane) {
    const int h = task & 7, t = (task >> 3) & 7, b = task >> 6;
    const bf16* PROJ = (const bf16*)(a.ws + WS_PROJ);
    const float* ck = a.in[4]; const float* cv = a.in[5]; const float* kn = a.out + O_KS; const float* vn = a.out + O_VS;
    LAS float* pl = (LAS float*)(lds + wave * ATT_WAVE_BYTES + ATT_STG);
    const int ks = lane >> 4, dq = lane & 15;
    f32x4 q4;
    { const u32x2 w = *(const u32x2*)(PROJ + (size_t)(MP + b * 8 + t) * NIN + h * 64 + 4 * dq); q4 = (f32x4){bflo(w.x), bfhi(w.x), bflo(w.y), bfhi(w.y)}; }
    const size_t cbase = ((size_t)b * WBUF * 8 + h) * 64 + 4 * dq, nbase = ((size_t)b * 8 * 8 + h) * 64 + 4 * dq;
#pragma unroll 1
    for (int br = 0; br < 3; ++br) {
        const int dil = 1 << (2 * br);
        const LAS float* bt = (const LAS float*)(lds + ATT_BTAB_OFF) + (br * 8 + h) * ATT_BT_LD;
#pragma unroll 1
        for (int it0 = 0; it0 < 33; it0 += 11) {
            f32x4 kv[11];
#pragma unroll
            for (int u = 0; u < 11; ++u) { int j = 4 * (it0 + u) + ks; j = j > 128 ? 128 : j; const int idx = WBUF + t - j * dil;
                kv[u] = (idx < WBUF) ? *(const f32x4*)(ck + cbase + (size_t)idx * 512) : *(const f32x4*)(kn + nbase + (size_t)(idx - WBUF) * 512); }
#pragma unroll
            for (int u = 0; u < 11; ++u) { const int j = 4 * (it0 + u) + ks; float d = q4.x * kv[u].x + q4.y * kv[u].y + q4.z * kv[u].z + q4.w * kv[u].w; d = row16_sum(d);
                if (dq == 0 && j <= 128) pl[br * ATT_BT_LD + j] = d + bt[j]; }
        }
    }
    LDS_WAIT(); asm volatile("" ::: "memory");
    float mx = -INFINITY;
#pragma unroll 1
    for (int i = lane; i < 3 * ATT_BT_LD; i += 64) { const int j = i % ATT_BT_LD; if (j <= 128) mx = fmaxf(mx, pl[i]); }
    mx = wave_max(mx);
    float l = 0.f;
#pragma unroll 1
    for (int i = lane; i < 3 * ATT_BT_LD; i += 64) { const int j = i % ATT_BT_LD; if (j <= 128) { const float p = __builtin_amdgcn_exp2f(pl[i] - mx); pl[i] = p; l += p; } }
    l = wave_sum(l);
    LDS_WAIT(); asm volatile("" ::: "memory");
    f32x4 o4 = {0.f, 0.f, 0.f, 0.f};
#pragma unroll 1
    for (int br = 0; br < 3; ++br) {
        const int dil = 1 << (2 * br);
#pragma unroll 1
        for (int it0 = 0; it0 < 33; it0 += 11) {
            f32x4 vv[11]; float pp[11];
#pragma unroll
            for (int u = 0; u < 11; ++u) { const int j0 = 4 * (it0 + u) + ks, j = j0 > 128 ? 128 : j0; const int idx = WBUF + t - j * dil;
                vv[u] = (idx < WBUF) ? *(const f32x4*)(cv + cbase + (size_t)idx * 512) : *(const f32x4*)(vn + nbase + (size_t)(idx - WBUF) * 512);
                pp[u] = (j0 <= 128) ? pl[br * ATT_BT_LD + j] : 0.f; }
#pragma unroll
            for (int u = 0; u < 11; ++u) o4 += vv[u] * pp[u];
        }
    }
#pragma unroll
    for (int e = 0; e < 4; ++e) { o4[e] += __shfl_xor(o4[e], 16); o4[e] += __shfl_xor(o4[e], 32); }
    if (lane < 16) { const float il = 1.f / l; u32x2 w; w.x = pk2(o4.x * il, o4.y * il); w.y = pk2(o4.z * il, o4.w * il);
        *(u32x2*)((bf16*)(a.ws + WS_MIX) + (size_t)(MP + b * 8 + t) * DM + h * 64 + 4 * dq) = w; }
    LDS_WAIT(); asm volatile("" ::: "memory");
}

__device__ __forceinline__ void ssd_sample_task(const Args& a, int k, int lane) {
    const float* XB = (const float*)(a.ws + WS_XBS); const float* DT = (const float*)(a.ws + WS_DT); float* YS = (float*)(a.ws + WS_YS);
    const int p4 = k & 15, h = (k >> 4) & 7, b = k >> 7, g = h >> 2, p = 4 * p4 + (lane >> 4), ng = lane & 15;
    const size_t sidx = ((size_t)((b * 8 + h) * 64 + p)) * 128 + 8 * ng;
    float s[8]; load8f(a.in[6] + sidx, s);
    const float A = -__expf(a.in[15][h]);
#pragma unroll 1
    for (int t0 = 0; t0 < TS; t0 += 4) {
        float dtv[4], xv[4], Bv[4][8], Cv[4][8];
#pragma unroll
        for (int q = 0; q < 4; ++q) { const int r = b * TS + t0 + q; dtv[q] = DT[(size_t)(MP + r) * 8 + h]; const float* xr = XB + (size_t)r * 1024; xv[q] = xr[h * 64 + p]; load8f(xr + 512 + g * 128 + 8 * ng, Bv[q]); load8f(xr + 768 + g * 128 + 8 * ng, Cv[q]); }
#pragma unroll
        for (int q = 0; q < 4; ++q) {
            const float da = __expf(dtv[q] * A), xd = dtv[q] * xv[q]; float y = 0.f;
#pragma unroll
            for (int e = 0; e < 8; ++e) { s[e] = da * s[e] + xd * Bv[q][e]; y += Cv[q][e] * s[e]; }
            y = row16_sum(y);
            if (ng == 0) YS[(size_t)(MP + b * TS + t0 + q) * 512 + h * 64 + p] = y;
        }
    }
    float* so = a.out + O_SS + sidx;
    *(f32x4*)so = (f32x4){s[0], s[1], s[2], s[3]}; *(f32x4*)(so + 4) = (f32x4){s[4], s[5], s[6], s[7]};
}
__device__ __forceinline__ void attn_combine_pass(const Args& a, int gtid, int NT) {
    const bf16* OBR = (const bf16*)(a.ws + WS_OBR); const float* LSE = (const float*)(a.ws + WS_LSE); bf16* MIX = (bf16*)(a.ws + WS_MIX);
    for (int it = gtid; it < MP * 64; it += NT) {
        const int row = it >> 6, c8 = it & 63, h = c8 >> 3;
        const float l0 = LSE[(size_t)row * 8 + h], l1 = LSE[(size_t)(MP + row) * 8 + h], l2 = LSE[(size_t)(2 * MP + row) * 8 + h];
        const float mx = fmaxf(l0, fmaxf(l1, l2));
        float w0 = __builtin_amdgcn_exp2f(l0 - mx), w1 = __builtin_amdgcn_exp2f(l1 - mx), w2 = __builtin_amdgcn_exp2f(l2 - mx);
        const float inv = 1.f / (w0 + w1 + w2); w0 *= inv; w1 *= inv; w2 *= inv;
        float o0[8], o1[8], o2[8];
        load8bf(OBR + (size_t)row * 512 + c8 * 8, o0); load8bf(OBR + ((size_t)MP + row) * 512 + c8 * 8, o1); load8bf(OBR + ((size_t)2 * MP + row) * 512 + c8 * 8, o2);
        float r[8];
#pragma unroll
        for (int k = 0; k < 8; ++k) r[k] = w0 * o0[k] + w1 * o1[k] + w2 * o2[k];
        v4u w; w.x = pk2(r[0], r[1]); w.y = pk2(r[2], r[3]); w.z = pk2(r[4], r[5]); w.w = pk2(r[6], r[7]);
        *(v4u*)(MIX + (size_t)row * DM + c8 * 8) = w;
    }
}
__device__ __forceinline__ void ssd_finish_pass(const Args& a, int gw, int NGW, int lane) {
    const bf16* XC = (const bf16*)(a.ws + WS_XC); const float* YS = (const float*)(a.ws + WS_YS); const bf16* PROJ = (const bf16*)(a.ws + WS_PROJ); bf16* MIX = (bf16*)(a.ws + WS_MIX);
    const float* dsk = a.in[16]; const float* gs = a.in[17];
    const int c = lane * 8; const float dh = dsk[c >> 6];
    float g8[8]; load8f(gs + c, g8);
    for (int m = gw; m < MT; m += NGW) {
        float y[8], x[8], z[8], v[8]; load8f(YS + (size_t)m * 512 + c, y); load8bf(XC + (size_t)m * 512 + c, x); load8bf(PROJ + (size_t)m * NIN + PC_Z + c, z);
        float ss = 0.f;
#pragma unroll
        for (int k = 0; k < 8; ++k) { v[k] = (y[k] + dh * x[k]) * siluf(z[k]); ss += v[k] * v[k]; }
#pragma unroll
        for (int o = 1; o < 32; o <<= 1) ss += __shfl_xor(ss, o);
        const float rs = 1.0f / sqrtf(ss * (1.f / 256.f) + EPS);
        v4u w; w.x = pk2(v[0] * rs * g8[0], v[1] * rs * g8[1]); w.y = pk2(v[2] * rs * g8[2], v[3] * rs * g8[3]); w.z = pk2(v[4] * rs * g8[4], v[5] * rs * g8[5]); w.w = pk2(v[6] * rs * g8[6], v[7] * rs * g8[7]);
        *(v4u*)(MIX + (size_t)m * DM + 512 + c) = w;
    }
}
__device__ __forceinline__ void ffn_conv_pass(const Args& a, int gtid, int NT) {
    const bf16* U = (const bf16*)(a.ws + WS_U); bf16* ACT = (bf16*)(a.ws + WS_ACT);
    const float* fw = a.in[21]; const float* fb = a.in[22]; const float* sf = a.in[8];
    constexpr int NC8 = DFF / 8, NPB = MP / 16, NITEMS = (NPB + NBS) * NC8;
    for (int it = gtid; it < NITEMS; it += NT) {
        const int blk = it / NC8, c = (it % NC8) * 8;
        float wa0[8], wa1[8], wa2[8], wb0[8], wb1[8], wb2[8], ba[8], bb[8], a2[8], a1[8], b2[8], b1[8];
        load8f(fw + c, wa0); load8f(fw + DFF2 + c, wa1); load8f(fw + 2 * DFF2 + c, wa2); load8f(fb + c, ba);
        load8f(fw + DFF + c, wb0); load8f(fw + DFF2 + DFF + c, wb1); load8f(fw + 2 * DFF2 + DFF + c, wb2); load8f(fb + DFF + c, bb);
        int m0, nr;
        if (blk < NPB) { m0 = blk * 16; nr = 16;
            if ((m0 & (SEQ - 1)) == 0) {
#pragma unroll
                for (int k = 0; k < 8; ++k) { a2[k] = 0.f; a1[k] = 0.f; b2[k] = 0.f; b1[k] = 0.f; }
            } else { load8bf(U + (size_t)(m0 - 2) * DFF2 + c, a2); load8bf(U + (size_t)(m0 - 1) * DFF2 + c, a1); load8bf(U + (size_t)(m0 - 2) * DFF2 + DFF + c, b2); load8bf(U + (size_t)(m0 - 1) * DFF2 + DFF + c, b1); }
        } else { const int b = blk - NPB; m0 = MP + b * 8; nr = 8;
            load8f(sf + (size_t)(b * 2) * DFF2 + c, a2); load8f(sf + (size_t)(b * 2 + 1) * DFF2 + c, a1); load8f(sf + (size_t)(b * 2) * DFF2 + DFF + c, b2); load8f(sf + (size_t)(b * 2 + 1) * DFF2 + DFF + c, b1); }
        for (int r = 0; r < nr; ++r) {
            float ua[8], ub[8], o[8]; load8bf(U + (size_t)(m0 + r) * DFF2 + c, ua); load8bf(U + (size_t)(m0 + r) * DFF2 + DFF + c, ub);
#pragma unroll
            for (int k = 0; k < 8; ++k) {
                const float ya = ba[k] + wa0[k] * a2[k] + wa1[k] * a1[k] + wa2[k] * ua[k], yb = bb[k] + wb0[k] * b2[k] + wb1[k] * b1[k] + wb2[k] * ub[k];
                o[k] = siluf(ya) * yb; a2[k] = a1[k]; a1[k] = ua[k]; b2[k] = b1[k]; b1[k] = ub[k];
            }
            v4u w; w.x = pk2(o[0], o[1]); w.y = pk2(o[2], o[3]); w.z = pk2(o[4], o[5]); w.w = pk2(o[6], o[7]);
            *(v4u*)(ACT + (size_t)(m0 + r) * DFF + c) = w;
        }
    }
}
__device__ __forceinline__ void final_norm_pass(const Args& a, int gw, int NGW, int lane) {
    const float* RS3 = (const float*)(a.ws + WS_RS3); const float* gf = a.in[27]; const bf16* H3b = (const bf16*)(a.ws + WS_MIX);
    float g[16];
    load8f(gf + lane * 16, *(float(*)[8])&g[0]); load8f(gf + lane * 16 + 8, *(float(*)[8])&g[8]);
    for (int m = gw; m < MT; m += NGW) {
        float* orow = (m < MP) ? a.out + O_Y + (size_t)m * DM : a.out + O_YS + (size_t)(m - MP) * DM;
        const float rs = 1.0f / sqrtf(RS3[m] * (1.f / DM) + EPS);
        float h[16]; load8bf(H3b + (size_t)m * DM + lane * 16, *(float(*)[8])&h[0]); load8bf(H3b + (size_t)m * DM + lane * 16 + 8, *(float(*)[8])&h[8]);
#pragma unroll
        for (int j = 0; j < 4; ++j) *(f32x4*)(orow + lane * 16 + 4 * j) = (f32x4){h[4 * j] * rs * g[4 * j], h[4 * j + 1] * rs * g[4 * j + 1], h[4 * j + 2] * rs * g[4 * j + 2], h[4 * j + 3] * rs * g[4 * j + 3]};
    }
}

typedef float f32x4m __attribute__((ext_vector_type(4)));
template <class Epi>
__device__ __forceinline__ void skinny_gemm(LAS unsigned char* lds, const bf16* A, const bf16* Wt, int N, int K, const Epi& E, int vcu, int G, int tid, int wave, int lane) {
    const int npieces = (MS / 16) * (N / 64), kslice = K / 8, nsteps = kslice / 32;
    const int r16 = lane & 15, kg = lane >> 4;
    for (int piece = vcu; piece < npieces; piece += G) {
        const int mb = piece & 15, nb = piece >> 4, m0 = mb * 16, n0 = nb * 64;
        const bf16* ap = A + (size_t)(m0 + r16) * K + wave * kslice + 8 * kg;
        const bf16* wp = Wt + (size_t)(n0 + r16) * K + wave * kslice + 8 * kg;
        f32x4m acc[4];
#pragma unroll
        for (int j = 0; j < 4; ++j) acc[j] = (f32x4m){0.f, 0.f, 0.f, 0.f};
        for (int s0 = 0; s0 < nsteps; s0 += 4) {
            bf16x8 af[4], wf[4][4];
#pragma unroll
            for (int u = 0; u < 4; ++u) if (s0 + u < nsteps) {
                af[u] = *(const bf16x8*)(ap + (s0 + u) * 32);
#pragma unroll
                for (int j = 0; j < 4; ++j) wf[u][j] = *(const bf16x8*)(wp + (size_t)(16 * j) * K + (s0 + u) * 32);
            }
#pragma unroll
            for (int u = 0; u < 4; ++u) if (s0 + u < nsteps) {
#pragma unroll
                for (int j = 0; j < 4; ++j) acc[j] = __builtin_amdgcn_mfma_f32_16x16x32_bf16(wf[u][j], af[u], acc[j], 0, 0, 0);
            }
        }
#pragma unroll
        for (int j = 0; j < 4; ++j) *(LAS f32x4m*)(lds + ((wave * 4 + j) * 64 + lane) * 16) = acc[j];
        LDS_WAIT(); __syncthreads();
        if (tid < 256) {
            const int j = tid >> 6, l2 = tid & 63;
            f32x4m v = *(const LAS f32x4m*)(lds + (j * 64 + l2) * 16);
#pragma unroll
            for (int w = 1; w < 8; ++w) v += *(const LAS f32x4m*)(lds + ((w * 4 + j) * 64 + l2) * 16);
            E.apply(m0 + (l2 & 15), n0 + 16 * j + 4 * (l2 >> 4), v);
        }
        LDS_WAIT(); __syncthreads();
    }
}
struct SEpiIn { bf16* PROJ; float* out;
    __device__ __forceinline__ void apply(int r, int c, f32x4m v) const {
        const float sc = (c < PC_K) ? C2 : 1.f; u32x2 w; w.x = pk2(v.x * sc, v.y * sc); w.y = pk2(v.z * sc, v.w * sc);
        *(u32x2*)(PROJ + (size_t)(MP + r) * NIN + c) = w;
        if (c >= PC_K && c < PC_Z) { const bool isk = c < PC_V; *(f32x4m*)(out + (isk ? O_KS : O_VS) + (size_t)r * 512 + (c - (isk ? PC_K : PC_V))) = v; }
        else if (c >= PC_X) { const int t = r & 7, b = r >> 3; if (t >= TS - 3) *(f32x4m*)(out + O_CS + (size_t)(b * 3 + t - (TS - 3)) * 1024 + (c - PC_X)) = v; }
    } };
struct SEpiOut { const float* xs; bf16* H1b; float* RS;
    __device__ __forceinline__ void apply(int r, int c, f32x4m v) const {
        const f32x4m h = *(const f32x4m*)(xs + (size_t)r * DM + c) + v; const size_t o = (size_t)(MP + r) * DM + c;
        u32x2 w; w.x = pk2(h.x, h.y); w.y = pk2(h.z, h.w); *(u32x2*)(H1b + o) = w;
        atomicAdd(RS + MP + r, (h.x * h.x + h.y * h.y) + (h.z * h.z + h.w * h.w));
    } };
struct SEpiPle { bf16* E; float* RS;
    __device__ __forceinline__ void apply(int r, int c, f32x4m v) const {
        u32x2 w; w.x = pk2(v.x, v.y); w.y = pk2(v.z, v.w); *(u32x2*)(E + (size_t)(MP + r) * DM + c) = w; atomicAdd(RS + MP + r, (v.x * v.x + v.y * v.y) + (v.z * v.z + v.w * v.w));
    } };
struct SEpiDown { bf16* Hb;
    __device__ __forceinline__ void apply(int r, int c, f32x4m v) const {
        u32x2* hp = (u32x2*)(Hb + (size_t)(MP + r) * DM + c); const u32x2 o = *hp;
        u32x2 w; w.x = pk2(bflo(o.x) + v.x, bfhi(o.x) + v.y); w.y = pk2(bflo(o.y) + v.z, bfhi(o.y) + v.w); *hp = w;
    } };
struct SEpiGate { const bf16* H2b; const bf16* E; const float* RSE; const float* gple; bf16* H3b; float* RS3;
    __device__ __forceinline__ void apply(int r, int c, f32x4m v) const {
        const size_t o = (size_t)(MP + r) * DM + c; const float rse = 1.0f / sqrtf(RSE[MP + r] * (1.f / DM) + EPS);
        const u32x2 eb = *(const u32x2*)(E + o), hb = *(const u32x2*)(H2b + o); const f32x4m gp = *(const f32x4m*)(gple + c);
        const float e4[4] = {bflo(eb.x), bfhi(eb.x), bflo(eb.y), bfhi(eb.y)}, h4[4] = {bflo(hb.x), bfhi(hb.x), bflo(hb.y), bfhi(hb.y)}; float h[4];
#pragma unroll
        for (int k = 0; k < 4; ++k) { const float g = 1.f / (1.f + __expf(-v[k])); h[k] = h4[k] + g * (e4[k] * rse * gp[k]); }
        u32x2 w; w.x = pk2(h[0], h[1]); w.y = pk2(h[2], h[3]); *(u32x2*)(H3b + o) = w;
        atomicAdd(RS3 + MP + r, (h[0] * h[0] + h[1] * h[1]) + (h[2] * h[2] + h[3] * h[3]));
    } };

constexpr int NPH = 12;
#ifndef DUP
#define DUP -1
#endif
#define REP(k) for (int rep_ = 0; rep_ < ((DUP) == (k) ? args.pad : 1); ++rep_)
#ifndef MK_N_LAUNCHES
#define MK_N_LAUNCHES 1
#endif
constexpr int N_LAUNCHES = MK_N_LAUNCHES;
__global__ void __launch_bounds__(NWAVES * 64, 2) mk_fwd(Args args) {
    extern __shared__ __attribute__((aligned(16))) unsigned char lds_raw[];
    LAS unsigned char* lds = (LAS unsigned char*)lds_raw;
    volatile LAS unsigned* MISC = (volatile LAS unsigned*)(lds + MISC_OFF);
    const int tid = threadIdx.x, lane = tid & 63, wave = __builtin_amdgcn_readfirstlane(tid >> 6);
    const int G = gridDim.x, bx = blockIdx.x, vcu = (G % 8 == 0) ? (bx % 8) * (G / 8) + bx / 8 : bx;
    const int gw = vcu * NWAVES + wave, NGW = G * NWAVES, gtid = vcu * (NWAVES * 64) + tid, NT = G * NWAVES * 64;
    unsigned char* ws = args.ws;
    gu32* ctl = (gu32*)(ws + WS_CTL);
    for (int u = tid; u < (LDS_BYTES - LDSCTL_OFF) / 4; u += NWAVES * 64) ((LAS unsigned*)(lds + LDSCTL_OFF))[u] = 0u;
    __syncthreads();
    XcdBarrier bar; bar.bar = (unsigned*)(ctl + CW_BAR); bar.x = 0; bar.st = nullptr;
    if (N_LAUNCHES == 1) bar = xcd_barrier_post((unsigned*)(ctl + CW_BAR), MISC + 8);
    const int lo = args.ph_lo, hi = args.ph_hi;
#ifndef PHMASK
#define PHMASK 0xfff
#endif
#define IN(k) (((PHMASK >> (k)) & 1) && lo <= (k) && (k) < hi)
#define SEAM(k) do { if (IN(k) && IN((k) + 1)) xcd_barrier(bar); } while (0)

    if (IN(0)) { REP(0) { p0_prologue(args, lds, gw, NGW, wave, lane); VM_WAIT(); __syncthreads(); } }
    SEAM(0);
    if (IN(1)) {
        pg8::Gemm g{(const pg8::bf16_t*)(ws + WS_XN), (const pg8::bf16_t*)(ws + WS_WIN), MP, NIN, DM}; pg8::StaticOrder S; S.init(MP, NIN, G, bx);
        EpiIn E{(pg8::bf16_t*)(ws + WS_PROJ), args.out};
        REP(1) pg8::gemm_phase<EpiIn, pg8::StaticOrder, PG8_ALIGN, PG8_SP2>(lds, g, S, E);
        { SEpiIn SE{(bf16*)(ws + WS_PROJ), args.out}; skinny_gemm(lds, (const bf16*)(ws + WS_XN) + (size_t)MP * DM, (const bf16*)(ws + WS_WIN), NIN, DM, SE, vcu, G, tid, wave, lane); }
    }
    SEAM(1);
    if (IN(2)) {
        attn_build_btab(args, lds, tid);
        conv_sample_pass(args, gtid, NT);
        __syncthreads();
#ifndef P2SUB
#define P2SUB 7
#endif
        REP(20) if (P2SUB & 1) for (int task = gw; task < NBS * TS * NH; task += NGW) attn_sample_task(args, lds, task, wave, lane);
        __syncthreads();
        REP(21) if (P2SUB & 2) for (int unit = gw; unit < NBP * NH * 3 * 128; unit += NGW) attn_prompt_unit(args, lds, unit, wave, lane);
        __syncthreads();
        REP(22) if (P2SUB & 4) for (int unit = vcu; unit < NBP * 32 * 8; unit += G) ssd_s1_unit(args, lds, unit, tid, wave, lane);
        VM_WAIT(); __syncthreads();
    }
    SEAM(2);
    if (IN(3)) {
        REP(30) ssd_s2_pass(args, gtid, NT);
        REP(31) for (int task = gw; task < NBS * 8 * 16; task += NGW) ssd_sample_task(args, task, lane);
        REP(32) attn_combine_pass(args, gtid, NT);
        VM_WAIT(); __syncthreads();
    }
    SEAM(3);
    if (IN(4)) {
        for (int unit = vcu; unit < NBP * 32 * 8; unit += G) ssd_s3_unit(args, unit, wave, lane);
        VM_WAIT(); __syncthreads();
    }
    SEAM(4);
    if (IN(5)) { REP(5) { ssd_finish_pass(args, gw, NGW, lane); VM_WAIT(); __syncthreads(); } }
    SEAM(5);
    if (IN(6)) {
        { pg8::Gemm g{(const pg8::bf16_t*)(ws + WS_MIX), (const pg8::bf16_t*)(ws + WS_WOUT), MP, DM, DM}; pg8::StaticOrder S; S.init(MP, DM, G, bx);
          EpiOut E{args.in[0], (pg8::bf16_t*)(ws + WS_XN), (float*)(ws + WS_RS1)};
#ifndef NO_GOUT
          pg8::gemm_phase<EpiOut, pg8::StaticOrder, PG8_ALIGN, PG8_SP2>(lds, g, S, E);
#endif
        }
#ifndef NOSK
        { SEpiOut SE{args.in[1], (bf16*)(ws + WS_XN), (float*)(ws + WS_RS1)}; skinny_gemm(lds, (const bf16*)(ws + WS_MIX) + (size_t)MP * DM, (const bf16*)(ws + WS_WOUT), DM, DM, SE, vcu, G, tid, wave, lane); }
#endif
        { int kple = DPLE; asm volatile("" : "+s"(kple));
          pg8::Gemm g{(const pg8::bf16_t*)(ws + WS_PB), (const pg8::bf16_t*)(ws + WS_WPLE), MP, DM, kple}; pg8::StaticOrder S; S.init(MP, DM, G, bx);
          EpiPle E{(pg8::bf16_t*)(ws + WS_E), (float*)(ws + WS_RSE)};
#ifndef NO_GPLE
          pg8::gemm_phase<EpiPle, pg8::StaticOrder, PG8_ALIGN, PG8_SP2>(lds, g, S, E);
#endif
        }
        { SEpiPle SE{(bf16*)(ws + WS_E), (float*)(ws + WS_RSE)}; skinny_gemm(lds, (const bf16*)(ws + WS_PB) + (size_t)MP * DPLE, (const bf16*)(ws + WS_WPLE), DM, DPLE, SE, vcu, G, tid, wave, lane); }
    }
    SEAM(6);
    if (IN(7)) {
        pg8::Gemm g{(const pg8::bf16_t*)(ws + WS_XN), (const pg8::bf16_t*)(ws + WS_WUP), MT, DFF2, DM}; pg8::StaticOrder S; S.init(MT, DFF2, G, bx);
        EpiUp E{(pg8::bf16_t*)(ws + WS_U), (const float*)(ws + WS_RS1), args.out};
        REP(7) pg8::gemm_phase<EpiUp, pg8::StaticOrder, PG8_ALIGN, PG8_SP2>(lds, g, S, E);
    }
    SEAM(7);
    if (IN(8)) { REP(8) { ffn_conv_pass(args, gtid, NT); VM_WAIT(); __syncthreads(); } }
    SEAM(8);
    if (IN(9)) {
        pg8::Gemm g{(const pg8::bf16_t*)(ws + WS_ACT), (const pg8::bf16_t*)(ws + WS_WDOWN), MP, DM, DFF}; pg8::StaticOrder S; S.init(MP, DM, G, bx);
        EpiDown E{(pg8::bf16_t*)(ws + WS_XN)};
        pg8::gemm_phase<EpiDown, pg8::StaticOrder, PG8_ALIGN, PG8_SP2>(lds, g, S, E);
        { SEpiDown SE{(bf16*)(ws + WS_XN)}; skinny_gemm(lds, (const bf16*)(ws + WS_ACT) + (size_t)MP * DFF, (const bf16*)(ws + WS_WDOWN), DM, DFF, SE, vcu, G, tid, wave, lane); }
    }
    SEAM(9);
    if (IN(10)) {
        pg8::Gemm g{(const pg8::bf16_t*)(ws + WS_XN), (const pg8::bf16_t*)(ws + WS_WGATE), MP, DM, DM}; pg8::StaticOrder S; S.init(MP, DM, G, bx);
        EpiGate E{(const pg8::bf16_t*)(ws + WS_XN), (const pg8::bf16_t*)(ws + WS_E), (const float*)(ws + WS_RSE), args.in[25], (pg8::bf16_t*)(ws + WS_MIX), (float*)(ws + WS_RS3)};
        pg8::gemm_phase<EpiGate, pg8::StaticOrder, PG8_ALIGN, PG8_SP2>(lds, g, S, E);
        { SEpiGate SE{(const bf16*)(ws + WS_XN), (const bf16*)(ws + WS_E), (const float*)(ws + WS_RSE), args.in[25], (bf16*)(ws + WS_MIX), (float*)(ws + WS_RS3)}; skinny_gemm(lds, (const bf16*)(ws + WS_XN) + (size_t)MP * DM, (const bf16*)(ws + WS_WGATE), DM, DM, SE, vcu, G, tid, wave, lane); }
    }
    SEAM(10);
    if (IN(11)) { final_norm_pass(args, gw, NGW, lane); }
#undef IN
#undef SEAM
}

extern "C" void kernel_launch(void* const* d_in, const int* in_sizes, int n_in, void* d_out, int out_size, void* d_ws, size_t ws_size, hipStream_t stream) {
    static int grid = 0;
    if (grid == 0) {
        if (n_in != 28 || out_size != (int)O_END || ws_size < WS_END) { fprintf(stderr, "kernel_launch: unexpected shapes: n_in %d out %d ws %zu\n", n_in, out_size, ws_size); grid = -1; return; }
        int dev = 0, cus = 0, per_cu = 0;
        if (hipGetDevice(&dev) != hipSuccess || hipDeviceGetAttribute(&cus, hipDeviceAttributeMultiprocessorCount, dev) != hipSuccess) { grid = -1; return; }
        if (hipFuncSetAttribute((const void*)mk_fwd, hipFuncAttributeMaxDynamicSharedMemorySize, LDS_BYTES) != hipSuccess) { fprintf(stderr, "kernel_launch: hipFuncSetAttribute failed\n"); grid = -1; return; }
        if (hipOccupancyMaxActiveBlocksPerMultiprocessor(&per_cu, (const void*)mk_fwd, NWAVES * 64, LDS_BYTES) != hipSuccess || per_cu < 1) fprintf(stderr, "kernel_launch: occupancy query says %d\n", per_cu);
        (void)hipGetLastError();
        grid = cus;
    }
    if (grid < 0) return;
    if (hipMemsetAsync((char*)d_ws + WS_CTL, 0, CTL_ZERO_BYTES, stream) != hipSuccess) { fprintf(stderr, "kernel_launch: memset failed\n"); return; }
    Args a{};
    for (int i = 0; i < 28; ++i) a.in[i] = (const float*)d_in[i];
    a.out = (float*)d_out; a.ws = (unsigned char*)d_ws; a.pad = 2;
    for (int li = 0; li < N_LAUNCHES; ++li) {
        if (N_LAUNCHES == 1) { a.ph_lo = 0; a.ph_hi = NPH; } else { a.ph_lo = li; a.ph_hi = li + 1; }
        a.li = li;
        hipLaunchKernelGGL(mk_fwd, dim3(grid), dim3(NWAVES * 64), LDS_BYTES, stream, a);
        const hipError_t le = hipPeekAtLastError();
        if (le != hipSuccess) { fprintf(stderr, "kernel_launch: launch %d failed: %s\n", li, hipGetErrorName(le)); break; }
    }
}
```

```cpp
#include <hip/hip_runtime.h>
#include <cstdio>
#include <cstdint>
namespace pg8 {
#define PG8_LAS __attribute__((address_space(3)))
typedef unsigned short bf16_t;
typedef short bf16x8 __attribute__((ext_vector_type(8)));
typedef float f32x4 __attribute__((ext_vector_type(4)));
typedef unsigned u32x4 __attribute__((ext_vector_type(4)));
constexpr int BM = 256, BK = 64, HALF = 128, HTB = HALF * BK * 2  , STAGE_BYTES = 8 * HTB, NXCD = 8, WGM = 8;

__host__ __device__ __forceinline__ int lds_byte(int r, int c) { const int st = (r >> 4) * 2 + (c >> 5), rr = r & 15, cc = c & 31, ob = rr * 64 + cc * 2; return st * 1024 + (ob ^ (((ob >> 9) & 1) << 5)); }
__host__ __device__ __forceinline__ void stage_rc(int b, int& R, int& C) { const int st = b / 1024, sb = b % 1024, swz = sb ^ (((sb >> 9) & 1) << 5); R = (st >> 1) * 16 + swz / 64; C = (st & 1) * 32 + (swz % 64) / 2; }
__host__ __device__ __forceinline__ int perm32(int rho) { const int n = rho >> 4, i = rho & 15; return 8 * (i >> 2) + 4 * n + (i & 3); }

struct Unit { int pm, pn; };
struct Gemm { const bf16_t* A; const bf16_t* Bt; int M, N, K; };

struct StaticOrder {
    int nM, nN, nwg, G, c;
    __host__ __device__ void init(int M, int N, int G_, int c_) { nM = M / BM; nN = N / BM; nwg = nM * nN; G = G_; c = c_; }
    __host__ __device__ bool next(int i, Unit& u) const {
        const long L = (long)i * G + c; if (L >= nwg) return false;
        int wgid = (int)L; { const int q = nwg / NXCD, r = nwg % NXCD, xcd = wgid % NXCD, off = wgid / NXCD; wgid = (xcd < r ? xcd * (q + 1) : r * (q + 1) + (xcd - r) * q) + off; }
        const int nig = WGM * nN, gid = wgid / nig, fm = gid * WGM, gsz = (nM - fm) < WGM ? (nM - fm) : WGM;
        u.pm = fm + ((wgid % nig) % gsz); u.pn = (wgid % nig) / gsz; return true;
    }
    __device__ __forceinline__ void a_ready(const Unit&) const {}
    __device__ __forceinline__ void done(const Unit&) const {}
};

__device__ __forceinline__ unsigned cvt_pk_bf16(float lo, float hi) { unsigned r; asm volatile("v_cvt_pk_bf16_f32 %0, %1, %2" : "=v"(r) : "v"(lo), "v"(hi)); return r; }
typedef float f32x2 __attribute__((ext_vector_type(2)));
template <class Epi, class Sched, bool ALIGN_EPI = false, bool SP2 = false>
__device__ __forceinline__ void gemm_phase(PG8_LAS unsigned char* lds, const Gemm g, const Sched& S, const Epi& E) {
    const int tid = threadIdx.x, wid = __builtin_amdgcn_readfirstlane(tid >> 6), lane = tid & 63, wr = wid >> 2, wc = wid & 3, fr = lane & 15, fq = lane >> 4;
    const int K = g.K, nt = K / BK;
    unsigned voffA[2], voffB[2];
#pragma unroll
    for (int i = 0; i < 2; ++i) { int R, C; stage_rc(tid * 16 + i * 8192, R, C); const int Rb = Epi::PERM ? ((R & ~31) + perm32(R & 31)) : R;
        voffA[i] = (unsigned)(R * K + C) * 2u; voffB[i] = (unsigned)(Rb * K + C) * 2u; }
    const size_t kstep = (size_t)(BK * 2);
    const size_t hstep = (size_t)HALF * K * 2;
    const size_t tstep = 2 * hstep;
    const unsigned ldsw = (unsigned)wid * 1024u;
    const int aoff = lds_byte(wr * 64 + fr, fq * 8), boff = lds_byte(wc * 32 + fr, fq * 8);
#define PG8_SA(b, h) (((b) * 2 + (h)) * HTB)
#define PG8_SB(b, h) ((4 + (b) * 2 + (h)) * HTB)
#define PG8_STAGE(bufoff, gbase, voff) do { _Pragma("unroll") for (int _i = 0; _i < 2; ++_i) \
        __builtin_amdgcn_global_load_lds((const unsigned*)((const char*)(gbase) + (voff)[_i]), (PG8_LAS unsigned*)(lds + (bufoff) + ldsw + _i * 8192), 16, 0, 0); } while (0)
#define PG8_LDA(dst, b, h) do { _Pragma("unroll") for (int m = 0; m < 4; ++m) _Pragma("unroll") for (int k = 0; k < 2; ++k) dst[m][k] = *(const PG8_LAS bf16x8*)(lds + PG8_SA(b, h) + aoff + m * 2048 + k * 1024); } while (0)
#define PG8_LDB(dst, b, h) do { _Pragma("unroll") for (int n = 0; n < 2; ++n) _Pragma("unroll") for (int k = 0; k < 2; ++k) dst[n][k] = *(const PG8_LAS bf16x8*)(lds + PG8_SB(b, h) + boff + n * 2048 + k * 1024); } while (0)
#define PG8_MMA(ai, bj, At, Bt) do { __builtin_amdgcn_s_setprio(1); _Pragma("unroll") for (int m = 0; m < 4; ++m) _Pragma("unroll") for (int n = 0; n < 2; ++n) _Pragma("unroll") for (int k = 0; k < 2; ++k) \
        acc[ai][bj][m][n] = __builtin_amdgcn_mfma_f32_16x16x32_bf16(Bt[n][k], At[m][k], acc[ai][bj][m][n], 0, 0, 0); __builtin_amdgcn_s_setprio(0); } while (0)
#define PG8_WAIT_V(n) asm volatile("s_waitcnt vmcnt(" #n ")" ::: "memory")
#define PG8_WAIT_L(n) asm volatile("s_waitcnt lgkmcnt(" #n ")" ::: "memory")
#define PG8_BAR __builtin_amdgcn_s_barrier()
#define PG8_SCHED __builtin_amdgcn_sched_barrier(0)
    Unit cur, nxt; int ui = 0;
    if (!S.next(0, cur)) return;
    f32x4 acc[2][2][4][2];
#pragma unroll
    for (int a = 0; a < 2; ++a)
#pragma unroll
        for (int b = 0; b < 2; ++b)
#pragma unroll
            for (int m = 0; m < 4; ++m)
#pragma unroll
                for (int n = 0; n < 2; ++n) acc[a][b][m][n] = (f32x4){0.f, 0.f, 0.f, 0.f};
    bf16x8 At[4][2], B0[2][2], B1[2][2];
    const char* cA = (const char*)g.A + (size_t)cur.pm * tstep; const char* cB = (const char*)g.Bt + (size_t)cur.pn * tstep;
    S.a_ready(cur);
    if constexpr (SP2) {
        PG8_STAGE(PG8_SB(0, 0), cB, voffB); PG8_STAGE(PG8_SB(0, 1), cB + hstep, voffB); PG8_STAGE(PG8_SA(0, 0), cA, voffA); PG8_STAGE(PG8_SA(0, 1), cA + hstep, voffA);
        if (wr == 1) PG8_BAR;
        PG8_WAIT_V(2); PG8_BAR;
        PG8_STAGE(PG8_SB(1, 0), cB + kstep, voffB); PG8_STAGE(PG8_SA(1, 0), cA + kstep, voffA); PG8_STAGE(PG8_SB(1, 1), cB + hstep + kstep, voffB);
        PG8_WAIT_V(6); PG8_BAR;
    } else {
        PG8_STAGE(PG8_SB(0, 0), cB, voffB); PG8_STAGE(PG8_SA(0, 0), cA, voffA); PG8_STAGE(PG8_SB(0, 1), cB + hstep, voffB); PG8_STAGE(PG8_SA(0, 1), cA + hstep, voffA);
        if (wr == 1) PG8_BAR;
        PG8_WAIT_V(4); PG8_BAR;
        PG8_STAGE(PG8_SB(1, 0), cB + kstep, voffB); PG8_STAGE(PG8_SA(1, 0), cA + kstep, voffA); PG8_STAGE(PG8_SB(1, 1), cB + hstep + kstep, voffB);
        PG8_WAIT_V(6); PG8_BAR;
    }
    for (;;) {
        const bool has_next = S.next(ui + 1, nxt);
        const char* nA = has_next ? (const char*)g.A + (size_t)nxt.pm * tstep : cA; const char* nB = has_next ? (const char*)g.Bt + (size_t)nxt.pn * tstep : cB;
        for (int t = 0; t < nt; t += 2) {
            const bool last = (t == nt - 2);
            const char* a1 = cA + (size_t)(t + 1) * kstep;
            const char* a2 = last ? nA : cA + (size_t)(t + 2) * kstep; const char* b2 = last ? nB : cB + (size_t)(t + 2) * kstep;
            const char* a3 = a2 + kstep; const char* b3 = b2 + kstep;
            if (last && has_next) S.a_ready(nxt);
            if constexpr (SP2) {
            PG8_LDB(B0, 0, 0); PG8_LDB(B1, 0, 1); PG8_SCHED; PG8_LDA(At, 0, 0); PG8_STAGE(PG8_SA(1, 1), a1 + hstep, voffA);
            PG8_WAIT_V(8); PG8_WAIT_L(0); PG8_BAR; PG8_MMA(0, 0, At, B0); PG8_MMA(0, 1, At, B1); PG8_BAR; PG8_SCHED;
            PG8_LDA(At, 0, 1); PG8_STAGE(PG8_SB(0, 0), b2, voffB); PG8_STAGE(PG8_SB(0, 1), b2 + hstep, voffB); PG8_STAGE(PG8_SA(0, 0), a2, voffA);
            PG8_WAIT_V(8); PG8_WAIT_L(0); PG8_BAR; PG8_MMA(1, 0, At, B0); PG8_MMA(1, 1, At, B1); PG8_BAR; PG8_SCHED;
            PG8_LDB(B0, 1, 0); PG8_LDB(B1, 1, 1); PG8_SCHED; PG8_LDA(At, 1, 0); PG8_STAGE(PG8_SA(0, 1), a2 + hstep, voffA);
            PG8_WAIT_V(8); PG8_WAIT_L(0); PG8_BAR; PG8_MMA(0, 0, At, B0); PG8_MMA(0, 1, At, B1); PG8_BAR; PG8_SCHED;
            PG8_LDA(At, 1, 1); PG8_STAGE(PG8_SB(1, 0), b3, voffB); PG8_STAGE(PG8_SB(1, 1), b3 + hstep, voffB); PG8_STAGE(PG8_SA(1, 0), a3, voffA);
            PG8_WAIT_V(8); PG8_WAIT_L(0); PG8_BAR; PG8_MMA(1, 0, At, B0); PG8_MMA(1, 1, At, B1); PG8_BAR; PG8_SCHED;
            } else {
            PG8_LDB(B0, 0, 0); PG8_SCHED; PG8_LDA(At, 0, 0); PG8_STAGE(PG8_SA(1, 1), a1 + hstep, voffA);
            PG8_WAIT_L(8); PG8_BAR; PG8_WAIT_L(0); PG8_MMA(0, 0, At, B0); PG8_BAR; PG8_SCHED;
            PG8_LDB(B1, 0, 1); PG8_STAGE(PG8_SB(0, 0), b2, voffB);
            PG8_BAR; PG8_WAIT_L(0); PG8_MMA(0, 1, At, B1); PG8_BAR;
            PG8_LDA(At, 0, 1); PG8_STAGE(PG8_SA(0, 0), a2, voffA);
            PG8_BAR; PG8_WAIT_L(0); PG8_MMA(1, 0, At, B0); PG8_BAR; PG8_SCHED;
            PG8_STAGE(PG8_SB(0, 1), b2 + hstep, voffB);
            PG8_WAIT_V(6); PG8_BAR; PG8_MMA(1, 1, At, B1); PG8_BAR;
            PG8_LDB(B0, 1, 0); PG8_SCHED; PG8_LDA(At, 1, 0); PG8_STAGE(PG8_SA(0, 1), a2 + hstep, voffA);
            PG8_WAIT_L(8); PG8_BAR; PG8_WAIT_L(0); PG8_MMA(0, 0, At, B0); PG8_BAR; PG8_SCHED;
            PG8_LDB(B1, 1, 1); PG8_STAGE(PG8_SB(1, 0), b3, voffB);
            PG8_BAR; PG8_WAIT_L(0); PG8_MMA(0, 1, At, B1); PG8_BAR;
            PG8_LDA(At, 1, 1); PG8_STAGE(PG8_SA(1, 0), a3, voffA);
            PG8_BAR; PG8_WAIT_L(0); PG8_MMA(1, 0, At, B0); PG8_BAR; PG8_SCHED;
            PG8_STAGE(PG8_SB(1, 1), b3 + hstep, voffB);
            PG8_WAIT_V(6); PG8_BAR; PG8_MMA(1, 1, At, B1); PG8_BAR;
            }
        }
        if constexpr (ALIGN_EPI) { if (wr == 0) PG8_BAR; }
        if constexpr (!Epi::AFTER_DRAIN) { E(acc, cur, wr, wc, fr, fq); S.done(cur); }
        if (!has_next) break;
#pragma unroll
        for (int a = 0; a < 2; ++a)
#pragma unroll
            for (int b = 0; b < 2; ++b)
#pragma unroll
                for (int m = 0; m < 4; ++m)
#pragma unroll
                    for (int n = 0; n < 2; ++n) acc[a][b][m][n] = (f32x4){0.f, 0.f, 0.f, 0.f};
        cur = nxt; cA = nA; cB = nB; ++ui;
        if constexpr (ALIGN_EPI) { if (wr == 1) PG8_BAR; }
    }
    PG8_WAIT_V(0);
    if constexpr (!ALIGN_EPI) { if (wr == 0) PG8_BAR; }
    PG8_BAR;
    if constexpr (Epi::AFTER_DRAIN) { E.fused(acc, cur, wr, wc, fr, fq, lds, wid, lane); S.done(cur); }
#undef PG8_SA
#undef PG8_SB
#undef PG8_STAGE
#undef PG8_LDA
#undef PG8_LDB
#undef PG8_MMA
#undef PG8_WAIT_V
#undef PG8_WAIT_L
#undef PG8_BAR
#undef PG8_SCHED
}
}

#ifndef PG8_SP2
#define PG8_SP2 true
#endif
#ifndef PG8_ALIGN
#define PG8_ALIGN true
#endif
#define GAS __attribute__((address_space(1)))
#define LAS __attribute__((address_space(3)))
typedef unsigned short bf16;
typedef unsigned v4u __attribute__((ext_vector_type(4)));
typedef float f32x4 __attribute__((ext_vector_type(4)));
typedef short bf16x8 __attribute__((ext_vector_type(8)));
typedef GAS unsigned gu32;
typedef GAS unsigned long long gu64;
#define RLX_AGENT __ATOMIC_RELAXED, __HIP_MEMORY_SCOPE_AGENT
#define LDS_WAIT() asm volatile("s_waitcnt lgkmcnt(0)" ::: "memory")
#define VM_WAIT() asm volatile("s_waitcnt vmcnt(0)" ::: "memory")
__device__ __forceinline__ unsigned long long rt() { return __builtin_amdgcn_s_memrealtime(); }
__device__ __forceinline__ unsigned f2bf(float f) { unsigned u = __builtin_bit_cast(unsigned, f); return (u + 0x7fffu + ((u >> 16) & 1u)) >> 16; }
__device__ __forceinline__ unsigned pk2(float lo, float hi) { typedef float f2_ __attribute__((ext_vector_type(2))); typedef __bf16 b2_ __attribute__((ext_vector_type(2))); f2_ v = {lo, hi}; b2_ b = __builtin_convertvector(v, b2_); return __builtin_bit_cast(unsigned, b); }

#define XB_TMO      128
#define XB_XCNT(j)  (256  + 64 * (j))
#define XB_XSUB(j)  (1280 + 64 * (j))
#define XB_XGEN(j)  (2304 + 64 * (j))
#define XB_TOP      3328
#define XB_TOPGEN   3392
#define XCD_BAR_WORDS 3456
#define XB_SPIN_CAP (1u << 18)

__device__ __forceinline__ unsigned xb_ld(unsigned* p)              { return __hip_atomic_load(p, __ATOMIC_RELAXED, __HIP_MEMORY_SCOPE_AGENT); }
__device__ __forceinline__ unsigned xb_add(unsigned* p, unsigned v) { return __hip_atomic_fetch_add(p, v, __ATOMIC_RELAXED, __HIP_MEMORY_SCOPE_AGENT); }
__device__ __forceinline__ unsigned xb_xcc_id() { return (unsigned)__builtin_amdgcn_s_getreg((3 << 11) | 20) & 0xFu; }
#define XB_SPIN(cond, bar) do { unsigned _sp = 0; while (cond) { __builtin_amdgcn_s_sleep(1); \
    if ((++_sp & 255u) == 0u) { if (xb_ld(&(bar)[XB_TMO])) break; if (_sp > XB_SPIN_CAP) { atomicAdd(&(bar)[XB_TMO], 1u); break; } } } } while (0)

struct XcdBarrier {
    unsigned* bar; unsigned x;
    volatile LAS unsigned* st;
};

__device__ __forceinline__ XcdBarrier xcd_barrier_post(unsigned* bar, volatile LAS unsigned* st) {
    XcdBarrier b; b.bar = bar; b.x = xb_xcc_id(); b.st = st;
    if (threadIdx.x == 0) (void)xb_add(&bar[XB_XCNT(b.x)], 1u);
    return b;
}
__device__ __forceinline__ void xcd_barrier_complete(unsigned* bar, unsigned x, unsigned& nloc, unsigned& nx) {
    const unsigned G = gridDim.x * gridDim.y * gridDim.z;
    unsigned sum, cnt, mine, sp = 0u;
    for (;;) {
        sum = 0u; cnt = 0u; mine = 0u;
#pragma unroll
        for (unsigned j = 0; j < 16; ++j) { const unsigned c = xb_ld(&bar[XB_XCNT(j)]); sum += c; cnt += (c > 0u) ? 1u : 0u; mine = (j == x) ? c : mine; }
        if (sum == G) break;
        __builtin_amdgcn_s_sleep(1);
        if ((++sp & 255u) == 0u) { if (xb_ld(&bar[XB_TMO])) break; if (sp > XB_SPIN_CAP) { atomicAdd(&bar[XB_TMO], 1u); break; } }
    }
    nloc = mine > 0u ? mine : 1u; nx = cnt > 0u ? cnt : 1u;
}

__device__ __forceinline__ void xcd_barrier(const XcdBarrier& b) {
    asm volatile("s_waitcnt vmcnt(0)" ::: "memory");
    __syncthreads();
    if (threadIdx.x == 0) {
        unsigned* bar = b.bar;
        __builtin_amdgcn_s_waitcnt(0);
        unsigned nloc = b.st[0], nx = b.st[1];
        if (nloc == 0u) { xcd_barrier_complete(bar, b.x, nloc, nx); b.st[0] = nloc; b.st[1] = nx; }
        const unsigned old = xb_add(&bar[XB_XSUB(b.x)], 1u);
        const unsigned gen = old / nloc;
        if (old + 1u == (gen + 1u) * nloc) {
            __builtin_amdgcn_fence(__ATOMIC_RELEASE, "agent");
            asm volatile("s_waitcnt vmcnt(0)" ::: "memory");
            const unsigned og = xb_add(&bar[XB_TOP], 1u);
            const unsigned tg = og / nx;
            if (og + 1u == (tg + 1u) * nx) xb_add(&bar[XB_TOPGEN], 1u);
            else XB_SPIN(xb_ld(&bar[XB_TOPGEN]) == tg, bar);
            __builtin_amdgcn_fence(__ATOMIC_ACQUIRE, "agent");
            xb_add(&bar[XB_XGEN(b.x)], 1u);
            asm volatile("s_waitcnt vmcnt(0)" ::: "memory");
        } else {
            XB_SPIN(xb_ld(&bar[XB_XGEN(b.x)]) == gen, bar);
            __builtin_amdgcn_fence(__ATOMIC_ACQUIRE, "agent");
            asm volatile("s_waitcnt vmcnt(0)" ::: "memory");
        }
    }
    __syncthreads();
}


constexpr int NWAVES = 8;
constexpr int DM = 1024, SEQ = 4096, NBP = 4, NBS = 32, TS = 8;
constexpr int MP = NBP * SEQ, MS = NBS * TS, MT = MP + MS;
constexpr int NH = 8, HD = 64, DSSM = 512, NST = 128, IN_LD = 3080, NIN = 3072;
constexpr int DFF = 2816, DFF2 = 5632, DPLE = 256, WBUF = 2048;
constexpr float EPS = 1e-6f, LOG2E = 1.4426950408889634f, C2 = 0.125f * 1.4426950408889634f;
constexpr int PC_K = 512, PC_V = 1024, PC_Z = 1536, PC_X = 2048;
constexpr size_t O_Y = 0, O_YS = 16777216, O_KP = 17039360, O_VP = 21233664, O_KS = 25427968, O_VS = 25559040, O_SP = 25690112, O_SS = 25952256,
                 O_CP = 28049408, O_CS = 28061696, O_FP = 28160000, O_FS = 28205056, O_END = 28565504;
constexpr size_t MiB = 1u << 20;
constexpr size_t WS_CTL = 0, CTL_ZERO_BYTES = 1 * MiB;
constexpr size_t WS_RS1 = 256 * 1024, WS_RSE = 384 * 1024, WS_RS3 = 512 * 1024;
constexpr size_t WS_WIN = 2 * MiB, WS_WOUT = 8 * MiB, WS_WUP = 10 * MiB, WS_WDOWN = 21 * MiB, WS_WPLE = 27 * MiB, WS_WGATE = 28 * MiB;
constexpr size_t WS_DT = 30 * MiB, WS_PB = 31 * MiB, WS_XN = 40 * MiB, WS_MIX = 73 * MiB, WS_H1 = 106 * MiB, WS_E = 171 * MiB;
constexpr size_t WS_PROJ = 236 * MiB, WS_OBR = 334 * MiB, WS_LSE = 382 * MiB, WS_XBS = 384 * MiB, WS_XC = 385 * MiB, WS_CC = 402 * MiB, WS_CS = 410 * MiB, WS_PREV = 442 * MiB,
                 WS_ACUM = 458 * MiB, WS_ACL = 458 * MiB + 768 * 1024, WS_YS = 459 * MiB;
constexpr size_t WS_U = 236 * MiB, WS_ACT = 415 * MiB, WS_END = 505 * MiB;
static_assert(WS_PROJ + (size_t)MT * NIN * 2 <= WS_OBR && WS_OBR + (size_t)3 * MP * 512 * 2 <= WS_LSE && WS_LSE + (size_t)3 * MP * 8 * 4 <= WS_XBS, "ws map A");
static_assert(WS_XBS + (size_t)MS * 1024 * 4 <= WS_XC && WS_XC + (size_t)MT * 512 * 2 <= WS_CC && WS_CC + (size_t)MP * 256 * 2 <= WS_CS && WS_CS + (size_t)MP / 128 * 8 * 64 * 128 * 4 <= WS_PREV && WS_PREV + (size_t)MP / 128 * 8 * 64 * 128 * 2 <= WS_ACUM && WS_ACUM + (size_t)MP * 8 * 4 <= WS_ACL && WS_ACL + 4096 <= WS_YS && WS_YS + (size_t)MT * 512 * 4 <= WS_END, "ws map B");
static_assert(WS_U + (size_t)MT * DFF2 * 2 <= WS_ACT && WS_ACT + (size_t)MT * DFF * 2 <= WS_END, "ws map C");
static_assert(WS_XN + (size_t)MT * DM * 2 <= WS_MIX && WS_MIX + (size_t)MT * DM * 2 <= WS_H1 && WS_H1 + (size_t)MT * DM * 4 <= WS_E && WS_E + (size_t)MT * DM * 4 <= WS_PROJ, "ws map D");
static_assert(WS_PB + (size_t)MT * DPLE * 2 <= WS_XN && WS_DT + (size_t)MT * 8 * 4 <= WS_PB, "ws map E");
constexpr int CW_TMO = 0, CW_BAR = 4096;
constexpr int RING_BYTES = 131072, LDSCTL_OFF = RING_BYTES, MISC_OFF = LDSCTL_OFF + 320, LDS_BYTES = 147456;

typedef float f32x16 __attribute__((ext_vector_type(16)));
typedef short v4i16_t __attribute__((ext_vector_type(4)));
typedef unsigned u32x2 __attribute__((ext_vector_type(2)));

__device__ const unsigned char BUCKET_TAB[3][132] = {
 {0,1,2,3,4,5,6,7,8,9,10,11,12,13,14,15,16,16,16,16,16,16,17,17,17,17,17,17,17,17,18,18,18,18,18,18,18,18,18,18,19,19,19,19,19,19,19,19,19,19,19,19,19,19,20,20,20,20,20,20,20,20,20,20,20,20,20,20,20,20,20,20,20,21,21,21,21,21,21,21,21,21,21,21,21,21,21,21,21,21,21,21,21,21,21,21,21,21,21,22,22,22,22,22,22,22,22,22,22,22,22,22,22,22,22,22,22,22,22,22,22,22,22,22,22,22,22,22,22,0,0,0},
 {0,4,8,12,16,16,17,17,18,18,19,19,19,19,20,20,20,20,20,21,21,21,21,21,21,22,22,22,22,22,22,22,22,22,23,23,23,23,23,23,23,23,23,23,23,23,24,24,24,24,24,24,24,24,24,24,24,24,24,24,24,24,25,25,25,25,25,25,25,25,25,25,25,25,25,25,25,25,25,25,25,25,25,26,26,26,26,26,26,26,26,26,26,26,26,26,26,26,26,26,26,26,26,26,26,26,26,26,26,26,26,26,26,27,27,27,27,27,27,27,27,27,27,27,27,27,27,27,27,0,0,0},
 {0,16,18,19,20,21,21,22,22,23,23,23,24,24,24,24,25,25,25,25,25,26,26,26,26,26,26,26,26,27,27,27,27,27,27,27,27,27,27,28,28,28,28,28,28,28,28,28,28,28,28,28,29,29,29,29,29,29,29,29,29,29,29,29,29,29,29,29,29,29,30,30,30,30,30,30,30,30,30,30,30,30,30,30,30,30,30,30,30,30,30,30,30,30,30,31,31,31,31,31,31,31,31,31,31,31,31,31,31,31,31,31,31,31,31,31,31,31,31,31,31,31,31,31,31,31,31,31,31,0,0,0}};

__device__ __forceinline__ float row16_sum(float v) {
    v += __builtin_bit_cast(float, __builtin_amdgcn_update_dpp(0, __builtin_bit_cast(int, v), 0xB1, 0xf, 0xf, true));
    v += __builtin_bit_cast(float, __builtin_amdgcn_update_dpp(0, __builtin_bit_cast(int, v), 0x4E, 0xf, 0xf, true));
    v += __builtin_bit_cast(float, __builtin_amdgcn_update_dpp(0, __builtin_bit_cast(int, v), 0x141, 0xf, 0xf, true));
    v += __builtin_bit_cast(float, __builtin_amdgcn_update_dpp(0, __builtin_bit_cast(int, v), 0x140, 0xf, 0xf, true));
    return v;
}
__device__ __forceinline__ float row16_max(float v) {
    v = fmaxf(v, __builtin_bit_cast(float, __builtin_amdgcn_update_dpp(__builtin_bit_cast(int, v), __builtin_bit_cast(int, v), 0xB1, 0xf, 0xf, false)));
    v = fmaxf(v, __builtin_bit_cast(float, __builtin_amdgcn_update_dpp(__builtin_bit_cast(int, v), __builtin_bit_cast(int, v), 0x4E, 0xf, 0xf, false)));
    v = fmaxf(v, __builtin_bit_cast(float, __builtin_amdgcn_update_dpp(__builtin_bit_cast(int, v), __builtin_bit_cast(int, v), 0x141, 0xf, 0xf, false)));
    v = fmaxf(v, __builtin_bit_cast(float, __builtin_amdgcn_update_dpp(__builtin_bit_cast(int, v), __builtin_bit_cast(int, v), 0x140, 0xf, 0xf, false)));
    return v;
}
__device__ __forceinline__ float wave_sum(float v) {
    v = row16_sum(v);
    auto s = __builtin_amdgcn_permlane16_swap(__float_as_uint(v), __float_as_uint(v), false, false);
    v = __uint_as_float(s[0]) + __uint_as_float(s[1]);
    auto t = __builtin_amdgcn_permlane32_swap(__float_as_uint(v), __float_as_uint(v), false, false);
    return __uint_as_float(t[0]) + __uint_as_float(t[1]);
}
__device__ __forceinline__ float wave_max(float v) {
    v = row16_max(v);
    auto s = __builtin_amdgcn_permlane16_swap(__float_as_uint(v), __float_as_uint(v), false, false);
    v = fmaxf(__uint_as_float(s[0]), __uint_as_float(s[1]));
    auto t = __builtin_amdgcn_permlane32_swap(__float_as_uint(v), __float_as_uint(v), false, false);
    return fmaxf(__uint_as_float(t[0]), __uint_as_float(t[1]));
}
__device__ __forceinline__ float bf2f(unsigned short b) { return __uint_as_float((unsigned)b << 16); }
__device__ __forceinline__ float bflo(unsigned w) { return __uint_as_float(w << 16); }
__device__ __forceinline__ float bfhi(unsigned w) { return __uint_as_float(w & 0xffff0000u); }
__device__ __forceinline__ float siluf(float x) { return x * __builtin_amdgcn_rcpf(1.f + __builtin_amdgcn_exp2f(-LOG2E * x)); }
__device__ __forceinline__ float softplusf(float x) { return fmaxf(x, 0.f) + log1pf(__expf(-fabsf(x))); }
__device__ __forceinline__ int crow(int r, int hi) { return (r & 3) + 8 * (r >> 2) + 4 * hi; }

__device__ __forceinline__ v4i16_t vtr(const LAS unsigned char* p) { return __builtin_amdgcn_ds_read_tr16_b64_v4i16((LAS v4i16_t*)p); }
__device__ __forceinline__ unsigned cvtpk_s(float lo, float hi) { typedef float f2 __attribute__((ext_vector_type(2))); typedef __bf16 b2 __attribute__((ext_vector_type(2))); f2 v = {lo, hi}; b2 b = __builtin_convertvector(v, b2); return __builtin_bit_cast(unsigned, b); }
struct Args { const float* in[28]; float* out; unsigned char* ws; int ph_lo, ph_hi, li, pad; };

struct EpiIn {
    static constexpr bool PERM = true, AFTER_DRAIN = false;
    pg8::bf16_t* PROJ; float* out;
    __device__ __forceinline__ void operator()(const pg8::f32x4 (&acc)[2][2][4][2], const pg8::Unit& u, int wr, int wc, int fr, int fq) const {
        const int pn = u.pn; const float sc = (pn < 2) ? C2 : 1.f;
        const int colb = pn * 256 + wc * 32 + 8 * fq;
#pragma unroll
        for (int ai = 0; ai < 2; ++ai)
#pragma unroll
            for (int m = 0; m < 4; ++m) {
                const int row = u.pm * 256 + ai * 128 + wr * 64 + m * 16 + fr;
#pragma unroll
                for (int bj = 0; bj < 2; ++bj) {
                    const int col = colb + bj * 128; const pg8::f32x4 v0 = acc[ai][bj][m][0], v1 = acc[ai][bj][m][1];
                    pg8::u32x4 w; w.x = pg8::cvt_pk_bf16(v0[0] * sc, v0[1] * sc); w.y = pg8::cvt_pk_bf16(v0[2] * sc, v0[3] * sc); w.z = pg8::cvt_pk_bf16(v1[0] * sc, v1[1] * sc); w.w = pg8::cvt_pk_bf16(v1[2] * sc, v1[3] * sc);
                    *(pg8::u32x4*)(PROJ + (unsigned)(row * NIN + col)) = w;
                    float* dst = nullptr;
                    if (pn >= 2 && pn < 6) {
                        const bool isk = pn < 4; const int c = col - (isk ? PC_K : PC_V);
                        if (row < MP) { const int t = row & (SEQ - 1), b = row >> 12; if (t >= SEQ - WBUF) dst = out + (isk ? O_KP : O_VP) + ((size_t)(b * WBUF + t - (SEQ - WBUF))) * 512 + c; }
                        else dst = out + (isk ? O_KS : O_VS) + (size_t)(row - MP) * 512 + c;
                    } else if (pn >= 8) {
                        const int c = col - PC_X;
                        if (row < MP) { const int t = row & (SEQ - 1), b = row >> 12; if (t >= SEQ - 3) dst = out + O_CP + (size_t)(b * 3 + t - (SEQ - 3)) * 1024 + c; }
                        else { const int r = row - MP, t = r & 7, b = r >> 3; if (t >= TS - 3) dst = out + O_CS + (size_t)(b * 3 + t - (TS - 3)) * 1024 + c; }
                    }
                    if (dst) { *(pg8::f32x4*)dst = v0; *(pg8::f32x4*)(dst + 4) = v1; }
                }
            }
    }
};
struct EpiOut {
    static constexpr bool PERM = false, AFTER_DRAIN = false;
    const float* xp; pg8::bf16_t* H1b; float* RS;
    __device__ __forceinline__ void operator()(const pg8::f32x4 (&acc)[2][2][4][2], const pg8::Unit& u, int wr, int wc, int fr, int fq) const {
        const int col0 = u.pn * 256 + wc * 32 + 4 * fq;
#pragma unroll
        for (int ai = 0; ai < 2; ++ai)
#pragma unroll
            for (int m = 0; m < 4; ++m) {
                const int row = u.pm * 256 + ai * 128 + wr * 64 + m * 16 + fr;
                const float* xrow = xp + (unsigned)(row * DM);
                float ss = 0.f;
#pragma unroll
                for (int bj = 0; bj < 2; ++bj)
#pragma unroll
                    for (int n = 0; n < 2; ++n) {
                        const int c = col0 + bj * 128 + n * 16;
                        const pg8::f32x4 h = *(const pg8::f32x4*)(xrow + c) + acc[ai][bj][m][n];
                        u32x2 w; w.x = pg8::cvt_pk_bf16(h[0], h[1]); w.y = pg8::cvt_pk_bf16(h[2], h[3]);
                        *(u32x2*)(H1b + (unsigned)(row * DM + c)) = w;
                        ss += (h[0] * h[0] + h[1] * h[1]) + (h[2] * h[2] + h[3] * h[3]);
                    }
                ss += __shfl_xor(ss, 16); ss += __shfl_xor(ss, 32);
                if (fq == 0) atomicAdd(RS + row, ss);
                asm volatile("" ::: "memory");
            }
    }
};
struct EpiUp {
    static constexpr bool PERM = true, AFTER_DRAIN = false;
    pg8::bf16_t* U; const float* RS; float* out;
    __device__ __forceinline__ void operator()(const pg8::f32x4 (&acc)[2][2][4][2], const pg8::Unit& u, int wr, int wc, int fr, int fq) const {
        const int colb = u.pn * 256 + wc * 32 + 8 * fq;
#pragma unroll
        for (int ai = 0; ai < 2; ++ai)
#pragma unroll
            for (int m = 0; m < 4; ++m) {
                const int row = u.pm * 256 + ai * 128 + wr * 64 + m * 16 + fr;
                const float rs = 1.0f / sqrtf(RS[row] * (1.f / DM) + EPS);
                float* dstb = nullptr;
                if (row < MP) { const int t = row & (SEQ - 1), b = row >> 12; if (t >= SEQ - 2) dstb = out + O_FP + (size_t)(b * 2 + t - (SEQ - 2)) * DFF2; }
                else { const int r = row - MP, t = r & 7, b = r >> 3; if (t >= TS - 2) dstb = out + O_FS + (size_t)(b * 2 + t - (TS - 2)) * DFF2; }
#pragma unroll
                for (int bj = 0; bj < 2; ++bj) {
                    const int col = colb + bj * 128; const pg8::f32x4 v0 = acc[ai][bj][m][0] * rs, v1 = acc[ai][bj][m][1] * rs;
                    pg8::u32x4 w; w.x = pg8::cvt_pk_bf16(v0[0], v0[1]); w.y = pg8::cvt_pk_bf16(v0[2], v0[3]); w.z = pg8::cvt_pk_bf16(v1[0], v1[1]); w.w = pg8::cvt_pk_bf16(v1[2], v1[3]);
                    *(pg8::u32x4*)(U + (unsigned)(row * DFF2 + col)) = w;
                    if (dstb) { *(pg8::f32x4*)(dstb + col) = v0; *(pg8::f32x4*)(dstb + col + 4) = v1; }
                }
            }
    }
};
struct EpiDown {
    static constexpr bool PERM = false, AFTER_DRAIN = false;
    pg8::bf16_t* Hb;
    __device__ __forceinline__ void operator()(const pg8::f32x4 (&acc)[2][2][4][2], const pg8::Unit& u, int wr, int wc, int fr, int fq) const {
        const int col0 = u.pn * 256 + wc * 32 + 4 * fq;
#pragma unroll
        for (int ai = 0; ai < 2; ++ai)
#pragma unroll
            for (int m = 0; m < 4; ++m) {
                const int row = u.pm * 256 + ai * 128 + wr * 64 + m * 16 + fr;
#pragma unroll
                for (int bj = 0; bj < 2; ++bj)
#pragma unroll
                    for (int n = 0; n < 2; ++n) {
                        const int c = col0 + bj * 128 + n * 16; u32x2* hp = (u32x2*)(Hb + (unsigned)(row * DM + c));
                        const u32x2 o = *hp; const pg8::f32x4 a = acc[ai][bj][m][n];
                        u32x2 w; w.x = pg8::cvt_pk_bf16(bflo(o.x) + a[0], bfhi(o.x) + a[1]); w.y = pg8::cvt_pk_bf16(bflo(o.y) + a[2], bfhi(o.y) + a[3]);
                        *hp = w;
                    }
                asm volatile("" ::: "memory");
            }
    }
};
struct EpiPle {
    static constexpr bool PERM = false, AFTER_DRAIN = false;
    pg8::bf16_t* E; float* RS;
    __device__ __forceinline__ void operator()(const pg8::f32x4 (&acc)[2][2][4][2], const pg8::Unit& u, int wr, int wc, int fr, int fq) const {
        const int col0 = u.pn * 256 + wc * 32 + 4 * fq;
#pragma unroll
        for (int ai = 0; ai < 2; ++ai)
#pragma unroll
            for (int m = 0; m < 4; ++m) {
                const int row = u.pm * 256 + ai * 128 + wr * 64 + m * 16 + fr; float ss = 0.f;
#pragma unroll
                for (int bj = 0; bj < 2; ++bj)
#pragma unroll
                    for (int n = 0; n < 2; ++n) {
                        const int c = col0 + bj * 128 + n * 16; const pg8::f32x4 h = acc[ai][bj][m][n];
                        u32x2 w; w.x = pg8::cvt_pk_bf16(h[0], h[1]); w.y = pg8::cvt_pk_bf16(h[2], h[3]);
                        *(u32x2*)(E + (unsigned)(row * DM + c)) = w;
                        ss += (h[0] * h[0] + h[1] * h[1]) + (h[2] * h[2] + h[3] * h[3]);
                    }
                ss += __shfl_xor(ss, 16); ss += __shfl_xor(ss, 32);
                if (fq == 0) atomicAdd(RS + row, ss);
            }
    }
};
struct EpiGate {
    static constexpr bool PERM = false, AFTER_DRAIN = false;
    const pg8::bf16_t* H2b; const pg8::bf16_t* E; const float* RSE; const float* gple; pg8::bf16_t* H3b; float* RS3;
    __device__ __forceinline__ void operator()(const pg8::f32x4 (&acc)[2][2][4][2], const pg8::Unit& u, int wr, int wc, int fr, int fq) const {
        const int col0 = u.pn * 256 + wc * 32 + 4 * fq;
        pg8::f32x4 gp[2][2];
#pragma unroll
        for (int bj = 0; bj < 2; ++bj)
#pragma unroll
            for (int n = 0; n < 2; ++n) gp[bj][n] = *(const pg8::f32x4*)(gple + col0 + bj * 128 + n * 16);
#pragma unroll
        for (int ai = 0; ai < 2; ++ai)
#pragma unroll
            for (int m = 0; m < 4; ++m) {
                const int row = u.pm * 256 + ai * 128 + wr * 64 + m * 16 + fr;
                const float rse = 1.0f / sqrtf(RSE[row] * (1.f / DM) + EPS);
                float ss = 0.f;
#pragma unroll
                for (int bj = 0; bj < 2; ++bj)
#pragma unroll
                    for (int n = 0; n < 2; ++n) {
                        const int c = col0 + bj * 128 + n * 16; const unsigned o = (unsigned)(row * DM + c);
                        const pg8::f32x4 a = acc[ai][bj][m][n]; const u32x2 eb = *(const u32x2*)(E + o), hb = *(const u32x2*)(H2b + o);
                        const float e4[4] = {bflo(eb.x), bfhi(eb.x), bflo(eb.y), bfhi(eb.y)}, h4[4] = {bflo(hb.x), bfhi(hb.x), bflo(hb.y), bfhi(hb.y)};
                        float h[4];
#pragma unroll
                        for (int k = 0; k < 4; ++k) { const float g = 1.f / (1.f + __expf(-a[k])); h[k] = h4[k] + g * (e4[k] * rse * gp[bj][n][k]); }
                        u32x2 w; w.x = pg8::cvt_pk_bf16(h[0], h[1]); w.y = pg8::cvt_pk_bf16(h[2], h[3]);
                        *(u32x2*)(H3b + o) = w;
                        ss += (h[0] * h[0] + h[1] * h[1]) + (h[2] * h[2] + h[3] * h[3]);
                    }
                ss += __shfl_xor(ss, 16); ss += __shfl_xor(ss, 32);
                if (fq == 0) atomicAdd(RS3 + row, ss);
                asm volatile("" ::: "memory");
            }
    }
};

__device__ __forceinline__ void load8bf(const bf16* p, float (&o)[8]) {
    const v4u w = *(const v4u*)p;
    o[0] = bflo(w.x); o[1] = bfhi(w.x); o[2] = bflo(w.y); o[3] = bfhi(w.y); o[4] = bflo(w.z); o[5] = bfhi(w.z); o[6] = bflo(w.w); o[7] = bfhi(w.w);
}
__device__ __forceinline__ void load8f(const float* p, float (&o)[8]) {
    const f32x4 a = *(const f32x4*)p, b = *(const f32x4*)(p + 4);
    o[0] = a.x; o[1] = a.y; o[2] = a.z; o[3] = a.w; o[4] = b.x; o[5] = b.y; o[6] = b.z; o[7] = b.w;
}
__device__ __forceinline__ void p0_transpose_item(const float* W, int ldn, int K, int N, bf16* WT, const float* gk, LAS float* scr, int item, int lane) {
    const int nblk = N / 32, kb = item / nblk, nb = item % nblk, k0 = 64 * kb, n0 = 32 * nb;
    const float* src = W + (size_t)(k0 + (lane >> 5)) * ldn + n0 + (lane & 31);
    float wv[32];
#pragma unroll
    for (int i = 0; i < 32; ++i) wv[i] = src[(size_t)(2 * i) * ldn];
#pragma unroll
    for (int i = 0; i < 32; ++i) scr[(2 * i + (lane >> 5)) * 33 + (lane & 31)] = wv[i];
    const int c = lane & 7;
    float g8[8];
    if (gk) load8f(gk + k0 + 8 * c, g8); else {
#pragma unroll
        for (int j = 0; j < 8; ++j) g8[j] = 1.f; }
    LDS_WAIT(); asm volatile("" ::: "memory");
#pragma unroll
    for (int j = 0; j < 4; ++j) { const int n = (lane >> 3) + 8 * j; const LAS float* sp = scr + (8 * c) * 33 + n;
        v4u o; o.x = pk2(sp[0 * 33] * g8[0], sp[1 * 33] * g8[1]); o.y = pk2(sp[2 * 33] * g8[2], sp[3 * 33] * g8[3]); o.z = pk2(sp[4 * 33] * g8[4], sp[5 * 33] * g8[5]); o.w = pk2(sp[6 * 33] * g8[6], sp[7 * 33] * g8[7]);
        *(GAS v4u*)(WT + (size_t)(n0 + n) * K + k0 + 8 * c) = o; }
    LDS_WAIT(); asm volatile("" ::: "memory");
}
__device__ __forceinline__ void p0_prologue(const Args& a, LAS unsigned char* lds, int gw, int NGW, int wave, int lane, int part = 3) {
    unsigned char* ws = a.ws;
    LAS float* scr = (LAS float*)(lds + wave * 8704);
    constexpr int I_IN = (DM / 64) * (NIN / 32), I_OUT = (DM / 64) * (DM / 32), I_UP = (DM / 64) * (DFF2 / 32), I_DN = (DFF / 64) * (DM / 32), I_PLE = (DPLE / 64) * (DM / 32), I_G = I_OUT;
    constexpr int NITEMS = I_IN + I_OUT + I_UP + I_DN + I_PLE + I_G;
    if (part & 1) for (int it = gw; it < NITEMS; it += NGW) {
        int r = it;
        if (r < I_IN)  { p0_transpose_item(a.in[11], IN_LD, DM, NIN, (bf16*)(ws + WS_WIN), a.in[10], scr, r, lane); continue; } r -= I_IN;
        if (r < I_OUT) { p0_transpose_item(a.in[18], DM, DM, DM, (bf16*)(ws + WS_WOUT), nullptr, scr, r, lane); continue; } r -= I_OUT;
        if (r < I_UP)  { p0_transpose_item(a.in[20], DFF2, DM, DFF2, (bf16*)(ws + WS_WUP), a.in[19], scr, r, lane); continue; } r -= I_UP;
        if (r < I_DN)  { p0_transpose_item(a.in[23], DM, DFF, DM, (bf16*)(ws + WS_WDOWN), nullptr, scr, r, lane); continue; } r -= I_DN;
        if (r < I_PLE) { p0_transpose_item(a.in[24], DM, DPLE, DM, (bf16*)(ws + WS_WPLE), nullptr, scr, r, lane); continue; } r -= I_PLE;
        p0_transpose_item(a.in[26], DM, DM, DM, (bf16*)(ws + WS_WGATE), nullptr, scr, r, lane);
    }
    const float* gmix = a.in[10]; const float* win = a.in[11]; const float* dtb = a.in[14];
    bf16* XN = (bf16*)(ws + WS_XN); bf16* PB = (bf16*)(ws + WS_PB); float* DT = (float*)(ws + WS_DT);
    LAS unsigned char* dtw = lds + 81920;
    for (int k = threadIdx.x; k < DM; k += NWAVES * 64) {
        const float gk = gmix[k]; const f32x4 w0 = *(const f32x4*)(win + (size_t)k * IN_LD + NIN) * gk, w1 = *(const f32x4*)(win + (size_t)k * IN_LD + NIN + 4) * gk;
        LAS f32x4* d = (LAS f32x4*)(dtw + (k >> 2) * 144 + (k & 3) * 32); d[0] = w0; d[1] = w1;
    }
    LDS_WAIT(); __syncthreads();
    f32x4 vn[4];
    if (gw < MT) { const float* xrow = (gw < MP) ? a.in[0] + (size_t)gw * DM : a.in[1] + (size_t)(gw - MP) * DM;
#pragma unroll
        for (int j = 0; j < 4; ++j) vn[j] = ((const GAS f32x4*)xrow + lane)[64 * j]; }
    if (part & 2) for (int m = gw; m < MT; m += NGW) {
        f32x4 v[4]; float s = 0.f;
#pragma unroll
        for (int j = 0; j < 4; ++j) { v[j] = vn[j]; s += (v[j].x * v[j].x + v[j].y * v[j].y) + (v[j].z * v[j].z + v[j].w * v[j].w); }
        { const int mn = m + NGW; if (mn < MT) { const float* xrow = (mn < MP) ? a.in[0] + (size_t)mn * DM : a.in[1] + (size_t)(mn - MP) * DM;
#pragma unroll
            for (int j = 0; j < 4; ++j) vn[j] = ((const GAS f32x4*)xrow + lane)[64 * j]; } }
        const float rstd = 1.0f / sqrtf(wave_sum(s) * (1.f / DM) + EPS);
        GAS unsigned long long* o8 = (GAS unsigned long long*)(XN + (size_t)m * DM) + lane;
        float dacc[8];
#pragma unroll
        for (int h = 0; h < 8; ++h) dacc[h] = 0.f;
#pragma unroll
        for (int j = 0; j < 4; ++j) {
            v[j] = v[j] * rstd;
            o8[64 * j] = (unsigned long long)pk2(v[j].x, v[j].y) | ((unsigned long long)pk2(v[j].z, v[j].w) << 32);
#pragma unroll
            for (int e = 0; e < 4; ++e) {
                const float xv = v[j][e];
                const LAS f32x4* d = (const LAS f32x4*)(dtw + (64 * j + lane) * 144 + e * 32);
                const f32x4 w0 = d[0], w1 = d[1];
                dacc[0] += xv * w0.x; dacc[1] += xv * w0.y; dacc[2] += xv * w0.z; dacc[3] += xv * w0.w;
                dacc[4] += xv * w1.x; dacc[5] += xv * w1.y; dacc[6] += xv * w1.z; dacc[7] += xv * w1.w;
            }
        }
#pragma unroll
        for (int h = 0; h < 8; ++h) dacc[h] = softplusf(wave_sum(dacc[h]) + dtb[h]);
        if (lane == 0) { *(f32x4*)(DT + (size_t)m * 8) = (f32x4){dacc[0], dacc[1], dacc[2], dacc[3]}; *(f32x4*)(DT + (size_t)m * 8 + 4) = (f32x4){dacc[4], dacc[5], dacc[6], dacc[7]}; }
        const float* prow = (m < MP) ? a.in[2] + (size_t)m * DPLE : a.in[3] + (size_t)(m - MP) * DPLE;
        const f32x4 pv = *((const f32x4*)prow + lane);
        *((GAS unsigned long long*)(PB + (size_t)m * DPLE) + lane) = (unsigned long long)pk2(pv.x, pv.y) | ((unsigned long long)pk2(pv.z, pv.w) << 32);
    }
}

__device__ __forceinline__ void conv_sample_pass(const Args& a, int gtid, int NT) {
    const bf16* PROJ = (const bf16*)(a.ws + WS_PROJ); float* XB = (float*)(a.ws + WS_XBS); bf16* XC = (bf16*)(a.ws + WS_XC);
    const float* cw = a.in[12]; const float* cb = a.in[13]; const float* sconv = a.in[7];
    for (int it = gtid; it < NBS * 128; it += NT) {
        const int b = it >> 7, c = (it & 127) * 8, m0 = MP + b * 8;
        float w0[8], w1[8], w2[8], w3[8], bb[8], x3[8], x2[8], x1[8];
        load8f(cw + c, w0); load8f(cw + 1024 + c, w1); load8f(cw + 2048 + c, w2); load8f(cw + 3072 + c, w3); load8f(cb + c, bb);
        load8f(sconv + (size_t)(b * 3 + 0) * 1024 + c, x3); load8f(sconv + (size_t)(b * 3 + 1) * 1024 + c, x2); load8f(sconv + (size_t)(b * 3 + 2) * 1024 + c, x1);
#pragma unroll
        for (int r = 0; r < 8; ++r) {
            float cur[8], y[8]; load8bf(PROJ + (size_t)(m0 + r) * NIN + PC_X + c, cur);
#pragma unroll
            for (int k = 0; k < 8; ++k) { y[k] = siluf(bb[k] + w0[k] * x3[k] + w1[k] * x2[k] + w2[k] * x1[k] + w3[k] * cur[k]); x3[k] = x2[k]; x2[k] = x1[k]; x1[k] = cur[k]; }
            float* o = XB + (size_t)(b * 8 + r) * 1024 + c;
            *(f32x4*)o = (f32x4){y[0], y[1], y[2], y[3]}; *(f32x4*)(o + 4) = (f32x4){y[4], y[5], y[6], y[7]};
            if (c < 512) { v4u w; w.x = pk2(y[0], y[1]); w.y = pk2(y[2], y[3]); w.z = pk2(y[4], y[5]); w.w = pk2(y[6], y[7]); *(v4u*)(XC + (size_t)(m0 + r) * 512 + c) = w; }
        }
    }
}

#ifndef S1SUB
#define S1SUB 7
#endif
constexpr int S1_BR = 0, S1_CR = 32768, S1_BT = 65536, S1_XT = 98304, S1_XW = 114688, S1_AC = 133120;
__device__ __forceinline__ void ssd_s1_unit(const Args& a, LAS unsigned char* lds, int unit, int tid, int wave, int lane) {
    asm volatile("" : "+v"(tid), "+v"(lane));
    const int h = unit & 7, c = (unit >> 3) & 31, b = unit >> 8, g = h >> 2, m0 = b * SEQ + c * 128;
    const bf16* PROJ = (const bf16*)(a.ws + WS_PROJ); const float* DT = (const float*)(a.ws + WS_DT);
    LAS float* ac = (LAS float*)(lds + S1_AC); LAS float* dts = ac + 128;
    const int r32 = lane & 31, hh = lane >> 5;
    const int o = tid % 40, rc = tid / 40, s0 = rc * 11;
    const int xcol = (o < 8) ? h * 64 + 8 * o : (o < 24) ? 512 + g * 128 + 8 * (o - 8) : 768 + g * 128 + 8 * (o - 24);
    const bool cact = tid < 480;
    v4u raw[14];
    if (cact) {
#pragma unroll
        for (int i = 0; i < 14; ++i) { int sr = s0 - 3 + i; sr = sr > 127 ? 127 : sr; if (c == 0 && sr < 0) sr = 0; raw[i] = *(const v4u*)(PROJ + (size_t)(m0 + sr) * NIN + PC_X + xcol); }
    }
    if (wave == 0) {
        const float A = -__expf(a.in[15][h]);
        const float d0 = DT[(size_t)(m0 + 2 * lane) * 8 + h], d1 = DT[(size_t)(m0 + 2 * lane + 1) * 8 + h];
        const float a0 = d0 * A, a1 = d1 * A; float v = a0 + a1;
#pragma unroll
        for (int d = 1; d < 64; d <<= 1) { const float n = __shfl_up(v, d); if (lane >= d) v += n; }
        const float e0 = v - a1, e1 = v;
        ac[2 * lane] = e0; ac[2 * lane + 1] = e1; dts[2 * lane] = d0; dts[2 * lane + 1] = d1;
        float* ACUM = (float*)(a.ws + WS_ACUM); ACUM[(size_t)(m0 + 2 * lane) * 8 + h] = e0; ACUM[(size_t)(m0 + 2 * lane + 1) * 8 + h] = e1;
        if (lane == 63) ((float*)(a.ws + WS_ACL))[(b * 32 + c) * 8 + h] = e1;
    }
    __syncthreads();
    if ((S1SUB & 1) && cact) {
        const float* cw = a.in[12]; const float* cb = a.in[13];
        float w0[8], w1[8], w2[8], w3[8], bb[8], x3[8], x2[8], x1[8];
        load8f(cw + xcol, w0); load8f(cw + 1024 + xcol, w1); load8f(cw + 2048 + xcol, w2); load8f(cw + 3072 + xcol, w3); load8f(cb + xcol, bb);
        const bool z0 = (c == 0 && rc == 0);
        { const v4u r3 = raw[0], r2 = raw[1], r1 = raw[2];
          x3[0] = bflo(r3.x); x3[1] = bfhi(r3.x); x3[2] = bflo(r3.y); x3[3] = bfhi(r3.y); x3[4] = bflo(r3.z); x3[5] = bfhi(r3.z); x3[6] = bflo(r3.w); x3[7] = bfhi(r3.w);
          x2[0] = bflo(r2.x); x2[1] = bfhi(r2.x); x2[2] = bflo(r2.y); x2[3] = bfhi(r2.y); x2[4] = bflo(r2.z); x2[5] = bfhi(r2.z); x2[6] = bflo(r2.w); x2[7] = bfhi(r2.w);
          x1[0] = bflo(r1.x); x1[1] = bfhi(r1.x); x1[2] = bflo(r1.y); x1[3] = bfhi(r1.y); x1[4] = bflo(r1.z); x1[5] = bfhi(r1.z); x1[6] = bflo(r1.w); x1[7] = bfhi(r1.w);
          if (z0) {
#pragma unroll
              for (int k = 0; k < 8; ++k) { x3[k] = 0.f; x2[k] = 0.f; x1[k] = 0.f; } } }
        const float aL = ac[127];
        bf16* XC = (bf16*)(a.ws + WS_XC); bf16* CC = (bf16*)(a.ws + WS_CC);
#pragma unroll
        for (int r = 0; r < 11; ++r) {
            const int sr = s0 + r;
            if (sr < 128) {
                const v4u rw = raw[3 + r]; float cur[8], y[8];
                cur[0] = bflo(rw.x); cur[1] = bfhi(rw.x); cur[2] = bflo(rw.y); cur[3] = bfhi(rw.y); cur[4] = bflo(rw.z); cur[5] = bfhi(rw.z); cur[6] = bflo(rw.w); cur[7] = bfhi(rw.w);
#pragma unroll
                for (int k = 0; k < 8; ++k) { y[k] = siluf(bb[k] + w0[k] * x3[k] + w1[k] * x2[k] + w2[k] * x1[k] + w3[k] * cur[k]); x3[k] = x2[k]; x2[k] = x1[k]; x1[k] = cur[k]; }
                v4u w; w.x = pk2(y[0], y[1]); w.y = pk2(y[2], y[3]); w.z = pk2(y[4], y[5]); w.w = pk2(y[6], y[7]);
                if (o < 8) {
                    const int off = (o >> 2) * 8192 + (sr >> 4) * 1024 + (sr & 15) * 64 + (o & 3) * 16;
                    *(LAS v4u*)(lds + S1_XT + off) = w;
                    const float de = __expf(aL - ac[sr]) * dts[sr];
                    v4u ww; ww.x = pk2(y[0] * de, y[1] * de); ww.y = pk2(y[2] * de, y[3] * de); ww.z = pk2(y[4] * de, y[5] * de); ww.w = pk2(y[6] * de, y[7] * de);
                    *(LAS v4u*)(lds + S1_XW + off) = ww;
                    *(v4u*)(XC + (size_t)(m0 + sr) * 512 + h * 64 + 8 * o) = w;
                } else if (o < 24) {
                    const int ch = o - 8;
                    *(LAS v4u*)(lds + S1_BR + sr * 256 + ((ch ^ (sr & 15)) << 4)) = w;
                    *(LAS v4u*)(lds + S1_BT + (ch >> 2) * 8192 + (sr >> 4) * 1024 + (sr & 15) * 64 + (ch & 3) * 16) = w;
                } else {
                    const int ch = o - 24;
                    *(LAS v4u*)(lds + S1_CR + sr * 256 + ((ch ^ (sr & 15)) << 4)) = w;
                    if ((h & 3) == 0) *(v4u*)(CC + (size_t)(m0 + sr) * 256 + g * 128 + 8 * ch) = w;
                }
            }
        }
    }
    __syncthreads();
    const int laneoff = ((lane >> 4) & 1) * 32 + (lane & 3) * 8 + (4 * hh + ((lane & 15) >> 2)) * 64;
    if (S1SUB & 2) {
        const int tb = wave >> 1, ph = wave & 1, tq = 32 * tb + r32;
        bf16x8 cq[8];
#pragma unroll
        for (int k = 0; k < 8; ++k) cq[k] = *(const LAS bf16x8*)(lds + S1_CR + tq * 256 + (((2 * k + hh) ^ (tq & 15)) << 4));
        const float act = ac[tq] * LOG2E;
        f32x16 o;
#pragma unroll
        for (int i = 0; i < 16; ++i) o[i] = 0.f;
#pragma unroll 1
        for (int sb = 0; sb <= tb; ++sb) {
            {
                f32x16 S;
#pragma unroll
                for (int i = 0; i < 16; ++i) S[i] = 0.f;
                const int sq = 32 * sb + r32;
#pragma unroll
                for (int k = 0; k < 8; ++k) { const bf16x8 bf = *(const LAS bf16x8*)(lds + S1_BR + sq * 256 + (((2 * k + hh) ^ (sq & 15)) << 4)); S = __builtin_amdgcn_mfma_f32_32x32x16_bf16(bf, cq[k], S, 0, 0, 0); }
#pragma unroll
                for (int i = 0; i < 16; ++i) { const int si = 32 * sb + crow(i, hh); const float e = __builtin_amdgcn_exp2f(act - ac[si] * LOG2E) * dts[si]; S[i] = (si <= tq) ? S[i] * e : 0.f; }
#pragma unroll
                for (int ks = 0; ks < 2; ++ks) {
                    v4u pw; pw.x = cvtpk_s(S[8 * ks + 0], S[8 * ks + 1]); pw.y = cvtpk_s(S[8 * ks + 2], S[8 * ks + 3]); pw.z = cvtpk_s(S[8 * ks + 4], S[8 * ks + 5]); pw.w = cvtpk_s(S[8 * ks + 6], S[8 * ks + 7]);
                    const bf16x8 pa = __builtin_bit_cast(bf16x8, pw);
                    const LAS unsigned char* xp = lds + S1_XT + ph * 8192 + (2 * sb + ks) * 1024 + laneoff;
                    const v4i16_t lo = vtr(xp), hi2 = vtr(xp + 512);
                    const bf16x8 xb = (bf16x8){lo[0], lo[1], lo[2], lo[3], hi2[0], hi2[1], hi2[2], hi2[3]};
                    o = __builtin_amdgcn_mfma_f32_32x32x16_bf16(pa, xb, o, 0, 0, 0);
                }
            }
        }
        float* YS = (float*)(a.ws + WS_YS);
#pragma unroll
        for (int i = 0; i < 16; ++i) YS[(size_t)(m0 + 32 * tb + crow(i, hh)) * 512 + h * 64 + 32 * ph + r32] = o[i];
    }
    if (S1SUB & 4) {
        const int pb = wave & 1, nb = wave >> 1;
        f32x16 st;
#pragma unroll
        for (int i = 0; i < 16; ++i) st[i] = 0.f;
#pragma unroll
        for (int k = 0; k < 8; ++k) {
            const LAS unsigned char* ap = lds + S1_XW + pb * 8192 + k * 1024 + laneoff; const LAS unsigned char* bp = lds + S1_BT + nb * 8192 + k * 1024 + laneoff;
            const v4i16_t al = vtr(ap), ah = vtr(ap + 512), bl = vtr(bp), bh = vtr(bp + 512);
            const bf16x8 af = (bf16x8){al[0], al[1], al[2], al[3], ah[0], ah[1], ah[2], ah[3]}, bf = (bf16x8){bl[0], bl[1], bl[2], bl[3], bh[0], bh[1], bh[2], bh[3]};
            st = __builtin_amdgcn_mfma_f32_32x32x16_bf16(af, bf, st, 0, 0, 0);
        }
        float* CS = (float*)(a.ws + WS_CS) + (size_t)((b * 32 + c) * 8 + h) * 64 * 128;
#pragma unroll
        for (int i = 0; i < 16; ++i) CS[(size_t)(32 * pb + crow(i, hh)) * 128 + 32 * nb + r32] = st[i];
    }
    LDS_WAIT(); __syncthreads();
}
__device__ __forceinline__ void ssd_s2_pass(const Args& a, int gtid, int NT) {
    typedef float f32x2t __attribute__((ext_vector_type(2)));
    const float* CS = (const float*)(a.ws + WS_CS); const float* ACL = (const float*)(a.ws + WS_ACL); bf16* PREV = (bf16*)(a.ws + WS_PREV);
    for (int it = gtid; it < NBP * 8 * 64 * 64; it += NT) {
        const int n2 = it & 63, p = (it >> 6) & 63, h = (it >> 12) & 7, b = it >> 15;
        f32x2t s = {0.f, 0.f};
#pragma unroll 8
        for (int c = 0; c < 32; ++c) {
            const size_t idx = ((size_t)((b * 32 + c) * 8 + h) * 64 + p) * 128 + 2 * n2;
            const f32x2t cs = *(const f32x2t*)(CS + idx); const float dec = __expf(ACL[(b * 32 + c) * 8 + h]);
            *(unsigned*)(PREV + idx) = pk2(s.x, s.y);
            s = s * dec + cs;
        }
        *(f32x2t*)(a.out + O_SP + ((size_t)((b * 8 + h) * 64 + p)) * 128 + 2 * n2) = s;
    }
}
__device__ __forceinline__ void ssd_s3_unit(const Args& a, int unit, int wave, int lane, float psc = 1.f) {
    asm volatile("" : "+v"(lane));
    const int h = unit & 7, c = (unit >> 3) & 31, b = unit >> 8, g = h >> 2, m0 = b * SEQ + c * 128;
    const int r32 = lane & 31, hh = lane >> 5, tb = wave >> 1, ph = wave & 1;
    const bf16* cp = (const bf16*)(a.ws + WS_CC) + (size_t)(m0 + 32 * tb + r32) * 256 + g * 128 + 8 * hh;
    const bf16* pp = (const bf16*)(a.ws + WS_PREV) + ((size_t)((b * 32 + c) * 8 + h) * 64 + 32 * ph + r32) * 128 + 8 * hh;
    bf16x8 cf[8], pf[8];
#pragma unroll
    for (int k = 0; k < 8; ++k) { cf[k] = *(const bf16x8*)(cp + 16 * k); pf[k] = *(const bf16x8*)(pp + 16 * k); }
    f32x16 acc;
#pragma unroll
    for (int i = 0; i < 16; ++i) acc[i] = 0.f;
#pragma unroll
    for (int k = 0; k < 8; ++k) acc = __builtin_amdgcn_mfma_f32_32x32x16_bf16(cf[k], pf[k], acc, 0, 0, 0);
    float* YS = (float*)(a.ws + WS_YS); const float* ACUM = (const float*)(a.ws + WS_ACUM);
#pragma unroll
    for (int i = 0; i < 16; ++i) { const size_t t = (size_t)(m0 + 32 * tb + crow(i, hh)); float* yp = YS + t * 512 + h * 64 + 32 * ph + r32; *yp = *yp + psc * __expf(ACUM[t * 8 + h]) * acc[i]; }
}

constexpr int ATT_WAVE_BYTES = 8704, ATT_VB = 0, ATT_STG = 4096, ATT_WSF = 8192, ATT_BTAB_OFF = 8 * ATT_WAVE_BYTES  , ATT_BT_LD = 132;

__device__ __forceinline__ void attn_build_btab(const Args& a, LAS unsigned char* lds, int tid) {
    LAS float* bt = (LAS float*)(lds + ATT_BTAB_OFF); const float* rb = a.in[9];
    for (int i = tid; i < 3 * 8 * 129; i += NWAVES * 64) { const int br = i / (8 * 129), rem = i % (8 * 129), h = rem / 129, j = rem % 129; bt[(br * 8 + h) * ATT_BT_LD + j] = rb[BUCKET_TAB[br][j] * 8 + h] * LOG2E; }
}
__device__ __forceinline__ void attn_prompt_unit(const Args& a, LAS unsigned char* lds, int unit, int wave, int lane) {
    asm volatile("" : "+v"(lane));
    const bf16* PROJ = (const bf16*)(a.ws + WS_PROJ);
    const int r32 = lane & 31, hi = lane >> 5;
    const int rq = unit & 127, bhb = unit >> 7, br = bhb % 3, bh = bhb / 3, h = bh & 7, b = bh >> 3;
    const int sh = 2 * br, dil = 1 << sh, nqb = 128 >> sh, r = rq / nqb, qb = rq % nqb, l0 = qb * 32;
    const size_t rowb = (size_t)b * SEQ;
    LAS unsigned char* wl = lds + wave * ATT_WAVE_BYTES;
    const LAS float* bt = (const LAS float*)(lds + ATT_BTAB_OFF) + (br * 8 + h) * ATT_BT_LD;
    bf16x8 qr[4];
    { const bf16* qp = PROJ + (rowb + (size_t)(l0 + r32) * dil + r) * NIN + h * 64 + hi * 8;
#pragma unroll
      for (int d0 = 0; d0 < 4; ++d0) qr[d0] = *(const bf16x8*)(qp + d0 * 16); }
    const int kb0 = (l0 >= 128) ? 0 : (4 - (l0 >> 5));
    f32x16 s[5];
    bf16x8 kfa[4], kfb[4];
#define ATT_KLOAD(dst, kb_) do { int kk_ = l0 - 128 + 32 * (kb_) + r32; kk_ = kk_ < 0 ? 0 : kk_; const bf16* kp_ = PROJ + (rowb + (size_t)kk_ * dil + r) * NIN + PC_K + h * 64 + hi * 8; \
        _Pragma("unroll") for (int d0 = 0; d0 < 4; ++d0) dst[d0] = *(const bf16x8*)(kp_ + d0 * 16); } while (0)
#define ATT_QK(src, kb_) do { _Pragma("unroll") for (int i = 0; i < 16; ++i) s[kb_][i] = 0.f; \
        if ((kb_) >= kb0) { _Pragma("unroll") for (int d0 = 0; d0 < 4; ++d0) s[kb_] = __builtin_amdgcn_mfma_f32_32x32x16_bf16(src[d0], qr[d0], s[kb_], 0, 0, 0); } } while (0)
    ATT_KLOAD(kfa, 0); ATT_KLOAD(kfb, 1);
    __builtin_amdgcn_sched_barrier(0);
    ATT_QK(kfa, 0); ATT_KLOAD(kfa, 2);
    __builtin_amdgcn_sched_barrier(0);
    ATT_QK(kfb, 1); ATT_KLOAD(kfb, 3);
    __builtin_amdgcn_sched_barrier(0);
    ATT_QK(kfa, 2); ATT_KLOAD(kfa, 4);
    __builtin_amdgcn_sched_barrier(0);
    ATT_QK(kfb, 3);
    __builtin_amdgcn_sched_barrier(0);
    ATT_QK(kfa, 4);
#undef ATT_KLOAD
#undef ATT_QK
    __builtin_amdgcn_sched_barrier(0);
    v4u vpre[5][4];
#pragma unroll
    for (int kb = 0; kb < 3; ++kb)
#pragma unroll
        for (int i = 0; i < 4; ++i) {
            const int idx = i * 64 + lane, key = idx >> 3, ch = idx & 7;
            int kk = l0 - 128 + 32 * kb + key; kk = kk < 0 ? 0 : kk;
            vpre[kb][i] = *(const v4u*)(PROJ + (rowb + (size_t)kk * dil + r) * NIN + PC_V + h * 64 + ch * 8);
        }
    __builtin_amdgcn_sched_barrier(0);
    float mx = -INFINITY;
    int J0 = r32 - 4 * hi + 128, T0 = 128 - l0 - 4 * hi;
    asm volatile("" : "+v"(J0), "+v"(T0));
#pragma unroll
    for (int kb = 0; kb < 5; ++kb)
#pragma unroll
        for (int i = 0; i < 16; ++i) {
            const int cst = (i & 3) + 8 * (i >> 2) + 32 * kb, j = J0 - cst;
            const bool valid = ((unsigned)j <= 128u) && (cst >= T0) && (kb >= kb0);
            const int jc = j < 0 ? 0 : (j > 128 ? 128 : j);
            const float v = valid ? s[kb][i] + bt[jc] : -INFINITY;
            s[kb][i] = v; mx = fmaxf(mx, v);
        }
    mx = fmaxf(mx, __shfl_xor(mx, 32));
    float l = 0.f;
#pragma unroll
    for (int kb = 0; kb < 5; ++kb)
#pragma unroll
        for (int i = 0; i < 16; ++i) { const float p = __builtin_amdgcn_exp2f(s[kb][i] - mx); s[kb][i] = p; l += p; }
    l += __shfl_xor(l, 32);
    __builtin_amdgcn_sched_barrier(0);
#pragma unroll
    for (int kb = 3; kb < 5; ++kb)
#pragma unroll
        for (int i = 0; i < 4; ++i) {
            const int idx = i * 64 + lane, key = idx >> 3, ch = idx & 7;
            int kk = l0 - 128 + 32 * kb + key; kk = kk < 0 ? 0 : kk;
            vpre[kb][i] = *(const v4u*)(PROJ + (rowb + (size_t)kk * dil + r) * NIN + PC_V + h * 64 + ch * 8);
        }
    f32x16 o[2];
#pragma unroll
    for (int i = 0; i < 16; ++i) { o[0][i] = 0.f; o[1][i] = 0.f; }
    const LAS unsigned char* vrd = wl + ATT_VB + ((lane >> 4) & 1) * 32 + (lane & 3) * 8 + (4 * hi + ((lane & 15) >> 2)) * 64;
#pragma unroll
    for (int kb = 0; kb < 5; ++kb) {
        if (kb >= kb0) {
#pragma unroll
            for (int i = 0; i < 4; ++i) {
                const int idx = i * 64 + lane, key = idx >> 3, ch = idx & 7;
                *(LAS v4u*)(wl + ATT_VB + (ch >> 2) * 2048 + (key >> 4) * 1024 + (key & 15) * 64 + (ch & 3) * 16) = vpre[kb][i];
            }
            LDS_WAIT();
#pragma unroll
            for (int ks = 0; ks < 2; ++ks) {
                v4u pw;
                pw.x = cvtpk_s(s[kb][8 * ks + 0], s[kb][8 * ks + 1]); pw.y = cvtpk_s(s[kb][8 * ks + 2], s[kb][8 * ks + 3]);
                pw.z = cvtpk_s(s[kb][8 * ks + 4], s[kb][8 * ks + 5]); pw.w = cvtpk_s(s[kb][8 * ks + 6], s[kb][8 * ks + 7]);
                const bf16x8 pa = __builtin_bit_cast(bf16x8, pw);
#pragma unroll
                for (int d0 = 0; d0 < 2; ++d0) {
                    const v4i16_t lo = vtr(vrd + d0 * 2048 + ks * 1024), hh = vtr(vrd + d0 * 2048 + ks * 1024 + 512);
                    const bf16x8 vb = (bf16x8){lo[0], lo[1], lo[2], lo[3], hh[0], hh[1], hh[2], hh[3]};
                    o[d0] = __builtin_amdgcn_mfma_f32_32x32x16_bf16(pa, vb, o[d0], 0, 0, 0);
                }
            }
            LDS_WAIT();
        }
    }
    LAS float* wsf = (LAS float*)(wl + ATT_WSF);
    if (hi == 0) wsf[r32] = l;
    LDS_WAIT();
    LAS bf16* stg = (LAS bf16*)(wl + ATT_STG);
#pragma unroll
    for (int i = 0; i < 16; ++i) {
        const int orow = crow(i, hi); const float rl = 1.0f / wsf[orow];
        stg[orow * 64 + r32] = (bf16)f2bf(o[0][i] * rl); stg[orow * 64 + 32 + r32] = (bf16)f2bf(o[1][i] * rl);
    }
    LDS_WAIT();
    bf16* OBR = (bf16*)(a.ws + WS_OBR) + (size_t)br * MP * 512;
#pragma unroll
    for (int i = 0; i < 4; ++i) {
        const int row = i * 8 + (lane >> 3), ch = lane & 7;
        const v4u v = *(const LAS v4u*)(stg + row * 64 + ch * 8);
        *(v4u*)(OBR + (rowb + (size_t)(l0 + row) * dil + r) * 512 + h * 64 + ch * 8) = v;
    }
    if (hi == 0) { float* LSE = (float*)(a.ws + WS_LSE) + (size_t)br * MP * 8; LSE[(rowb + (size_t)(l0 + r32) * dil + r) * 8 + h] = mx + __builtin_amdgcn_logf(l); }
    LDS_WAIT();
}

__device__ __forceinline__ void attn_sample_task(const Args& a, LAS unsigned char* lds, int task, int wave, int lane) {
    const int h = task & 7, t = (task >> 3) & 7, b = task >> 6;
    const bf16* PROJ = (const bf16*)(a.ws + WS_PROJ);
    const float* ck = a.in[4]; const float* cv = a.in[5]; const float* kn = a.out + O_KS; const float* vn = a.out + O_VS;
    LAS float* pl = (LAS float*)(lds + wave * ATT_WAVE_BYTES + ATT_STG);
    const int ks = lane >> 4, dq = lane & 15;
    f32x4 q4;
    { const u32x2 w = *(const u32x2*)(PROJ + (size_t)(MP + b * 8 + t) * NIN + h * 64 + 4 * dq); q4 = (f32x4){bflo(w.x), bfhi(w.x), bflo(w.y), bfhi(w.y)}; }
    const size_t cbase = ((size_t)b * WBUF * 8 + h) * 64 + 4 * dq, nbase = ((size_t)b * 8 * 8 + h) * 64 + 4 * dq;
#pragma unroll 1
    for (int br = 0; br < 3; ++br) {
        const int dil = 1 << (2 * br);
        const LAS float* bt = (const LAS float*)(lds + ATT_BTAB_OFF) + (br * 8 + h) * ATT_BT_LD;
#pragma unroll 1
        for (int it0 = 0; it0 < 33; it0 += 11) {
            f32x4 kv[11];
#pragma unroll
            for (int u = 0; u < 11; ++u) { int j = 4 * (it0 + u) + ks; j = j > 128 ? 128 : j; const int idx = WBUF + t - j * dil;
                kv[u] = (idx < WBUF) ? *(const f32x4*)(ck + cbase + (size_t)idx * 512) : *(const f32x4*)(kn + nbase + (size_t)(idx - WBUF) * 512); }
#pragma unroll
            for (int u = 0; u < 11; ++u) { const int j = 4 * (it0 + u) + ks; float d = q4.x * kv[u].x + q4.y * kv[u].y + q4.z * kv[u].z + q4.w * kv[u].w; d = row16_sum(d);
                if (dq == 0 && j <= 128) pl[br * ATT_BT_LD + j] = d + bt[j]; }
        }
    }
    LDS_WAIT(); asm volatile("" ::: "memory");
    float mx = -INFINITY;
#pragma unroll 1
    for (int i = lane; i < 3 * ATT_BT_LD; i += 64) { const int j = i % ATT_BT_LD; if (j <= 128) mx = fmaxf(mx, pl[i]); }
    mx = wave_max(mx);
    float l = 0.f;
#pragma unroll 1
    for (int i = lane; i < 3 * ATT_BT_LD; i += 64) { const int j = i % ATT_BT_LD; if (j <= 128) { const float p = __builtin_amdgcn_exp2f(pl[i] - mx); pl[i] = p; l += p; } }
    l = wave_sum(l);
    LDS_WAIT(); asm volatile("" ::: "memory");
    f32x4 o4 = {0.f, 0.f, 0.f, 0.f};
#pragma unroll 1
    for (int br = 0; br < 3; ++br) {
        const int dil = 1 << (2 * br);
#pragma unroll 1
        for (int it0 = 0; it0 < 33; it0 += 11) {
            f32x4 vv[11]; float pp[11];
#pragma unroll
            for (int u = 0; u < 11; ++u) { const int j0 = 4 * (it0 + u) + ks, j = j0 > 128 ? 128 : j0; const int idx = WBUF + t - j * dil;
                vv[u] = (idx < WBUF) ? *(const f32x4*)(cv + cbase + (size_t)idx * 512) : *(const f32x4*)(vn + nbase + (size_t)(idx - WBUF) * 512);
                pp[u] = (j0 <= 128) ? pl[br * ATT_BT_LD + j] : 0.f; }
#pragma unroll
            for (int u = 0; u < 11; ++u) o4 += vv[u] * pp[u];
        }
    }
#pragma unroll
    for (int e = 0; e < 4; ++e) { o4[e] += __shfl_xor(o4[e], 16); o4[e] += __shfl_xor(o4[e], 32); }
    if (lane < 16) { const float il = 1.f / l; u32x2 w; w.x = pk2(o4.x * il, o4.y * il); w.y = pk2(o4.z * il, o4.w * il);
        *(u32x2*)((bf16*)(a.ws + WS_MIX) + (size_t)(MP + b * 8 + t) * DM + h * 64 + 4 * dq) = w; }
    LDS_WAIT(); asm volatile("" ::: "memory");
}

__device__ __forceinline__ void ssd_sample_task(const Args& a, int k, int lane) {
    const float* XB = (const float*)(a.ws + WS_XBS); const float* DT = (const float*)(a.ws + WS_DT); float* YS = (float*)(a.ws + WS_YS);
    const int p4 = k & 15, h = (k >> 4) & 7, b = k >> 7, g = h >> 2, p = 4 * p4 + (lane >> 4), ng = lane & 15;
    const size_t sidx = ((size_t)((b * 8 + h) * 64 + p)) * 128 + 8 * ng;
    float s[8]; load8f(a.in[6] + sidx, s);
    const float A = -__expf(a.in[15][h]);
#pragma unroll 1
    for (int t0 = 0; t0 < TS; t0 += 4) {
        float dtv[4], xv[4], Bv[4][8], Cv[4][8];
#pragma unroll
        for (int q = 0; q < 4; ++q) { const int r = b * TS + t0 + q; dtv[q] = DT[(size_t)(MP + r) * 8 + h]; const float* xr = XB + (size_t)r * 1024; xv[q] = xr[h * 64 + p]; load8f(xr + 512 + g * 128 + 8 * ng, Bv[q]); load8f(xr + 768 + g * 128 + 8 * ng, Cv[q]); }
#pragma unroll
        for (int q = 0; q < 4; ++q) {
            const float da = __expf(dtv[q] * A), xd = dtv[q] * xv[q]; float y = 0.f;
#pragma unroll
            for (int e = 0; e < 8; ++e) { s[e] = da * s[e] + xd * Bv[q][e]; y += Cv[q][e] * s[e]; }
            y = row16_sum(y);
            if (ng == 0) YS[(size_t)(MP + b * TS + t0 + q) * 512 + h * 64 + p] = y;
        }
    }
    float* so = a.out + O_SS + sidx;
    *(f32x4*)so = (f32x4){s[0], s[1], s[2], s[3]}; *(f32x4*)(so + 4) = (f32x4){s[4], s[5], s[6], s[7]};
}
__device__ __forceinline__ void attn_combine_pass(const Args& a, int gtid, int NT) {
    const bf16* OBR = (const bf16*)(a.ws + WS_OBR); const float* LSE = (const float*)(a.ws + WS_LSE); bf16* MIX = (bf16*)(a.ws + WS_MIX);
    for (int it = gtid; it < MP * 64; it += NT) {
        const int row = it >> 6, c8 = it & 63, h = c8 >> 3;
        const float l0 = LSE[(size_t)row * 8 + h], l1 = LSE[(size_t)(MP + row) * 8 + h], l2 = LSE[(size_t)(2 * MP + row) * 8 + h];
        const float mx = fmaxf(l0, fmaxf(l1, l2));
        float w0 = __builtin_amdgcn_exp2f(l0 - mx), w1 = __builtin_amdgcn_exp2f(l1 - mx), w2 = __builtin_amdgcn_exp2f(l2 - mx);
        const float inv = 1.f / (w0 + w1 + w2); w0 *= inv; w1 *= inv; w2 *= inv;
        float o0[8], o1[8], o2[8];
        load8bf(OBR + (size_t)row * 512 + c8 * 8, o0); load8bf(OBR + ((size_t)MP + row) * 512 + c8 * 8, o1); load8bf(OBR + ((size_t)2 * MP + row) * 512 + c8 * 8, o2);
        float r[8];
#pragma unroll
        for (int k = 0; k < 8; ++k) r[k] = w0 * o0[k] + w1 * o1[k] + w2 * o2[k];
        v4u w; w.x = pk2(r[0], r[1]); w.y = pk2(r[2], r[3]); w.z = pk2(r[4], r[5]); w.w = pk2(r[6], r[7]);
        *(v4u*)(MIX + (size_t)row * DM + c8 * 8) = w;
    }
}
__device__ __forceinline__ void ssd_finish_pass(const Args& a, int gw, int NGW, int lane) {
    const bf16* XC = (const bf16*)(a.ws + WS_XC); const float* YS = (const float*)(a.ws + WS_YS); const bf16* PROJ = (const bf16*)(a.ws + WS_PROJ); bf16* MIX = (bf16*)(a.ws + WS_MIX);
    const float* dsk = a.in[16]; const float* gs = a.in[17];
    const int c = lane * 8; const float dh = dsk[c >> 6];
    float g8[8]; load8f(gs + c, g8);
    for (int m = gw; m < MT; m += NGW) {
        float y[8], x[8], z[8], v[8]; load8f(YS + (size_t)m * 512 + c, y); load8bf(XC + (size_t)m * 512 + c, x); load8bf(PROJ + (size_t)m * NIN + PC_Z + c, z);
        float ss = 0.f;
#pragma unroll
        for (int k = 0; k < 8; ++k) { v[k] = (y[k] + dh * x[k]) * siluf(z[k]); ss += v[k] * v[k]; }
#pragma unroll
        for (int o = 1; o < 32; o <<= 1) ss += __shfl_xor(ss, o);
        const float rs = 1.0f / sqrtf(ss * (1.f / 256.f) + EPS);
        v4u w; w.x = pk2(v[0] * rs * g8[0], v[1] * rs * g8[1]); w.y = pk2(v[2] * rs * g8[2], v[3] * rs * g8[3]); w.z = pk2(v[4] * rs * g8[4], v[5] * rs * g8[5]); w.w = pk2(v[6] * rs * g8[6], v[7] * rs * g8[7]);
        *(v4u*)(MIX + (size_t)m * DM + 512 + c) = w;
    }
}
__device__ __forceinline__ void ffn_conv_pass(const Args& a, int gtid, int NT) {
    const bf16* U = (const bf16*)(a.ws + WS_U); bf16* ACT = (bf16*)(a.ws + WS_ACT);
    const float* fw = a.in[21]; const float* fb = a.in[22]; const float* sf = a.in[8];
    constexpr int NC8 = DFF / 8, NPB = MP / 16, NITEMS = (NPB + NBS) * NC8;
    for (int it = gtid; it < NITEMS; it += NT) {
        const int blk = it / NC8, c = (it % NC8) * 8;
        float wa0[8], wa1[8], wa2[8], wb0[8], wb1[8], wb2[8], ba[8], bb[8], a2[8], a1[8], b2[8], b1[8];
        load8f(fw + c, wa0); load8f(fw + DFF2 + c, wa1); load8f(fw + 2 * DFF2 + c, wa2); load8f(fb + c, ba);
        load8f(fw + DFF + c, wb0); load8f(fw + DFF2 + DFF + c, wb1); load8f(fw + 2 * DFF2 + DFF + c, wb2); load8f(fb + DFF + c, bb);
        int m0, nr;
        if (blk < NPB) { m0 = blk * 16; nr = 16;
            if ((m0 & (SEQ - 1)) == 0) {
#pragma unroll
                for (int k = 0; k < 8; ++k) { a2[k] = 0.f; a1[k] = 0.f; b2[k] = 0.f; b1[k] = 0.f; }
            } else { load8bf(U + (size_t)(m0 - 2) * DFF2 + c, a2); load8bf(U + (size_t)(m0 - 1) * DFF2 + c, a1); load8bf(U + (size_t)(m0 - 2) * DFF2 + DFF + c, b2); load8bf(U + (size_t)(m0 - 1) * DFF2 + DFF + c, b1); }
        } else { const int b = blk - NPB; m0 = MP + b * 8; nr = 8;
            load8f(sf + (size_t)(b * 2) * DFF2 + c, a2); load8f(sf + (size_t)(b * 2 + 1) * DFF2 + c, a1); load8f(sf + (size_t)(b * 2) * DFF2 + DFF + c, b2); load8f(sf + (size_t)(b * 2 + 1) * DFF2 + DFF + c, b1); }
        for (int r = 0; r < nr; ++r) {
            float ua[8], ub[8], o[8]; load8bf(U + (size_t)(m0 + r) * DFF2 + c, ua); load8bf(U + (size_t)(m0 + r) * DFF2 + DFF + c, ub);
#pragma unroll
            for (int k = 0; k < 8; ++k) {
                const float ya = ba[k] + wa0[k] * a2[k] + wa1[k] * a1[k] + wa2[k] * ua[k], yb = bb[k] + wb0[k] * b2[k] + wb1[k] * b1[k] + wb2[k] * ub[k];
                o[k] = siluf(ya) * yb; a2[k] = a1[k]; a1[k] = ua[k]; b2[k] = b1[k]; b1[k] = ub[k];
            }
            v4u w; w.x = pk2(o[0], o[1]); w.y = pk2(o[2], o[3]); w.z = pk2(o[4], o[5]); w.w = pk2(o[6], o[7]);
            *(v4u*)(ACT + (size_t)(m0 + r) * DFF + c) = w;
        }
    }
}
__device__ __forceinline__ void final_norm_pass(const Args& a, int gw, int NGW, int lane) {
    const float* RS3 = (const float*)(a.ws + WS_RS3); const float* gf = a.in[27]; const bf16* H3b = (const bf16*)(a.ws + WS_MIX);
    float g[16];
    load8f(gf + lane * 16, *(float(*)[8])&g[0]); load8f(gf + lane * 16 + 8, *(float(*)[8])&g[8]);
    for (int m = gw; m < MT; m += NGW) {
        float* orow = (m < MP) ? a.out + O_Y + (size_t)m * DM : a.out + O_YS + (size_t)(m - MP) * DM;
        const float rs = 1.0f / sqrtf(RS3[m] * (1.f / DM) + EPS);
        float h[16]; load8bf(H3b + (size_t)m * DM + lane * 16, *(float(*)[8])&h[0]); load8bf(H3b + (size_t)m * DM + lane * 16 + 8, *(float(*)[8])&h[8]);
#pragma unroll
        for (int j = 0; j < 4; ++j) *(f32x4*)(orow + lane * 16 + 4 * j) = (f32x4){h[4 * j] * rs * g[4 * j], h[4 * j + 1] * rs * g[4 * j + 1], h[4 * j + 2] * rs * g[4 * j + 2], h[4 * j + 3] * rs * g[4 * j + 3]};
    }
}

typedef float f32x4m __attribute__((ext_vector_type(4)));
template <class Epi>
__device__ __forceinline__ void skinny_gemm(LAS unsigned char* lds, const bf16* A, const bf16* Wt, int N, int K, const Epi& E, int vcu, int G, int tid, int wave, int lane) {
    const int npieces = (MS / 16) * (N / 64), kslice = K / 8, nsteps = kslice / 32;
    const int r16 = lane & 15, kg = lane >> 4;
    for (int piece = vcu; piece < npieces; piece += G) {
        const int mb = piece & 15, nb = piece >> 4, m0 = mb * 16, n0 = nb * 64;
        const bf16* ap = A + (size_t)(m0 + r16) * K + wave * kslice + 8 * kg;
        const bf16* wp = Wt + (size_t)(n0 + r16) * K + wave * kslice + 8 * kg;
        f32x4m acc[4];
#pragma unroll
        for (int j = 0; j < 4; ++j) acc[j] = (f32x4m){0.f, 0.f, 0.f, 0.f};
        for (int s0 = 0; s0 < nsteps; s0 += 4) {
            bf16x8 af[4], wf[4][4];
#pragma unroll
            for (int u = 0; u < 4; ++u) if (s0 + u < nsteps) {
                af[u] = *(const bf16x8*)(ap + (s0 + u) * 32);
#pragma unroll
                for (int j = 0; j < 4; ++j) wf[u][j] = *(const bf16x8*)(wp + (size_t)(16 * j) * K + (s0 + u) * 32);
            }
#pragma unroll
            for (int u = 0; u < 4; ++u) if (s0 + u < nsteps) {
#pragma unroll
                for (int j = 0; j < 4; ++j) acc[j] = __builtin_amdgcn_mfma_f32_16x16x32_bf16(wf[u][j], af[u], acc[j], 0, 0, 0);
            }
        }
#pragma unroll
        for (int j = 0; j < 4; ++j) *(LAS f32x4m*)(lds + ((wave * 4 + j) * 64 + lane) * 16) = acc[j];
        LDS_WAIT(); __syncthreads();
        if (tid < 256) {
            const int j = tid >> 6, l2 = tid & 63;
            f32x4m v = *(const LAS f32x4m*)(lds + (j * 64 + l2) * 16);
#pragma unroll
            for (int w = 1; w < 8; ++w) v += *(const LAS f32x4m*)(lds + ((w * 4 + j) * 64 + l2) * 16);
            E.apply(m0 + (l2 & 15), n0 + 16 * j + 4 * (l2 >> 4), v);
        }
        LDS_WAIT(); __syncthreads();
    }
}
struct SEpiIn { bf16* PROJ; float* out;
    __device__ __forceinline__ void apply(int r, int c, f32x4m v) const {
        const float sc = (c < PC_K) ? C2 : 1.f; u32x2 w; w.x = pk2(v.x * sc, v.y * sc); w.y = pk2(v.z * sc, v.w * sc);
        *(u32x2*)(PROJ + (size_t)(MP + r) * NIN + c) = w;
        if (c >= PC_K && c < PC_Z) { const bool isk = c < PC_V; *(f32x4m*)(out + (isk ? O_KS : O_VS) + (size_t)r * 512 + (c - (isk ? PC_K : PC_V))) = v; }
        else if (c >= PC_X) { const int t = r & 7, b = r >> 3; if (t >= TS - 3) *(f32x4m*)(out + O_CS + (size_t)(b * 3 + t - (TS - 3)) * 1024 + (c - PC_X)) = v; }
    } };
struct SEpiOut { const float* xs; bf16* H1b; float* RS;
    __device__ __forceinline__ void apply(int r, int c, f32x4m v) const {
        const f32x4m h = *(const f32x4m*)(xs + (size_t)r * DM + c) + v; const size_t o = (size_t)(MP + r) * DM + c;
        u32x2 w; w.x = pk2(h.x, h.y); w.y = pk2(h.z, h.w); *(u32x2*)(H1b + o) = w;
        atomicAdd(RS + MP + r, (h.x * h.x + h.y * h.y) + (h.z * h.z + h.w * h.w));
    } };
struct SEpiPle { bf16* E; float* RS;
    __device__ __forceinline__ void apply(int r, int c, f32x4m v) const {
        u32x2 w; w.x = pk2(v.x, v.y); w.y = pk2(v.z, v.w); *(u32x2*)(E + (size_t)(MP + r) * DM + c) = w; atomicAdd(RS + MP + r, (v.x * v.x + v.y * v.y) + (v.z * v.z + v.w * v.w));
    } };
struct SEpiDown { bf16* Hb;
    __device__ __forceinline__ void apply(int r, int c, f32x4m v) const {
        u32x2* hp = (u32x2*)(Hb + (size_t)(MP + r) * DM + c); const u32x2 o = *hp;
        u32x2 w; w.x = pk2(bflo(o.x) + v.x, bfhi(o.x) + v.y); w.y = pk2(bflo(o.y) + v.z, bfhi(o.y) + v.w); *hp = w;
    } };
struct SEpiGate { const bf16* H2b; const bf16* E; const float* RSE; const float* gple; bf16* H3b; float* RS3;
    __device__ __forceinline__ void apply(int r, int c, f32x4m v) const {
        const size_t o = (size_t)(MP + r) * DM + c; const float rse = 1.0f / sqrtf(RSE[MP + r] * (1.f / DM) + EPS);
        const u32x2 eb = *(const u32x2*)(E + o), hb = *(const u32x2*)(H2b + o); const f32x4m gp = *(const f32x4m*)(gple + c);
        const float e4[4] = {bflo(eb.x), bfhi(eb.x), bflo(eb.y), bfhi(eb.y)}, h4[4] = {bflo(hb.x), bfhi(hb.x), bflo(hb.y), bfhi(hb.y)}; float h[4];
#pragma unroll
        for (int k = 0; k < 4; ++k) { const float g = 1.f / (1.f + __expf(-v[k])); h[k] = h4[k] + g * (e4[k] * rse * gp[k]); }
        u32x2 w; w.x = pk2(h[0], h[1]); w.y = pk2(h[2], h[3]); *(u32x2*)(H3b + o) = w;
        atomicAdd(RS3 + MP + r, (h[0] * h[0] + h[1] * h[1]) + (h[2] * h[2] + h[3] * h[3]));
    } };

constexpr int NPH = 12;
#ifndef DUP
#define DUP -1
#endif
#define REP(k) for (int rep_ = 0; rep_ < ((DUP) == (k) ? args.pad : 1); ++rep_)
#ifndef MK_N_LAUNCHES
#define MK_N_LAUNCHES 1
#endif
constexpr int N_LAUNCHES = MK_N_LAUNCHES;
__global__ void __launch_bounds__(NWAVES * 64, 2) mk_fwd(Args args) {
    extern __shared__ __attribute__((aligned(16))) unsigned char lds_raw[];
    LAS unsigned char* lds = (LAS unsigned char*)lds_raw;
    volatile LAS unsigned* MISC = (volatile LAS unsigned*)(lds + MISC_OFF);
    const int tid = threadIdx.x, lane = tid & 63, wave = __builtin_amdgcn_readfirstlane(tid >> 6);
    const int G = gridDim.x, bx = blockIdx.x, vcu = (G % 8 == 0) ? (bx % 8) * (G / 8) + bx / 8 : bx;
    const int gw = vcu * NWAVES + wave, NGW = G * NWAVES, gtid = vcu * (NWAVES * 64) + tid, NT = G * NWAVES * 64;
    unsigned char* ws = args.ws;
    gu32* ctl = (gu32*)(ws + WS_CTL);
    for (int u = tid; u < (LDS_BYTES - LDSCTL_OFF) / 4; u += NWAVES * 64) ((LAS unsigned*)(lds + LDSCTL_OFF))[u] = 0u;
    __syncthreads();
    XcdBarrier bar; bar.bar = (unsigned*)(ctl + CW_BAR); bar.x = 0; bar.st = nullptr;
    if (N_LAUNCHES == 1) bar = xcd_barrier_post((unsigned*)(ctl + CW_BAR), MISC + 8);
    const int lo = args.ph_lo, hi = args.ph_hi;
#ifndef PHMASK
#define PHMASK 0xfff
#endif
#define IN(k) (((PHMASK >> (k)) & 1) && lo <= (k) && (k) < hi)
#define SEAM(k) do { if (IN(k) && IN((k) + 1)) xcd_barrier(bar); } while (0)

    if (IN(0)) { REP(0) { p0_prologue(args, lds, gw, NGW, wave, lane); VM_WAIT(); __syncthreads(); }
        if ((DUP) == 100) { p0_prologue(args, lds, gw, NGW, wave, lane, args.pad - 1); VM_WAIT(); __syncthreads(); }
        if ((DUP) == 101) { p0_prologue(args, lds, gw, NGW, wave, lane, args.pad); VM_WAIT(); __syncthreads(); } }
    SEAM(0);
    if (IN(1)) {
        pg8::Gemm g{(const pg8::bf16_t*)(ws + WS_XN), (const pg8::bf16_t*)(ws + WS_WIN), MP, NIN, DM}; pg8::StaticOrder S; S.init(MP, NIN, G, bx);
        EpiIn E{(pg8::bf16_t*)(ws + WS_PROJ), args.out};
        REP(1) pg8::gemm_phase<EpiIn, pg8::StaticOrder, PG8_ALIGN, PG8_SP2>(lds, g, S, E);
        { SEpiIn SE{(bf16*)(ws + WS_PROJ), args.out}; skinny_gemm(lds, (const bf16*)(ws + WS_XN) + (size_t)MP * DM, (const bf16*)(ws + WS_WIN), NIN, DM, SE, vcu, G, tid, wave, lane); }
    }
    SEAM(1);
    if (IN(2)) {
        attn_build_btab(args, lds, tid);
        conv_sample_pass(args, gtid, NT);
        __syncthreads();
#ifndef P2SUB
#define P2SUB 7
#endif
        REP(20) if (P2SUB & 1) for (int task = gw; task < NBS * TS * NH; task += NGW) attn_sample_task(args, lds, task, wave, lane);
        __syncthreads();
        REP(21) if (P2SUB & 2) for (int unit = gw; unit < NBP * NH * 3 * 128; unit += NGW) attn_prompt_unit(args, lds, unit, wave, lane);
        __syncthreads();
        REP(22) if (P2SUB & 4) for (int unit = vcu; unit < NBP * 32 * 8; unit += G) ssd_s1_unit(args, lds, unit, tid, wave, lane);
        VM_WAIT(); __syncthreads();
    }
    SEAM(2);
    if (IN(3)) {
        REP(30) ssd_s2_pass(args, gtid, NT);
        REP(31) for (int task = gw; task < NBS * 8 * 16; task += NGW) ssd_sample_task(args, task, lane);
        REP(32) attn_combine_pass(args, gtid, NT);
        VM_WAIT(); __syncthreads();
    }
    SEAM(3);
    if ((DUP) == 99) { for (int q_ = 0; q_ < 5 * args.pad; ++q_) xcd_barrier(bar); }
    if (IN(4)) {
        REP(4) for (int unit = vcu; unit < NBP * 32 * 8; unit += G) ssd_s3_unit(args, unit, wave, lane, rep_ == 0 ? 1.f : 0.f);
        VM_WAIT(); __syncthreads();
    }
    SEAM(4);
    if (IN(5)) { REP(5) { ssd_finish_pass(args, gw, NGW, lane); VM_WAIT(); __syncthreads(); } }
    SEAM(5);
    if (IN(6)) {
        { pg8::Gemm g{(const pg8::bf16_t*)(ws + WS_MIX), (const pg8::bf16_t*)(ws + WS_WOUT), MP, DM, DM}; pg8::StaticOrder S; S.init(MP, DM, G, bx);
          REP(60) { EpiOut E{args.in[0], (pg8::bf16_t*)(ws + WS_XN), rep_ == 0 ? (float*)(ws + WS_RS1) : (float*)(ws + WS_H1)};
#ifndef NO_GOUT
          pg8::gemm_phase<EpiOut, pg8::StaticOrder, PG8_ALIGN, PG8_SP2>(lds, g, S, E);
#endif
        } }
#ifndef NOSK
        { SEpiOut SE{args.in[1], (bf16*)(ws + WS_XN), (float*)(ws + WS_RS1)}; skinny_gemm(lds, (const bf16*)(ws + WS_MIX) + (size_t)MP * DM, (const bf16*)(ws + WS_WOUT), DM, DM, SE, vcu, G, tid, wave, lane); }
#endif
        { int kple = DPLE; asm volatile("" : "+s"(kple));
          pg8::Gemm g{(const pg8::bf16_t*)(ws + WS_PB), (const pg8::bf16_t*)(ws + WS_WPLE), MP, DM, kple}; pg8::StaticOrder S; S.init(MP, DM, G, bx);
          EpiPle E{(pg8::bf16_t*)(ws + WS_E), (float*)(ws + WS_RSE)};
#ifndef NO_GPLE
          pg8::gemm_phase<EpiPle, pg8::StaticOrder, PG8_ALIGN, PG8_SP2>(lds, g, S, E);
#endif
        }
        { SEpiPle SE{(bf16*)(ws + WS_E), (float*)(ws + WS_RSE)}; skinny_gemm(lds, (const bf16*)(ws + WS_PB) + (size_t)MP * DPLE, (const bf16*)(ws + WS_WPLE), DM, DPLE, SE, vcu, G, tid, wave, lane); }
    }
    SEAM(6);
    if (IN(7)) {
        pg8::Gemm g{(const pg8::bf16_t*)(ws + WS_XN), (const pg8::bf16_t*)(ws + WS_WUP), MT, DFF2, DM}; pg8::StaticOrder S; S.init(MT, DFF2, G, bx);
        EpiUp E{(pg8::bf16_t*)(ws + WS_U), (const float*)(ws + WS_RS1), args.out};
        REP(7) pg8::gemm_phase<EpiUp, pg8::StaticOrder, PG8_ALIGN, PG8_SP2>(lds, g, S, E);
    }
    SEAM(7);
    if (IN(8)) { REP(8) { ffn_conv_pass(args, gtid, NT); VM_WAIT(); __syncthreads(); } }
    SEAM(8);
    if (IN(9)) {
        pg8::Gemm g{(const pg8::bf16_t*)(ws + WS_ACT), (const pg8::bf16_t*)(ws + WS_WDOWN), MP, DM, DFF}; pg8::StaticOrder S; S.init(MP, DM, G, bx);
        EpiDown E{(pg8::bf16_t*)(ws + WS_XN)};
        pg8::gemm_phase<EpiDown, pg8::StaticOrder, PG8_ALIGN, PG8_SP2>(lds, g, S, E);
        { SEpiDown SE{(bf16*)(ws + WS_XN)}; skinny_gemm(lds, (const bf16*)(ws + WS_ACT) + (size_t)MP * DFF, (const bf16*)(ws + WS_WDOWN), DM, DFF, SE, vcu, G, tid, wave, lane); }
    }
    SEAM(9);
    if (IN(10)) {
        pg8::Gemm g{(const pg8::bf16_t*)(ws + WS_XN), (const pg8::bf16_t*)(ws + WS_WGATE), MP, DM, DM}; pg8::StaticOrder S; S.init(MP, DM, G, bx);
        EpiGate E{(const pg8::bf16_t*)(ws + WS_XN), (const pg8::bf16_t*)(ws + WS_E), (const float*)(ws + WS_RSE), args.in[25], (pg8::bf16_t*)(ws + WS_MIX), (float*)(ws + WS_RS3)};
        pg8::gemm_phase<EpiGate, pg8::StaticOrder, PG8_ALIGN, PG8_SP2>(lds, g, S, E);
        { SEpiGate SE{(const bf16*)(ws + WS_XN), (const bf16*)(ws + WS_E), (const float*)(ws + WS_RSE), args.in[25], (bf16*)(ws + WS_MIX), (float*)(ws + WS_RS3)}; skinny_gemm(lds, (const bf16*)(ws + WS_XN) + (size_t)MP * DM, (const bf16*)(ws + WS_WGATE), DM, DM, SE, vcu, G, tid, wave, lane); }
    }
    SEAM(10);
    if (IN(11)) { REP(11) final_norm_pass(args, gw, NGW, lane); }
#undef IN
#undef SEAM
}

extern "C" void kernel_launch(void* const* d_in, const int* in_sizes, int n_in, void* d_out, int out_size, void* d_ws, size_t ws_size, hipStream_t stream) {
    static int grid = 0;
    if (grid == 0) {
        if (n_in != 28 || out_size != (int)O_END || ws_size < WS_END) { fprintf(stderr, "kernel_launch: unexpected shapes: n_in %d out %d ws %zu\n", n_in, out_size, ws_size); grid = -1; return; }
        int dev = 0, cus = 0, per_cu = 0;
        if (hipGetDevice(&dev) != hipSuccess || hipDeviceGetAttribute(&cus, hipDeviceAttributeMultiprocessorCount, dev) != hipSuccess) { grid = -1; return; }
        if (hipFuncSetAttribute((const void*)mk_fwd, hipFuncAttributeMaxDynamicSharedMemorySize, LDS_BYTES) != hipSuccess) { fprintf(stderr, "kernel_launch: hipFuncSetAttribute failed\n"); grid = -1; return; }
        if (hipOccupancyMaxActiveBlocksPerMultiprocessor(&per_cu, (const void*)mk_fwd, NWAVES * 64, LDS_BYTES) != hipSuccess || per_cu < 1) fprintf(stderr, "kernel_launch: occupancy query says %d\n", per_cu);
        (void)hipGetLastError();
        grid = cus;
    }
    if (grid < 0) return;
    if (hipMemsetAsync((char*)d_ws + WS_CTL, 0, CTL_ZERO_BYTES, stream) != hipSuccess) { fprintf(stderr, "kernel_launch: memset failed\n"); return; }
    Args a{};
    for (int i = 0; i < 28; ++i) a.in[i] = (const float*)d_in[i];
    a.out = (float*)d_out; a.ws = (unsigned char*)d_ws; a.pad = 2;
    for (int li = 0; li < N_LAUNCHES; ++li) {
        if (N_LAUNCHES == 1) { a.ph_lo = 0; a.ph_hi = NPH; } else { a.ph_lo = li; a.ph_hi = li + 1; }
        a.li = li;
        hipLaunchKernelGGL(mk_fwd, dim3(grid), dim3(NWAVES * 64), LDS_BYTES, stream, a);
        const hipError_t le = hipPeekAtLastError();
        if (le != hipSuccess) { fprintf(stderr, "kernel_launch: launch %d failed: %s\n", li, hipGetErrorName(le)); break; }
    }
}
```

```cpp
#include <hip/hip_runtime.h>
#include <cstdio>
#include <cstdint>
namespace pg8 {
#define PG8_LAS __attribute__((address_space(3)))
typedef unsigned short bf16_t;
typedef short bf16x8 __attribute__((ext_vector_type(8)));
typedef float f32x4 __attribute__((ext_vector_type(4)));
typedef unsigned u32x4 __attribute__((ext_vector_type(4)));
constexpr int BM = 256, BK = 64, HALF = 128, HTB = HALF * BK * 2  , STAGE_BYTES = 8 * HTB, NXCD = 8, WGM = 8;

__host__ __device__ __forceinline__ int lds_byte(int r, int c) { const int st = (r >> 4) * 2 + (c >> 5), rr = r & 15, cc = c & 31, ob = rr * 64 + cc * 2; return st * 1024 + (ob ^ (((ob >> 9) & 1) << 5)); }
__host__ __device__ __forceinline__ void stage_rc(int b, int& R, int& C) { const int st = b / 1024, sb = b % 1024, swz = sb ^ (((sb >> 9) & 1) << 5); R = (st >> 1) * 16 + swz / 64; C = (st & 1) * 32 + (swz % 64) / 2; }
__host__ __device__ __forceinline__ int perm32(int rho) { const int n = rho >> 4, i = rho & 15; return 8 * (i >> 2) + 4 * n + (i & 3); }

struct Unit { int pm, pn; };
struct Gemm { const bf16_t* A; const bf16_t* Bt; int M, N, K; };

struct StaticOrder {
    int nM, nN, nwg, G, c;
    __host__ __device__ void init(int M, int N, int G_, int c_) { nM = M / BM; nN = N / BM; nwg = nM * nN; G = G_; c = c_; }
    __host__ __device__ bool next(int i, Unit& u) const {
        const long L = (long)i * G + c; if (L >= nwg) return false;
        int wgid = (int)L; { const int q = nwg / NXCD, r = nwg % NXCD, xcd = wgid % NXCD, off = wgid / NXCD; wgid = (xcd < r ? xcd * (q + 1) : r * (q + 1) + (xcd - r) * q) + off; }
        const int nig = WGM * nN, gid = wgid / nig, fm = gid * WGM, gsz = (nM - fm) < WGM ? (nM - fm) : WGM;
        u.pm = fm + ((wgid % nig) % gsz); u.pn = (wgid % nig) / gsz; return true;
    }
    __device__ __forceinline__ void a_ready(const Unit&) const {}
    __device__ __forceinline__ void done(const Unit&) const {}
};

__device__ __forceinline__ unsigned cvt_pk_bf16(float lo, float hi) { unsigned r; asm volatile("v_cvt_pk_bf16_f32 %0, %1, %2" : "=v"(r) : "v"(lo), "v"(hi)); return r; }
typedef float f32x2 __attribute__((ext_vector_type(2)));
template <class Epi, class Sched, bool ALIGN_EPI = false, bool SP2 = false>
__device__ __forceinline__ void gemm_phase(PG8_LAS unsigned char* lds, const Gemm g, const Sched& S, const Epi& E) {
    const int tid = threadIdx.x, wid = __builtin_amdgcn_readfirstlane(tid >> 6), lane = tid & 63, wr = wid >> 2, wc = wid & 3, fr = lane & 15, fq = lane >> 4;
    const int K = g.K, nt = K / BK;
    unsigned voffA[2], voffB[2];
#pragma unroll
    for (int i = 0; i < 2; ++i) { int R, C; stage_rc(tid * 16 + i * 8192, R, C); const int Rb = Epi::PERM ? ((R & ~31) + perm32(R & 31)) : R;
        voffA[i] = (unsigned)(R * K + C) * 2u; voffB[i] = (unsigned)(Rb * K + C) * 2u; }
    const size_t kstep = (size_t)(BK * 2);
    const size_t hstep = (size_t)HALF * K * 2;
    const size_t tstep = 2 * hstep;
    const unsigned ldsw = (unsigned)wid * 1024u;
    const int aoff = lds_byte(wr * 64 + fr, fq * 8), boff = lds_byte(wc * 32 + fr, fq * 8);
#define PG8_SA(b, h) (((b) * 2 + (h)) * HTB)
#define PG8_SB(b, h) ((4 + (b) * 2 + (h)) * HTB)
#define PG8_STAGE(bufoff, gbase, voff) do { _Pragma("unroll") for (int _i = 0; _i < 2; ++_i) \
        __builtin_amdgcn_global_load_lds((const unsigned*)((const char*)(gbase) + (voff)[_i]), (PG8_LAS unsigned*)(lds + (bufoff) + ldsw + _i * 8192), 16, 0, 0); } while (0)
#define PG8_LDA(dst, b, h) do { _Pragma("unroll") for (int m = 0; m < 4; ++m) _Pragma("unroll") for (int k = 0; k < 2; ++k) dst[m][k] = *(const PG8_LAS bf16x8*)(lds + PG8_SA(b, h) + aoff + m * 2048 + k * 1024); } while (0)
#define PG8_LDB(dst, b, h) do { _Pragma("unroll") for (int n = 0; n < 2; ++n) _Pragma("unroll") for (int k = 0; k < 2; ++k) dst[n][k] = *(const PG8_LAS bf16x8*)(lds + PG8_SB(b, h) + boff + n * 2048 + k * 1024); } while (0)
#define PG8_MMA(ai, bj, At, Bt) do { __builtin_amdgcn_s_setprio(1); _Pragma("unroll") for (int m = 0; m < 4; ++m) _Pragma("unroll") for (int n = 0; n < 2; ++n) _Pragma("unroll") for (int k = 0; k < 2; ++k) \
        acc[ai][bj][m][n] = __builtin_amdgcn_mfma_f32_16x16x32_bf16(Bt[n][k], At[m][k], acc[ai][bj][m][n], 0, 0, 0); __builtin_amdgcn_s_setprio(0); } while (0)
#define PG8_WAIT_V(n) asm volatile("s_waitcnt vmcnt(" #n ")" ::: "memory")
#define PG8_WAIT_L(n) asm volatile("s_waitcnt lgkmcnt(" #n ")" ::: "memory")
#define PG8_BAR __builtin_amdgcn_s_barrier()
#define PG8_SCHED __builtin_amdgcn_sched_barrier(0)
    Unit cur, nxt; int ui = 0;
    if (!S.next(0, cur)) return;
    f32x4 acc[2][2][4][2];
#pragma unroll
    for (int a = 0; a < 2; ++a)
#pragma unroll
        for (int b = 0; b < 2; ++b)
#pragma unroll
            for (int m = 0; m < 4; ++m)
#pragma unroll
                for (int n = 0; n < 2; ++n) acc[a][b][m][n] = (f32x4){0.f, 0.f, 0.f, 0.f};
    bf16x8 At[4][2], B0[2][2], B1[2][2];
    const char* cA = (const char*)g.A + (size_t)cur.pm * tstep; const char* cB = (const char*)g.Bt + (size_t)cur.pn * tstep;
    S.a_ready(cur);
    if constexpr (SP2) {
        PG8_STAGE(PG8_SB(0, 0), cB, voffB); PG8_STAGE(PG8_SB(0, 1), cB + hstep, voffB); PG8_STAGE(PG8_SA(0, 0), cA, voffA); PG8_STAGE(PG8_SA(0, 1), cA + hstep, voffA);
        if (wr == 1) PG8_BAR;
        PG8_WAIT_V(2); PG8_BAR;
        PG8_STAGE(PG8_SB(1, 0), cB + kstep, voffB); PG8_STAGE(PG8_SA(1, 0), cA + kstep, voffA); PG8_STAGE(PG8_SB(1, 1), cB + hstep + kstep, voffB);
        PG8_WAIT_V(6); PG8_BAR;
    } else {
        PG8_STAGE(PG8_SB(0, 0), cB, voffB); PG8_STAGE(PG8_SA(0, 0), cA, voffA); PG8_STAGE(PG8_SB(0, 1), cB + hstep, voffB); PG8_STAGE(PG8_SA(0, 1), cA + hstep, voffA);
        if (wr == 1) PG8_BAR;
        PG8_WAIT_V(4); PG8_BAR;
        PG8_STAGE(PG8_SB(1, 0), cB + kstep, voffB); PG8_STAGE(PG8_SA(1, 0), cA + kstep, voffA); PG8_STAGE(PG8_SB(1, 1), cB + hstep + kstep, voffB);
        PG8_WAIT_V(6); PG8_BAR;
    }
    for (;;) {
        const bool has_next = S.next(ui + 1, nxt);
        const char* nA = has_next ? (const char*)g.A + (size_t)nxt.pm * tstep : cA; const char* nB = has_next ? (const char*)g.Bt + (size_t)nxt.pn * tstep : cB;
        for (int t = 0; t < nt; t += 2) {
            const bool last = (t == nt - 2);
            const char* a1 = cA + (size_t)(t + 1) * kstep;
            const char* a2 = last ? nA : cA + (size_t)(t + 2) * kstep; const char* b2 = last ? nB : cB + (size_t)(t + 2) * kstep;
            const char* a3 = a2 + kstep; const char* b3 = b2 + kstep;
            if (last && has_next) S.a_ready(nxt);
            if constexpr (SP2) {
            PG8_LDB(B0, 0, 0); PG8_LDB(B1, 0, 1); PG8_SCHED; PG8_LDA(At, 0, 0); PG8_STAGE(PG8_SA(1, 1), a1 + hstep, voffA);
            PG8_WAIT_V(8); PG8_WAIT_L(0); PG8_BAR; PG8_MMA(0, 0, At, B0); PG8_MMA(0, 1, At, B1); PG8_BAR; PG8_SCHED;
            PG8_LDA(At, 0, 1); PG8_STAGE(PG8_SB(0, 0), b2, voffB); PG8_STAGE(PG8_SB(0, 1), b2 + hstep, voffB); PG8_STAGE(PG8_SA(0, 0), a2, voffA);
            PG8_WAIT_V(8); PG8_WAIT_L(0); PG8_BAR; PG8_MMA(1, 0, At, B0); PG8_MMA(1, 1, At, B1); PG8_BAR; PG8_SCHED;
            PG8_LDB(B0, 1, 0); PG8_LDB(B1, 1, 1); PG8_SCHED; PG8_LDA(At, 1, 0); PG8_STAGE(PG8_SA(0, 1), a2 + hstep, voffA);
            PG8_WAIT_V(8); PG8_WAIT_L(0); PG8_BAR; PG8_MMA(0, 0, At, B0); PG8_MMA(0, 1, At, B1); PG8_BAR; PG8_SCHED;
            PG8_LDA(At, 1, 1); PG8_STAGE(PG8_SB(1, 0), b3, voffB); PG8_STAGE(PG8_SB(1, 1), b3 + hstep, voffB); PG8_STAGE(PG8_SA(1, 0), a3, voffA);
            PG8_WAIT_V(8); PG8_WAIT_L(0); PG8_BAR; PG8_MMA(1, 0, At, B0); PG8_MMA(1, 1, At, B1); PG8_BAR; PG8_SCHED;
            } else {
            PG8_LDB(B0, 0, 0); PG8_SCHED; PG8_LDA(At, 0, 0); PG8_STAGE(PG8_SA(1, 1), a1 + hstep, voffA);
            PG8_WAIT_L(8); PG8_BAR; PG8_WAIT_L(0); PG8_MMA(0, 0, At, B0); PG8_BAR; PG8_SCHED;
            PG8_LDB(B1, 0, 1); PG8_STAGE(PG8_SB(0, 0), b2, voffB);
            PG8_BAR; PG8_WAIT_L(0); PG8_MMA(0, 1, At, B1); PG8_BAR;
            PG8_LDA(At, 0, 1); PG8_STAGE(PG8_SA(0, 0), a2, voffA);
            PG8_BAR; PG8_WAIT_L(0); PG8_MMA(1, 0, At, B0); PG8_BAR; PG8_SCHED;
            PG8_STAGE(PG8_SB(0, 1), b2 + hstep, voffB);
            PG8_WAIT_V(6); PG8_BAR; PG8_MMA(1, 1, At, B1); PG8_BAR;
            PG8_LDB(B0, 1, 0); PG8_SCHED; PG8_LDA(At, 1, 0); PG8_STAGE(PG8_SA(0, 1), a2 + hstep, voffA);
            PG8_WAIT_L(8); PG8_BAR; PG8_WAIT_L(0); PG8_MMA(0, 0, At, B0); PG8_BAR; PG8_SCHED;
            PG8_LDB(B1, 1, 1); PG8_STAGE(PG8_SB(1, 0), b3, voffB);
            PG8_BAR; PG8_WAIT_L(0); PG8_MMA(0, 1, At, B1); PG8_BAR;
            PG8_LDA(At, 1, 1); PG8_STAGE(PG8_SA(1, 0), a3, voffA);
            PG8_BAR; PG8_WAIT_L(0); PG8_MMA(1, 0, At, B0); PG8_BAR; PG8_SCHED;
            PG8_STAGE(PG8_SB(1, 1), b3 + hstep, voffB);
            PG8_WAIT_V(6); PG8_BAR; PG8_MMA(1, 1, At, B1); PG8_BAR;
            }
        }
        if constexpr (ALIGN_EPI) { if (wr == 0) PG8_BAR; }
        if constexpr (!Epi::AFTER_DRAIN) { E(acc, cur, wr, wc, fr, fq); S.done(cur); }
        if (!has_next) break;
#pragma unroll
        for (int a = 0; a < 2; ++a)
#pragma unroll
            for (int b = 0; b < 2; ++b)
#pragma unroll
                for (int m = 0; m < 4; ++m)
#pragma unroll
                    for (int n = 0; n < 2; ++n) acc[a][b][m][n] = (f32x4){0.f, 0.f, 0.f, 0.f};
        cur = nxt; cA = nA; cB = nB; ++ui;
        if constexpr (ALIGN_EPI) { if (wr == 1) PG8_BAR; }
    }
    PG8_WAIT_V(0);
    if constexpr (!ALIGN_EPI) { if (wr == 0) PG8_BAR; }
    PG8_BAR;
    if constexpr (Epi::AFTER_DRAIN) { E.fused(acc, cur, wr, wc, fr, fq, lds, wid, lane); S.done(cur); }
#undef PG8_SA
#undef PG8_SB
#undef PG8_STAGE
#undef PG8_LDA
#undef PG8_LDB
#undef PG8_MMA
#undef PG8_WAIT_V
#undef PG8_WAIT_L
#undef PG8_BAR
#undef PG8_SCHED
}
}

#ifndef PG8_SP2
#define PG8_SP2 true
#endif
#ifndef PG8_ALIGN
#define PG8_ALIGN true
#endif
#define GAS __attribute__((address_space(1)))
#define LAS __attribute__((address_space(3)))
typedef unsigned short bf16;
typedef unsigned v4u __attribute__((ext_vector_type(4)));
typedef float f32x4 __attribute__((ext_vector_type(4)));
typedef short bf16x8 __attribute__((ext_vector_type(8)));
typedef GAS unsigned gu32;
typedef GAS unsigned long long gu64;
#define RLX_AGENT __ATOMIC_RELAXED, __HIP_MEMORY_SCOPE_AGENT
#define LDS_WAIT() asm volatile("s_waitcnt lgkmcnt(0)" ::: "memory")
#define VM_WAIT() asm volatile("s_waitcnt vmcnt(0)" ::: "memory")
__device__ __forceinline__ unsigned long long rt() { return __builtin_amdgcn_s_memrealtime(); }
__device__ __forceinline__ unsigned f2bf(float f) { unsigned u = __builtin_bit_cast(unsigned, f); return (u + 0x7fffu + ((u >> 16) & 1u)) >> 16; }
__device__ __forceinline__ unsigned pk2(float lo, float hi) { typedef float f2_ __attribute__((ext_vector_type(2))); typedef __bf16 b2_ __attribute__((ext_vector_type(2))); f2_ v = {lo, hi}; b2_ b = __builtin_convertvector(v, b2_); return __builtin_bit_cast(unsigned, b); }

#define XB_TMO      128
#define XB_XCNT(j)  (256  + 64 * (j))
#define XB_XSUB(j)  (1280 + 64 * (j))
#define XB_XGEN(j)  (2304 + 64 * (j))
#define XB_TOP      3328
#define XB_TOPGEN   3392
#define XCD_BAR_WORDS 3456
#define XB_SPIN_CAP (1u << 18)

__device__ __forceinline__ unsigned xb_ld(unsigned* p)              { return __hip_atomic_load(p, __ATOMIC_RELAXED, __HIP_MEMORY_SCOPE_AGENT); }
__device__ __forceinline__ unsigned xb_add(unsigned* p, unsigned v) { return __hip_atomic_fetch_add(p, v, __ATOMIC_RELAXED, __HIP_MEMORY_SCOPE_AGENT); }
__device__ __forceinline__ unsigned xb_xcc_id() { return (unsigned)__builtin_amdgcn_s_getreg((3 << 11) | 20) & 0xFu; }
#define XB_SPIN(cond, bar) do { unsigned _sp = 0; while (cond) { __builtin_amdgcn_s_sleep(1); \
    if ((++_sp & 255u) == 0u) { if (xb_ld(&(bar)[XB_TMO])) break; if (_sp > XB_SPIN_CAP) { atomicAdd(&(bar)[XB_TMO], 1u); break; } } } } while (0)

struct XcdBarrier {
    unsigned* bar; unsigned x;
    volatile LAS unsigned* st;
};

__device__ __forceinline__ XcdBarrier xcd_barrier_post(unsigned* bar, volatile LAS unsigned* st) {
    XcdBarrier b; b.bar = bar; b.x = xb_xcc_id(); b.st = st;
    if (threadIdx.x == 0) (void)xb_add(&bar[XB_XCNT(b.x)], 1u);
    return b;
}
__device__ __forceinline__ void xcd_barrier_complete(unsigned* bar, unsigned x, unsigned& nloc, unsigned& nx) {
    const unsigned G = gridDim.x * gridDim.y * gridDim.z;
    unsigned sum, cnt, mine, sp = 0u;
    for (;;) {
        sum = 0u; cnt = 0u; mine = 0u;
#pragma unroll
        for (unsigned j = 0; j < 16; ++j) { const unsigned c = xb_ld(&bar[XB_XCNT(j)]); sum += c; cnt += (c > 0u) ? 1u : 0u; mine = (j == x) ? c : mine; }
        if (sum == G) break;
        __builtin_amdgcn_s_sleep(1);
        if ((++sp & 255u) == 0u) { if (xb_ld(&bar[XB_TMO])) break; if (sp > XB_SPIN_CAP) { atomicAdd(&bar[XB_TMO], 1u); break; } }
    }
    nloc = mine > 0u ? mine : 1u; nx = cnt > 0u ? cnt : 1u;
}

__device__ __forceinline__ void xcd_barrier(const XcdBarrier& b) {
    asm volatile("s_waitcnt vmcnt(0)" ::: "memory");
    __syncthreads();
    if (threadIdx.x == 0) {
        unsigned* bar = b.bar;
        __builtin_amdgcn_s_waitcnt(0);
        unsigned nloc = b.st[0], nx = b.st[1];
        if (nloc == 0u) { xcd_barrier_complete(bar, b.x, nloc, nx); b.st[0] = nloc; b.st[1] = nx; }
        const unsigned old = xb_add(&bar[XB_XSUB(b.x)], 1u);
        const unsigned gen = old / nloc;
        if (old + 1u == (gen + 1u) * nloc) {
            __builtin_amdgcn_fence(__ATOMIC_RELEASE, "agent");
            asm volatile("s_waitcnt vmcnt(0)" ::: "memory");
            const unsigned og = xb_add(&bar[XB_TOP], 1u);
            const unsigned tg = og / nx;
            if (og + 1u == (tg + 1u) * nx) xb_add(&bar[XB_TOPGEN], 1u);
            else XB_SPIN(xb_ld(&bar[XB_TOPGEN]) == tg, bar);
            __builtin_amdgcn_fence(__ATOMIC_ACQUIRE, "agent");
            xb_add(&bar[XB_XGEN(b.x)], 1u);
            asm volatile("s_waitcnt vmcnt(0)" ::: "memory");
        } else {
            XB_SPIN(xb_ld(&bar[XB_XGEN(b.x)]) == gen, bar);
            __builtin_amdgcn_fence(__ATOMIC_ACQUIRE, "agent");
            asm volatile("s_waitcnt vmcnt(0)" ::: "memory");
        }
    }
    __syncthreads();
}


constexpr int NWAVES = 8;
constexpr int DM = 1024, SEQ = 4096, NBP = 4, NBS = 32, TS = 8;
constexpr int MP = NBP * SEQ, MS = NBS * TS, MT = MP + MS;
constexpr int NH = 8, HD = 64, DSSM = 512, NST = 128, IN_LD = 3080, NIN = 3072;
constexpr int DFF = 2816, DFF2 = 5632, DPLE = 256, WBUF = 2048;
constexpr float EPS = 1e-6f, LOG2E = 1.4426950408889634f, C2 = 0.125f * 1.4426950408889634f;
constexpr int PC_K = 512, PC_V = 1024, PC_Z = 1536, PC_X = 2048;
constexpr size_t O_Y = 0, O_YS = 16777216, O_KP = 17039360, O_VP = 21233664, O_KS = 25427968, O_VS = 25559040, O_SP = 25690112, O_SS = 25952256,
                 O_CP = 28049408, O_CS = 28061696, O_FP = 28160000, O_FS = 28205056, O_END = 28565504;
constexpr size_t MiB = 1u << 20;
constexpr size_t WS_CTL = 0, CTL_ZERO_BYTES = 1 * MiB;
constexpr size_t WS_RS1 = 256 * 1024, WS_RSE = 384 * 1024, WS_RS3 = 512 * 1024;
constexpr size_t WS_WIN = 2 * MiB, WS_WOUT = 8 * MiB, WS_WUP = 10 * MiB, WS_WDOWN = 21 * MiB, WS_WPLE = 27 * MiB, WS_WGATE = 28 * MiB;
constexpr size_t WS_DT = 30 * MiB, WS_PB = 31 * MiB, WS_XN = 40 * MiB, WS_MIX = 73 * MiB, WS_H1 = 106 * MiB, WS_E = 171 * MiB;
constexpr size_t WS_PROJ = 236 * MiB, WS_OBR = 334 * MiB, WS_LSE = 382 * MiB, WS_XBS = 384 * MiB, WS_XC = 385 * MiB, WS_CC = 402 * MiB, WS_CS = 410 * MiB, WS_PREV = 442 * MiB,
                 WS_ACUM = 458 * MiB, WS_ACL = 458 * MiB + 768 * 1024, WS_YS = 459 * MiB;
constexpr size_t WS_U = 236 * MiB, WS_UH = 236 * MiB, WS_US = 244 * MiB, WS_ACT = 415 * MiB, WS_END = 505 * MiB;
static_assert(WS_PROJ + (size_t)MT * NIN * 2 <= WS_OBR && WS_OBR + (size_t)3 * MP * 512 * 2 <= WS_LSE && WS_LSE + (size_t)3 * MP * 8 * 4 <= WS_XBS, "ws map A");
static_assert(WS_XBS + (size_t)MS * 1024 * 4 <= WS_XC && WS_XC + (size_t)MT * 512 * 2 <= WS_CC && WS_CC + (size_t)MP * 256 * 2 <= WS_CS && WS_CS + (size_t)MP / 128 * 8 * 64 * 128 * 4 <= WS_PREV && WS_PREV + (size_t)MP / 128 * 8 * 64 * 128 * 2 <= WS_ACUM && WS_ACUM + (size_t)MP * 8 * 4 <= WS_ACL && WS_ACL + 4096 <= WS_YS && WS_YS + (size_t)MT * 512 * 4 <= WS_END, "ws map B");
static_assert(WS_U + (size_t)MT * DFF2 * 2 <= WS_ACT && WS_ACT + (size_t)MT * DFF * 2 <= WS_END, "ws map C");
static_assert(WS_XN + (size_t)MT * DM * 2 <= WS_MIX && WS_MIX + (size_t)MT * DM * 2 <= WS_H1 && WS_H1 + (size_t)MT * DM * 4 <= WS_E && WS_E + (size_t)MT * DM * 4 <= WS_PROJ, "ws map D");
static_assert(WS_PB + (size_t)MT * DPLE * 2 <= WS_XN && WS_DT + (size_t)MT * 8 * 4 <= WS_PB, "ws map E");
constexpr int CW_TMO = 0, CW_BAR = 4096;
constexpr int RING_BYTES = 131072, LDSCTL_OFF = RING_BYTES, MISC_OFF = LDSCTL_OFF + 320, LDS_BYTES = 147456;

typedef float f32x16 __attribute__((ext_vector_type(16)));
typedef short v4i16_t __attribute__((ext_vector_type(4)));
typedef unsigned u32x2 __attribute__((ext_vector_type(2)));

__device__ const unsigned char BUCKET_TAB[3][132] = {
 {0,1,2,3,4,5,6,7,8,9,10,11,12,13,14,15,16,16,16,16,16,16,17,17,17,17,17,17,17,17,18,18,18,18,18,18,18,18,18,18,19,19,19,19,19,19,19,19,19,19,19,19,19,19,20,20,20,20,20,20,20,20,20,20,20,20,20,20,20,20,20,20,20,21,21,21,21,21,21,21,21,21,21,21,21,21,21,21,21,21,21,21,21,21,21,21,21,21,21,22,22,22,22,22,22,22,22,22,22,22,22,22,22,22,22,22,22,22,22,22,22,22,22,22,22,22,22,22,22,0,0,0},
 {0,4,8,12,16,16,17,17,18,18,19,19,19,19,20,20,20,20,20,21,21,21,21,21,21,22,22,22,22,22,22,22,22,22,23,23,23,23,23,23,23,23,23,23,23,23,24,24,24,24,24,24,24,24,24,24,24,24,24,24,24,24,25,25,25,25,25,25,25,25,25,25,25,25,25,25,25,25,25,25,25,25,25,26,26,26,26,26,26,26,26,26,26,26,26,26,26,26,26,26,26,26,26,26,26,26,26,26,26,26,26,26,26,27,27,27,27,27,27,27,27,27,27,27,27,27,27,27,27,0,0,0},
 {0,16,18,19,20,21,21,22,22,23,23,23,24,24,24,24,25,25,25,25,25,26,26,26,26,26,26,26,26,27,27,27,27,27,27,27,27,27,27,28,28,28,28,28,28,28,28,28,28,28,28,28,29,29,29,29,29,29,29,29,29,29,29,29,29,29,29,29,29,29,30,30,30,30,30,30,30,30,30,30,30,30,30,30,30,30,30,30,30,30,30,30,30,30,30,31,31,31,31,31,31,31,31,31,31,31,31,31,31,31,31,31,31,31,31,31,31,31,31,31,31,31,31,31,31,31,31,31,31,0,0,0}};

__device__ __forceinline__ float row16_sum(float v) {
    v += __builtin_bit_cast(float, __builtin_amdgcn_update_dpp(0, __builtin_bit_cast(int, v), 0xB1, 0xf, 0xf, true));
    v += __builtin_bit_cast(float, __builtin_amdgcn_update_dpp(0, __builtin_bit_cast(int, v), 0x4E, 0xf, 0xf, true));
    v += __builtin_bit_cast(float, __builtin_amdgcn_update_dpp(0, __builtin_bit_cast(int, v), 0x141, 0xf, 0xf, true));
    v += __builtin_bit_cast(float, __builtin_amdgcn_update_dpp(0, __builtin_bit_cast(int, v), 0x140, 0xf, 0xf, true));
    return v;
}
__device__ __forceinline__ float row16_max(float v) {
    v = fmaxf(v, __builtin_bit_cast(float, __builtin_amdgcn_update_dpp(__builtin_bit_cast(int, v), __builtin_bit_cast(int, v), 0xB1, 0xf, 0xf, false)));
    v = fmaxf(v, __builtin_bit_cast(float, __builtin_amdgcn_update_dpp(__builtin_bit_cast(int, v), __builtin_bit_cast(int, v), 0x4E, 0xf, 0xf, false)));
    v = fmaxf(v, __builtin_bit_cast(float, __builtin_amdgcn_update_dpp(__builtin_bit_cast(int, v), __builtin_bit_cast(int, v), 0x141, 0xf, 0xf, false)));
    v = fmaxf(v, __builtin_bit_cast(float, __builtin_amdgcn_update_dpp(__builtin_bit_cast(int, v), __builtin_bit_cast(int, v), 0x140, 0xf, 0xf, false)));
    return v;
}
__device__ __forceinline__ float wave_sum(float v) {
    v = row16_sum(v);
    auto s = __builtin_amdgcn_permlane16_swap(__float_as_uint(v), __float_as_uint(v), false, false);
    v = __uint_as_float(s[0]) + __uint_as_float(s[1]);
    auto t = __builtin_amdgcn_permlane32_swap(__float_as_uint(v), __float_as_uint(v), false, false);
    return __uint_as_float(t[0]) + __uint_as_float(t[1]);
}
__device__ __forceinline__ float wave_max(float v) {
    v = row16_max(v);
    auto s = __builtin_amdgcn_permlane16_swap(__float_as_uint(v), __float_as_uint(v), false, false);
    v = fmaxf(__uint_as_float(s[0]), __uint_as_float(s[1]));
    auto t = __builtin_amdgcn_permlane32_swap(__float_as_uint(v), __float_as_uint(v), false, false);
    return fmaxf(__uint_as_float(t[0]), __uint_as_float(t[1]));
}
__device__ __forceinline__ float bf2f(unsigned short b) { return __uint_as_float((unsigned)b << 16); }
__device__ __forceinline__ float bflo(unsigned w) { return __uint_as_float(w << 16); }
__device__ __forceinline__ float bfhi(unsigned w) { return __uint_as_float(w & 0xffff0000u); }
__device__ __forceinline__ float siluf(float x) { return x * __builtin_amdgcn_rcpf(1.f + __builtin_amdgcn_exp2f(-LOG2E * x)); }
__device__ __forceinline__ float softplusf(float x) { return fmaxf(x, 0.f) + log1pf(__expf(-fabsf(x))); }
__device__ __forceinline__ int crow(int r, int hi) { return (r & 3) + 8 * (r >> 2) + 4 * hi; }

__device__ __forceinline__ v4i16_t vtr(const LAS unsigned char* p) { return __builtin_amdgcn_ds_read_tr16_b64_v4i16((LAS v4i16_t*)p); }
__device__ __forceinline__ unsigned cvtpk_s(float lo, float hi) { typedef float f2 __attribute__((ext_vector_type(2))); typedef __bf16 b2 __attribute__((ext_vector_type(2))); f2 v = {lo, hi}; b2 b = __builtin_convertvector(v, b2); return __builtin_bit_cast(unsigned, b); }
struct Args { const float* in[28]; float* out; unsigned char* ws; int ph_lo, ph_hi, li, pad; };

struct EpiIn {
    static constexpr bool PERM = true, AFTER_DRAIN = false;
    pg8::bf16_t* PROJ; float* out;
    __device__ __forceinline__ void operator()(const pg8::f32x4 (&acc)[2][2][4][2], const pg8::Unit& u, int wr, int wc, int fr, int fq) const {
        const int pn = u.pn; const float sc = (pn < 2) ? C2 : 1.f;
        const int colb = pn * 256 + wc * 32 + 8 * fq;
#pragma unroll
        for (int ai = 0; ai < 2; ++ai)
#pragma unroll
            for (int m = 0; m < 4; ++m) {
                const int row = u.pm * 256 + ai * 128 + wr * 64 + m * 16 + fr;
#pragma unroll
                for (int bj = 0; bj < 2; ++bj) {
                    const int col = colb + bj * 128; const pg8::f32x4 v0 = acc[ai][bj][m][0], v1 = acc[ai][bj][m][1];
                    pg8::u32x4 w; w.x = pg8::cvt_pk_bf16(v0[0] * sc, v0[1] * sc); w.y = pg8::cvt_pk_bf16(v0[2] * sc, v0[3] * sc); w.z = pg8::cvt_pk_bf16(v1[0] * sc, v1[1] * sc); w.w = pg8::cvt_pk_bf16(v1[2] * sc, v1[3] * sc);
                    *(pg8::u32x4*)(PROJ + (unsigned)(row * NIN + col)) = w;
                    float* dst = nullptr;
                    if (pn >= 2 && pn < 6) {
                        const bool isk = pn < 4; const int c = col - (isk ? PC_K : PC_V);
                        if (row < MP) { const int t = row & (SEQ - 1), b = row >> 12; if (t >= SEQ - WBUF) dst = out + (isk ? O_KP : O_VP) + ((size_t)(b * WBUF + t - (SEQ - WBUF))) * 512 + c; }
                        else dst = out + (isk ? O_KS : O_VS) + (size_t)(row - MP) * 512 + c;
                    } else if (pn >= 8) {
                        const int c = col - PC_X;
                        if (row < MP) { const int t = row & (SEQ - 1), b = row >> 12; if (t >= SEQ - 3) dst = out + O_CP + (size_t)(b * 3 + t - (SEQ - 3)) * 1024 + c; }
                        else { const int r = row - MP, t = r & 7, b = r >> 3; if (t >= TS - 3) dst = out + O_CS + (size_t)(b * 3 + t - (TS - 3)) * 1024 + c; }
                    }
                    if (dst) { *(pg8::f32x4*)dst = v0; *(pg8::f32x4*)(dst + 4) = v1; }
                }
            }
    }
};
struct EpiOut {
    static constexpr bool PERM = false, AFTER_DRAIN = false;
    const float* xp; pg8::bf16_t* H1b; float* RS;
    __device__ __forceinline__ void operator()(const pg8::f32x4 (&acc)[2][2][4][2], const pg8::Unit& u, int wr, int wc, int fr, int fq) const {
        const int col0 = u.pn * 256 + wc * 32 + 4 * fq;
#pragma unroll
        for (int ai = 0; ai < 2; ++ai)
#pragma unroll
            for (int m = 0; m < 4; ++m) {
                const int row = u.pm * 256 + ai * 128 + wr * 64 + m * 16 + fr;
                const float* xrow = xp + (unsigned)(row * DM);
                float ss = 0.f;
#pragma unroll
                for (int bj = 0; bj < 2; ++bj)
#pragma unroll
                    for (int n = 0; n < 2; ++n) {
                        const int c = col0 + bj * 128 + n * 16;
                        const pg8::f32x4 h = *(const pg8::f32x4*)(xrow + c) + acc[ai][bj][m][n];
                        u32x2 w; w.x = pg8::cvt_pk_bf16(h[0], h[1]); w.y = pg8::cvt_pk_bf16(h[2], h[3]);
                        *(u32x2*)(H1b + (unsigned)(row * DM + c)) = w;
                        ss += (h[0] * h[0] + h[1] * h[1]) + (h[2] * h[2] + h[3] * h[3]);
                    }
                ss += __shfl_xor(ss, 16); ss += __shfl_xor(ss, 32);
                if (fq == 0) atomicAdd(RS + row, ss);
                asm volatile("" ::: "memory");
            }
    }
};
template <int CTRL> __device__ __forceinline__ unsigned dppu(unsigned x) { return (unsigned)__builtin_amdgcn_update_dpp(0, (int)x, CTRL, 0xf, 0xf, true); }
constexpr int XCH_OFF = 135168;
struct EpiUp {
    static constexpr bool PERM = true, AFTER_DRAIN = false;
    pg8::bf16_t* ACT; const float* RS; float* out; float* UH; float* US; const float* fw; const float* fb; LAS unsigned char* lds;
    __device__ __forceinline__ void operator()(pg8::f32x4 (&acc)[2][2][4][2], const pg8::Unit& u, int wr, int wc, int fr, int fq) const {
        asm volatile("" : "+v"(fr), "+v"(fq));
        const int jb = wc * 32 + 8 * fq, ca = u.pn * 128 + jb;
        const bool samp = u.pm >= MP / 256;
        unsigned P[2][2][4][2][2];
#pragma unroll
        for (int ai = 0; ai < 2; ++ai)
#pragma unroll
            for (int m = 0; m < 4; ++m) {
                const int rt = ai * 128 + wr * 64 + m * 16 + fr, row = u.pm * 256 + rt;
                const float rs = __builtin_amdgcn_rsqf(RS[row] * (1.f / DM) + EPS);
                float* d = nullptr; float* d2 = nullptr;
                if (samp) { d = US + (unsigned)(rt * DFF2); if ((rt & 7) >= TS - 2) d2 = out + O_FS + (size_t)((rt >> 3) * 2 + (rt & 7) - (TS - 2)) * DFF2; }
                else {
                    if (ai == 0 && m == 0 && wr == 0 && fr < 2) d = UH + (unsigned)((u.pm * 4 + fr) * DFF2);
                    if (ai == 1 && m == 3 && wr == 1 && fr >= 14) { d = UH + (unsigned)((u.pm * 4 + 2 + fr - 14) * DFF2); if ((u.pm & 15) == 15) d2 = out + O_FP + (size_t)((u.pm >> 4) * 2 + fr - 14) * DFF2; }
                }
#pragma unroll
                for (int bj = 0; bj < 2; ++bj) {
                    const pg8::f32x4 v0 = acc[ai][bj][m][0] * rs, v1 = acc[ai][bj][m][1] * rs;
                    if (d) { *(pg8::f32x4*)(d + bj * DFF + ca) = v0; *(pg8::f32x4*)(d + bj * DFF + ca + 4) = v1; }
                    if (d2) { *(pg8::f32x4*)(d2 + bj * DFF + ca) = v0; *(pg8::f32x4*)(d2 + bj * DFF + ca + 4) = v1; }
                    P[ai][bj][m][0][0] = pg8::cvt_pk_bf16(v0[0], v0[1]); P[ai][bj][m][0][1] = pg8::cvt_pk_bf16(v0[2], v0[3]);
                    P[ai][bj][m][1][0] = pg8::cvt_pk_bf16(v1[0], v1[1]); P[ai][bj][m][1][1] = pg8::cvt_pk_bf16(v1[2], v1[3]);
                }
            }
        LAS unsigned char* xch = lds + XCH_OFF;
        if (fr >= 14) {
#pragma unroll
            for (int ai = 0; ai < 2; ++ai)
#pragma unroll
                for (int bj = 0; bj < 2; ++bj)
                    *(LAS pg8::u32x4*)(xch + (((1 + 2 * ai + wr) * 2 + fr - 14) * 256 + bj * 128 + jb) * 2) = (pg8::u32x4){P[ai][bj][3][0][0], P[ai][bj][3][0][1], P[ai][bj][3][1][0], P[ai][bj][3][1][1]};
        }
        asm volatile("s_waitcnt lgkmcnt(0)" ::: "memory"); __builtin_amdgcn_s_barrier(); asm volatile("" ::: "memory");
#pragma unroll
        for (int ai = 0; ai < 2; ++ai) {
            const int q = 2 * ai + wr;
            pg8::u32x4 H2[2], H1[2];
#pragma unroll
            for (int bj = 0; bj < 2; ++bj) { H2[bj] = *(const LAS pg8::u32x4*)(xch + ((q * 2 + 0) * 256 + bj * 128 + jb) * 2); H1[bj] = *(const LAS pg8::u32x4*)(xch + ((q * 2 + 1) * 256 + bj * 128 + jb) * 2); }
#pragma unroll
            for (int n = 0; n < 2; ++n)
#pragma unroll
                for (int h = 0; h < 2; ++h) {
                    const int cc = ca + 4 * n + 2 * h;
                    typedef float f2t __attribute__((ext_vector_type(2)));
                    f2t W0[2], W1[2], W2[2], BB[2];
#pragma unroll
                    for (int bj = 0; bj < 2; ++bj) { const float* wp = fw + bj * DFF + cc; W0[bj] = *(const f2t*)wp; W1[bj] = *(const f2t*)(wp + DFF2); W2[bj] = *(const f2t*)(wp + 2 * DFF2); BB[bj] = *(const f2t*)(fb + bj * DFF + cc); }
#pragma unroll
                    for (int m = 3; m >= 0; --m) {
                        float y[2][2];
#pragma unroll
                        for (int bj = 0; bj < 2; ++bj) {
                            const unsigned cur = P[ai][bj][m][n][h];
                            const unsigned c1 = dppu<0x121>(cur), c2 = dppu<0x122>(cur);
                            unsigned q1, q2;
                            if (m > 0) { const unsigned pv = P[ai][bj][m > 0 ? m - 1 : 0][n][h]; q1 = dppu<0x121>(pv); q2 = dppu<0x122>(pv); }
                            else { const unsigned hh1 = H1[bj][2 * n + h], hh2 = H2[bj][2 * n + h]; q1 = hh1; q2 = (fr == 0) ? hh2 : hh1; }
                            const unsigned p1 = (fr >= 1) ? c1 : q1, p2 = (fr >= 2) ? c2 : q2;
                            y[bj][0] = BB[bj].x + W0[bj].x * bflo(p2) + W1[bj].x * bflo(p1) + W2[bj].x * bflo(cur);
                            y[bj][1] = BB[bj].y + W0[bj].y * bfhi(p2) + W1[bj].y * bfhi(p1) + W2[bj].y * bfhi(cur);
                        }
                        P[ai][0][m][n][h] = pg8::cvt_pk_bf16(siluf(y[0][0]) * y[1][0], siluf(y[0][1]) * y[1][1]);
                        __builtin_amdgcn_sched_barrier(0);
                    }
                }
        }
#pragma unroll
        for (int ai = 0; ai < 2; ++ai)
#pragma unroll
            for (int m = 0; m < 4; ++m) {
                const int row = u.pm * 256 + ai * 128 + wr * 64 + m * 16 + fr;
                *(pg8::u32x4*)(ACT + (unsigned)(row * DFF + ca)) = (pg8::u32x4){P[ai][0][m][0][0], P[ai][0][m][0][1], P[ai][0][m][1][0], P[ai][0][m][1][1]};
            }
    }
};
struct EpiDown {
    static constexpr bool PERM = false, AFTER_DRAIN = false;
    pg8::bf16_t* Hb; float psc;
    __device__ __forceinline__ void operator()(const pg8::f32x4 (&acc)[2][2][4][2], const pg8::Unit& u, int wr, int wc, int fr, int fq) const {
        const int col0 = u.pn * 256 + wc * 32 + 4 * fq;
#pragma unroll
        for (int ai = 0; ai < 2; ++ai)
#pragma unroll
            for (int m = 0; m < 4; ++m) {
                const int row = u.pm * 256 + ai * 128 + wr * 64 + m * 16 + fr;
#pragma unroll
                for (int bj = 0; bj < 2; ++bj)
#pragma unroll
                    for (int n = 0; n < 2; ++n) {
                        const int c = col0 + bj * 128 + n * 16; u32x2* hp = (u32x2*)(Hb + (unsigned)(row * DM + c));
                        const u32x2 o = *hp; const pg8::f32x4 a = acc[ai][bj][m][n] * psc;
                        u32x2 w; w.x = pg8::cvt_pk_bf16(bflo(o.x) + a[0], bfhi(o.x) + a[1]); w.y = pg8::cvt_pk_bf16(bflo(o.y) + a[2], bfhi(o.y) + a[3]);
                        *hp = w;
                    }
                asm volatile("" ::: "memory");
            }
    }
};
struct EpiPle {
    static constexpr bool PERM = false, AFTER_DRAIN = false;
    pg8::bf16_t* E; float* RS;
    __device__ __forceinline__ void operator()(const pg8::f32x4 (&acc)[2][2][4][2], const pg8::Unit& u, int wr, int wc, int fr, int fq) const {
        const int col0 = u.pn * 256 + wc * 32 + 4 * fq;
#pragma unroll
        for (int ai = 0; ai < 2; ++ai)
#pragma unroll
            for (int m = 0; m < 4; ++m) {
                const int row = u.pm * 256 + ai * 128 + wr * 64 + m * 16 + fr; float ss = 0.f;
#pragma unroll
                for (int bj = 0; bj < 2; ++bj)
#pragma unroll
                    for (int n = 0; n < 2; ++n) {
                        const int c = col0 + bj * 128 + n * 16; const pg8::f32x4 h = acc[ai][bj][m][n];
                        u32x2 w; w.x = pg8::cvt_pk_bf16(h[0], h[1]); w.y = pg8::cvt_pk_bf16(h[2], h[3]);
                        *(u32x2*)(E + (unsigned)(row * DM + c)) = w;
                        ss += (h[0] * h[0] + h[1] * h[1]) + (h[2] * h[2] + h[3] * h[3]);
                    }
                ss += __shfl_xor(ss, 16); ss += __shfl_xor(ss, 32);
                if (fq == 0) atomicAdd(RS + row, ss);
            }
    }
};
struct EpiGate {
    static constexpr bool PERM = false, AFTER_DRAIN = false;
    const pg8::bf16_t* H2b; const pg8::bf16_t* E; const float* RSE; const float* gple; pg8::bf16_t* H3b; float* RS3;
    __device__ __forceinline__ void operator()(const pg8::f32x4 (&acc)[2][2][4][2], const pg8::Unit& u, int wr, int wc, int fr, int fq) const {
        const int col0 = u.pn * 256 + wc * 32 + 4 * fq;
        pg8::f32x4 gp[2][2];
#pragma unroll
        for (int bj = 0; bj < 2; ++bj)
#pragma unroll
            for (int n = 0; n < 2; ++n) gp[bj][n] = *(const pg8::f32x4*)(gple + col0 + bj * 128 + n * 16);
#pragma unroll
        for (int ai = 0; ai < 2; ++ai)
#pragma unroll
            for (int m = 0; m < 4; ++m) {
                const int row = u.pm * 256 + ai * 128 + wr * 64 + m * 16 + fr;
                const float rse = 1.0f / sqrtf(RSE[row] * (1.f / DM) + EPS);
                float ss = 0.f;
#pragma unroll
                for (int bj = 0; bj < 2; ++bj)
#pragma unroll
                    for (int n = 0; n < 2; ++n) {
                        const int c = col0 + bj * 128 + n * 16; const unsigned o = (unsigned)(row * DM + c);
                        const pg8::f32x4 a = acc[ai][bj][m][n]; const u32x2 eb = *(const u32x2*)(E + o), hb = *(const u32x2*)(H2b + o);
                        const float e4[4] = {bflo(eb.x), bfhi(eb.x), bflo(eb.y), bfhi(eb.y)}, h4[4] = {bflo(hb.x), bfhi(hb.x), bflo(hb.y), bfhi(hb.y)};
                        float h[4];
#pragma unroll
                        for (int k = 0; k < 4; ++k) { const float g = 1.f / (1.f + __expf(-a[k])); h[k] = h4[k] + g * (e4[k] * rse * gp[bj][n][k]); }
                        u32x2 w; w.x = pg8::cvt_pk_bf16(h[0], h[1]); w.y = pg8::cvt_pk_bf16(h[2], h[3]);
                        *(u32x2*)(H3b + o) = w;
                        ss += (h[0] * h[0] + h[1] * h[1]) + (h[2] * h[2] + h[3] * h[3]);
                    }
                ss += __shfl_xor(ss, 16); ss += __shfl_xor(ss, 32);
                if (fq == 0) atomicAdd(RS3 + row, ss);
                asm volatile("" ::: "memory");
            }
    }
};

__device__ __forceinline__ void load8bf(const bf16* p, float (&o)[8]) {
    const v4u w = *(const v4u*)p;
    o[0] = bflo(w.x); o[1] = bfhi(w.x); o[2] = bflo(w.y); o[3] = bfhi(w.y); o[4] = bflo(w.z); o[5] = bfhi(w.z); o[6] = bflo(w.w); o[7] = bfhi(w.w);
}
__device__ __forceinline__ void load8f(const float* p, float (&o)[8]) {
    const f32x4 a = *(const f32x4*)p, b = *(const f32x4*)(p + 4);
    o[0] = a.x; o[1] = a.y; o[2] = a.z; o[3] = a.w; o[4] = b.x; o[5] = b.y; o[6] = b.z; o[7] = b.w;
}
__device__ __forceinline__ void p0_transpose_item(const float* W, int ldn, int K, int N, bf16* WT, const float* gk, LAS float* scr, int item, int lane, bool upperm = false) {
    const int nblk = N / 32, kb = item / nblk, nb = item % nblk, k0 = 64 * kb, n0 = 32 * nb;
    const int nd0 = !upperm ? n0 : (n0 < DFF ? 256 * (n0 >> 7) + (n0 & 127) : 256 * ((n0 - DFF) >> 7) + 128 + ((n0 - DFF) & 127));
    const float* src = W + (size_t)(k0 + (lane >> 5)) * ldn + n0 + (lane & 31);
    float wv[32];
#pragma unroll
    for (int i = 0; i < 32; ++i) wv[i] = src[(size_t)(2 * i) * ldn];
#pragma unroll
    for (int i = 0; i < 32; ++i) scr[(2 * i + (lane >> 5)) * 33 + (lane & 31)] = wv[i];
    const int c = lane & 7;
    float g8[8];
    if (gk) load8f(gk + k0 + 8 * c, g8); else {
#pragma unroll
        for (int j = 0; j < 8; ++j) g8[j] = 1.f; }
    LDS_WAIT(); asm volatile("" ::: "memory");
#pragma unroll
    for (int j = 0; j < 4; ++j) { const int n = (lane >> 3) + 8 * j; const LAS float* sp = scr + (8 * c) * 33 + n;
        v4u o; o.x = pk2(sp[0 * 33] * g8[0], sp[1 * 33] * g8[1]); o.y = pk2(sp[2 * 33] * g8[2], sp[3 * 33] * g8[3]); o.z = pk2(sp[4 * 33] * g8[4], sp[5 * 33] * g8[5]); o.w = pk2(sp[6 * 33] * g8[6], sp[7 * 33] * g8[7]);
        *(GAS v4u*)(WT + (size_t)(nd0 + n) * K + k0 + 8 * c) = o; }
    LDS_WAIT(); asm volatile("" ::: "memory");
}
__device__ __forceinline__ void p0_prologue(const Args& a, LAS unsigned char* lds, int gw, int NGW, int wave, int lane, int part = 3) {
    unsigned char* ws = a.ws;
    LAS float* scr = (LAS float*)(lds + wave * 8704);
    constexpr int I_IN = (DM / 64) * (NIN / 32), I_OUT = (DM / 64) * (DM / 32), I_UP = (DM / 64) * (DFF2 / 32), I_DN = (DFF / 64) * (DM / 32), I_PLE = (DPLE / 64) * (DM / 32), I_G = I_OUT;
    constexpr int NITEMS = I_IN + I_OUT + I_UP + I_DN + I_PLE + I_G;
    if (part & 1) for (int it = gw; it < NITEMS; it += NGW) {
        int r = it;
        if (r < I_IN)  { p0_transpose_item(a.in[11], IN_LD, DM, NIN, (bf16*)(ws + WS_WIN), a.in[10], scr, r, lane); continue; } r -= I_IN;
        if (r < I_OUT) { p0_transpose_item(a.in[18], DM, DM, DM, (bf16*)(ws + WS_WOUT), nullptr, scr, r, lane); continue; } r -= I_OUT;
        if (r < I_UP)  { p0_transpose_item(a.in[20], DFF2, DM, DFF2, (bf16*)(ws + WS_WUP), a.in[19], scr, r, lane, true); continue; } r -= I_UP;
        if (r < I_DN)  { p0_transpose_item(a.in[23], DM, DFF, DM, (bf16*)(ws + WS_WDOWN), nullptr, scr, r, lane); continue; } r -= I_DN;
        if (r < I_PLE) { p0_transpose_item(a.in[24], DM, DPLE, DM, (bf16*)(ws + WS_WPLE), nullptr, scr, r, lane); continue; } r -= I_PLE;
        p0_transpose_item(a.in[26], DM, DM, DM, (bf16*)(ws + WS_WGATE), nullptr, scr, r, lane);
    }
    const float* gmix = a.in[10]; const float* win = a.in[11]; const float* dtb = a.in[14];
    bf16* XN = (bf16*)(ws + WS_XN); bf16* PB = (bf16*)(ws + WS_PB); float* DT = (float*)(ws + WS_DT);
    LAS unsigned char* dtw = lds + 81920;
    for (int k = threadIdx.x; k < DM; k += NWAVES * 64) {
        const float gk = gmix[k]; const f32x4 w0 = *(const f32x4*)(win + (size_t)k * IN_LD + NIN) * gk, w1 = *(const f32x4*)(win + (size_t)k * IN_LD + NIN + 4) * gk;
        LAS f32x4* d = (LAS f32x4*)(dtw + (k >> 2) * 144 + (k & 3) * 32); d[0] = w0; d[1] = w1;
    }
    LDS_WAIT(); __syncthreads();
    f32x4 vn[4];
    if (gw < MT) { const float* xrow = (gw < MP) ? a.in[0] + (size_t)gw * DM : a.in[1] + (size_t)(gw - MP) * DM;
#pragma unroll
        for (int j = 0; j < 4; ++j) vn[j] = ((const GAS f32x4*)xrow + lane)[64 * j]; }
    if (part & 2) for (int m = gw; m < MT; m += NGW) {
        f32x4 v[4]; float s = 0.f;
#pragma unroll
        for (int j = 0; j < 4; ++j) { v[j] = vn[j]; s += (v[j].x * v[j].x + v[j].y * v[j].y) + (v[j].z * v[j].z + v[j].w * v[j].w); }
        { const int mn = m + NGW; if (mn < MT) { const float* xrow = (mn < MP) ? a.in[0] + (size_t)mn * DM : a.in[1] + (size_t)(mn - MP) * DM;
#pragma unroll
            for (int j = 0; j < 4; ++j) vn[j] = ((const GAS f32x4*)xrow + lane)[64 * j]; } }
        const float rstd = 1.0f / sqrtf(wave_sum(s) * (1.f / DM) + EPS);
        GAS unsigned long long* o8 = (GAS unsigned long long*)(XN + (size_t)m * DM) + lane;
        float dacc[8];
#pragma unroll
        for (int h = 0; h < 8; ++h) dacc[h] = 0.f;
#pragma unroll
        for (int j = 0; j < 4; ++j) {
            v[j] = v[j] * rstd;
            o8[64 * j] = (unsigned long long)pk2(v[j].x, v[j].y) | ((unsigned long long)pk2(v[j].z, v[j].w) << 32);
#pragma unroll
            for (int e = 0; e < 4; ++e) {
                const float xv = v[j][e];
                const LAS f32x4* d = (const LAS f32x4*)(dtw + (64 * j + lane) * 144 + e * 32);
                const f32x4 w0 = d[0], w1 = d[1];
                dacc[0] += xv * w0.x; dacc[1] += xv * w0.y; dacc[2] += xv * w0.z; dacc[3] += xv * w0.w;
                dacc[4] += xv * w1.x; dacc[5] += xv * w1.y; dacc[6] += xv * w1.z; dacc[7] += xv * w1.w;
            }
        }
#pragma unroll
        for (int h = 0; h < 8; ++h) dacc[h] = softplusf(wave_sum(dacc[h]) + dtb[h]);
        if (lane == 0) { *(f32x4*)(DT + (size_t)m * 8) = (f32x4){dacc[0], dacc[1], dacc[2], dacc[3]}; *(f32x4*)(DT + (size_t)m * 8 + 4) = (f32x4){dacc[4], dacc[5], dacc[6], dacc[7]}; }
        const float* prow = (m < MP) ? a.in[2] + (size_t)m * DPLE : a.in[3] + (size_t)(m - MP) * DPLE;
        const f32x4 pv = *((const f32x4*)prow + lane);
        *((GAS unsigned long long*)(PB + (size_t)m * DPLE) + lane) = (unsigned long long)pk2(pv.x, pv.y) | ((unsigned long long)pk2(pv.z, pv.w) << 32);
    }
}

__device__ __forceinline__ void conv_sample_pass(const Args& a, int gtid, int NT) {
    const bf16* PROJ = (const bf16*)(a.ws + WS_PROJ); float* XB = (float*)(a.ws + WS_XBS); bf16* XC = (bf16*)(a.ws + WS_XC);
    const float* cw = a.in[12]; const float* cb = a.in[13]; const float* sconv = a.in[7];
    for (int it = gtid; it < NBS * 128; it += NT) {
        const int b = it >> 7, c = (it & 127) * 8, m0 = MP + b * 8;
        float w0[8], w1[8], w2[8], w3[8], bb[8], x3[8], x2[8], x1[8];
        load8f(cw + c, w0); load8f(cw + 1024 + c, w1); load8f(cw + 2048 + c, w2); load8f(cw + 3072 + c, w3); load8f(cb + c, bb);
        load8f(sconv + (size_t)(b * 3 + 0) * 1024 + c, x3); load8f(sconv + (size_t)(b * 3 + 1) * 1024 + c, x2); load8f(sconv + (size_t)(b * 3 + 2) * 1024 + c, x1);
#pragma unroll
        for (int r = 0; r < 8; ++r) {
            float cur[8], y[8]; load8bf(PROJ + (size_t)(m0 + r) * NIN + PC_X + c, cur);
#pragma unroll
            for (int k = 0; k < 8; ++k) { y[k] = siluf(bb[k] + w0[k] * x3[k] + w1[k] * x2[k] + w2[k] * x1[k] + w3[k] * cur[k]); x3[k] = x2[k]; x2[k] = x1[k]; x1[k] = cur[k]; }
            float* o = XB + (size_t)(b * 8 + r) * 1024 + c;
            *(f32x4*)o = (f32x4){y[0], y[1], y[2], y[3]}; *(f32x4*)(o + 4) = (f32x4){y[4], y[5], y[6], y[7]};
            if (c < 512) { v4u w; w.x = pk2(y[0], y[1]); w.y = pk2(y[2], y[3]); w.z = pk2(y[4], y[5]); w.w = pk2(y[6], y[7]); *(v4u*)(XC + (size_t)(m0 + r) * 512 + c) = w; }
        }
    }
}

#ifndef S1SUB
#define S1SUB 7
#endif
constexpr int S1_BR = 0, S1_CR = 32768, S1_BT = 65536, S1_XT = 98304, S1_XW = 114688, S1_AC = 133120;
__device__ __forceinline__ void ssd_s1_unit(const Args& a, LAS unsigned char* lds, int unit, int tid, int wave, int lane) {
    asm volatile("" : "+v"(tid), "+v"(lane));
    const int h = unit & 7, c = (unit >> 3) & 31, b = unit >> 8, g = h >> 2, m0 = b * SEQ + c * 128;
    const bf16* PROJ = (const bf16*)(a.ws + WS_PROJ); const float* DT = (const float*)(a.ws + WS_DT);
    LAS float* ac = (LAS float*)(lds + S1_AC); LAS float* dts = ac + 128;
    const int r32 = lane & 31, hh = lane >> 5;
    const int o = tid % 40, rc = tid / 40, s0 = rc * 11;
    const int xcol = (o < 8) ? h * 64 + 8 * o : (o < 24) ? 512 + g * 128 + 8 * (o - 8) : 768 + g * 128 + 8 * (o - 24);
    const bool cact = tid < 480;
    v4u raw[14];
    if (cact) {
#pragma unroll
        for (int i = 0; i < 14; ++i) { int sr = s0 - 3 + i; sr = sr > 127 ? 127 : sr; if (c == 0 && sr < 0) sr = 0; raw[i] = *(const v4u*)(PROJ + (size_t)(m0 + sr) * NIN + PC_X + xcol); }
    }
    if (wave == 0) {
        const float A = -__expf(a.in[15][h]);
        const float d0 = DT[(size_t)(m0 + 2 * lane) * 8 + h], d1 = DT[(size_t)(m0 + 2 * lane + 1) * 8 + h];
        const float a0 = d0 * A, a1 = d1 * A; float v = a0 + a1;
#pragma unroll
        for (int d = 1; d < 64; d <<= 1) { const float n = __shfl_up(v, d); if (lane >= d) v += n; }
        const float e0 = v - a1, e1 = v;
        ac[2 * lane] = e0; ac[2 * lane + 1] = e1; dts[2 * lane] = d0; dts[2 * lane + 1] = d1;
        float* ACUM = (float*)(a.ws + WS_ACUM); ACUM[(size_t)(m0 + 2 * lane) * 8 + h] = e0; ACUM[(size_t)(m0 + 2 * lane + 1) * 8 + h] = e1;
        if (lane == 63) ((float*)(a.ws + WS_ACL))[(b * 32 + c) * 8 + h] = e1;
    }
    __syncthreads();
    if ((S1SUB & 1) && cact) {
        const float* cw = a.in[12]; const float* cb = a.in[13];
        float w0[8], w1[8], w2[8], w3[8], bb[8], x3[8], x2[8], x1[8];
        load8f(cw + xcol, w0); load8f(cw + 1024 + xcol, w1); load8f(cw + 2048 + xcol, w2); load8f(cw + 3072 + xcol, w3); load8f(cb + xcol, bb);
        const bool z0 = (c == 0 && rc == 0);
        { const v4u r3 = raw[0], r2 = raw[1], r1 = raw[2];
          x3[0] = bflo(r3.x); x3[1] = bfhi(r3.x); x3[2] = bflo(r3.y); x3[3] = bfhi(r3.y); x3[4] = bflo(r3.z); x3[5] = bfhi(r3.z); x3[6] = bflo(r3.w); x3[7] = bfhi(r3.w);
          x2[0] = bflo(r2.x); x2[1] = bfhi(r2.x); x2[2] = bflo(r2.y); x2[3] = bfhi(r2.y); x2[4] = bflo(r2.z); x2[5] = bfhi(r2.z); x2[6] = bflo(r2.w); x2[7] = bfhi(r2.w);
          x1[0] = bflo(r1.x); x1[1] = bfhi(r1.x); x1[2] = bflo(r1.y); x1[3] = bfhi(r1.y); x1[4] = bflo(r1.z); x1[5] = bfhi(r1.z); x1[6] = bflo(r1.w); x1[7] = bfhi(r1.w);
          if (z0) {
#pragma unroll
              for (int k = 0; k < 8; ++k) { x3[k] = 0.f; x2[k] = 0.f; x1[k] = 0.f; } } }
        const float aL = ac[127];
        bf16* XC = (bf16*)(a.ws + WS_XC); bf16* CC = (bf16*)(a.ws + WS_CC);
#pragma unroll
        for (int r = 0; r < 11; ++r) {
            const int sr = s0 + r;
            if (sr < 128) {
                const v4u rw = raw[3 + r]; float cur[8], y[8];
                cur[0] = bflo(rw.x); cur[1] = bfhi(rw.x); cur[2] = bflo(rw.y); cur[3] = bfhi(rw.y); cur[4] = bflo(rw.z); cur[5] = bfhi(rw.z); cur[6] = bflo(rw.w); cur[7] = bfhi(rw.w);
#pragma unroll
                for (int k = 0; k < 8; ++k) { y[k] = siluf(bb[k] + w0[k] * x3[k] + w1[k] * x2[k] + w2[k] * x1[k] + w3[k] * cur[k]); x3[k] = x2[k]; x2[k] = x1[k]; x1[k] = cur[k]; }
                v4u w; w.x = pk2(y[0], y[1]); w.y = pk2(y[2], y[3]); w.z = pk2(y[4], y[5]); w.w = pk2(y[6], y[7]);
                if (o < 8) {
                    const int off = (o >> 2) * 8192 + (sr >> 4) * 1024 + (sr & 15) * 64 + (o & 3) * 16;
                    *(LAS v4u*)(lds + S1_XT + off) = w;
                    const float de = __expf(aL - ac[sr]) * dts[sr];
                    v4u ww; ww.x = pk2(y[0] * de, y[1] * de); ww.y = pk2(y[2] * de, y[3] * de); ww.z = pk2(y[4] * de, y[5] * de); ww.w = pk2(y[6] * de, y[7] * de);
                    *(LAS v4u*)(lds + S1_XW + off) = ww;
                    *(v4u*)(XC + (size_t)(m0 + sr) * 512 + h * 64 + 8 * o) = w;
                } else if (o < 24) {
                    const int ch = o - 8;
                    *(LAS v4u*)(lds + S1_BR + sr * 256 + ((ch ^ (sr & 15)) << 4)) = w;
                    *(LAS v4u*)(lds + S1_BT + (ch >> 2) * 8192 + (sr >> 4) * 1024 + (sr & 15) * 64 + (ch & 3) * 16) = w;
                } else {
                    const int ch = o - 24;
                    *(LAS v4u*)(lds + S1_CR + sr * 256 + ((ch ^ (sr & 15)) << 4)) = w;
                    if ((h & 3) == 0) *(v4u*)(CC + (size_t)(m0 + sr) * 256 + g * 128 + 8 * ch) = w;
                }
            }
        }
    }
    __syncthreads();
    const int laneoff = ((lane >> 4) & 1) * 32 + (lane & 3) * 8 + (4 * hh + ((lane & 15) >> 2)) * 64;
    if (S1SUB & 2) {
        const int tb = wave >> 1, ph = wave & 1, tq = 32 * tb + r32;
        bf16x8 cq[8];
#pragma unroll
        for (int k = 0; k < 8; ++k) cq[k] = *(const LAS bf16x8*)(lds + S1_CR + tq * 256 + (((2 * k + hh) ^ (tq & 15)) << 4));
        const float act = ac[tq] * LOG2E;
        f32x16 o;
#pragma unroll
        for (int i = 0; i < 16; ++i) o[i] = 0.f;
#pragma unroll 1
        for (int sb = 0; sb <= tb; ++sb) {
            {
                f32x16 S;
#pragma unroll
                for (int i = 0; i < 16; ++i) S[i] = 0.f;
                const int sq = 32 * sb + r32;
#pragma unroll
                for (int k = 0; k < 8; ++k) { const bf16x8 bf = *(const LAS bf16x8*)(lds + S1_BR + sq * 256 + (((2 * k + hh) ^ (sq & 15)) << 4)); S = __builtin_amdgcn_mfma_f32_32x32x16_bf16(bf, cq[k], S, 0, 0, 0); }
#pragma unroll
                for (int i = 0; i < 16; ++i) { const int si = 32 * sb + crow(i, hh); const float e = __builtin_amdgcn_exp2f(act - ac[si] * LOG2E) * dts[si]; S[i] = (si <= tq) ? S[i] * e : 0.f; }
#pragma unroll
                for (int ks = 0; ks < 2; ++ks) {
                    v4u pw; pw.x = cvtpk_s(S[8 * ks + 0], S[8 * ks + 1]); pw.y = cvtpk_s(S[8 * ks + 2], S[8 * ks + 3]); pw.z = cvtpk_s(S[8 * ks + 4], S[8 * ks + 5]); pw.w = cvtpk_s(S[8 * ks + 6], S[8 * ks + 7]);
                    const bf16x8 pa = __builtin_bit_cast(bf16x8, pw);
                    const LAS unsigned char* xp = lds + S1_XT + ph * 8192 + (2 * sb + ks) * 1024 + laneoff;
                    const v4i16_t lo = vtr(xp), hi2 = vtr(xp + 512);
                    const bf16x8 xb = (bf16x8){lo[0], lo[1], lo[2], lo[3], hi2[0], hi2[1], hi2[2], hi2[3]};
                    o = __builtin_amdgcn_mfma_f32_32x32x16_bf16(pa, xb, o, 0, 0, 0);
                }
            }
        }
        float* YS = (float*)(a.ws + WS_YS);
#pragma unroll
        for (int i = 0; i < 16; ++i) YS[(size_t)(m0 + 32 * tb + crow(i, hh)) * 512 + h * 64 + 32 * ph + r32] = o[i];
    }
    if (S1SUB & 4) {
        const int pb = wave & 1, nb = wave >> 1;
        f32x16 st;
#pragma unroll
        for (int i = 0; i < 16; ++i) st[i] = 0.f;
#pragma unroll
        for (int k = 0; k < 8; ++k) {
            const LAS unsigned char* ap = lds + S1_XW + pb * 8192 + k * 1024 + laneoff; const LAS unsigned char* bp = lds + S1_BT + nb * 8192 + k * 1024 + laneoff;
            const v4i16_t al = vtr(ap), ah = vtr(ap + 512), bl = vtr(bp), bh = vtr(bp + 512);
            const bf16x8 af = (bf16x8){al[0], al[1], al[2], al[3], ah[0], ah[1], ah[2], ah[3]}, bf = (bf16x8){bl[0], bl[1], bl[2], bl[3], bh[0], bh[1], bh[2], bh[3]};
            st = __builtin_amdgcn_mfma_f32_32x32x16_bf16(af, bf, st, 0, 0, 0);
        }
        float* CS = (float*)(a.ws + WS_CS) + (size_t)((b * 32 + c) * 8 + h) * 64 * 128;
#pragma unroll
        for (int i = 0; i < 16; ++i) CS[(size_t)(32 * pb + crow(i, hh)) * 128 + 32 * nb + r32] = st[i];
    }
    LDS_WAIT(); __syncthreads();
}
__device__ __forceinline__ void ssd_s2_pass(const Args& a, int gtid, int NT) {
    typedef float f32x2t __attribute__((ext_vector_type(2)));
    const float* CS = (const float*)(a.ws + WS_CS); const float* ACL = (const float*)(a.ws + WS_ACL); bf16* PREV = (bf16*)(a.ws + WS_PREV);
    for (int it = gtid; it < NBP * 8 * 64 * 64; it += NT) {
        const int n2 = it & 63, p = (it >> 6) & 63, h = (it >> 12) & 7, b = it >> 15;
        f32x2t s = {0.f, 0.f};
#pragma unroll 8
        for (int c = 0; c < 32; ++c) {
            const size_t idx = ((size_t)((b * 32 + c) * 8 + h) * 64 + p) * 128 + 2 * n2;
            const f32x2t cs = *(const f32x2t*)(CS + idx); const float dec = __expf(ACL[(b * 32 + c) * 8 + h]);
            *(unsigned*)(PREV + idx) = pk2(s.x, s.y);
            s = s * dec + cs;
        }
        *(f32x2t*)(a.out + O_SP + ((size_t)((b * 8 + h) * 64 + p)) * 128 + 2 * n2) = s;
    }
}
__device__ __forceinline__ void ssd_s3_unit(const Args& a, int unit, int wave, int lane, float psc = 1.f) {
    asm volatile("" : "+v"(lane));
    const int h = unit & 7, c = (unit >> 3) & 31, b = unit >> 8, g = h >> 2, m0 = b * SEQ + c * 128;
    const int r32 = lane & 31, hh = lane >> 5, tb = wave >> 1, ph = wave & 1;
    const bf16* cp = (const bf16*)(a.ws + WS_CC) + (size_t)(m0 + 32 * tb + r32) * 256 + g * 128 + 8 * hh;
    const bf16* pp = (const bf16*)(a.ws + WS_PREV) + ((size_t)((b * 32 + c) * 8 + h) * 64 + 32 * ph + r32) * 128 + 8 * hh;
    bf16x8 cf[8], pf[8];
#pragma unroll
    for (int k = 0; k < 8; ++k) { cf[k] = *(const bf16x8*)(cp + 16 * k); pf[k] = *(const bf16x8*)(pp + 16 * k); }
    f32x16 acc;
#pragma unroll
    for (int i = 0; i < 16; ++i) acc[i] = 0.f;
#pragma unroll
    for (int k = 0; k < 8; ++k) acc = __builtin_amdgcn_mfma_f32_32x32x16_bf16(cf[k], pf[k], acc, 0, 0, 0);
    float* YS = (float*)(a.ws + WS_YS); const float* ACUM = (const float*)(a.ws + WS_ACUM);
#pragma unroll
    for (int i = 0; i < 16; ++i) { const size_t t = (size_t)(m0 + 32 * tb + crow(i, hh)); float* yp = YS + t * 512 + h * 64 + 32 * ph + r32; *yp = *yp + psc * __expf(ACUM[t * 8 + h]) * acc[i]; }
}

constexpr int ATT_WAVE_BYTES = 8704, ATT_VB = 0, ATT_STG = 4096, ATT_WSF = 8192, ATT_BTAB_OFF = 8 * ATT_WAVE_BYTES  , ATT_BT_LD = 132;

__device__ __forceinline__ void attn_build_btab(const Args& a, LAS unsigned char* lds, int tid) {
    LAS float* bt = (LAS float*)(lds + ATT_BTAB_OFF); const float* rb = a.in[9];
    for (int i = tid; i < 3 * 8 * 129; i += NWAVES * 64) { const int br = i / (8 * 129), rem = i % (8 * 129), h = rem / 129, j = rem % 129; bt[(br * 8 + h) * ATT_BT_LD + j] = rb[BUCKET_TAB[br][j] * 8 + h] * LOG2E; }
}
__device__ __forceinline__ void attn_prompt_unit(const Args& a, LAS unsigned char* lds, int unit, int wave, int lane) {
    asm volatile("" : "+v"(lane));
    const bf16* PROJ = (const bf16*)(a.ws + WS_PROJ);
    const int r32 = lane & 31, hi = lane >> 5;
    const int rq = unit & 127, bhb = unit >> 7, br = bhb % 3, bh = bhb / 3, h = bh & 7, b = bh >> 3;
    const int sh = 2 * br, dil = 1 << sh, nqb = 128 >> sh, r = rq / nqb, qb = rq % nqb, l0 = qb * 32;
    const size_t rowb = (size_t)b * SEQ;
    LAS unsigned char* wl = lds + wave * ATT_WAVE_BYTES;
    const LAS float* bt = (const LAS float*)(lds + ATT_BTAB_OFF) + (br * 8 + h) * ATT_BT_LD;
    bf16x8 qr[4];
    { const bf16* qp = PROJ + (rowb + (size_t)(l0 + r32) * dil + r) * NIN + h * 64 + hi * 8;
#pragma unroll
      for (int d0 = 0; d0 < 4; ++d0) qr[d0] = *(const bf16x8*)(qp + d0 * 16); }
    const int kb0 = (l0 >= 128) ? 0 : (4 - (l0 >> 5));
    f32x16 s[5];
    bf16x8 kfa[4], kfb[4];
#define ATT_KLOAD(dst, kb_) do { int kk_ = l0 - 128 + 32 * (kb_) + r32; kk_ = kk_ < 0 ? 0 : kk_; const bf16* kp_ = PROJ + (rowb + (size_t)kk_ * dil + r) * NIN + PC_K + h * 64 + hi * 8; \
        _Pragma("unroll") for (int d0 = 0; d0 < 4; ++d0) dst[d0] = *(const bf16x8*)(kp_ + d0 * 16); } while (0)
#define ATT_QK(src, kb_) do { _Pragma("unroll") for (int i = 0; i < 16; ++i) s[kb_][i] = 0.f; \
        if ((kb_) >= kb0) { _Pragma("unroll") for (int d0 = 0; d0 < 4; ++d0) s[kb_] = __builtin_amdgcn_mfma_f32_32x32x16_bf16(src[d0], qr[d0], s[kb_], 0, 0, 0); } } while (0)
    ATT_KLOAD(kfa, 0); ATT_KLOAD(kfb, 1);
    __builtin_amdgcn_sched_barrier(0);
    ATT_QK(kfa, 0); ATT_KLOAD(kfa, 2);
    __builtin_amdgcn_sched_barrier(0);
    ATT_QK(kfb, 1); ATT_KLOAD(kfb, 3);
    __builtin_amdgcn_sched_barrier(0);
    ATT_QK(kfa, 2); ATT_KLOAD(kfa, 4);
    __builtin_amdgcn_sched_barrier(0);
    ATT_QK(kfb, 3);
    __builtin_amdgcn_sched_barrier(0);
    ATT_QK(kfa, 4);
#undef ATT_KLOAD
#undef ATT_QK
    __builtin_amdgcn_sched_barrier(0);
    v4u vpre[5][4];
#pragma unroll
    for (int kb = 0; kb < 3; ++kb)
#pragma unroll
        for (int i = 0; i < 4; ++i) {
            const int idx = i * 64 + lane, key = idx >> 3, ch = idx & 7;
            int kk = l0 - 128 + 32 * kb + key; kk = kk < 0 ? 0 : kk;
            vpre[kb][i] = *(const v4u*)(PROJ + (rowb + (size_t)kk * dil + r) * NIN + PC_V + h * 64 + ch * 8);
        }
    __builtin_amdgcn_sched_barrier(0);
    float mx = -INFINITY;
    int J0 = r32 - 4 * hi + 128, T0 = 128 - l0 - 4 * hi;
    asm volatile("" : "+v"(J0), "+v"(T0));
#pragma unroll
    for (int kb = 0; kb < 5; ++kb)
#pragma unroll
        for (int i = 0; i < 16; ++i) {
            const int cst = (i & 3) + 8 * (i >> 2) + 32 * kb, j = J0 - cst;
            const bool valid = ((unsigned)j <= 128u) && (cst >= T0) && (kb >= kb0);
            const int jc = j < 0 ? 0 : (j > 128 ? 128 : j);
            const float v = valid ? s[kb][i] + bt[jc] : -INFINITY;
            s[kb][i] = v; mx = fmaxf(mx, v);
        }
    mx = fmaxf(mx, __shfl_xor(mx, 32));
    float l = 0.f;
#pragma unroll
    for (int kb = 0; kb < 5; ++kb)
#pragma unroll
        for (int i = 0; i < 16; ++i) { const float p = __builtin_amdgcn_exp2f(s[kb][i] - mx); s[kb][i] = p; l += p; }
    l += __shfl_xor(l, 32);
    __builtin_amdgcn_sched_barrier(0);
#pragma unroll
    for (int kb = 3; kb < 5; ++kb)
#pragma unroll
        for (int i = 0; i < 4; ++i) {
            const int idx = i * 64 + lane, key = idx >> 3, ch = idx & 7;
            int kk = l0 - 128 + 32 * kb + key; kk = kk < 0 ? 0 : kk;
            vpre[kb][i] = *(const v4u*)(PROJ + (rowb + (size_t)kk * dil + r) * NIN + PC_V + h * 64 + ch * 8);
        }
    f32x16 o[2];
#pragma unroll
    for (int i = 0; i < 16; ++i) { o[0][i] = 0.f; o[1][i] = 0.f; }
    const LAS unsigned char* vrd = wl + ATT_VB + ((lane >> 4) & 1) * 32 + (lane & 3) * 8 + (4 * hi + ((lane & 15) >> 2)) * 64;
#pragma unroll
    for (int kb = 0; kb < 5; ++kb) {
        if (kb >= kb0) {
#pragma unroll
            for (int i = 0; i < 4; ++i) {
                const int idx = i * 64 + lane, key = idx >> 3, ch = idx & 7;
                *(LAS v4u*)(wl + ATT_VB + (ch >> 2) * 2048 + (key >> 4) * 1024 + (key & 15) * 64 + (ch & 3) * 16) = vpre[kb][i];
            }
            LDS_WAIT();
#pragma unroll
            for (int ks = 0; ks < 2; ++ks) {
                v4u pw;
                pw.x = cvtpk_s(s[kb][8 * ks + 0], s[kb][8 * ks + 1]); pw.y = cvtpk_s(s[kb][8 * ks + 2], s[kb][8 * ks + 3]);
                pw.z = cvtpk_s(s[kb][8 * ks + 4], s[kb][8 * ks + 5]); pw.w = cvtpk_s(s[kb][8 * ks + 6], s[kb][8 * ks + 7]);
                const bf16x8 pa = __builtin_bit_cast(bf16x8, pw);
#pragma unroll
                for (int d0 = 0; d0 < 2; ++d0) {
                    const v4i16_t lo = vtr(vrd + d0 * 2048 + ks * 1024), hh = vtr(vrd + d0 * 2048 + ks * 1024 + 512);
                    const bf16x8 vb = (bf16x8){lo[0], lo[1], lo[2], lo[3], hh[0], hh[1], hh[2], hh[3]};
                    o[d0] = __builtin_amdgcn_mfma_f32_32x32x16_bf16(pa, vb, o[d0], 0, 0, 0);
                }
            }
            LDS_WAIT();
        }
    }
    LAS float* wsf = (LAS float*)(wl + ATT_WSF);
    if (hi == 0) wsf[r32] = l;
    LDS_WAIT();
    LAS bf16* stg = (LAS bf16*)(wl + ATT_STG);
#pragma unroll
    for (int i = 0; i < 16; ++i) {
        const int orow = crow(i, hi); const float rl = 1.0f / wsf[orow];
        stg[orow * 64 + r32] = (bf16)f2bf(o[0][i] * rl); stg[orow * 64 + 32 + r32] = (bf16)f2bf(o[1][i] * rl);
    }
    LDS_WAIT();
    bf16* OBR = (bf16*)(a.ws + WS_OBR) + (size_t)br * MP * 512;
#pragma unroll
    for (int i = 0; i < 4; ++i) {
        const int row = i * 8 + (lane >> 3), ch = lane & 7;
        const v4u v = *(const LAS v4u*)(stg + row * 64 + ch * 8);
        *(v4u*)(OBR + (rowb + (size_t)(l0 + row) * dil + r) * 512 + h * 64 + ch * 8) = v;
    }
    if (hi == 0) { float* LSE = (float*)(a.ws + WS_LSE) + (size_t)br * MP * 8; LSE[(rowb + (size_t)(l0 + r32) * dil + r) * 8 + h] = mx + __builtin_amdgcn_logf(l); }
    LDS_WAIT();
}

__device__ __forceinline__ void attn_sample_task(const Args& a, LAS unsigned char* lds, int task, int wave, int lane) {
    const int h = task & 7, t = (task >> 3) & 7, b = task >> 6;
    const bf16* PROJ = (const bf16*)(a.ws + WS_PROJ);
    const float* ck = a.in[4]; const float* cv = a.in[5]; const float* kn = a.out + O_KS; const float* vn = a.out + O_VS;
    LAS float* pl = (LAS float*)(lds + wave * ATT_WAVE_BYTES + ATT_STG);
    const int ks = lane >> 4, dq = lane & 15;
    f32x4 q4;
    { const u32x2 w = *(const u32x2*)(PROJ + (size_t)(MP + b * 8 + t) * NIN + h * 64 + 4 * dq); q4 = (f32x4){bflo(w.x), bfhi(w.x), bflo(w.y), bfhi(w.y)}; }
    const size_t cbase = ((size_t)b * WBUF * 8 + h) * 64 + 4 * dq, nbase = ((size_t)b * 8 * 8 + h) * 64 + 4 * dq;
#pragma unroll 1
    for (int br = 0; br < 3; ++br) {
        const int dil = 1 << (2 * br);
        const LAS float* bt = (const LAS float*)(lds + ATT_BTAB_OFF) + (br * 8 + h) * ATT_BT_LD;
#pragma unroll 1
        for (int it0 = 0; it0 < 33; it0 += 11) {
            f32x4 kv[11];
#pragma unroll
            for (int u = 0; u < 11; ++u) { int j = 4 * (it0 + u) + ks; j = j > 128 ? 128 : j; const int idx = WBUF + t - j * dil;
                kv[u] = (idx < WBUF) ? *(const f32x4*)(ck + cbase + (size_t)idx * 512) : *(const f32x4*)(kn + nbase + (size_t)(idx - WBUF) * 512); }
#pragma unroll
            for (int u = 0; u < 11; ++u) { const int j = 4 * (it0 + u) + ks; float d = q4.x * kv[u].x + q4.y * kv[u].y + q4.z * kv[u].z + q4.w * kv[u].w; d = row16_sum(d);
                if (dq == 0 && j <= 128) pl[br * ATT_BT_LD + j] = d + bt[j]; }
        }
    }
    LDS_WAIT(); asm volatile("" ::: "memory");
    float mx = -INFINITY;
#pragma unroll 1
    for (int i = lane; i < 3 * ATT_BT_LD; i += 64) { const int j = i % ATT_BT_LD; if (j <= 128) mx = fmaxf(mx, pl[i]); }
    mx = wave_max(mx);
    float l = 0.f;
#pragma unroll 1
    for (int i = lane; i < 3 * ATT_BT_LD; i += 64) { const int j = i % ATT_BT_LD; if (j <= 128) { const float p = __builtin_amdgcn_exp2f(pl[i] - mx); pl[i] = p; l += p; } }
    l = wave_sum(l);
    LDS_WAIT(); asm volatile("" ::: "memory");
    f32x4 o4 = {0.f, 0.f, 0.f, 0.f};
#pragma unroll 1
    for (int br = 0; br < 3; ++br) {
        const int dil = 1 << (2 * br);
#pragma unroll 1
        for (int it0 = 0; it0 < 33; it0 += 11) {
            f32x4 vv[11]; float pp[11];
#pragma unroll
            for (int u = 0; u < 11; ++u) { const int j0 = 4 * (it0 + u) + ks, j = j0 > 128 ? 128 : j0; const int idx = WBUF + t - j * dil;
                vv[u] = (idx < WBUF) ? *(const f32x4*)(cv + cbase + (size_t)idx * 512) : *(const f32x4*)(vn + nbase + (size_t)(idx - WBUF) * 512);
                pp[u] = (j0 <= 128) ? pl[br * ATT_BT_LD + j] : 0.f; }
#pragma unroll
            for (int u = 0; u < 11; ++u) o4 += vv[u] * pp[u];
        }
    }
#pragma unroll
    for (int e = 0; e < 4; ++e) { o4[e] += __shfl_xor(o4[e], 16); o4[e] += __shfl_xor(o4[e], 32); }
    if (lane < 16) { const float il = 1.f / l; u32x2 w; w.x = pk2(o4.x * il, o4.y * il); w.y = pk2(o4.z * il, o4.w * il);
        *(u32x2*)((bf16*)(a.ws + WS_MIX) + (size_t)(MP + b * 8 + t) * DM + h * 64 + 4 * dq) = w; }
    LDS_WAIT(); asm volatile("" ::: "memory");
}

__device__ __forceinline__ void ssd_sample_task(const Args& a, int k, int lane) {
    const float* XB = (const float*)(a.ws + WS_XBS); const float* DT = (const float*)(a.ws + WS_DT); float* YS = (float*)(a.ws + WS_YS);
    const int p4 = k & 15, h = (k >> 4) & 7, b = k >> 7, g = h >> 2, p = 4 * p4 + (lane >> 4), ng = lane & 15;
    const size_t sidx = ((size_t)((b * 8 + h) * 64 + p)) * 128 + 8 * ng;
    float s[8]; load8f(a.in[6] + sidx, s);
    const float A = -__expf(a.in[15][h]);
#pragma unroll 1
    for (int t0 = 0; t0 < TS; t0 += 4) {
        float dtv[4], xv[4], Bv[4][8], Cv[4][8];
#pragma unroll
        for (int q = 0; q < 4; ++q) { const int r = b * TS + t0 + q; dtv[q] = DT[(size_t)(MP + r) * 8 + h]; const float* xr = XB + (size_t)r * 1024; xv[q] = xr[h * 64 + p]; load8f(xr + 512 + g * 128 + 8 * ng, Bv[q]); load8f(xr + 768 + g * 128 + 8 * ng, Cv[q]); }
#pragma unroll
        for (int q = 0; q < 4; ++q) {
            const float da = __expf(dtv[q] * A), xd = dtv[q] * xv[q]; float y = 0.f;
#pragma unroll
            for (int e = 0; e < 8; ++e) { s[e] = da * s[e] + xd * Bv[q][e]; y += Cv[q][e] * s[e]; }
            y = row16_sum(y);
            if (ng == 0) YS[(size_t)(MP + b * TS + t0 + q) * 512 + h * 64 + p] = y;
        }
    }
    float* so = a.out + O_SS + sidx;
    *(f32x4*)so = (f32x4){s[0], s[1], s[2], s[3]}; *(f32x4*)(so + 4) = (f32x4){s[4], s[5], s[6], s[7]};
}
__device__ __forceinline__ void attn_combine_pass(const Args& a, int gtid, int NT) {
    const bf16* OBR = (const bf16*)(a.ws + WS_OBR); const float* LSE = (const float*)(a.ws + WS_LSE); bf16* MIX = (bf16*)(a.ws + WS_MIX);
    for (int it = gtid; it < MP * 64; it += NT) {
        const int row = it >> 6, c8 = it & 63, h = c8 >> 3;
        const float l0 = LSE[(size_t)row * 8 + h], l1 = LSE[(size_t)(MP + row) * 8 + h], l2 = LSE[(size_t)(2 * MP + row) * 8 + h];
        const float mx = fmaxf(l0, fmaxf(l1, l2));
        float w0 = __builtin_amdgcn_exp2f(l0 - mx), w1 = __builtin_amdgcn_exp2f(l1 - mx), w2 = __builtin_amdgcn_exp2f(l2 - mx);
        const float inv = 1.f / (w0 + w1 + w2); w0 *= inv; w1 *= inv; w2 *= inv;
        float o0[8], o1[8], o2[8];
        load8bf(OBR + (size_t)row * 512 + c8 * 8, o0); load8bf(OBR + ((size_t)MP + row) * 512 + c8 * 8, o1); load8bf(OBR + ((size_t)2 * MP + row) * 512 + c8 * 8, o2);
        float r[8];
#pragma unroll
        for (int k = 0; k < 8; ++k) r[k] = w0 * o0[k] + w1 * o1[k] + w2 * o2[k];
        v4u w; w.x = pk2(r[0], r[1]); w.y = pk2(r[2], r[3]); w.z = pk2(r[4], r[5]); w.w = pk2(r[6], r[7]);
        *(v4u*)(MIX + (size_t)row * DM + c8 * 8) = w;
    }
}
__device__ __forceinline__ void ssd_finish_pass(const Args& a, int gw, int NGW, int lane) {
    const bf16* XC = (const bf16*)(a.ws + WS_XC); const float* YS = (const float*)(a.ws + WS_YS); const bf16* PROJ = (const bf16*)(a.ws + WS_PROJ); bf16* MIX = (bf16*)(a.ws + WS_MIX);
    const float* dsk = a.in[16]; const float* gs = a.in[17];
    const int c = lane * 8; const float dh = dsk[c >> 6];
    float g8[8]; load8f(gs + c, g8);
    for (int m = gw; m < MT; m += NGW) {
        float y[8], x[8], z[8], v[8]; load8f(YS + (size_t)m * 512 + c, y); load8bf(XC + (size_t)m * 512 + c, x); load8bf(PROJ + (size_t)m * NIN + PC_Z + c, z);
        float ss = 0.f;
#pragma unroll
        for (int k = 0; k < 8; ++k) { v[k] = (y[k] + dh * x[k]) * siluf(z[k]); ss += v[k] * v[k]; }
#pragma unroll
        for (int o = 1; o < 32; o <<= 1) ss += __shfl_xor(ss, o);
        const float rs = 1.0f / sqrtf(ss * (1.f / 256.f) + EPS);
        v4u w; w.x = pk2(v[0] * rs * g8[0], v[1] * rs * g8[1]); w.y = pk2(v[2] * rs * g8[2], v[3] * rs * g8[3]); w.z = pk2(v[4] * rs * g8[4], v[5] * rs * g8[5]); w.w = pk2(v[6] * rs * g8[6], v[7] * rs * g8[7]);
        *(v4u*)(MIX + (size_t)m * DM + 512 + c) = w;
    }
}
__device__ __forceinline__ void ffn_fixup_pass(const Args& a, int gtid, int NT) {
    const float* UH = (const float*)(a.ws + WS_UH); const float* US = (const float*)(a.ws + WS_US); bf16* ACT = (bf16*)(a.ws + WS_ACT);
    const float* fw = a.in[21]; const float* fb = a.in[22]; const float* sf = a.in[8];
    constexpr int NC8 = DFF / 8, NPT = MP / 256, NITEMS = (NPT + NBS) * NC8;
    for (int it = gtid; it < NITEMS; it += NT) {
        const int blk = it / NC8, c = (it % NC8) * 8;
        float wa0[8], wa1[8], wa2[8], wb0[8], wb1[8], wb2[8], ba[8], bb[8], a2[8], a1[8], b2[8], b1[8];
        load8f(fw + c, wa0); load8f(fw + DFF2 + c, wa1); load8f(fw + 2 * DFF2 + c, wa2); load8f(fb + c, ba);
        load8f(fw + DFF + c, wb0); load8f(fw + DFF2 + DFF + c, wb1); load8f(fw + 2 * DFF2 + DFF + c, wb2); load8f(fb + DFF + c, bb);
        const float* src; int m0, nr;
        if (blk < NPT) { m0 = blk * 256; nr = 2; src = UH + (size_t)(blk * 4) * DFF2;
            if ((blk & 15) == 0) {
#pragma unroll
                for (int k = 0; k < 8; ++k) { a2[k] = 0.f; a1[k] = 0.f; b2[k] = 0.f; b1[k] = 0.f; }
            } else { const float* pv = UH + (size_t)((blk - 1) * 4 + 2) * DFF2; load8f(pv + c, a2); load8f(pv + DFF2 + c, a1); load8f(pv + DFF + c, b2); load8f(pv + DFF2 + DFF + c, b1); }
        } else { const int b = blk - NPT; m0 = MP + b * 8; nr = 8; src = US + (size_t)(b * 8) * DFF2;
            load8f(sf + (size_t)(b * 2) * DFF2 + c, a2); load8f(sf + (size_t)(b * 2 + 1) * DFF2 + c, a1); load8f(sf + (size_t)(b * 2) * DFF2 + DFF + c, b2); load8f(sf + (size_t)(b * 2 + 1) * DFF2 + DFF + c, b1); }
        for (int r = 0; r < nr; ++r) {
            float ua[8], ub[8], o[8]; load8f(src + (size_t)r * DFF2 + c, ua); load8f(src + (size_t)r * DFF2 + DFF + c, ub);
#pragma unroll
            for (int k = 0; k < 8; ++k) {
                const float ya = ba[k] + wa0[k] * a2[k] + wa1[k] * a1[k] + wa2[k] * ua[k], yb = bb[k] + wb0[k] * b2[k] + wb1[k] * b1[k] + wb2[k] * ub[k];
                o[k] = siluf(ya) * yb; a2[k] = a1[k]; a1[k] = ua[k]; b2[k] = b1[k]; b1[k] = ub[k];
            }
            v4u w; w.x = pk2(o[0], o[1]); w.y = pk2(o[2], o[3]); w.z = pk2(o[4], o[5]); w.w = pk2(o[6], o[7]);
            *(v4u*)(ACT + (size_t)(m0 + r) * DFF + c) = w;
        }
    }
}
__device__ __forceinline__ void final_norm_pass(const Args& a, int gw, int NGW, int lane) {
    const float* RS3 = (const float*)(a.ws + WS_RS3); const float* gf = a.in[27]; const bf16* H3b = (const bf16*)(a.ws + WS_MIX);
    float g[16];
    load8f(gf + lane * 16, *(float(*)[8])&g[0]); load8f(gf + lane * 16 + 8, *(float(*)[8])&g[8]);
    for (int m = gw; m < MT; m += NGW) {
        float* orow = (m < MP) ? a.out + O_Y + (size_t)m * DM : a.out + O_YS + (size_t)(m - MP) * DM;
        const float rs = 1.0f / sqrtf(RS3[m] * (1.f / DM) + EPS);
        float h[16]; load8bf(H3b + (size_t)m * DM + lane * 16, *(float(*)[8])&h[0]); load8bf(H3b + (size_t)m * DM + lane * 16 + 8, *(float(*)[8])&h[8]);
#pragma unroll
        for (int j = 0; j < 4; ++j) *(f32x4*)(orow + lane * 16 + 4 * j) = (f32x4){h[4 * j] * rs * g[4 * j], h[4 * j + 1] * rs * g[4 * j + 1], h[4 * j + 2] * rs * g[4 * j + 2], h[4 * j + 3] * rs * g[4 * j + 3]};
    }
}

typedef float f32x4m __attribute__((ext_vector_type(4)));
template <class Epi>
__device__ __forceinline__ void skinny_gemm(LAS unsigned char* lds, const bf16* A, const bf16* Wt, int N, int K, const Epi& E, int vcu, int G, int tid, int wave, int lane) {
    const int npieces = (MS / 16) * (N / 64), kslice = K / 8, nsteps = kslice / 32;
    const int r16 = lane & 15, kg = lane >> 4;
    for (int piece = vcu; piece < npieces; piece += G) {
        const int mb = piece & 15, nb = piece >> 4, m0 = mb * 16, n0 = nb * 64;
        const bf16* ap = A + (size_t)(m0 + r16) * K + wave * kslice + 8 * kg;
        const bf16* wp = Wt + (size_t)(n0 + r16) * K + wave * kslice + 8 * kg;
        f32x4m acc[4];
#pragma unroll
        for (int j = 0; j < 4; ++j) acc[j] = (f32x4m){0.f, 0.f, 0.f, 0.f};
        for (int s0 = 0; s0 < nsteps; s0 += 4) {
            bf16x8 af[4], wf[4][4];
#pragma unroll
            for (int u = 0; u < 4; ++u) if (s0 + u < nsteps) {
                af[u] = *(const bf16x8*)(ap + (s0 + u) * 32);
#pragma unroll
                for (int j = 0; j < 4; ++j) wf[u][j] = *(const bf16x8*)(wp + (size_t)(16 * j) * K + (s0 + u) * 32);
            }
#pragma unroll
            for (int u = 0; u < 4; ++u) if (s0 + u < nsteps) {
#pragma unroll
                for (int j = 0; j < 4; ++j) acc[j] = __builtin_amdgcn_mfma_f32_16x16x32_bf16(wf[u][j], af[u], acc[j], 0, 0, 0);
            }
        }
#pragma unroll
        for (int j = 0; j < 4; ++j) *(LAS f32x4m*)(lds + ((wave * 4 + j) * 64 + lane) * 16) = acc[j];
        LDS_WAIT(); __syncthreads();
        if (tid < 256) {
            const int j = tid >> 6, l2 = tid & 63;
            f32x4m v = *(const LAS f32x4m*)(lds + (j * 64 + l2) * 16);
#pragma unroll
            for (int w = 1; w < 8; ++w) v += *(const LAS f32x4m*)(lds + ((w * 4 + j) * 64 + l2) * 16);
            E.apply(m0 + (l2 & 15), n0 + 16 * j + 4 * (l2 >> 4), v);
        }
        LDS_WAIT(); __syncthreads();
    }
}
struct SEpiIn { bf16* PROJ; float* out;
    __device__ __forceinline__ void apply(int r, int c, f32x4m v) const {
        const float sc = (c < PC_K) ? C2 : 1.f; u32x2 w; w.x = pk2(v.x * sc, v.y * sc); w.y = pk2(v.z * sc, v.w * sc);
        *(u32x2*)(PROJ + (size_t)(MP + r) * NIN + c) = w;
        if (c >= PC_K && c < PC_Z) { const bool isk = c < PC_V; *(f32x4m*)(out + (isk ? O_KS : O_VS) + (size_t)r * 512 + (c - (isk ? PC_K : PC_V))) = v; }
        else if (c >= PC_X) { const int t = r & 7, b = r >> 3; if (t >= TS - 3) *(f32x4m*)(out + O_CS + (size_t)(b * 3 + t - (TS - 3)) * 1024 + (c - PC_X)) = v; }
    } };
struct SEpiOut { const float* xs; bf16* H1b; float* RS;
    __device__ __forceinline__ void apply(int r, int c, f32x4m v) const {
        const f32x4m h = *(const f32x4m*)(xs + (size_t)r * DM + c) + v; const size_t o = (size_t)(MP + r) * DM + c;
        u32x2 w; w.x = pk2(h.x, h.y); w.y = pk2(h.z, h.w); *(u32x2*)(H1b + o) = w;
        atomicAdd(RS + MP + r, (h.x * h.x + h.y * h.y) + (h.z * h.z + h.w * h.w));
    } };
struct SEpiPle { bf16* E; float* RS;
    __device__ __forceinline__ void apply(int r, int c, f32x4m v) const {
        u32x2 w; w.x = pk2(v.x, v.y); w.y = pk2(v.z, v.w); *(u32x2*)(E + (size_t)(MP + r) * DM + c) = w; atomicAdd(RS + MP + r, (v.x * v.x + v.y * v.y) + (v.z * v.z + v.w * v.w));
    } };
struct SEpiDown { bf16* Hb;
    __device__ __forceinline__ void apply(int r, int c, f32x4m v) const {
        u32x2* hp = (u32x2*)(Hb + (size_t)(MP + r) * DM + c); const u32x2 o = *hp;
        u32x2 w; w.x = pk2(bflo(o.x) + v.x, bfhi(o.x) + v.y); w.y = pk2(bflo(o.y) + v.z, bfhi(o.y) + v.w); *hp = w;
    } };
struct SEpiGate { const bf16* H2b; const bf16* E; const float* RSE; const float* gple; bf16* H3b; float* RS3;
    __device__ __forceinline__ void apply(int r, int c, f32x4m v) const {
        const size_t o = (size_t)(MP + r) * DM + c; const float rse = 1.0f / sqrtf(RSE[MP + r] * (1.f / DM) + EPS);
        const u32x2 eb = *(const u32x2*)(E + o), hb = *(const u32x2*)(H2b + o); const f32x4m gp = *(const f32x4m*)(gple + c);
        const float e4[4] = {bflo(eb.x), bfhi(eb.x), bflo(eb.y), bfhi(eb.y)}, h4[4] = {bflo(hb.x), bfhi(hb.x), bflo(hb.y), bfhi(hb.y)}; float h[4];
#pragma unroll
        for (int k = 0; k < 4; ++k) { const float g = 1.f / (1.f + __expf(-v[k])); h[k] = h4[k] + g * (e4[k] * rse * gp[k]); }
        u32x2 w; w.x = pk2(h[0], h[1]); w.y = pk2(h[2], h[3]); *(u32x2*)(H3b + o) = w;
        atomicAdd(RS3 + MP + r, (h[0] * h[0] + h[1] * h[1]) + (h[2] * h[2] + h[3] * h[3]));
    } };

constexpr int NPH = 12;
#ifndef DUP
#define DUP -1
#endif
#define REP(k) for (int rep_ = 0; rep_ < ((DUP) == (k) ? args.pad : 1); ++rep_)
#ifndef MK_N_LAUNCHES
#define MK_N_LAUNCHES 1
#endif
constexpr int N_LAUNCHES = MK_N_LAUNCHES;
__global__ void __launch_bounds__(NWAVES * 64, 2) mk_fwd(Args args) {
    extern __shared__ __attribute__((aligned(16))) unsigned char lds_raw[];
    LAS unsigned char* lds = (LAS unsigned char*)lds_raw;
    volatile LAS unsigned* MISC = (volatile LAS unsigned*)(lds + MISC_OFF);
    const int tid = threadIdx.x, lane = tid & 63, wave = __builtin_amdgcn_readfirstlane(tid >> 6);
    const int G = gridDim.x, bx = blockIdx.x, vcu = (G % 8 == 0) ? (bx % 8) * (G / 8) + bx / 8 : bx;
    const int gw = vcu * NWAVES + wave, NGW = G * NWAVES, gtid = vcu * (NWAVES * 64) + tid, NT = G * NWAVES * 64;
    unsigned char* ws = args.ws;
    gu32* ctl = (gu32*)(ws + WS_CTL);
    for (int u = tid; u < (LDS_BYTES - LDSCTL_OFF) / 4; u += NWAVES * 64) ((LAS unsigned*)(lds + LDSCTL_OFF))[u] = 0u;
    __syncthreads();
    XcdBarrier bar; bar.bar = (unsigned*)(ctl + CW_BAR); bar.x = 0; bar.st = nullptr;
    if (N_LAUNCHES == 1) bar = xcd_barrier_post((unsigned*)(ctl + CW_BAR), MISC + 8);
    const int lo = args.ph_lo, hi = args.ph_hi;
#ifndef PHMASK
#define PHMASK 0xfff
#endif
#define IN(k) (((PHMASK >> (k)) & 1) && lo <= (k) && (k) < hi)
#define SEAM(k) do { if (IN(k) && IN((k) + 1)) xcd_barrier(bar); } while (0)

    if (IN(0)) { REP(0) { p0_prologue(args, lds, gw, NGW, wave, lane); VM_WAIT(); __syncthreads(); }
        if ((DUP) == 100) { p0_prologue(args, lds, gw, NGW, wave, lane, args.pad - 1); VM_WAIT(); __syncthreads(); }
        if ((DUP) == 101) { p0_prologue(args, lds, gw, NGW, wave, lane, args.pad); VM_WAIT(); __syncthreads(); } }
    SEAM(0);
    if (IN(1)) {
        pg8::Gemm g{(const pg8::bf16_t*)(ws + WS_XN), (const pg8::bf16_t*)(ws + WS_WIN), MP, NIN, DM}; pg8::StaticOrder S; S.init(MP, NIN, G, bx);
        EpiIn E{(pg8::bf16_t*)(ws + WS_PROJ), args.out};
        pg8::gemm_phase<EpiIn, pg8::StaticOrder, PG8_ALIGN, PG8_SP2>(lds, g, S, E);
        if ((DUP) == 1) pg8::gemm_phase<EpiIn, pg8::StaticOrder, PG8_ALIGN, PG8_SP2>(lds, g, S, E);
        { SEpiIn SE{(bf16*)(ws + WS_PROJ), args.out}; skinny_gemm(lds, (const bf16*)(ws + WS_XN) + (size_t)MP * DM, (const bf16*)(ws + WS_WIN), NIN, DM, SE, vcu, G, tid, wave, lane); }
    }
    SEAM(1);
    if (IN(2)) {
        attn_build_btab(args, lds, tid);
        conv_sample_pass(args, gtid, NT);
        __syncthreads();
#ifndef P2SUB
#define P2SUB 7
#endif
        REP(20) if (P2SUB & 1) for (int task = gw; task < NBS * TS * NH; task += NGW) attn_sample_task(args, lds, task, wave, lane);
        __syncthreads();
        REP(21) if (P2SUB & 2) for (int unit = gw; unit < NBP * NH * 3 * 128; unit += NGW) attn_prompt_unit(args, lds, unit, wave, lane);
        __syncthreads();
        REP(22) if (P2SUB & 4) for (int unit = vcu; unit < NBP * 32 * 8; unit += G) ssd_s1_unit(args, lds, unit, tid, wave, lane);
        VM_WAIT(); __syncthreads();
    }
    SEAM(2);
    if (IN(3)) {
        REP(30) ssd_s2_pass(args, gtid, NT);
        REP(31) for (int task = gw; task < NBS * 8 * 16; task += NGW) ssd_sample_task(args, task, lane);
        REP(32) attn_combine_pass(args, gtid, NT);
        VM_WAIT(); __syncthreads();
    }
    SEAM(3);
    if ((DUP) == 99) { for (int q_ = 0; q_ < 5 * args.pad; ++q_) xcd_barrier(bar); }
    if (IN(4)) {
        REP(4) for (int unit = vcu; unit < NBP * 32 * 8; unit += G) ssd_s3_unit(args, unit, wave, lane, rep_ == 0 ? 1.f : 0.f);
        VM_WAIT(); __syncthreads();
    }
    SEAM(4);
    if (IN(5)) { REP(5) { ssd_finish_pass(args, gw, NGW, lane); VM_WAIT(); __syncthreads(); } }
    SEAM(5);
    if (IN(6)) {
        { pg8::Gemm g{(const pg8::bf16_t*)(ws + WS_MIX), (const pg8::bf16_t*)(ws + WS_WOUT), MP, DM, DM}; pg8::StaticOrder S; S.init(MP, DM, G, bx);
          REP(60) { EpiOut E{args.in[0], (pg8::bf16_t*)(ws + WS_XN), rep_ == 0 ? (float*)(ws + WS_RS1) : (float*)(ws + WS_H1)};
#ifndef NO_GOUT
          pg8::gemm_phase<EpiOut, pg8::StaticOrder, PG8_ALIGN, PG8_SP2>(lds, g, S, E);
#endif
        } }
#ifndef NOSK
        { SEpiOut SE{args.in[1], (bf16*)(ws + WS_XN), (float*)(ws + WS_RS1)}; skinny_gemm(lds, (const bf16*)(ws + WS_MIX) + (size_t)MP * DM, (const bf16*)(ws + WS_WOUT), DM, DM, SE, vcu, G, tid, wave, lane); }
#endif
        { int kple = DPLE; asm volatile("" : "+s"(kple));
          pg8::Gemm g{(const pg8::bf16_t*)(ws + WS_PB), (const pg8::bf16_t*)(ws + WS_WPLE), MP, DM, kple}; pg8::StaticOrder S; S.init(MP, DM, G, bx);
          EpiPle E{(pg8::bf16_t*)(ws + WS_E), (float*)(ws + WS_RSE)};
#ifndef NO_GPLE
          pg8::gemm_phase<EpiPle, pg8::StaticOrder, PG8_ALIGN, PG8_SP2>(lds, g, S, E);
#endif
        }
        { SEpiPle SE{(bf16*)(ws + WS_E), (float*)(ws + WS_RSE)}; skinny_gemm(lds, (const bf16*)(ws + WS_PB) + (size_t)MP * DPLE, (const bf16*)(ws + WS_WPLE), DM, DPLE, SE, vcu, G, tid, wave, lane); }
    }
    SEAM(6);
    if (IN(7)) {
        pg8::Gemm g{(const pg8::bf16_t*)(ws + WS_XN), (const pg8::bf16_t*)(ws + WS_WUP), MT, DFF2, DM}; pg8::StaticOrder S; S.init(MT, DFF2, G, bx);
        EpiUp E{(pg8::bf16_t*)(ws + WS_ACT), (const float*)(ws + WS_RS1), args.out, (float*)(ws + WS_UH), (float*)(ws + WS_US), args.in[21], args.in[22], lds};
        REP(7) pg8::gemm_phase<EpiUp, pg8::StaticOrder, PG8_ALIGN, PG8_SP2>(lds, g, S, E);
    }
    SEAM(7);
    if (IN(8)) { REP(8) { ffn_fixup_pass(args, gtid, NT); VM_WAIT(); __syncthreads(); } }
    SEAM(8);
    if (IN(9)) {
        pg8::Gemm g{(const pg8::bf16_t*)(ws + WS_ACT), (const pg8::bf16_t*)(ws + WS_WDOWN), MP, DM, DFF}; pg8::StaticOrder S; S.init(MP, DM, G, bx);
        { EpiDown E{(pg8::bf16_t*)(ws + WS_XN), 1.f};
        pg8::gemm_phase<EpiDown, pg8::StaticOrder, PG8_ALIGN, PG8_SP2>(lds, g, S, E); }
        if ((DUP) == 9) { EpiDown E{(pg8::bf16_t*)(ws + WS_XN), 0.f};
        pg8::gemm_phase<EpiDown, pg8::StaticOrder, PG8_ALIGN, PG8_SP2>(lds, g, S, E); }
        { SEpiDown SE{(bf16*)(ws + WS_XN)}; skinny_gemm(lds, (const bf16*)(ws + WS_ACT) + (size_t)MP * DFF, (const bf16*)(ws + WS_WDOWN), DM, DFF, SE, vcu, G, tid, wave, lane); }
    }
    SEAM(9);
    if (IN(10)) {
        pg8::Gemm g{(const pg8::bf16_t*)(ws + WS_XN), (const pg8::bf16_t*)(ws + WS_WGATE), MP, DM, DM}; pg8::StaticOrder S; S.init(MP, DM, G, bx);
        REP(10) { EpiGate E{(const pg8::bf16_t*)(ws + WS_XN), (const pg8::bf16_t*)(ws + WS_E), (const float*)(ws + WS_RSE), args.in[25], (pg8::bf16_t*)(ws + WS_MIX), rep_ == 0 ? (float*)(ws + WS_RS3) : (float*)(ws + WS_H1)};
        pg8::gemm_phase<EpiGate, pg8::StaticOrder, PG8_ALIGN, PG8_SP2>(lds, g, S, E); }
        { SEpiGate SE{(const bf16*)(ws + WS_XN), (const bf16*)(ws + WS_E), (const float*)(ws + WS_RSE), args.in[25], (bf16*)(ws + WS_MIX), (float*)(ws + WS_RS3)}; skinny_gemm(lds, (const bf16*)(ws + WS_XN) + (size_t)MP * DM, (const bf16*)(ws + WS_WGATE), DM, DM, SE, vcu, G, tid, wave, lane); }
    }
    SEAM(10);
    if (IN(11)) { REP(11) final_norm_pass(args, gw, NGW, lane); }
#undef IN
#undef SEAM
}

extern "C" void kernel_launch(void* const* d_in, const int* in_sizes, int n_in, void* d_out, int out_size, void* d_ws, size_t ws_size, hipStream_t stream) {
    static int grid = 0;
    if (grid == 0) {
        if (n_in != 28 || out_size != (int)O_END || ws_size < WS_END) { fprintf(stderr, "kernel_launch: unexpected shapes: n_in %d out %d ws %zu\n", n_in, out_size, ws_size); grid = -1; return; }
        int dev = 0, cus = 0, per_cu = 0;
        if (hipGetDevice(&dev) != hipSuccess || hipDeviceGetAttribute(&cus, hipDeviceAttributeMultiprocessorCount, dev) != hipSuccess) { grid = -1; return; }
        if (hipFuncSetAttribute((const void*)mk_fwd, hipFuncAttributeMaxDynamicSharedMemorySize, LDS_BYTES) != hipSuccess) { fprintf(stderr, "kernel_launch: hipFuncSetAttribute failed\n"); grid = -1; return; }
        if (hipOccupancyMaxActiveBlocksPerMultiprocessor(&per_cu, (const void*)mk_fwd, NWAVES * 64, LDS_BYTES) != hipSuccess || per_cu < 1) fprintf(stderr, "kernel_launch: occupancy query says %d\n", per_cu);
        (void)hipGetLastError();
        grid = cus;
    }
    if (grid < 0) return;
    if (hipMemsetAsync((char*)d_ws + WS_CTL, 0, CTL_ZERO_BYTES, stream) != hipSuccess) { fprintf(stderr, "kernel_launch: memset failed\n"); return; }
    Args a{};
    for (int i = 0; i < 28; ++i) a.in[i] = (const float*)d_in[i];
    a.out = (float*)d_out; a.ws = (unsigned char*)d_ws; a.pad = 2;
    for (int li = 0; li < N_LAUNCHES; ++li) {
        if (N_LAUNCHES == 1) { a.ph_lo = 0; a.ph_hi = NPH; } else { a.ph_lo = li; a.ph_hi = li + 1; }
        a.li = li;
        hipLaunchKernelGGL(mk_fwd, dim3(grid), dim3(NWAVES * 64), LDS_BYTES, stream, a);
        const hipError_t le = hipPeekAtLastError();
        if (le != hipSuccess) { fprintf(stderr, "kernel_launch: launch %d failed: %s\n", li, hipGetErrorName(le)); break; }
    }
}
```

```cpp
#include <hip/hip_runtime.h>
#include <cstdio>
#include <cstdint>
namespace pg8 {
#define PG8_LAS __attribute__((address_space(3)))
typedef unsigned short bf16_t;
typedef short bf16x8 __attribute__((ext_vector_type(8)));
typedef float f32x4 __attribute__((ext_vector_type(4)));
typedef unsigned u32x4 __attribute__((ext_vector_type(4)));
constexpr int BM = 256, BK = 64, HALF = 128, HTB = HALF * BK * 2  , STAGE_BYTES = 8 * HTB, NXCD = 8, WGM = 8;

__host__ __device__ __forceinline__ int lds_byte(int r, int c) { const int st = (r >> 4) * 2 + (c >> 5), rr = r & 15, cc = c & 31, ob = rr * 64 + cc * 2; return st * 1024 + (ob ^ (((ob >> 9) & 1) << 5)); }
__host__ __device__ __forceinline__ void stage_rc(int b, int& R, int& C) { const int st = b / 1024, sb = b % 1024, swz = sb ^ (((sb >> 9) & 1) << 5); R = (st >> 1) * 16 + swz / 64; C = (st & 1) * 32 + (swz % 64) / 2; }
__host__ __device__ __forceinline__ int perm32(int rho) { const int n = rho >> 4, i = rho & 15; return 8 * (i >> 2) + 4 * n + (i & 3); }

struct Unit { int pm, pn; };
struct Gemm { const bf16_t* A; const bf16_t* Bt; int M, N, K; };

struct StaticOrder {
    int nM, nN, nwg, G, c;
    __host__ __device__ void init(int M, int N, int G_, int c_) { nM = M / BM; nN = N / BM; nwg = nM * nN; G = G_; c = c_; }
    __host__ __device__ bool next(int i, Unit& u) const {
        const long L = (long)i * G + c; if (L >= nwg) return false;
        int wgid = (int)L; { const int q = nwg / NXCD, r = nwg % NXCD, xcd = wgid % NXCD, off = wgid / NXCD; wgid = (xcd < r ? xcd * (q + 1) : r * (q + 1) + (xcd - r) * q) + off; }
        const int nig = WGM * nN, gid = wgid / nig, fm = gid * WGM, gsz = (nM - fm) < WGM ? (nM - fm) : WGM;
        u.pm = fm + ((wgid % nig) % gsz); u.pn = (wgid % nig) / gsz; return true;
    }
    __device__ __forceinline__ void a_ready(const Unit&) const {}
    __device__ __forceinline__ void done(const Unit&) const {}
};

__device__ __forceinline__ unsigned cvt_pk_bf16(float lo, float hi) { unsigned r; asm volatile("v_cvt_pk_bf16_f32 %0, %1, %2" : "=v"(r) : "v"(lo), "v"(hi)); return r; }
typedef float f32x2 __attribute__((ext_vector_type(2)));
template <class Epi, class Sched, bool ALIGN_EPI = false, bool SP2 = false>
__device__ __forceinline__ void gemm_phase(PG8_LAS unsigned char* lds, const Gemm g, const Sched& S, const Epi& E) {
    const int tid = threadIdx.x, wid = __builtin_amdgcn_readfirstlane(tid >> 6), lane = tid & 63, wr = wid >> 2, wc = wid & 3, fr = lane & 15, fq = lane >> 4;
    const int K = g.K, nt = K / BK;
    unsigned voffA[2], voffB[2];
#pragma unroll
    for (int i = 0; i < 2; ++i) { int R, C; stage_rc(tid * 16 + i * 8192, R, C); const int Rb = Epi::PERM ? ((R & ~31) + perm32(R & 31)) : R;
        voffA[i] = (unsigned)(R * K + C) * 2u; voffB[i] = (unsigned)(Rb * K + C) * 2u; }
    const size_t kstep = (size_t)(BK * 2);
    const size_t hstep = (size_t)HALF * K * 2;
    const size_t tstep = 2 * hstep;
    const unsigned ldsw = (unsigned)wid * 1024u;
    const int aoff = lds_byte(wr * 64 + fr, fq * 8), boff = lds_byte(wc * 32 + fr, fq * 8);
#define PG8_SA(b, h) (((b) * 2 + (h)) * HTB)
#define PG8_SB(b, h) ((4 + (b) * 2 + (h)) * HTB)
#define PG8_STAGE(bufoff, gbase, voff) do { _Pragma("unroll") for (int _i = 0; _i < 2; ++_i) \
        __builtin_amdgcn_global_load_lds((const unsigned*)((const char*)(gbase) + (voff)[_i]), (PG8_LAS unsigned*)(lds + (bufoff) + ldsw + _i * 8192), 16, 0, 0); } while (0)
#define PG8_LDA(dst, b, h) do { _Pragma("unroll") for (int m = 0; m < 4; ++m) _Pragma("unroll") for (int k = 0; k < 2; ++k) dst[m][k] = *(const PG8_LAS bf16x8*)(lds + PG8_SA(b, h) + aoff + m * 2048 + k * 1024); } while (0)
#define PG8_LDB(dst, b, h) do { _Pragma("unroll") for (int n = 0; n < 2; ++n) _Pragma("unroll") for (int k = 0; k < 2; ++k) dst[n][k] = *(const PG8_LAS bf16x8*)(lds + PG8_SB(b, h) + boff + n * 2048 + k * 1024); } while (0)
#define PG8_MMA(ai, bj, At, Bt) do { __builtin_amdgcn_s_setprio(1); _Pragma("unroll") for (int m = 0; m < 4; ++m) _Pragma("unroll") for (int n = 0; n < 2; ++n) _Pragma("unroll") for (int k = 0; k < 2; ++k) \
        acc[ai][bj][m][n] = __builtin_amdgcn_mfma_f32_16x16x32_bf16(Bt[n][k], At[m][k], acc[ai][bj][m][n], 0, 0, 0); __builtin_amdgcn_s_setprio(0); } while (0)
#define PG8_WAIT_V(n) asm volatile("s_waitcnt vmcnt(" #n ")" ::: "memory")
#define PG8_WAIT_L(n) asm volatile("s_waitcnt lgkmcnt(" #n ")" ::: "memory")
#define PG8_BAR __builtin_amdgcn_s_barrier()
#define PG8_SCHED __builtin_amdgcn_sched_barrier(0)
    Unit cur, nxt; int ui = 0;
    if (!S.next(0, cur)) return;
    f32x4 acc[2][2][4][2];
#pragma unroll
    for (int a = 0; a < 2; ++a)
#pragma unroll
        for (int b = 0; b < 2; ++b)
#pragma unroll
            for (int m = 0; m < 4; ++m)
#pragma unroll
                for (int n = 0; n < 2; ++n) acc[a][b][m][n] = (f32x4){0.f, 0.f, 0.f, 0.f};
    bf16x8 At[4][2], B0[2][2], B1[2][2];
    const char* cA = (const char*)g.A + (size_t)cur.pm * tstep; const char* cB = (const char*)g.Bt + (size_t)cur.pn * tstep;
    S.a_ready(cur);
    if constexpr (SP2) {
        PG8_STAGE(PG8_SB(0, 0), cB, voffB); PG8_STAGE(PG8_SB(0, 1), cB + hstep, voffB); PG8_STAGE(PG8_SA(0, 0), cA, voffA); PG8_STAGE(PG8_SA(0, 1), cA + hstep, voffA);
        if (wr == 1) PG8_BAR;
        PG8_WAIT_V(2); PG8_BAR;
        PG8_STAGE(PG8_SB(1, 0), cB + kstep, voffB); PG8_STAGE(PG8_SA(1, 0), cA + kstep, voffA); PG8_STAGE(PG8_SB(1, 1), cB + hstep + kstep, voffB);
        PG8_WAIT_V(6); PG8_BAR;
    } else {
        PG8_STAGE(PG8_SB(0, 0), cB, voffB); PG8_STAGE(PG8_SA(0, 0), cA, voffA); PG8_STAGE(PG8_SB(0, 1), cB + hstep, voffB); PG8_STAGE(PG8_SA(0, 1), cA + hstep, voffA);
        if (wr == 1) PG8_BAR;
        PG8_WAIT_V(4); PG8_BAR;
        PG8_STAGE(PG8_SB(1, 0), cB + kstep, voffB); PG8_STAGE(PG8_SA(1, 0), cA + kstep, voffA); PG8_STAGE(PG8_SB(1, 1), cB + hstep + kstep, voffB);
        PG8_WAIT_V(6); PG8_BAR;
    }
    for (;;) {
        const bool has_next = S.next(ui + 1, nxt);
        const char* nA = has_next ? (const char*)g.A + (size_t)nxt.pm * tstep : cA; const char* nB = has_next ? (const char*)g.Bt + (size_t)nxt.pn * tstep : cB;
        for (int t = 0; t < nt; t += 2) {
            const bool last = (t == nt - 2);
            const char* a1 = cA + (size_t)(t + 1) * kstep;
            const char* a2 = last ? nA : cA + (size_t)(t + 2) * kstep; const char* b2 = last ? nB : cB + (size_t)(t + 2) * kstep;
            const char* a3 = a2 + kstep; const char* b3 = b2 + kstep;
            if (last && has_next) S.a_ready(nxt);
            if constexpr (SP2) {
            PG8_LDB(B0, 0, 0); PG8_LDB(B1, 0, 1); PG8_SCHED; PG8_LDA(At, 0, 0); PG8_STAGE(PG8_SA(1, 1), a1 + hstep, voffA);
            PG8_WAIT_V(8); PG8_WAIT_L(0); PG8_BAR; PG8_MMA(0, 0, At, B0); PG8_MMA(0, 1, At, B1); PG8_BAR; PG8_SCHED;
            PG8_LDA(At, 0, 1); PG8_STAGE(PG8_SB(0, 0), b2, voffB); PG8_STAGE(PG8_SB(0, 1), b2 + hstep, voffB); PG8_STAGE(PG8_SA(0, 0), a2, voffA);
            PG8_WAIT_V(8); PG8_WAIT_L(0); PG8_BAR; PG8_MMA(1, 0, At, B0); PG8_MMA(1, 1, At, B1); PG8_BAR; PG8_SCHED;
            PG8_LDB(B0, 1, 0); PG8_LDB(B1, 1, 1); PG8_SCHED; PG8_LDA(At, 1, 0); PG8_STAGE(PG8_SA(0, 1), a2 + hstep, voffA);
            PG8_WAIT_V(8); PG8_WAIT_L(0); PG8_BAR; PG8_MMA(0, 0, At, B0); PG8_MMA(0, 1, At, B1); PG8_BAR; PG8_SCHED;
            PG8_LDA(At, 1, 1); PG8_STAGE(PG8_SB(1, 0), b3, voffB); PG8_STAGE(PG8_SB(1, 1), b3 + hstep, voffB); PG8_STAGE(PG8_SA(1, 0), a3, voffA);
            PG8_WAIT_V(8); PG8_WAIT_L(0); PG8_BAR; PG8_MMA(1, 0, At, B0); PG8_MMA(1, 1, At, B1); PG8_BAR; PG8_SCHED;
            } else {
            PG8_LDB(B0, 0, 0); PG8_SCHED; PG8_LDA(At, 0, 0); PG8_STAGE(PG8_SA(1, 1), a1 + hstep, voffA);
            PG8_WAIT_L(8); PG8_BAR; PG8_WAIT_L(0); PG8_MMA(0, 0, At, B0); PG8_BAR; PG8_SCHED;
            PG8_LDB(B1, 0, 1); PG8_STAGE(PG8_SB(0, 0), b2, voffB);
            PG8_BAR; PG8_WAIT_L(0); PG8_MMA(0, 1, At, B1); PG8_BAR;
            PG8_LDA(At, 0, 1); PG8_STAGE(PG8_SA(0, 0), a2, voffA);
            PG8_BAR; PG8_WAIT_L(0); PG8_MMA(1, 0, At, B0); PG8_BAR; PG8_SCHED;
            PG8_STAGE(PG8_SB(0, 1), b2 + hstep, voffB);
            PG8_WAIT_V(6); PG8_BAR; PG8_MMA(1, 1, At, B1); PG8_BAR;
            PG8_LDB(B0, 1, 0); PG8_SCHED; PG8_LDA(At, 1, 0); PG8_STAGE(PG8_SA(0, 1), a2 + hstep, voffA);
            PG8_WAIT_L(8); PG8_BAR; PG8_WAIT_L(0); PG8_MMA(0, 0, At, B0); PG8_BAR; PG8_SCHED;
            PG8_LDB(B1, 1, 1); PG8_STAGE(PG8_SB(1, 0), b3, voffB);
            PG8_BAR; PG8_WAIT_L(0); PG8_MMA(0, 1, At, B1); PG8_BAR;
            PG8_LDA(At, 1, 1); PG8_STAGE(PG8_SA(1, 0), a3, voffA);
            PG8_BAR; PG8_WAIT_L(0); PG8_MMA(1, 0, At, B0); PG8_BAR; PG8_SCHED;
            PG8_STAGE(PG8_SB(1, 1), b3 + hstep, voffB);
            PG8_WAIT_V(6); PG8_BAR; PG8_MMA(1, 1, At, B1); PG8_BAR;
            }
        }
        if constexpr (ALIGN_EPI) { if (wr == 0) PG8_BAR; }
        if constexpr (!Epi::AFTER_DRAIN) { E(acc, cur, wr, wc, fr, fq); S.done(cur); }
        if (!has_next) break;
#pragma unroll
        for (int a = 0; a < 2; ++a)
#pragma unroll
            for (int b = 0; b < 2; ++b)
#pragma unroll
                for (int m = 0; m < 4; ++m)
#pragma unroll
                    for (int n = 0; n < 2; ++n) acc[a][b][m][n] = (f32x4){0.f, 0.f, 0.f, 0.f};
        cur = nxt; cA = nA; cB = nB; ++ui;
        if constexpr (ALIGN_EPI) { if (wr == 1) PG8_BAR; }
    }
    PG8_WAIT_V(0);
    if constexpr (!ALIGN_EPI) { if (wr == 0) PG8_BAR; }
    PG8_BAR;
    if constexpr (Epi::AFTER_DRAIN) { E.fused(acc, cur, wr, wc, fr, fq, lds, wid, lane); S.done(cur); }
#undef PG8_SA
#undef PG8_SB
#undef PG8_STAGE
#undef PG8_LDA
#undef PG8_LDB
#undef PG8_MMA
#undef PG8_WAIT_V
#undef PG8_WAIT_L
#undef PG8_BAR
#undef PG8_SCHED
}
}

#ifndef PG8_SP2
#define PG8_SP2 true
#endif
#ifndef PG8_ALIGN
#define PG8_ALIGN true
#endif
#define GAS __attribute__((address_space(1)))
#define LAS __attribute__((address_space(3)))
typedef unsigned short bf16;
typedef unsigned v4u __attribute__((ext_vector_type(4)));
typedef float f32x4 __attribute__((ext_vector_type(4)));
typedef short bf16x8 __attribute__((ext_vector_type(8)));
typedef GAS unsigned gu32;
typedef GAS unsigned long long gu64;
#define RLX_AGENT __ATOMIC_RELAXED, __HIP_MEMORY_SCOPE_AGENT
#define LDS_WAIT() asm volatile("s_waitcnt lgkmcnt(0)" ::: "memory")
#define VM_WAIT() asm volatile("s_waitcnt vmcnt(0)" ::: "memory")
__device__ __forceinline__ unsigned long long rt() { return __builtin_amdgcn_s_memrealtime(); }
__device__ __forceinline__ unsigned f2bf(float f) { unsigned u = __builtin_bit_cast(unsigned, f); return (u + 0x7fffu + ((u >> 16) & 1u)) >> 16; }
__device__ __forceinline__ unsigned pk2(float lo, float hi) { typedef float f2_ __attribute__((ext_vector_type(2))); typedef __bf16 b2_ __attribute__((ext_vector_type(2))); f2_ v = {lo, hi}; b2_ b = __builtin_convertvector(v, b2_); return __builtin_bit_cast(unsigned, b); }

#define XB_TMO      128
#define XB_XCNT(j)  (256  + 64 * (j))
#define XB_XSUB(j)  (1280 + 64 * (j))
#define XB_XGEN(j)  (2304 + 64 * (j))
#define XB_TOP      3328
#define XB_TOPGEN   3392
#define XCD_BAR_WORDS 3456
#define XB_SPIN_CAP (1u << 18)

__device__ __forceinline__ unsigned xb_ld(unsigned* p)              { return __hip_atomic_load(p, __ATOMIC_RELAXED, __HIP_MEMORY_SCOPE_AGENT); }
__device__ __forceinline__ unsigned xb_add(unsigned* p, unsigned v) { return __hip_atomic_fetch_add(p, v, __ATOMIC_RELAXED, __HIP_MEMORY_SCOPE_AGENT); }
__device__ __forceinline__ unsigned xb_xcc_id() { return (unsigned)__builtin_amdgcn_s_getreg((3 << 11) | 20) & 0xFu; }
#define XB_SPIN(cond, bar) do { unsigned _sp = 0; while (cond) { __builtin_amdgcn_s_sleep(1); \
    if ((++_sp & 255u) == 0u) { if (xb_ld(&(bar)[XB_TMO])) break; if (_sp > XB_SPIN_CAP) { atomicAdd(&(bar)[XB_TMO], 1u); break; } } } } while (0)

struct XcdBarrier {
    unsigned* bar; unsigned x;
    volatile LAS unsigned* st;
};

__device__ __forceinline__ XcdBarrier xcd_barrier_post(unsigned* bar, volatile LAS unsigned* st) {
    XcdBarrier b; b.bar = bar; b.x = xb_xcc_id(); b.st = st;
    if (threadIdx.x == 0) (void)xb_add(&bar[XB_XCNT(b.x)], 1u);
    return b;
}
__device__ __forceinline__ void xcd_barrier_complete(unsigned* bar, unsigned x, unsigned& nloc, unsigned& nx) {
    const unsigned G = gridDim.x * gridDim.y * gridDim.z;
    unsigned sum, cnt, mine, sp = 0u;
    for (;;) {
        sum = 0u; cnt = 0u; mine = 0u;
#pragma unroll
        for (unsigned j = 0; j < 16; ++j) { const unsigned c = xb_ld(&bar[XB_XCNT(j)]); sum += c; cnt += (c > 0u) ? 1u : 0u; mine = (j == x) ? c : mine; }
        if (sum == G) break;
        __builtin_amdgcn_s_sleep(1);
        if ((++sp & 255u) == 0u) { if (xb_ld(&bar[XB_TMO])) break; if (sp > XB_SPIN_CAP) { atomicAdd(&bar[XB_TMO], 1u); break; } }
    }
    nloc = mine > 0u ? mine : 1u; nx = cnt > 0u ? cnt : 1u;
}

__device__ __forceinline__ void xcd_barrier(const XcdBarrier& b) {
    asm volatile("s_waitcnt vmcnt(0)" ::: "memory");
    __syncthreads();
    if (threadIdx.x == 0) {
        unsigned* bar = b.bar;
        __builtin_amdgcn_s_waitcnt(0);
        unsigned nloc = b.st[0], nx = b.st[1];
        if (nloc == 0u) { xcd_barrier_complete(bar, b.x, nloc, nx); b.st[0] = nloc; b.st[1] = nx; }
        const unsigned old = xb_add(&bar[XB_XSUB(b.x)], 1u);
        const unsigned gen = old / nloc;
        if (old + 1u == (gen + 1u) * nloc) {
            __builtin_amdgcn_fence(__ATOMIC_RELEASE, "agent");
            asm volatile("s_waitcnt vmcnt(0)" ::: "memory");
            const unsigned og = xb_add(&bar[XB_TOP], 1u);
            const unsigned tg = og / nx;
            if (og + 1u == (tg + 1u) * nx) xb_add(&bar[XB_TOPGEN], 1u);
            else XB_SPIN(xb_ld(&bar[XB_TOPGEN]) == tg, bar);
            __builtin_amdgcn_fence(__ATOMIC_ACQUIRE, "agent");
            xb_add(&bar[XB_XGEN(b.x)], 1u);
            asm volatile("s_waitcnt vmcnt(0)" ::: "memory");
        } else {
            XB_SPIN(xb_ld(&bar[XB_XGEN(b.x)]) == gen, bar);
            __builtin_amdgcn_fence(__ATOMIC_ACQUIRE, "agent");
            asm volatile("s_waitcnt vmcnt(0)" ::: "memory");
        }
    }
    __syncthreads();
}


constexpr int NWAVES = 8;
constexpr int DM = 1024, SEQ = 4096, NBP = 4, NBS = 32, TS = 8;
constexpr int MP = NBP * SEQ, MS = NBS * TS, MT = MP + MS;
constexpr int NH = 8, HD = 64, DSSM = 512, NST = 128, IN_LD = 3080, NIN = 3072;
constexpr int DFF = 2816, DFF2 = 5632, DPLE = 256, WBUF = 2048;
constexpr float EPS = 1e-6f, LOG2E = 1.4426950408889634f, C2 = 0.125f * 1.4426950408889634f;
constexpr int PC_K = 512, PC_V = 1024, PC_Z = 1536, PC_X = 2048;
constexpr size_t O_Y = 0, O_YS = 16777216, O_KP = 17039360, O_VP = 21233664, O_KS = 25427968, O_VS = 25559040, O_SP = 25690112, O_SS = 25952256,
                 O_CP = 28049408, O_CS = 28061696, O_FP = 28160000, O_FS = 28205056, O_END = 28565504;
constexpr size_t MiB = 1u << 20;
constexpr size_t WS_CTL = 0, CTL_ZERO_BYTES = 1 * MiB;
constexpr size_t WS_RS1 = 256 * 1024, WS_RSE = 384 * 1024, WS_RS3 = 512 * 1024;
constexpr size_t WS_WIN = 2 * MiB, WS_WOUT = 8 * MiB, WS_WUP = 10 * MiB, WS_WDOWN = 21 * MiB, WS_WPLE = 27 * MiB, WS_WGATE = 28 * MiB;
constexpr size_t WS_DT = 30 * MiB, WS_PB = 31 * MiB, WS_XN = 40 * MiB, WS_MIX = 73 * MiB, WS_H1 = 106 * MiB, WS_E = 171 * MiB;
constexpr size_t WS_PROJ = 236 * MiB, WS_OBR = 334 * MiB, WS_LSE = 382 * MiB, WS_XBS = 384 * MiB, WS_XC = 385 * MiB, WS_CC = 402 * MiB, WS_CS = 410 * MiB, WS_PREV = 442 * MiB,
                 WS_ACUM = 458 * MiB, WS_ACL = 458 * MiB + 768 * 1024, WS_YS = 459 * MiB;
constexpr size_t WS_U = 236 * MiB, WS_UH = 236 * MiB, WS_US = 244 * MiB, WS_ACT = 415 * MiB, WS_END = 505 * MiB;
static_assert(WS_PROJ + (size_t)MT * NIN * 2 <= WS_OBR && WS_OBR + (size_t)3 * MP * 512 * 2 <= WS_LSE && WS_LSE + (size_t)3 * MP * 8 * 4 <= WS_XBS, "ws map A");
static_assert(WS_XBS + (size_t)MS * 1024 * 4 <= WS_XC && WS_XC + (size_t)MT * 512 * 2 <= WS_CC && WS_CC + (size_t)MP * 256 * 2 <= WS_CS && WS_CS + (size_t)MP / 128 * 8 * 64 * 128 * 4 <= WS_PREV && WS_PREV + (size_t)MP / 128 * 8 * 64 * 128 * 2 <= WS_ACUM && WS_ACUM + (size_t)MP * 8 * 4 <= WS_ACL && WS_ACL + 4096 <= WS_YS && WS_YS + (size_t)MT * 512 * 4 <= WS_END, "ws map B");
static_assert(WS_U + (size_t)MT * DFF2 * 2 <= WS_ACT && WS_ACT + (size_t)MT * DFF * 2 <= WS_END, "ws map C");
static_assert(WS_XN + (size_t)MT * DM * 2 <= WS_MIX && WS_MIX + (size_t)MT * DM * 2 <= WS_H1 && WS_H1 + (size_t)MT * DM * 4 <= WS_E && WS_E + (size_t)MT * DM * 4 <= WS_PROJ, "ws map D");
static_assert(WS_PB + (size_t)MT * DPLE * 2 <= WS_XN && WS_DT + (size_t)MT * 8 * 4 <= WS_PB, "ws map E");
constexpr int CW_TMO = 0, CW_BAR = 4096;
constexpr int RING_BYTES = 131072, LDSCTL_OFF = RING_BYTES, MISC_OFF = LDSCTL_OFF + 320, LDS_BYTES = 147456;

typedef float f32x16 __attribute__((ext_vector_type(16)));
typedef short v4i16_t __attribute__((ext_vector_type(4)));
typedef unsigned u32x2 __attribute__((ext_vector_type(2)));

__device__ const unsigned char BUCKET_TAB[3][132] = {
 {0,1,2,3,4,5,6,7,8,9,10,11,12,13,14,15,16,16,16,16,16,16,17,17,17,17,17,17,17,17,18,18,18,18,18,18,18,18,18,18,19,19,19,19,19,19,19,19,19,19,19,19,19,19,20,20,20,20,20,20,20,20,20,20,20,20,20,20,20,20,20,20,20,21,21,21,21,21,21,21,21,21,21,21,21,21,21,21,21,21,21,21,21,21,21,21,21,21,21,22,22,22,22,22,22,22,22,22,22,22,22,22,22,22,22,22,22,22,22,22,22,22,22,22,22,22,22,22,22,0,0,0},
 {0,4,8,12,16,16,17,17,18,18,19,19,19,19,20,20,20,20,20,21,21,21,21,21,21,22,22,22,22,22,22,22,22,22,23,23,23,23,23,23,23,23,23,23,23,23,24,24,24,24,24,24,24,24,24,24,24,24,24,24,24,24,25,25,25,25,25,25,25,25,25,25,25,25,25,25,25,25,25,25,25,25,25,26,26,26,26,26,26,26,26,26,26,26,26,26,26,26,26,26,26,26,26,26,26,26,26,26,26,26,26,26,26,27,27,27,27,27,27,27,27,27,27,27,27,27,27,27,27,0,0,0},
 {0,16,18,19,20,21,21,22,22,23,23,23,24,24,24,24,25,25,25,25,25,26,26,26,26,26,26,26,26,27,27,27,27,27,27,27,27,27,27,28,28,28,28,28,28,28,28,28,28,28,28,28,29,29,29,29,29,29,29,29,29,29,29,29,29,29,29,29,29,29,30,30,30,30,30,30,30,30,30,30,30,30,30,30,30,30,30,30,30,30,30,30,30,30,30,31,31,31,31,31,31,31,31,31,31,31,31,31,31,31,31,31,31,31,31,31,31,31,31,31,31,31,31,31,31,31,31,31,31,0,0,0}};

__device__ __forceinline__ float row16_sum(float v) {
    v += __builtin_bit_cast(float, __builtin_amdgcn_update_dpp(0, __builtin_bit_cast(int, v), 0xB1, 0xf, 0xf, true));
    v += __builtin_bit_cast(float, __builtin_amdgcn_update_dpp(0, __builtin_bit_cast(int, v), 0x4E, 0xf, 0xf, true));
    v += __builtin_bit_cast(float, __builtin_amdgcn_update_dpp(0, __builtin_bit_cast(int, v), 0x141, 0xf, 0xf, true));
    v += __builtin_bit_cast(float, __builtin_amdgcn_update_dpp(0, __builtin_bit_cast(int, v), 0x140, 0xf, 0xf, true));
    return v;
}
__device__ __forceinline__ float row16_max(float v) {
    v = fmaxf(v, __builtin_bit_cast(float, __builtin_amdgcn_update_dpp(__builtin_bit_cast(int, v), __builtin_bit_cast(int, v), 0xB1, 0xf, 0xf, false)));
    v = fmaxf(v, __builtin_bit_cast(float, __builtin_amdgcn_update_dpp(__builtin_bit_cast(int, v), __builtin_bit_cast(int, v), 0x4E, 0xf, 0xf, false)));
    v = fmaxf(v, __builtin_bit_cast(float, __builtin_amdgcn_update_dpp(__builtin_bit_cast(int, v), __builtin_bit_cast(int, v), 0x141, 0xf, 0xf, false)));
    v = fmaxf(v, __builtin_bit_cast(float, __builtin_amdgcn_update_dpp(__builtin_bit_cast(int, v), __builtin_bit_cast(int, v), 0x140, 0xf, 0xf, false)));
    return v;
}
__device__ __forceinline__ float wave_sum(float v) {
    v = row16_sum(v);
    auto s = __builtin_amdgcn_permlane16_swap(__float_as_uint(v), __float_as_uint(v), false, false);
    v = __uint_as_float(s[0]) + __uint_as_float(s[1]);
    auto t = __builtin_amdgcn_permlane32_swap(__float_as_uint(v), __float_as_uint(v), false, false);
    return __uint_as_float(t[0]) + __uint_as_float(t[1]);
}
__device__ __forceinline__ float wave_max(float v) {
    v = row16_max(v);
    auto s = __builtin_amdgcn_permlane16_swap(__float_as_uint(v), __float_as_uint(v), false, false);
    v = fmaxf(__uint_as_float(s[0]), __uint_as_float(s[1]));
    auto t = __builtin_amdgcn_permlane32_swap(__float_as_uint(v), __float_as_uint(v), false, false);
    return fmaxf(__uint_as_float(t[0]), __uint_as_float(t[1]));
}
__device__ __forceinline__ float bf2f(unsigned short b) { return __uint_as_float((unsigned)b << 16); }
__device__ __forceinline__ float bflo(unsigned w) { return __uint_as_float(w << 16); }
__device__ __forceinline__ float bfhi(unsigned w) { return __uint_as_float(w & 0xffff0000u); }
__device__ __forceinline__ float siluf(float x) { return x * __builtin_amdgcn_rcpf(1.f + __builtin_amdgcn_exp2f(-LOG2E * x)); }
__device__ __forceinline__ float softplusf(float x) { return fmaxf(x, 0.f) + log1pf(__expf(-fabsf(x))); }
__device__ __forceinline__ int crow(int r, int hi) { return (r & 3) + 8 * (r >> 2) + 4 * hi; }

__device__ __forceinline__ v4i16_t vtr(const LAS unsigned char* p) { return __builtin_amdgcn_ds_read_tr16_b64_v4i16((LAS v4i16_t*)p); }
__device__ __forceinline__ unsigned cvtpk_s(float lo, float hi) { typedef float f2 __attribute__((ext_vector_type(2))); typedef __bf16 b2 __attribute__((ext_vector_type(2))); f2 v = {lo, hi}; b2 b = __builtin_convertvector(v, b2); return __builtin_bit_cast(unsigned, b); }
struct Args { const float* in[28]; float* out; unsigned char* ws; int ph_lo, ph_hi, li, pad; };

struct EpiIn {
    static constexpr bool PERM = true, AFTER_DRAIN = false;
    pg8::bf16_t* PROJ; float* out;
    __device__ __forceinline__ void operator()(const pg8::f32x4 (&acc)[2][2][4][2], const pg8::Unit& u, int wr, int wc, int fr, int fq) const {
        const int pn = u.pn; const float sc = (pn < 2) ? C2 : 1.f;
        const int colb = pn * 256 + wc * 32 + 8 * fq;
#pragma unroll
        for (int ai = 0; ai < 2; ++ai)
#pragma unroll
            for (int m = 0; m < 4; ++m) {
                const int row = u.pm * 256 + ai * 128 + wr * 64 + m * 16 + fr;
#pragma unroll
                for (int bj = 0; bj < 2; ++bj) {
                    const int col = colb + bj * 128; const pg8::f32x4 v0 = acc[ai][bj][m][0], v1 = acc[ai][bj][m][1];
                    pg8::u32x4 w; w.x = pg8::cvt_pk_bf16(v0[0] * sc, v0[1] * sc); w.y = pg8::cvt_pk_bf16(v0[2] * sc, v0[3] * sc); w.z = pg8::cvt_pk_bf16(v1[0] * sc, v1[1] * sc); w.w = pg8::cvt_pk_bf16(v1[2] * sc, v1[3] * sc);
                    *(pg8::u32x4*)(PROJ + (unsigned)(row * NIN + col)) = w;
                    float* dst = nullptr;
                    if (pn >= 2 && pn < 6) {
                        const bool isk = pn < 4; const int c = col - (isk ? PC_K : PC_V);
                        if (row < MP) { const int t = row & (SEQ - 1), b = row >> 12; if (t >= SEQ - WBUF) dst = out + (isk ? O_KP : O_VP) + ((size_t)(b * WBUF + t - (SEQ - WBUF))) * 512 + c; }
                        else dst = out + (isk ? O_KS : O_VS) + (size_t)(row - MP) * 512 + c;
                    } else if (pn >= 8) {
                        const int c = col - PC_X;
                        if (row < MP) { const int t = row & (SEQ - 1), b = row >> 12; if (t >= SEQ - 3) dst = out + O_CP + (size_t)(b * 3 + t - (SEQ - 3)) * 1024 + c; }
                        else { const int r = row - MP, t = r & 7, b = r >> 3; if (t >= TS - 3) dst = out + O_CS + (size_t)(b * 3 + t - (TS - 3)) * 1024 + c; }
                    }
                    if (dst) { *(pg8::f32x4*)dst = v0; *(pg8::f32x4*)(dst + 4) = v1; }
                }
            }
    }
};
struct EpiOut {
    static constexpr bool PERM = false, AFTER_DRAIN = false;
    const float* xp; pg8::bf16_t* H1b; float* RS;
    __device__ __forceinline__ void operator()(const pg8::f32x4 (&acc)[2][2][4][2], const pg8::Unit& u, int wr, int wc, int fr, int fq) const {
        const int col0 = u.pn * 256 + wc * 32 + 4 * fq;
#pragma unroll
        for (int ai = 0; ai < 2; ++ai)
#pragma unroll
            for (int m = 0; m < 4; ++m) {
                const int row = u.pm * 256 + ai * 128 + wr * 64 + m * 16 + fr;
                const float* xrow = xp + (unsigned)(row * DM);
                float ss = 0.f;
#pragma unroll
                for (int bj = 0; bj < 2; ++bj)
#pragma unroll
                    for (int n = 0; n < 2; ++n) {
                        const int c = col0 + bj * 128 + n * 16;
                        const pg8::f32x4 h = *(const pg8::f32x4*)(xrow + c) + acc[ai][bj][m][n];
                        u32x2 w; w.x = pg8::cvt_pk_bf16(h[0], h[1]); w.y = pg8::cvt_pk_bf16(h[2], h[3]);
                        *(u32x2*)(H1b + (unsigned)(row * DM + c)) = w;
                        ss += (h[0] * h[0] + h[1] * h[1]) + (h[2] * h[2] + h[3] * h[3]);
                    }
                ss += __shfl_xor(ss, 16); ss += __shfl_xor(ss, 32);
                if (fq == 0) atomicAdd(RS + row, ss);
                asm volatile("" ::: "memory");
            }
    }
};
template <int CTRL> __device__ __forceinline__ unsigned dppu(unsigned x) { return (unsigned)__builtin_amdgcn_update_dpp(0, (int)x, CTRL, 0xf, 0xf, true); }
constexpr int XCH_OFF = 135168;
struct EpiUp {
    static constexpr bool PERM = true, AFTER_DRAIN = false;
    pg8::bf16_t* ACT; const float* RS; float* out; float* UH; float* US; const float* fw; const float* fb; LAS unsigned char* lds;
    __device__ __forceinline__ void operator()(pg8::f32x4 (&acc)[2][2][4][2], const pg8::Unit& u, int wr, int wc, int fr, int fq) const {
        asm volatile("" : "+v"(fr), "+v"(fq));
        const int jb = wc * 32 + 8 * fq, ca = u.pn * 128 + jb;
        const bool samp = u.pm >= MP / 256;
        unsigned P[2][2][4][2][2];
#pragma unroll
        for (int ai = 0; ai < 2; ++ai)
#pragma unroll
            for (int m = 0; m < 4; ++m) {
                const int rt = ai * 128 + wr * 64 + m * 16 + fr, row = u.pm * 256 + rt;
                const float rs = __builtin_amdgcn_rsqf(RS[row] * (1.f / DM) + EPS);
                float* d = nullptr; float* d2 = nullptr;
                if (samp) { d = US + (unsigned)(rt * DFF2); if ((rt & 7) >= TS - 2) d2 = out + O_FS + (size_t)((rt >> 3) * 2 + (rt & 7) - (TS - 2)) * DFF2; }
                else {
                    if (ai == 0 && m == 0 && wr == 0 && fr < 2) d = UH + (unsigned)((u.pm * 4 + fr) * DFF2);
                    if (ai == 1 && m == 3 && wr == 1 && fr >= 14) { d = UH + (unsigned)((u.pm * 4 + 2 + fr - 14) * DFF2); if ((u.pm & 15) == 15) d2 = out + O_FP + (size_t)((u.pm >> 4) * 2 + fr - 14) * DFF2; }
                }
#pragma unroll
                for (int bj = 0; bj < 2; ++bj) {
                    const pg8::f32x4 v0 = acc[ai][bj][m][0] * rs, v1 = acc[ai][bj][m][1] * rs;
                    if (d) { *(pg8::f32x4*)(d + bj * DFF + ca) = v0; *(pg8::f32x4*)(d + bj * DFF + ca + 4) = v1; }
                    if (d2) { *(pg8::f32x4*)(d2 + bj * DFF + ca) = v0; *(pg8::f32x4*)(d2 + bj * DFF + ca + 4) = v1; }
                    P[ai][bj][m][0][0] = pg8::cvt_pk_bf16(v0[0], v0[1]); P[ai][bj][m][0][1] = pg8::cvt_pk_bf16(v0[2], v0[3]);
                    P[ai][bj][m][1][0] = pg8::cvt_pk_bf16(v1[0], v1[1]); P[ai][bj][m][1][1] = pg8::cvt_pk_bf16(v1[2], v1[3]);
                }
            }
        LAS unsigned char* xch = lds + XCH_OFF;
        if (fr >= 14) {
#pragma unroll
            for (int ai = 0; ai < 2; ++ai)
#pragma unroll
                for (int bj = 0; bj < 2; ++bj)
                    *(LAS pg8::u32x4*)(xch + (((1 + 2 * ai + wr) * 2 + fr - 14) * 256 + bj * 128 + jb) * 2) = (pg8::u32x4){P[ai][bj][3][0][0], P[ai][bj][3][0][1], P[ai][bj][3][1][0], P[ai][bj][3][1][1]};
        }
        asm volatile("s_waitcnt lgkmcnt(0)" ::: "memory"); __builtin_amdgcn_s_barrier(); asm volatile("" ::: "memory");
#pragma unroll
        for (int ai = 0; ai < 2; ++ai) {
            const int q = 2 * ai + wr;
            pg8::u32x4 H2[2], H1[2];
#pragma unroll
            for (int bj = 0; bj < 2; ++bj) { H2[bj] = *(const LAS pg8::u32x4*)(xch + ((q * 2 + 0) * 256 + bj * 128 + jb) * 2); H1[bj] = *(const LAS pg8::u32x4*)(xch + ((q * 2 + 1) * 256 + bj * 128 + jb) * 2); }
#pragma unroll
            for (int n = 0; n < 2; ++n)
#pragma unroll
                for (int h = 0; h < 2; ++h) {
                    const int cc = ca + 4 * n + 2 * h;
                    typedef float f2t __attribute__((ext_vector_type(2)));
                    f2t W0[2], W1[2], W2[2], BB[2];
#pragma unroll
                    for (int bj = 0; bj < 2; ++bj) { const float* wp = fw + bj * DFF + cc; W0[bj] = *(const f2t*)wp; W1[bj] = *(const f2t*)(wp + DFF2); W2[bj] = *(const f2t*)(wp + 2 * DFF2); BB[bj] = *(const f2t*)(fb + bj * DFF + cc); }
#pragma unroll
                    for (int m = 3; m >= 0; --m) {
                        float y[2][2];
#pragma unroll
                        for (int bj = 0; bj < 2; ++bj) {
                            const unsigned cur = P[ai][bj][m][n][h];
                            const unsigned c1 = dppu<0x121>(cur), c2 = dppu<0x122>(cur);
                            unsigned q1, q2;
                            if (m > 0) { const unsigned pv = P[ai][bj][m > 0 ? m - 1 : 0][n][h]; q1 = dppu<0x121>(pv); q2 = dppu<0x122>(pv); }
                            else { const unsigned hh1 = H1[bj][2 * n + h], hh2 = H2[bj][2 * n + h]; q1 = hh1; q2 = (fr == 0) ? hh2 : hh1; }
                            const unsigned p1 = (fr >= 1) ? c1 : q1, p2 = (fr >= 2) ? c2 : q2;
                            y[bj][0] = BB[bj].x + W0[bj].x * bflo(p2) + W1[bj].x * bflo(p1) + W2[bj].x * bflo(cur);
                            y[bj][1] = BB[bj].y + W0[bj].y * bfhi(p2) + W1[bj].y * bfhi(p1) + W2[bj].y * bfhi(cur);
                        }
                        P[ai][0][m][n][h] = pg8::cvt_pk_bf16(siluf(y[0][0]) * y[1][0], siluf(y[0][1]) * y[1][1]);
                        __builtin_amdgcn_sched_barrier(0);
                    }
                }
        }
#pragma unroll
        for (int ai = 0; ai < 2; ++ai)
#pragma unroll
            for (int m = 0; m < 4; ++m) {
                const int row = u.pm * 256 + ai * 128 + wr * 64 + m * 16 + fr;
                *(pg8::u32x4*)(ACT + (unsigned)(row * DFF + ca)) = (pg8::u32x4){P[ai][0][m][0][0], P[ai][0][m][0][1], P[ai][0][m][1][0], P[ai][0][m][1][1]};
            }
    }
};
struct EpiDown {
    static constexpr bool PERM = false, AFTER_DRAIN = false;
    pg8::bf16_t* Hb; float psc;
    __device__ __forceinline__ void operator()(const pg8::f32x4 (&acc)[2][2][4][2], const pg8::Unit& u, int wr, int wc, int fr, int fq) const {
        const int col0 = u.pn * 256 + wc * 32 + 4 * fq;
#pragma unroll
        for (int ai = 0; ai < 2; ++ai)
#pragma unroll
            for (int m = 0; m < 4; ++m) {
                const int row = u.pm * 256 + ai * 128 + wr * 64 + m * 16 + fr;
#pragma unroll
                for (int bj = 0; bj < 2; ++bj)
#pragma unroll
                    for (int n = 0; n < 2; ++n) {
                        const int c = col0 + bj * 128 + n * 16; u32x2* hp = (u32x2*)(Hb + (unsigned)(row * DM + c));
                        const u32x2 o = *hp; const pg8::f32x4 a = acc[ai][bj][m][n] * psc;
                        u32x2 w; w.x = pg8::cvt_pk_bf16(bflo(o.x) + a[0], bfhi(o.x) + a[1]); w.y = pg8::cvt_pk_bf16(bflo(o.y) + a[2], bfhi(o.y) + a[3]);
                        *hp = w;
                    }
                asm volatile("" ::: "memory");
            }
    }
};
struct EpiPle {
    static constexpr bool PERM = false, AFTER_DRAIN = false;
    pg8::bf16_t* E; float* RS;
    __device__ __forceinline__ void operator()(const pg8::f32x4 (&acc)[2][2][4][2], const pg8::Unit& u, int wr, int wc, int fr, int fq) const {
        const int col0 = u.pn * 256 + wc * 32 + 4 * fq;
#pragma unroll
        for (int ai = 0; ai < 2; ++ai)
#pragma unroll
            for (int m = 0; m < 4; ++m) {
                const int row = u.pm * 256 + ai * 128 + wr * 64 + m * 16 + fr; float ss = 0.f;
#pragma unroll
                for (int bj = 0; bj < 2; ++bj)
#pragma unroll
                    for (int n = 0; n < 2; ++n) {
                        const int c = col0 + bj * 128 + n * 16; const pg8::f32x4 h = acc[ai][bj][m][n];
                        u32x2 w; w.x = pg8::cvt_pk_bf16(h[0], h[1]); w.y = pg8::cvt_pk_bf16(h[2], h[3]);
                        *(u32x2*)(E + (unsigned)(row * DM + c)) = w;
                        ss += (h[0] * h[0] + h[1] * h[1]) + (h[2] * h[2] + h[3] * h[3]);
                    }
                ss += __shfl_xor(ss, 16); ss += __shfl_xor(ss, 32);
                if (fq == 0) atomicAdd(RS + row, ss);
            }
    }
};
struct EpiGate {
    static constexpr bool PERM = false, AFTER_DRAIN = false;
    const pg8::bf16_t* H2b; const pg8::bf16_t* E; const float* RSE; const float* gple; pg8::bf16_t* H3b; float* RS3;
    __device__ __forceinline__ void operator()(const pg8::f32x4 (&acc)[2][2][4][2], const pg8::Unit& u, int wr, int wc, int fr, int fq) const {
        const int col0 = u.pn * 256 + wc * 32 + 4 * fq;
        pg8::f32x4 gp[2][2];
#pragma unroll
        for (int bj = 0; bj < 2; ++bj)
#pragma unroll
            for (int n = 0; n < 2; ++n) gp[bj][n] = *(const pg8::f32x4*)(gple + col0 + bj * 128 + n * 16);
#pragma unroll
        for (int ai = 0; ai < 2; ++ai)
#pragma unroll
            for (int m = 0; m < 4; ++m) {
                const int row = u.pm * 256 + ai * 128 + wr * 64 + m * 16 + fr;
                const float rse = 1.0f / sqrtf(RSE[row] * (1.f / DM) + EPS);
                float ss = 0.f;
#pragma unroll
                for (int bj = 0; bj < 2; ++bj)
#pragma unroll
                    for (int n = 0; n < 2; ++n) {
                        const int c = col0 + bj * 128 + n * 16; const unsigned o = (unsigned)(row * DM + c);
                        const pg8::f32x4 a = acc[ai][bj][m][n]; const u32x2 eb = *(const u32x2*)(E + o), hb = *(const u32x2*)(H2b + o);
                        const float e4[4] = {bflo(eb.x), bfhi(eb.x), bflo(eb.y), bfhi(eb.y)}, h4[4] = {bflo(hb.x), bfhi(hb.x), bflo(hb.y), bfhi(hb.y)};
                        float h[4];
#pragma unroll
                        for (int k = 0; k < 4; ++k) { const float g = 1.f / (1.f + __expf(-a[k])); h[k] = h4[k] + g * (e4[k] * rse * gp[bj][n][k]); }
                        u32x2 w; w.x = pg8::cvt_pk_bf16(h[0], h[1]); w.y = pg8::cvt_pk_bf16(h[2], h[3]);
                        *(u32x2*)(H3b + o) = w;
                        ss += (h[0] * h[0] + h[1] * h[1]) + (h[2] * h[2] + h[3] * h[3]);
                    }
                ss += __shfl_xor(ss, 16); ss += __shfl_xor(ss, 32);
                if (fq == 0) atomicAdd(RS3 + row, ss);
                asm volatile("" ::: "memory");
            }
    }
};

__device__ __forceinline__ void load8bf(const bf16* p, float (&o)[8]) {
    const v4u w = *(const v4u*)p;
    o[0] = bflo(w.x); o[1] = bfhi(w.x); o[2] = bflo(w.y); o[3] = bfhi(w.y); o[4] = bflo(w.z); o[5] = bfhi(w.z); o[6] = bflo(w.w); o[7] = bfhi(w.w);
}
__device__ __forceinline__ void load8f(const float* p, float (&o)[8]) {
    const f32x4 a = *(const f32x4*)p, b = *(const f32x4*)(p + 4);
    o[0] = a.x; o[1] = a.y; o[2] = a.z; o[3] = a.w; o[4] = b.x; o[5] = b.y; o[6] = b.z; o[7] = b.w;
}
__device__ __forceinline__ void p0_transpose_item(const float* W, int ldn, int K, int N, bf16* WT, const float* gk, LAS float* scr, int item, int lane, bool upperm = false) {
    const int nblk = N / 32, kb = item / nblk, nb = item % nblk, k0 = 64 * kb, n0 = 32 * nb;
    const int nd0 = !upperm ? n0 : (n0 < DFF ? 256 * (n0 >> 7) + (n0 & 127) : 256 * ((n0 - DFF) >> 7) + 128 + ((n0 - DFF) & 127));
    const float* src = W + (size_t)(k0 + (lane >> 5)) * ldn + n0 + (lane & 31);
    float wv[32];
#pragma unroll
    for (int i = 0; i < 32; ++i) wv[i] = src[(size_t)(2 * i) * ldn];
#pragma unroll
    for (int i = 0; i < 32; ++i) scr[(2 * i + (lane >> 5)) * 33 + (lane & 31)] = wv[i];
    const int c = lane & 7;
    float g8[8];
    if (gk) load8f(gk + k0 + 8 * c, g8); else {
#pragma unroll
        for (int j = 0; j < 8; ++j) g8[j] = 1.f; }
    LDS_WAIT(); asm volatile("" ::: "memory");
#pragma unroll
    for (int j = 0; j < 4; ++j) { const int n = (lane >> 3) + 8 * j; const LAS float* sp = scr + (8 * c) * 33 + n;
        v4u o; o.x = pk2(sp[0 * 33] * g8[0], sp[1 * 33] * g8[1]); o.y = pk2(sp[2 * 33] * g8[2], sp[3 * 33] * g8[3]); o.z = pk2(sp[4 * 33] * g8[4], sp[5 * 33] * g8[5]); o.w = pk2(sp[6 * 33] * g8[6], sp[7 * 33] * g8[7]);
        *(GAS v4u*)(WT + (size_t)(nd0 + n) * K + k0 + 8 * c) = o; }
    LDS_WAIT(); asm volatile("" ::: "memory");
}
__device__ __forceinline__ void p0_prologue(const Args& a, LAS unsigned char* lds, int gw, int NGW, int wave, int lane, int part = 3) {
    unsigned char* ws = a.ws;
    LAS float* scr = (LAS float*)(lds + wave * 8704);
    constexpr int I_IN = (DM / 64) * (NIN / 32), I_OUT = (DM / 64) * (DM / 32), I_UP = (DM / 64) * (DFF2 / 32), I_DN = (DFF / 64) * (DM / 32), I_PLE = (DPLE / 64) * (DM / 32), I_G = I_OUT;
    constexpr int NITEMS = I_IN + I_OUT + I_UP + I_DN + I_PLE + I_G;
    if (part & 1) for (int it = gw; it < NITEMS; it += NGW) {
        int r = it;
        if (r < I_IN)  { p0_transpose_item(a.in[11], IN_LD, DM, NIN, (bf16*)(ws + WS_WIN), a.in[10], scr, r, lane); continue; } r -= I_IN;
        if (r < I_OUT) { p0_transpose_item(a.in[18], DM, DM, DM, (bf16*)(ws + WS_WOUT), nullptr, scr, r, lane); continue; } r -= I_OUT;
        if (r < I_UP)  { p0_transpose_item(a.in[20], DFF2, DM, DFF2, (bf16*)(ws + WS_WUP), a.in[19], scr, r, lane, true); continue; } r -= I_UP;
        if (r < I_DN)  { p0_transpose_item(a.in[23], DM, DFF, DM, (bf16*)(ws + WS_WDOWN), nullptr, scr, r, lane); continue; } r -= I_DN;
        if (r < I_PLE) { p0_transpose_item(a.in[24], DM, DPLE, DM, (bf16*)(ws + WS_WPLE), nullptr, scr, r, lane); continue; } r -= I_PLE;
        p0_transpose_item(a.in[26], DM, DM, DM, (bf16*)(ws + WS_WGATE), nullptr, scr, r, lane);
    }
    const float* gmix = a.in[10]; const float* win = a.in[11]; const float* dtb = a.in[14];
    bf16* XN = (bf16*)(ws + WS_XN); bf16* PB = (bf16*)(ws + WS_PB); float* DT = (float*)(ws + WS_DT);
    LAS unsigned char* dtw = lds + 81920;
    for (int k = threadIdx.x; k < DM; k += NWAVES * 64) {
        const float gk = gmix[k]; const f32x4 w0 = *(const f32x4*)(win + (size_t)k * IN_LD + NIN) * gk, w1 = *(const f32x4*)(win + (size_t)k * IN_LD + NIN + 4) * gk;
        LAS f32x4* d = (LAS f32x4*)(dtw + (k >> 2) * 144 + (k & 3) * 32); d[0] = w0; d[1] = w1;
    }
    LDS_WAIT(); __syncthreads();
    f32x4 vn[4];
    if (gw < MT) { const float* xrow = (gw < MP) ? a.in[0] + (size_t)gw * DM : a.in[1] + (size_t)(gw - MP) * DM;
#pragma unroll
        for (int j = 0; j < 4; ++j) vn[j] = ((const GAS f32x4*)xrow + lane)[64 * j]; }
    if (part & 2) for (int m = gw; m < MT; m += NGW) {
        f32x4 v[4]; float s = 0.f;
#pragma unroll
        for (int j = 0; j < 4; ++j) { v[j] = vn[j]; s += (v[j].x * v[j].x + v[j].y * v[j].y) + (v[j].z * v[j].z + v[j].w * v[j].w); }
        { const int mn = m + NGW; if (mn < MT) { const float* xrow = (mn < MP) ? a.in[0] + (size_t)mn * DM : a.in[1] + (size_t)(mn - MP) * DM;
#pragma unroll
            for (int j = 0; j < 4; ++j) vn[j] = ((const GAS f32x4*)xrow + lane)[64 * j]; } }
        const float rstd = 1.0f / sqrtf(wave_sum(s) * (1.f / DM) + EPS);
        GAS unsigned long long* o8 = (GAS unsigned long long*)(XN + (size_t)m * DM) + lane;
        float dacc[8];
#pragma unroll
        for (int h = 0; h < 8; ++h) dacc[h] = 0.f;
#pragma unroll
        for (int j = 0; j < 4; ++j) {
            v[j] = v[j] * rstd;
            o8[64 * j] = (unsigned long long)pk2(v[j].x, v[j].y) | ((unsigned long long)pk2(v[j].z, v[j].w) << 32);
#pragma unroll
            for (int e = 0; e < 4; ++e) {
                const float xv = v[j][e];
                const LAS f32x4* d = (const LAS f32x4*)(dtw + (64 * j + lane) * 144 + e * 32);
                const f32x4 w0 = d[0], w1 = d[1];
                dacc[0] += xv * w0.x; dacc[1] += xv * w0.y; dacc[2] += xv * w0.z; dacc[3] += xv * w0.w;
                dacc[4] += xv * w1.x; dacc[5] += xv * w1.y; dacc[6] += xv * w1.z; dacc[7] += xv * w1.w;
            }
        }
#pragma unroll
        for (int h = 0; h < 8; ++h) dacc[h] = softplusf(wave_sum(dacc[h]) + dtb[h]);
        if (lane == 0) { *(f32x4*)(DT + (size_t)m * 8) = (f32x4){dacc[0], dacc[1], dacc[2], dacc[3]}; *(f32x4*)(DT + (size_t)m * 8 + 4) = (f32x4){dacc[4], dacc[5], dacc[6], dacc[7]}; }
        const float* prow = (m < MP) ? a.in[2] + (size_t)m * DPLE : a.in[3] + (size_t)(m - MP) * DPLE;
        const f32x4 pv = *((const f32x4*)prow + lane);
        *((GAS unsigned long long*)(PB + (size_t)m * DPLE) + lane) = (unsigned long long)pk2(pv.x, pv.y) | ((unsigned long long)pk2(pv.z, pv.w) << 32);
    }
}

__device__ __forceinline__ void conv_sample_pass(const Args& a, int gtid, int NT) {
    const bf16* PROJ = (const bf16*)(a.ws + WS_PROJ); float* XB = (float*)(a.ws + WS_XBS); bf16* XC = (bf16*)(a.ws + WS_XC);
    const float* cw = a.in[12]; const float* cb = a.in[13]; const float* sconv = a.in[7];
    for (int it = gtid; it < NBS * 128; it += NT) {
        const int b = it >> 7, c = (it & 127) * 8, m0 = MP + b * 8;
        float w0[8], w1[8], w2[8], w3[8], bb[8], x3[8], x2[8], x1[8];
        load8f(cw + c, w0); load8f(cw + 1024 + c, w1); load8f(cw + 2048 + c, w2); load8f(cw + 3072 + c, w3); load8f(cb + c, bb);
        load8f(sconv + (size_t)(b * 3 + 0) * 1024 + c, x3); load8f(sconv + (size_t)(b * 3 + 1) * 1024 + c, x2); load8f(sconv + (size_t)(b * 3 + 2) * 1024 + c, x1);
#pragma unroll
        for (int r = 0; r < 8; ++r) {
            float cur[8], y[8]; load8bf(PROJ + (size_t)(m0 + r) * NIN + PC_X + c, cur);
#pragma unroll
            for (int k = 0; k < 8; ++k) { y[k] = siluf(bb[k] + w0[k] * x3[k] + w1[k] * x2[k] + w2[k] * x1[k] + w3[k] * cur[k]); x3[k] = x2[k]; x2[k] = x1[k]; x1[k] = cur[k]; }
            float* o = XB + (size_t)(b * 8 + r) * 1024 + c;
            *(f32x4*)o = (f32x4){y[0], y[1], y[2], y[3]}; *(f32x4*)(o + 4) = (f32x4){y[4], y[5], y[6], y[7]};
            if (c < 512) { v4u w; w.x = pk2(y[0], y[1]); w.y = pk2(y[2], y[3]); w.z = pk2(y[4], y[5]); w.w = pk2(y[6], y[7]); *(v4u*)(XC + (size_t)(m0 + r) * 512 + c) = w; }
        }
    }
}

#ifndef S1SUB
#define S1SUB 7
#endif
constexpr int S1_BR = 0, S1_CR = 32768, S1_BT = 65536, S1_XT = 98304, S1_XW = 114688, S1_AC = 133120;
__device__ __forceinline__ void ssd_s1_unit(const Args& a, LAS unsigned char* lds, int unit, int tid, int wave, int lane) {
    asm volatile("" : "+v"(tid), "+v"(lane));
    const int h = unit & 7, c = (unit >> 3) & 31, b = unit >> 8, g = h >> 2, m0 = b * SEQ + c * 128;
    const bf16* PROJ = (const bf16*)(a.ws + WS_PROJ); const float* DT = (const float*)(a.ws + WS_DT);
    LAS float* ac = (LAS float*)(lds + S1_AC); LAS float* dts = ac + 128;
    const int r32 = lane & 31, hh = lane >> 5;
    const int o = tid % 40, rc = tid / 40, s0 = rc * 11;
    const int xcol = (o < 8) ? h * 64 + 8 * o : (o < 24) ? 512 + g * 128 + 8 * (o - 8) : 768 + g * 128 + 8 * (o - 24);
    const bool cact = tid < 480;
    v4u raw[14];
    if (cact) {
#pragma unroll
        for (int i = 0; i < 14; ++i) { int sr = s0 - 3 + i; sr = sr > 127 ? 127 : sr; if (c == 0 && sr < 0) sr = 0; raw[i] = *(const v4u*)(PROJ + (size_t)(m0 + sr) * NIN + PC_X + xcol); }
    }
    if (wave == 0) {
        const float A = -__expf(a.in[15][h]);
        const float d0 = DT[(size_t)(m0 + 2 * lane) * 8 + h], d1 = DT[(size_t)(m0 + 2 * lane + 1) * 8 + h];
        const float a0 = d0 * A, a1 = d1 * A; float v = a0 + a1;
#pragma unroll
        for (int d = 1; d < 64; d <<= 1) { const float n = __shfl_up(v, d); if (lane >= d) v += n; }
        const float e0 = v - a1, e1 = v;
        ac[2 * lane] = e0; ac[2 * lane + 1] = e1; dts[2 * lane] = d0; dts[2 * lane + 1] = d1;
        float* ACUM = (float*)(a.ws + WS_ACUM); ACUM[(size_t)(m0 + 2 * lane) * 8 + h] = e0; ACUM[(size_t)(m0 + 2 * lane + 1) * 8 + h] = e1;
        if (lane == 63) ((float*)(a.ws + WS_ACL))[(b * 32 + c) * 8 + h] = e1;
    }
    __syncthreads();
    if ((S1SUB & 1) && cact) {
        const float* cw = a.in[12]; const float* cb = a.in[13];
        float w0[8], w1[8], w2[8], w3[8], bb[8], x3[8], x2[8], x1[8];
        load8f(cw + xcol, w0); load8f(cw + 1024 + xcol, w1); load8f(cw + 2048 + xcol, w2); load8f(cw + 3072 + xcol, w3); load8f(cb + xcol, bb);
        const bool z0 = (c == 0 && rc == 0);
        { const v4u r3 = raw[0], r2 = raw[1], r1 = raw[2];
          x3[0] = bflo(r3.x); x3[1] = bfhi(r3.x); x3[2] = bflo(r3.y); x3[3] = bfhi(r3.y); x3[4] = bflo(r3.z); x3[5] = bfhi(r3.z); x3[6] = bflo(r3.w); x3[7] = bfhi(r3.w);
          x2[0] = bflo(r2.x); x2[1] = bfhi(r2.x); x2[2] = bflo(r2.y); x2[3] = bfhi(r2.y); x2[4] = bflo(r2.z); x2[5] = bfhi(r2.z); x2[6] = bflo(r2.w); x2[7] = bfhi(r2.w);
          x1[0] = bflo(r1.x); x1[1] = bfhi(r1.x); x1[2] = bflo(r1.y); x1[3] = bfhi(r1.y); x1[4] = bflo(r1.z); x1[5] = bfhi(r1.z); x1[6] = bflo(r1.w); x1[7] = bfhi(r1.w);
          if (z0) {
#pragma unroll
              for (int k = 0; k < 8; ++k) { x3[k] = 0.f; x2[k] = 0.f; x1[k] = 0.f; } } }
        const float aL = ac[127];
        bf16* XC = (bf16*)(a.ws + WS_XC); bf16* CC = (bf16*)(a.ws + WS_CC);
#pragma unroll
        for (int r = 0; r < 11; ++r) {
            const int sr = s0 + r;
            if (sr < 128) {
                const v4u rw = raw[3 + r]; float cur[8], y[8];
                cur[0] = bflo(rw.x); cur[1] = bfhi(rw.x); cur[2] = bflo(rw.y); cur[3] = bfhi(rw.y); cur[4] = bflo(rw.z); cur[5] = bfhi(rw.z); cur[6] = bflo(rw.w); cur[7] = bfhi(rw.w);
#pragma unroll
                for (int k = 0; k < 8; ++k) { y[k] = siluf(bb[k] + w0[k] * x3[k] + w1[k] * x2[k] + w2[k] * x1[k] + w3[k] * cur[k]); x3[k] = x2[k]; x2[k] = x1[k]; x1[k] = cur[k]; }
                v4u w; w.x = pk2(y[0], y[1]); w.y = pk2(y[2], y[3]); w.z = pk2(y[4], y[5]); w.w = pk2(y[6], y[7]);
                if (o < 8) {
                    const int off = (o >> 2) * 8192 + (sr >> 4) * 1024 + (sr & 15) * 64 + (o & 3) * 16;
                    *(LAS v4u*)(lds + S1_XT + off) = w;
                    const float de = __expf(aL - ac[sr]) * dts[sr];
                    v4u ww; ww.x = pk2(y[0] * de, y[1] * de); ww.y = pk2(y[2] * de, y[3] * de); ww.z = pk2(y[4] * de, y[5] * de); ww.w = pk2(y[6] * de, y[7] * de);
                    *(LAS v4u*)(lds + S1_XW + off) = ww;
                    *(v4u*)(XC + (size_t)(m0 + sr) * 512 + h * 64 + 8 * o) = w;
                } else if (o < 24) {
                    const int ch = o - 8;
                    *(LAS v4u*)(lds + S1_BR + sr * 256 + ((ch ^ (sr & 15)) << 4)) = w;
                    *(LAS v4u*)(lds + S1_BT + (ch >> 2) * 8192 + (sr >> 4) * 1024 + (sr & 15) * 64 + (ch & 3) * 16) = w;
                } else {
                    const int ch = o - 24;
                    *(LAS v4u*)(lds + S1_CR + sr * 256 + ((ch ^ (sr & 15)) << 4)) = w;
                    if ((h & 3) == 0) *(v4u*)(CC + (size_t)(m0 + sr) * 256 + g * 128 + 8 * ch) = w;
                }
            }
        }
    }
    __syncthreads();
    const int laneoff = ((lane >> 4) & 1) * 32 + (lane & 3) * 8 + (4 * hh + ((lane & 15) >> 2)) * 64;
    if (S1SUB & 2) {
        const int tb = wave >> 1, ph = wave & 1, tq = 32 * tb + r32;
        bf16x8 cq[8];
#pragma unroll
        for (int k = 0; k < 8; ++k) cq[k] = *(const LAS bf16x8*)(lds + S1_CR + tq * 256 + (((2 * k + hh) ^ (tq & 15)) << 4));
        const float act = ac[tq] * LOG2E;
        f32x16 o;
#pragma unroll
        for (int i = 0; i < 16; ++i) o[i] = 0.f;
#pragma unroll 1
        for (int sb = 0; sb <= tb; ++sb) {
            {
                f32x16 S;
#pragma unroll
                for (int i = 0; i < 16; ++i) S[i] = 0.f;
                const int sq = 32 * sb + r32;
#pragma unroll
                for (int k = 0; k < 8; ++k) { const bf16x8 bf = *(const LAS bf16x8*)(lds + S1_BR + sq * 256 + (((2 * k + hh) ^ (sq & 15)) << 4)); S = __builtin_amdgcn_mfma_f32_32x32x16_bf16(bf, cq[k], S, 0, 0, 0); }
#pragma unroll
                for (int i = 0; i < 16; ++i) { const int si = 32 * sb + crow(i, hh); const float e = __builtin_amdgcn_exp2f(act - ac[si] * LOG2E) * dts[si]; S[i] = (si <= tq) ? S[i] * e : 0.f; }
#pragma unroll
                for (int ks = 0; ks < 2; ++ks) {
                    v4u pw; pw.x = cvtpk_s(S[8 * ks + 0], S[8 * ks + 1]); pw.y = cvtpk_s(S[8 * ks + 2], S[8 * ks + 3]); pw.z = cvtpk_s(S[8 * ks + 4], S[8 * ks + 5]); pw.w = cvtpk_s(S[8 * ks + 6], S[8 * ks + 7]);
                    const bf16x8 pa = __builtin_bit_cast(bf16x8, pw);
                    const LAS unsigned char* xp = lds + S1_XT + ph * 8192 + (2 * sb + ks) * 1024 + laneoff;
                    const v4i16_t lo = vtr(xp), hi2 = vtr(xp + 512);
                    const bf16x8 xb = (bf16x8){lo[0], lo[1], lo[2], lo[3], hi2[0], hi2[1], hi2[2], hi2[3]};
                    o = __builtin_amdgcn_mfma_f32_32x32x16_bf16(pa, xb, o, 0, 0, 0);
                }
            }
        }
        float* YS = (float*)(a.ws + WS_YS);
#pragma unroll
        for (int i = 0; i < 16; ++i) YS[(size_t)(m0 + 32 * tb + crow(i, hh)) * 512 + h * 64 + 32 * ph + r32] = o[i];
    }
    if (S1SUB & 4) {
        const int pb = wave & 1, nb = wave >> 1;
        f32x16 st;
#pragma unroll
        for (int i = 0; i < 16; ++i) st[i] = 0.f;
#pragma unroll
        for (int k = 0; k < 8; ++k) {
            const LAS unsigned char* ap = lds + S1_XW + pb * 8192 + k * 1024 + laneoff; const LAS unsigned char* bp = lds + S1_BT + nb * 8192 + k * 1024 + laneoff;
            const v4i16_t al = vtr(ap), ah = vtr(ap + 512), bl = vtr(bp), bh = vtr(bp + 512);
            const bf16x8 af = (bf16x8){al[0], al[1], al[2], al[3], ah[0], ah[1], ah[2], ah[3]}, bf = (bf16x8){bl[0], bl[1], bl[2], bl[3], bh[0], bh[1], bh[2], bh[3]};
            st = __builtin_amdgcn_mfma_f32_32x32x16_bf16(af, bf, st, 0, 0, 0);
        }
        float* CS = (float*)(a.ws + WS_CS) + (size_t)((b * 32 + c) * 8 + h) * 64 * 128;
#pragma unroll
        for (int i = 0; i < 16; ++i) CS[(size_t)(32 * pb + crow(i, hh)) * 128 + 32 * nb + r32] = st[i];
    }
    LDS_WAIT(); __syncthreads();
}
__device__ __forceinline__ void ssd_s2_pass(const Args& a, int gtid, int NT) {
    typedef float f32x2t __attribute__((ext_vector_type(2)));
    const float* CS = (const float*)(a.ws + WS_CS); const float* ACL = (const float*)(a.ws + WS_ACL); bf16* PREV = (bf16*)(a.ws + WS_PREV);
    for (int it = gtid; it < NBP * 8 * 64 * 64; it += NT) {
        const int n2 = it & 63, p = (it >> 6) & 63, h = (it >> 12) & 7, b = it >> 15;
        f32x2t s = {0.f, 0.f};
#pragma unroll 8
        for (int c = 0; c < 32; ++c) {
            const size_t idx = ((size_t)((b * 32 + c) * 8 + h) * 64 + p) * 128 + 2 * n2;
            const f32x2t cs = *(const f32x2t*)(CS + idx); const float dec = __expf(ACL[(b * 32 + c) * 8 + h]);
            *(unsigned*)(PREV + idx) = pk2(s.x, s.y);
            s = s * dec + cs;
        }
        *(f32x2t*)(a.out + O_SP + ((size_t)((b * 8 + h) * 64 + p)) * 128 + 2 * n2) = s;
    }
}
__device__ __forceinline__ void ssd_s3_unit(const Args& a, int unit, int wave, int lane, float psc = 1.f) {
    asm volatile("" : "+v"(lane));
    const int h = unit & 7, c = (unit >> 3) & 31, b = unit >> 8, g = h >> 2, m0 = b * SEQ + c * 128;
    const int r32 = lane & 31, hh = lane >> 5, tb = wave >> 1, ph = wave & 1;
    const bf16* cp = (const bf16*)(a.ws + WS_CC) + (size_t)(m0 + 32 * tb + r32) * 256 + g * 128 + 8 * hh;
    const bf16* pp = (const bf16*)(a.ws + WS_PREV) + ((size_t)((b * 32 + c) * 8 + h) * 64 + 32 * ph + r32) * 128 + 8 * hh;
    bf16x8 cf[8], pf[8];
#pragma unroll
    for (int k = 0; k < 8; ++k) { cf[k] = *(const bf16x8*)(cp + 16 * k); pf[k] = *(const bf16x8*)(pp + 16 * k); }
    f32x16 acc;
#pragma unroll
    for (int i = 0; i < 16; ++i) acc[i] = 0.f;
#pragma unroll
    for (int k = 0; k < 8; ++k) acc = __builtin_amdgcn_mfma_f32_32x32x16_bf16(cf[k], pf[k], acc, 0, 0, 0);
    float* YS = (float*)(a.ws + WS_YS); const float* ACUM = (const float*)(a.ws + WS_ACUM);
#pragma unroll
    for (int i = 0; i < 16; ++i) { const size_t t = (size_t)(m0 + 32 * tb + crow(i, hh)); float* yp = YS + t * 512 + h * 64 + 32 * ph + r32; *yp = *yp + psc * __expf(ACUM[t * 8 + h]) * acc[i]; }
}

constexpr int ATT_WAVE_BYTES = 8704, ATT_VB = 0, ATT_STG = 4096, ATT_WSF = 8192, ATT_BTAB_OFF = 8 * ATT_WAVE_BYTES  , ATT_BT_LD = 132;

__device__ __forceinline__ void attn_build_btab(const Args& a, LAS unsigned char* lds, int tid) {
    LAS float* bt = (LAS float*)(lds + ATT_BTAB_OFF); const float* rb = a.in[9];
    for (int i = tid; i < 3 * 8 * 129; i += NWAVES * 64) { const int br = i / (8 * 129), rem = i % (8 * 129), h = rem / 129, j = rem % 129; bt[(br * 8 + h) * ATT_BT_LD + j] = rb[BUCKET_TAB[br][j] * 8 + h] * LOG2E; }
}
__device__ __forceinline__ void attn_prompt_unit(const Args& a, LAS unsigned char* lds, int unit, int wave, int lane) {
    asm volatile("" : "+v"(lane));
    const bf16* PROJ = (const bf16*)(a.ws + WS_PROJ);
    const int r32 = lane & 31, hi = lane >> 5;
    const int rq = unit & 127, bhb = unit >> 7, br = bhb % 3, bh = bhb / 3, h = bh & 7, b = bh >> 3;
    const int sh = 2 * br, dil = 1 << sh, nqb = 128 >> sh, r = rq / nqb, qb = rq % nqb, l0 = qb * 32;
    const size_t rowb = (size_t)b * SEQ;
    LAS unsigned char* wl = lds + wave * ATT_WAVE_BYTES;
    const LAS float* bt = (const LAS float*)(lds + ATT_BTAB_OFF) + (br * 8 + h) * ATT_BT_LD;
    bf16x8 qr[4];
    { const bf16* qp = PROJ + (rowb + (size_t)(l0 + r32) * dil + r) * NIN + h * 64 + hi * 8;
#pragma unroll
      for (int d0 = 0; d0 < 4; ++d0) qr[d0] = *(const bf16x8*)(qp + d0 * 16); }
    const int kb0 = (l0 >= 128) ? 0 : (4 - (l0 >> 5));
    f32x16 s[5];
    bf16x8 kfa[4], kfb[4];
#define ATT_KLOAD(dst, kb_) do { int kk_ = l0 - 128 + 32 * (kb_) + r32; kk_ = kk_ < 0 ? 0 : kk_; const bf16* kp_ = PROJ + (rowb + (size_t)kk_ * dil + r) * NIN + PC_K + h * 64 + hi * 8; \
        _Pragma("unroll") for (int d0 = 0; d0 < 4; ++d0) dst[d0] = *(const bf16x8*)(kp_ + d0 * 16); } while (0)
#define ATT_QK(src, kb_) do { _Pragma("unroll") for (int i = 0; i < 16; ++i) s[kb_][i] = 0.f; \
        if ((kb_) >= kb0) { _Pragma("unroll") for (int d0 = 0; d0 < 4; ++d0) s[kb_] = __builtin_amdgcn_mfma_f32_32x32x16_bf16(src[d0], qr[d0], s[kb_], 0, 0, 0); } } while (0)
    ATT_KLOAD(kfa, 0); ATT_KLOAD(kfb, 1);
    __builtin_amdgcn_sched_barrier(0);
    ATT_QK(kfa, 0); ATT_KLOAD(kfa, 2);
    __builtin_amdgcn_sched_barrier(0);
    ATT_QK(kfb, 1); ATT_KLOAD(kfb, 3);
    __builtin_amdgcn_sched_barrier(0);
    ATT_QK(kfa, 2); ATT_KLOAD(kfa, 4);
    __builtin_amdgcn_sched_barrier(0);
    ATT_QK(kfb, 3);
    __builtin_amdgcn_sched_barrier(0);
    ATT_QK(kfa, 4);
#undef ATT_KLOAD
#undef ATT_QK
    __builtin_amdgcn_sched_barrier(0);
    v4u vpre[5][4];
#pragma unroll
    for (int kb = 0; kb < 3; ++kb)
#pragma unroll
        for (int i = 0; i < 4; ++i) {
            const int idx = i * 64 + lane, key = idx >> 3, ch = idx & 7;
            int kk = l0 - 128 + 32 * kb + key; kk = kk < 0 ? 0 : kk;
            vpre[kb][i] = *(const v4u*)(PROJ + (rowb + (size_t)kk * dil + r) * NIN + PC_V + h * 64 + ch * 8);
        }
    __builtin_amdgcn_sched_barrier(0);
    float mx = -INFINITY;
    int J0 = r32 - 4 * hi + 128, T0 = 128 - l0 - 4 * hi;
    asm volatile("" : "+v"(J0), "+v"(T0));
#pragma unroll
    for (int kb = 0; kb < 5; ++kb)
#pragma unroll
        for (int i = 0; i < 16; ++i) {
            const int cst = (i & 3) + 8 * (i >> 2) + 32 * kb, j = J0 - cst;
            const bool valid = ((unsigned)j <= 128u) && (cst >= T0) && (kb >= kb0);
            const int jc = j < 0 ? 0 : (j > 128 ? 128 : j);
            const float v = valid ? s[kb][i] + bt[jc] : -INFINITY;
            s[kb][i] = v; mx = fmaxf(mx, v);
        }
    mx = fmaxf(mx, __shfl_xor(mx, 32));
    float l = 0.f;
#pragma unroll
    for (int kb = 0; kb < 5; ++kb)
#pragma unroll
        for (int i = 0; i < 16; ++i) { const float p = __builtin_amdgcn_exp2f(s[kb][i] - mx); s[kb][i] = p; l += p; }
    l += __shfl_xor(l, 32);
    __builtin_amdgcn_sched_barrier(0);
#pragma unroll
    for (int kb = 3; kb < 5; ++kb)
#pragma unroll
        for (int i = 0; i < 4; ++i) {
            const int idx = i * 64 + lane, key = idx >> 3, ch = idx & 7;
            int kk = l0 - 128 + 32 * kb + key; kk = kk < 0 ? 0 : kk;
            vpre[kb][i] = *(const v4u*)(PROJ + (rowb + (size_t)kk * dil + r) * NIN + PC_V + h * 64 + ch * 8);
        }
    f32x16 o[2];
#pragma unroll
    for (int i = 0; i < 16; ++i) { o[0][i] = 0.f; o[1][i] = 0.f; }
    const LAS unsigned char* vrd = wl + ATT_VB + ((lane >> 4) & 1) * 32 + (lane & 3) * 8 + (4 * hi + ((lane & 15) >> 2)) * 64;
#pragma unroll
    for (int kb = 0; kb < 5; ++kb) {
        if (kb >= kb0) {
#pragma unroll
            for (int i = 0; i < 4; ++i) {
                const int idx = i * 64 + lane, key = idx >> 3, ch = idx & 7;
                *(LAS v4u*)(wl + ATT_VB + (ch >> 2) * 2048 + (key >> 4) * 1024 + (key & 15) * 64 + (ch & 3) * 16) = vpre[kb][i];
            }
            LDS_WAIT();
#pragma unroll
            for (int ks = 0; ks < 2; ++ks) {
                v4u pw;
                pw.x = cvtpk_s(s[kb][8 * ks + 0], s[kb][8 * ks + 1]); pw.y = cvtpk_s(s[kb][8 * ks + 2], s[kb][8 * ks + 3]);
                pw.z = cvtpk_s(s[kb][8 * ks + 4], s[kb][8 * ks + 5]); pw.w = cvtpk_s(s[kb][8 * ks + 6], s[kb][8 * ks + 7]);
                const bf16x8 pa = __builtin_bit_cast(bf16x8, pw);
#pragma unroll
                for (int d0 = 0; d0 < 2; ++d0) {
                    const v4i16_t lo = vtr(vrd + d0 * 2048 + ks * 1024), hh = vtr(vrd + d0 * 2048 + ks * 1024 + 512);
                    const bf16x8 vb = (bf16x8){lo[0], lo[1], lo[2], lo[3], hh[0], hh[1], hh[2], hh[3]};
                    o[d0] = __builtin_amdgcn_mfma_f32_32x32x16_bf16(pa, vb, o[d0], 0, 0, 0);
                }
            }
            LDS_WAIT();
        }
    }
    LAS float* wsf = (LAS float*)(wl + ATT_WSF);
    if (hi == 0) wsf[r32] = l;
    LDS_WAIT();
    LAS bf16* stg = (LAS bf16*)(wl + ATT_STG);
#pragma unroll
    for (int i = 0; i < 16; ++i) {
        const int orow = crow(i, hi); const float rl = 1.0f / wsf[orow];
        stg[orow * 64 + r32] = (bf16)f2bf(o[0][i] * rl); stg[orow * 64 + 32 + r32] = (bf16)f2bf(o[1][i] * rl);
    }
    LDS_WAIT();
    bf16* OBR = (bf16*)(a.ws + WS_OBR) + (size_t)br * MP * 512;
#pragma unroll
    for (int i = 0; i < 4; ++i) {
        const int row = i * 8 + (lane >> 3), ch = lane & 7;
        const v4u v = *(const LAS v4u*)(stg + row * 64 + ch * 8);
        *(v4u*)(OBR + (rowb + (size_t)(l0 + row) * dil + r) * 512 + h * 64 + ch * 8) = v;
    }
    if (hi == 0) { float* LSE = (float*)(a.ws + WS_LSE) + (size_t)br * MP * 8; LSE[(rowb + (size_t)(l0 + r32) * dil + r) * 8 + h] = mx + __builtin_amdgcn_logf(l); }
    LDS_WAIT();
}

__device__ __forceinline__ void attn_sample_task(const Args& a, LAS unsigned char* lds, int task, int wave, int lane) {
    const int h = task & 7, t = (task >> 3) & 7, b = task >> 6;
    const bf16* PROJ = (const bf16*)(a.ws + WS_PROJ);
    const float* ck = a.in[4]; const float* cv = a.in[5]; const float* kn = a.out + O_KS; const float* vn = a.out + O_VS;
    LAS float* pl = (LAS float*)(lds + wave * ATT_WAVE_BYTES + ATT_STG);
    const int ks = lane >> 4, dq = lane & 15;
    f32x4 q4;
    { const u32x2 w = *(const u32x2*)(PROJ + (size_t)(MP + b * 8 + t) * NIN + h * 64 + 4 * dq); q4 = (f32x4){bflo(w.x), bfhi(w.x), bflo(w.y), bfhi(w.y)}; }
    const size_t cbase = ((size_t)b * WBUF * 8 + h) * 64 + 4 * dq, nbase = ((size_t)b * 8 * 8 + h) * 64 + 4 * dq;
#pragma unroll 1
    for (int br = 0; br < 3; ++br) {
        const int dil = 1 << (2 * br);
        const LAS float* bt = (const LAS float*)(lds + ATT_BTAB_OFF) + (br * 8 + h) * ATT_BT_LD;
#pragma unroll 1
        for (int it0 = 0; it0 < 33; it0 += 11) {
            f32x4 kv[11];
#pragma unroll
            for (int u = 0; u < 11; ++u) { int j = 4 * (it0 + u) + ks; j = j > 128 ? 128 : j; const int idx = WBUF + t - j * dil;
                kv[u] = (idx < WBUF) ? *(const f32x4*)(ck + cbase + (size_t)idx * 512) : *(const f32x4*)(kn + nbase + (size_t)(idx - WBUF) * 512); }
#pragma unroll
            for (int u = 0; u < 11; ++u) { const int j = 4 * (it0 + u) + ks; float d = q4.x * kv[u].x + q4.y * kv[u].y + q4.z * kv[u].z + q4.w * kv[u].w; d = row16_sum(d);
                if (dq == 0 && j <= 128) pl[br * ATT_BT_LD + j] = d + bt[j]; }
        }
    }
    LDS_WAIT(); asm volatile("" ::: "memory");
    float mx = -INFINITY;
#pragma unroll 1
    for (int i = lane; i < 3 * ATT_BT_LD; i += 64) { const int j = i % ATT_BT_LD; if (j <= 128) mx = fmaxf(mx, pl[i]); }
    mx = wave_max(mx);
    float l = 0.f;
#pragma unroll 1
    for (int i = lane; i < 3 * ATT_BT_LD; i += 64) { const int j = i % ATT_BT_LD; if (j <= 128) { const float p = __builtin_amdgcn_exp2f(pl[i] - mx); pl[i] = p; l += p; } }
    l = wave_sum(l);
    LDS_WAIT(); asm volatile("" ::: "memory");
    f32x4 o4 = {0.f, 0.f, 0.f, 0.f};
#pragma unroll 1
    for (int br = 0; br < 3; ++br) {
        const int dil = 1 << (2 * br);
#pragma unroll 1
        for (int it0 = 0; it0 < 33; it0 += 11) {
            f32x4 vv[11]; float pp[11];
#pragma unroll
            for (int u = 0; u < 11; ++u) { const int j0 = 4 * (it0 + u) + ks, j = j0 > 128 ? 128 : j0; const int idx = WBUF + t - j * dil;
                vv[u] = (idx < WBUF) ? *(const f32x4*)(cv + cbase + (size_t)idx * 512) : *(const f32x4*)(vn + nbase + (size_t)(idx - WBUF) * 512);
                pp[u] = (j0 <= 128) ? pl[br * ATT_BT_LD + j] : 0.f; }
#pragma unroll
            for (int u = 0; u < 11; ++u) o4 += vv[u] * pp[u];
        }
    }
#pragma unroll
    for (int e = 0; e < 4; ++e) { o4[e] += __shfl_xor(o4[e], 16); o4[e] += __shfl_xor(o4[e], 32); }
    if (lane < 16) { const float il = 1.f / l; u32x2 w; w.x = pk2(o4.x * il, o4.y * il); w.y = pk2(o4.z * il, o4.w * il);
        *(u32x2*)((bf16*)(a.ws + WS_MIX) + (size_t)(MP + b * 8 + t) * DM + h * 64 + 4 * dq) = w; }
    LDS_WAIT(); asm volatile("" ::: "memory");
}

__device__ __forceinline__ void ssd_sample_task(const Args& a, int k, int lane) {
    const float* XB = (const float*)(a.ws + WS_XBS); const float* DT = (const float*)(a.ws + WS_DT); float* YS = (float*)(a.ws + WS_YS);
    const int p4 = k & 15, h = (k >> 4) & 7, b = k >> 7, g = h >> 2, p = 4 * p4 + (lane >> 4), ng = lane & 15;
    const size_t sidx = ((size_t)((b * 8 + h) * 64 + p)) * 128 + 8 * ng;
    float s[8]; load8f(a.in[6] + sidx, s);
    const float A = -__expf(a.in[15][h]);
#pragma unroll 1
    for (int t0 = 0; t0 < TS; t0 += 4) {
        float dtv[4], xv[4], Bv[4][8], Cv[4][8];
#pragma unroll
        for (int q = 0; q < 4; ++q) { const int r = b * TS + t0 + q; dtv[q] = DT[(size_t)(MP + r) * 8 + h]; const float* xr = XB + (size_t)r * 1024; xv[q] = xr[h * 64 + p]; load8f(xr + 512 + g * 128 + 8 * ng, Bv[q]); load8f(xr + 768 + g * 128 + 8 * ng, Cv[q]); }
#pragma unroll
        for (int q = 0; q < 4; ++q) {
            const float da = __expf(dtv[q] * A), xd = dtv[q] * xv[q]; float y = 0.f;
#pragma unroll
            for (int e = 0; e < 8; ++e) { s[e] = da * s[e] + xd * Bv[q][e]; y += Cv[q][e] * s[e]; }
            y = row16_sum(y);
            if (ng == 0) YS[(size_t)(MP + b * TS + t0 + q) * 512 + h * 64 + p] = y;
        }
    }
    float* so = a.out + O_SS + sidx;
    *(f32x4*)so = (f32x4){s[0], s[1], s[2], s[3]}; *(f32x4*)(so + 4) = (f32x4){s[4], s[5], s[6], s[7]};
}
__device__ __forceinline__ void attn_combine_pass(const Args& a, int gtid, int NT) {
    const bf16* OBR = (const bf16*)(a.ws + WS_OBR); const float* LSE = (const float*)(a.ws + WS_LSE); bf16* MIX = (bf16*)(a.ws + WS_MIX);
    for (int it = gtid; it < MP * 64; it += NT) {
        const int row = it >> 6, c8 = it & 63, h = c8 >> 3;
        const float l0 = LSE[(size_t)row * 8 + h], l1 = LSE[(size_t)(MP + row) * 8 + h], l2 = LSE[(size_t)(2 * MP + row) * 8 + h];
        const float mx = fmaxf(l0, fmaxf(l1, l2));
        float w0 = __builtin_amdgcn_exp2f(l0 - mx), w1 = __builtin_amdgcn_exp2f(l1 - mx), w2 = __builtin_amdgcn_exp2f(l2 - mx);
        const float inv = 1.f / (w0 + w1 + w2); w0 *= inv; w1 *= inv; w2 *= inv;
        float o0[8], o1[8], o2[8];
        load8bf(OBR + (size_t)row * 512 + c8 * 8, o0); load8bf(OBR + ((size_t)MP + row) * 512 + c8 * 8, o1); load8bf(OBR + ((size_t)2 * MP + row) * 512 + c8 * 8, o2);
        float r[8];
#pragma unroll
        for (int k = 0; k < 8; ++k) r[k] = w0 * o0[k] + w1 * o1[k] + w2 * o2[k];
        v4u w; w.x = pk2(r[0], r[1]); w.y = pk2(r[2], r[3]); w.z = pk2(r[4], r[5]); w.w = pk2(r[6], r[7]);
        *(v4u*)(MIX + (size_t)row * DM + c8 * 8) = w;
    }
}
__device__ __forceinline__ void ssd_finish_pass(const Args& a, int gw, int NGW, int lane) {
    const bf16* XC = (const bf16*)(a.ws + WS_XC); const float* YS = (const float*)(a.ws + WS_YS); const bf16* PROJ = (const bf16*)(a.ws + WS_PROJ); bf16* MIX = (bf16*)(a.ws + WS_MIX);
    const float* dsk = a.in[16]; const float* gs = a.in[17];
    const int c = lane * 8; const float dh = dsk[c >> 6];
    float g8[8]; load8f(gs + c, g8);
    for (int m = gw; m < MT; m += NGW) {
        float y[8], x[8], z[8], v[8]; load8f(YS + (size_t)m * 512 + c, y); load8bf(XC + (size_t)m * 512 + c, x); load8bf(PROJ + (size_t)m * NIN + PC_Z + c, z);
        float ss = 0.f;
#pragma unroll
        for (int k = 0; k < 8; ++k) { v[k] = (y[k] + dh * x[k]) * siluf(z[k]); ss += v[k] * v[k]; }
#pragma unroll
        for (int o = 1; o < 32; o <<= 1) ss += __shfl_xor(ss, o);
        const float rs = 1.0f / sqrtf(ss * (1.f / 256.f) + EPS);
        v4u w; w.x = pk2(v[0] * rs * g8[0], v[1] * rs * g8[1]); w.y = pk2(v[2] * rs * g8[2], v[3] * rs * g8[3]); w.z = pk2(v[4] * rs * g8[4], v[5] * rs * g8[5]); w.w = pk2(v[6] * rs * g8[6], v[7] * rs * g8[7]);
        *(v4u*)(MIX + (size_t)m * DM + 512 + c) = w;
    }
}
__device__ __forceinline__ void ffn_fixup_pass(const Args& a, int gtid, int NT) {
    const float* UH = (const float*)(a.ws + WS_UH); const float* US = (const float*)(a.ws + WS_US); bf16* ACT = (bf16*)(a.ws + WS_ACT);
    const float* fw = a.in[21]; const float* fb = a.in[22]; const float* sf = a.in[8];
    constexpr int NC8 = DFF / 8, NPT = MP / 256, NITEMS = (NPT + NBS) * NC8;
    for (int it = gtid; it < NITEMS; it += NT) {
        const int blk = it / NC8, c = (it % NC8) * 8;
        float wa0[8], wa1[8], wa2[8], wb0[8], wb1[8], wb2[8], ba[8], bb[8], a2[8], a1[8], b2[8], b1[8];
        load8f(fw + c, wa0); load8f(fw + DFF2 + c, wa1); load8f(fw + 2 * DFF2 + c, wa2); load8f(fb + c, ba);
        load8f(fw + DFF + c, wb0); load8f(fw + DFF2 + DFF + c, wb1); load8f(fw + 2 * DFF2 + DFF + c, wb2); load8f(fb + DFF + c, bb);
        const float* src; int m0, nr;
        if (blk < NPT) { m0 = blk * 256; nr = 2; src = UH + (size_t)(blk * 4) * DFF2;
            if ((blk & 15) == 0) {
#pragma unroll
                for (int k = 0; k < 8; ++k) { a2[k] = 0.f; a1[k] = 0.f; b2[k] = 0.f; b1[k] = 0.f; }
            } else { const float* pv = UH + (size_t)((blk - 1) * 4 + 2) * DFF2; load8f(pv + c, a2); load8f(pv + DFF2 + c, a1); load8f(pv + DFF + c, b2); load8f(pv + DFF2 + DFF + c, b1); }
        } else { const int b = blk - NPT; m0 = MP + b * 8; nr = 8; src = US + (size_t)(b * 8) * DFF2;
            load8f(sf + (size_t)(b * 2) * DFF2 + c, a2); load8f(sf + (size_t)(b * 2 + 1) * DFF2 + c, a1); load8f(sf + (size_t)(b * 2) * DFF2 + DFF + c, b2); load8f(sf + (size_t)(b * 2 + 1) * DFF2 + DFF + c, b1); }
        for (int r = 0; r < nr; ++r) {
            float ua[8], ub[8], o[8]; load8f(src + (size_t)r * DFF2 + c, ua); load8f(src + (size_t)r * DFF2 + DFF + c, ub);
#pragma unroll
            for (int k = 0; k < 8; ++k) {
                const float ya = ba[k] + wa0[k] * a2[k] + wa1[k] * a1[k] + wa2[k] * ua[k], yb = bb[k] + wb0[k] * b2[k] + wb1[k] * b1[k] + wb2[k] * ub[k];
                o[k] = siluf(ya) * yb; a2[k] = a1[k]; a1[k] = ua[k]; b2[k] = b1[k]; b1[k] = ub[k];
            }
            v4u w; w.x = pk2(o[0], o[1]); w.y = pk2(o[2], o[3]); w.z = pk2(o[4], o[5]); w.w = pk2(o[6], o[7]);
            *(v4u*)(ACT + (size_t)(m0 + r) * DFF + c) = w;
        }
    }
}
__device__ __forceinline__ void final_norm_pass(const Args& a, int gw, int NGW, int lane) {
    const float* RS3 = (const float*)(a.ws + WS_RS3); const float* gf = a.in[27]; const bf16* H3b = (const bf16*)(a.ws + WS_MIX);
    float g[16];
    load8f(gf + lane * 16, *(float(*)[8])&g[0]); load8f(gf + lane * 16 + 8, *(float(*)[8])&g[8]);
    for (int m = gw; m < MT; m += NGW) {
        float* orow = (m < MP) ? a.out + O_Y + (size_t)m * DM : a.out + O_YS + (size_t)(m - MP) * DM;
        const float rs = 1.0f / sqrtf(RS3[m] * (1.f / DM) + EPS);
        float h[16]; load8bf(H3b + (size_t)m * DM + lane * 16, *(float(*)[8])&h[0]); load8bf(H3b + (size_t)m * DM + lane * 16 + 8, *(float(*)[8])&h[8]);
#pragma unroll
        for (int j = 0; j < 4; ++j) *(f32x4*)(orow + lane * 16 + 4 * j) = (f32x4){h[4 * j] * rs * g[4 * j], h[4 * j + 1] * rs * g[4 * j + 1], h[4 * j + 2] * rs * g[4 * j + 2], h[4 * j + 3] * rs * g[4 * j + 3]};
    }
}

typedef float f32x4m __attribute__((ext_vector_type(4)));
template <class Epi>
__device__ __forceinline__ void skinny_gemm(LAS unsigned char* lds, const bf16* A, const bf16* Wt, int N, int K, const Epi& E, int vcu, int G, int tid, int wave, int lane) {
    const int npieces = (MS / 16) * (N / 64), kslice = K / 8, nsteps = kslice / 32;
    const int r16 = lane & 15, kg = lane >> 4;
    for (int piece = vcu; piece < npieces; piece += G) {
        const int mb = piece & 15, nb = piece >> 4, m0 = mb * 16, n0 = nb * 64;
        const bf16* ap = A + (size_t)(m0 + r16) * K + wave * kslice + 8 * kg;
        const bf16* wp = Wt + (size_t)(n0 + r16) * K + wave * kslice + 8 * kg;
        f32x4m acc[4];
#pragma unroll
        for (int j = 0; j < 4; ++j) acc[j] = (f32x4m){0.f, 0.f, 0.f, 0.f};
        for (int s0 = 0; s0 < nsteps; s0 += 4) {
            bf16x8 af[4], wf[4][4];
#pragma unroll
            for (int u = 0; u < 4; ++u) if (s0 + u < nsteps) {
                af[u] = *(const bf16x8*)(ap + (s0 + u) * 32);
#pragma unroll
                for (int j = 0; j < 4; ++j) wf[u][j] = *(const bf16x8*)(wp + (size_t)(16 * j) * K + (s0 + u) * 32);
            }
#pragma unroll
            for (int u = 0; u < 4; ++u) if (s0 + u < nsteps) {
#pragma unroll
                for (int j = 0; j < 4; ++j) acc[j] = __builtin_amdgcn_mfma_f32_16x16x32_bf16(wf[u][j], af[u], acc[j], 0, 0, 0);
            }
        }
#pragma unroll
        for (int j = 0; j < 4; ++j) *(LAS f32x4m*)(lds + ((wave * 4 + j) * 64 + lane) * 16) = acc[j];
        LDS_WAIT(); __syncthreads();
        if (tid < 256) {
            const int j = tid >> 6, l2 = tid & 63;
            f32x4m v = *(const LAS f32x4m*)(lds + (j * 64 + l2) * 16);
#pragma unroll
            for (int w = 1; w < 8; ++w) v += *(const LAS f32x4m*)(lds + ((w * 4 + j) * 64 + l2) * 16);
            E.apply(m0 + (l2 & 15), n0 + 16 * j + 4 * (l2 >> 4), v);
        }
        LDS_WAIT(); __syncthreads();
    }
}
struct SEpiIn { bf16* PROJ; float* out;
    __device__ __forceinline__ void apply(int r, int c, f32x4m v) const {
        const float sc = (c < PC_K) ? C2 : 1.f; u32x2 w; w.x = pk2(v.x * sc, v.y * sc); w.y = pk2(v.z * sc, v.w * sc);
        *(u32x2*)(PROJ + (size_t)(MP + r) * NIN + c) = w;
        if (c >= PC_K && c < PC_Z) { const bool isk = c < PC_V; *(f32x4m*)(out + (isk ? O_KS : O_VS) + (size_t)r * 512 + (c - (isk ? PC_K : PC_V))) = v; }
        else if (c >= PC_X) { const int t = r & 7, b = r >> 3; if (t >= TS - 3) *(f32x4m*)(out + O_CS + (size_t)(b * 3 + t - (TS - 3)) * 1024 + (c - PC_X)) = v; }
    } };
struct SEpiOut { const float* xs; bf16* H1b; float* RS;
    __device__ __forceinline__ void apply(int r, int c, f32x4m v) const {
        const f32x4m h = *(const f32x4m*)(xs + (size_t)r * DM + c) + v; const size_t o = (size_t)(MP + r) * DM + c;
        u32x2 w; w.x = pk2(h.x, h.y); w.y = pk2(h.z, h.w); *(u32x2*)(H1b + o) = w;
        atomicAdd(RS + MP + r, (h.x * h.x + h.y * h.y) + (h.z * h.z + h.w * h.w));
    } };
struct SEpiPle { bf16* E; float* RS;
    __device__ __forceinline__ void apply(int r, int c, f32x4m v) const {
        u32x2 w; w.x = pk2(v.x, v.y); w.y = pk2(v.z, v.w); *(u32x2*)(E + (size_t)(MP + r) * DM + c) = w; atomicAdd(RS + MP + r, (v.x * v.x + v.y * v.y) + (v.z * v.z + v.w * v.w));
    } };
struct SEpiDown { bf16* Hb;
    __device__ __forceinline__ void apply(int r, int c, f32x4m v) const {
        u32x2* hp = (u32x2*)(Hb + (size_t)(MP + r) * DM + c); const u32x2 o = *hp;
        u32x2 w; w.x = pk2(bflo(o.x) + v.x, bfhi(o.x) + v.y); w.y = pk2(bflo(o.y) + v.z, bfhi(o.y) + v.w); *hp = w;
    } };
struct SEpiGate { const bf16* H2b; const bf16* E; const float* RSE; const float* gple; bf16* H3b; float* RS3;
    __device__ __forceinline__ void apply(int r, int c, f32x4m v) const {
        const size_t o = (size_t)(MP + r) * DM + c; const float rse = 1.0f / sqrtf(RSE[MP + r] * (1.f / DM) + EPS);
        const u32x2 eb = *(const u32x2*)(E + o), hb = *(const u32x2*)(H2b + o); const f32x4m gp = *(const f32x4m*)(gple + c);
        const float e4[4] = {bflo(eb.x), bfhi(eb.x), bflo(eb.y), bfhi(eb.y)}, h4[4] = {bflo(hb.x), bfhi(hb.x), bflo(hb.y), bfhi(hb.y)}; float h[4];
#pragma unroll
        for (int k = 0; k < 4; ++k) { const float g = 1.f / (1.f + __expf(-v[k])); h[k] = h4[k] + g * (e4[k] * rse * gp[k]); }
        u32x2 w; w.x = pk2(h[0], h[1]); w.y = pk2(h[2], h[3]); *(u32x2*)(H3b + o) = w;
        atomicAdd(RS3 + MP + r, (h[0] * h[0] + h[1] * h[1]) + (h[2] * h[2] + h[3] * h[3]));
    } };

struct SubsetOrder {
    int nN, nwg, nsub, cl;
    __device__ void init(int M, int N, int G_, int c_, int c0) { nN = N / 256; nwg = (M / 256) * nN; nsub = G_ - c0; cl = c_ - c0; }
    __device__ bool next(int i, pg8::Unit& u) const { if (cl < 0) return false; const int L = i * nsub + cl; if (L >= nwg) return false; u.pm = L / nN; u.pn = L % nN; return true; }
    __device__ __forceinline__ void a_ready(const pg8::Unit&) const {}
    __device__ __forceinline__ void done(const pg8::Unit&) const {}
};
constexpr int NPH = 12;
#ifndef DUP
#define DUP -1
#endif
#define REP(k) for (int rep_ = 0; rep_ < ((DUP) == (k) ? args.pad : 1); ++rep_)
#ifndef MK_N_LAUNCHES
#define MK_N_LAUNCHES 1
#endif
constexpr int N_LAUNCHES = MK_N_LAUNCHES;
__global__ void __launch_bounds__(NWAVES * 64, 2) mk_fwd(Args args) {
    extern __shared__ __attribute__((aligned(16))) unsigned char lds_raw[];
    LAS unsigned char* lds = (LAS unsigned char*)lds_raw;
    volatile LAS unsigned* MISC = (volatile LAS unsigned*)(lds + MISC_OFF);
    const int tid = threadIdx.x, lane = tid & 63, wave = __builtin_amdgcn_readfirstlane(tid >> 6);
    const int G = gridDim.x, bx = blockIdx.x, vcu = (G % 8 == 0) ? (bx % 8) * (G / 8) + bx / 8 : bx;
    const int gw = vcu * NWAVES + wave, NGW = G * NWAVES, gtid = vcu * (NWAVES * 64) + tid, NT = G * NWAVES * 64;
    unsigned char* ws = args.ws;
    gu32* ctl = (gu32*)(ws + WS_CTL);
    for (int u = tid; u < (LDS_BYTES - LDSCTL_OFF) / 4; u += NWAVES * 64) ((LAS unsigned*)(lds + LDSCTL_OFF))[u] = 0u;
    __syncthreads();
    XcdBarrier bar; bar.bar = (unsigned*)(ctl + CW_BAR); bar.x = 0; bar.st = nullptr;
    if (N_LAUNCHES == 1) bar = xcd_barrier_post((unsigned*)(ctl + CW_BAR), MISC + 8);
    const int lo = args.ph_lo, hi = args.ph_hi;
#ifndef PHMASK
#define PHMASK 0xfff
#endif
#define IN(k) (((PHMASK >> (k)) & 1) && lo <= (k) && (k) < hi)
#define SEAM(k) do { if (IN(k) && IN((k) + 1)) xcd_barrier(bar); } while (0)

    if (IN(0)) { REP(0) { p0_prologue(args, lds, gw, NGW, wave, lane); VM_WAIT(); __syncthreads(); }
        if ((DUP) == 100) { p0_prologue(args, lds, gw, NGW, wave, lane, args.pad - 1); VM_WAIT(); __syncthreads(); }
        if ((DUP) == 101) { p0_prologue(args, lds, gw, NGW, wave, lane, args.pad); VM_WAIT(); __syncthreads(); } }
    SEAM(0);
    if (IN(1)) {
        pg8::Gemm g{(const pg8::bf16_t*)(ws + WS_XN), (const pg8::bf16_t*)(ws + WS_WIN), MP, NIN, DM}; pg8::StaticOrder S; S.init(MP, NIN, G, bx);
        EpiIn E{(pg8::bf16_t*)(ws + WS_PROJ), args.out};
        pg8::gemm_phase<EpiIn, pg8::StaticOrder, PG8_ALIGN, PG8_SP2>(lds, g, S, E);
        if ((DUP) == 1) pg8::gemm_phase<EpiIn, pg8::StaticOrder, PG8_ALIGN, PG8_SP2>(lds, g, S, E);
        { SEpiIn SE{(bf16*)(ws + WS_PROJ), args.out}; skinny_gemm(lds, (const bf16*)(ws + WS_XN) + (size_t)MP * DM, (const bf16*)(ws + WS_WIN), NIN, DM, SE, vcu, G, tid, wave, lane); }
    }
    SEAM(1);
    if (IN(2)) {
        attn_build_btab(args, lds, tid);
        conv_sample_pass(args, gtid, NT);
        __syncthreads();
#ifndef P2SUB
#define P2SUB 7
#endif
        REP(20) if (P2SUB & 1) for (int task = gw; task < NBS * TS * NH; task += NGW) attn_sample_task(args, lds, task, wave, lane);
        __syncthreads();
        REP(21) if (P2SUB & 2) for (int unit = gw; unit < NBP * NH * 3 * 128; unit += NGW) attn_prompt_unit(args, lds, unit, wave, lane);
        __syncthreads();
        REP(22) if (P2SUB & 4) for (int unit = vcu; unit < NBP * 32 * 8; unit += G) ssd_s1_unit(args, lds, unit, tid, wave, lane);
        VM_WAIT(); __syncthreads();
    }
    SEAM(2);
    if (IN(3)) {
        REP(30) ssd_s2_pass(args, gtid, NT);
        REP(31) for (int task = gw; task < NBS * 8 * 16; task += NGW) ssd_sample_task(args, task, lane);
        REP(32) attn_combine_pass(args, gtid, NT);
        VM_WAIT(); __syncthreads();
    }
    SEAM(3);
    if ((DUP) == 99) { for (int q_ = 0; q_ < 5 * args.pad; ++q_) xcd_barrier(bar); }
    if (IN(4)) {
        REP(4) for (int unit = vcu; unit < NBP * 32 * 8; unit += G) ssd_s3_unit(args, unit, wave, lane, rep_ == 0 ? 1.f : 0.f);
        VM_WAIT(); __syncthreads();
    }
    SEAM(4);
    if (IN(5)) { REP(5) { ssd_finish_pass(args, gw, NGW, lane); VM_WAIT(); __syncthreads(); } }
    SEAM(5);
    if (IN(6)) {
        { pg8::Gemm g{(const pg8::bf16_t*)(ws + WS_MIX), (const pg8::bf16_t*)(ws + WS_WOUT), MP, DM, DM}; pg8::StaticOrder S; S.init(MP, DM, G, bx);
          REP(60) { EpiOut E{args.in[0], (pg8::bf16_t*)(ws + WS_XN), rep_ == 0 ? (float*)(ws + WS_RS1) : (float*)(ws + WS_H1)};
#ifndef NO_GOUT
          pg8::gemm_phase<EpiOut, pg8::StaticOrder, PG8_ALIGN, PG8_SP2>(lds, g, S, E);
#endif
        } }
#ifndef NOSK
        { SEpiOut SE{args.in[1], (bf16*)(ws + WS_XN), (float*)(ws + WS_RS1)}; skinny_gemm(lds, (const bf16*)(ws + WS_MIX) + (size_t)MP * DM, (const bf16*)(ws + WS_WOUT), DM, DM, SE, vcu, G, tid, wave, lane); }
#endif
        { SEpiPle SE{(bf16*)(ws + WS_E), (float*)(ws + WS_RSE)}; skinny_gemm(lds, (const bf16*)(ws + WS_PB) + (size_t)MP * DPLE, (const bf16*)(ws + WS_WPLE), DM, DPLE, SE, vcu, G, tid, wave, lane); }
    }
    SEAM(6);
    if (IN(7)) {
        pg8::Gemm g{(const pg8::bf16_t*)(ws + WS_XN), (const pg8::bf16_t*)(ws + WS_WUP), MT, DFF2, DM}; pg8::StaticOrder S; S.init(MT, DFF2, G, bx);
        EpiUp E{(pg8::bf16_t*)(ws + WS_ACT), (const float*)(ws + WS_RS1), args.out, (float*)(ws + WS_UH), (float*)(ws + WS_US), args.in[21], args.in[22], lds};
        REP(7) pg8::gemm_phase<EpiUp, pg8::StaticOrder, PG8_ALIGN, PG8_SP2>(lds, g, S, E);
        { int kple = DPLE; asm volatile("" : "+s"(kple));
          const int nup = (MT / 256) * (DFF2 / 256), c0 = (nup % G) ? (nup % G) : G;
          pg8::Gemm g{(const pg8::bf16_t*)(ws + WS_PB), (const pg8::bf16_t*)(ws + WS_WPLE), MP, DM, kple}; SubsetOrder S; S.init(MP, DM, G, bx, c0 < G ? c0 : 0);
          EpiPle E{(pg8::bf16_t*)(ws + WS_E), (float*)(ws + WS_RSE)};
          pg8::gemm_phase<EpiPle, SubsetOrder, PG8_ALIGN, PG8_SP2>(lds, g, S, E); }
    }
    SEAM(7);
    if (IN(8)) { REP(8) { ffn_fixup_pass(args, gtid, NT); VM_WAIT(); __syncthreads(); } }
    SEAM(8);
    if (IN(9)) {
        pg8::Gemm g{(const pg8::bf16_t*)(ws + WS_ACT), (const pg8::bf16_t*)(ws + WS_WDOWN), MP, DM, DFF}; pg8::StaticOrder S; S.init(MP, DM, G, bx);
        { EpiDown E{(pg8::bf16_t*)(ws + WS_XN), 1.f};
        pg8::gemm_phase<EpiDown, pg8::StaticOrder, PG8_ALIGN, PG8_SP2>(lds, g, S, E); }
        if ((DUP) == 9) { EpiDown E{(pg8::bf16_t*)(ws + WS_XN), 0.f};
        pg8::gemm_phase<EpiDown, pg8::StaticOrder, PG8_ALIGN, PG8_SP2>(lds, g, S, E); }
        { SEpiDown SE{(bf16*)(ws + WS_XN)}; skinny_gemm(lds, (const bf16*)(ws + WS_ACT) + (size_t)MP * DFF, (const bf16*)(ws + WS_WDOWN), DM, DFF, SE, vcu, G, tid, wave, lane); }
    }
    SEAM(9);
    if (IN(10)) {
        pg8::Gemm g{(const pg8::bf16_t*)(ws + WS_XN), (const pg8::bf16_t*)(ws + WS_WGATE), MP, DM, DM}; pg8::StaticOrder S; S.init(MP, DM, G, bx);
        REP(10) { EpiGate E{(const pg8::bf16_t*)(ws + WS_XN), (const pg8::bf16_t*)(ws + WS_E), (const float*)(ws + WS_RSE), args.in[25], (pg8::bf16_t*)(ws + WS_MIX), rep_ == 0 ? (float*)(ws + WS_RS3) : (float*)(ws + WS_H1)};
        pg8::gemm_phase<EpiGate, pg8::StaticOrder, PG8_ALIGN, PG8_SP2>(lds, g, S, E); }
        { SEpiGate SE{(const bf16*)(ws + WS_XN), (const bf16*)(ws + WS_E), (const float*)(ws + WS_RSE), args.in[25], (bf16*)(ws + WS_MIX), (float*)(ws + WS_RS3)}; skinny_gemm(lds, (const bf16*)(ws + WS_XN) + (size_t)MP * DM, (const bf16*)(ws + WS_WGATE), DM, DM, SE, vcu, G, tid, wave, lane); }
    }
    SEAM(10);
    if (IN(11)) { REP(11) final_norm_pass(args, gw, NGW, lane); }
#undef IN
#undef SEAM
}

extern "C" void kernel_launch(void* const* d_in, const int* in_sizes, int n_in, void* d_out, int out_size, void* d_ws, size_t ws_size, hipStream_t stream) {
    static int grid = 0;
    if (grid == 0) {
        if (n_in != 28 || out_size != (int)O_END || ws_size < WS_END) { fprintf(stderr, "kernel_launch: unexpected shapes: n_in %d out %d ws %zu\n", n_in, out_size, ws_size); grid = -1; return; }
        int dev = 0, cus = 0, per_cu = 0;
        if (hipGetDevice(&dev) != hipSuccess || hipDeviceGetAttribute(&cus, hipDeviceAttributeMultiprocessorCount, dev) != hipSuccess) { grid = -1; return; }
        if (hipFuncSetAttribute((const void*)mk_fwd, hipFuncAttributeMaxDynamicSharedMemorySize, LDS_BYTES) != hipSuccess) { fprintf(stderr, "kernel_launch: hipFuncSetAttribute failed\n"); grid = -1; return; }
        if (hipOccupancyMaxActiveBlocksPerMultiprocessor(&per_cu, (const void*)mk_fwd, NWAVES * 64, LDS_BYTES) != hipSuccess || per_cu < 1) fprintf(stderr, "kernel_launch: occupancy query says %d\n", per_cu);
        (void)hipGetLastError();
        grid = cus;
    }
    if (grid < 0) return;
    if (hipMemsetAsync((char*)d_ws + WS_CTL, 0, CTL_ZERO_BYTES, stream) != hipSuccess) { fprintf(stderr, "kernel_launch: memset failed\n"); return; }
    Args a{};
    for (int i = 0; i < 28; ++i) a.in[i] = (const float*)d_in[i];
    a.out = (float*)d_out; a.ws = (unsigned char*)d_ws; a.pad = 2;
    for (int li = 0; li < N_LAUNCHES; ++li) {
        if (N_LAUNCHES == 1) { a.ph_lo = 0; a.ph_hi = NPH; } else { a.ph_lo = li; a.ph_hi = li + 1; }
        a.li = li;
        hipLaunchKernelGGL(mk_fwd, dim3(grid), dim3(NWAVES * 64), LDS_BYTES, stream, a);
        const hipError_t le = hipPeekAtLastError();
        if (le != hipSuccess) { fprintf(stderr, "kernel_launch: launch %d failed: %s\n", li, hipGetErrorName(le)); break; }
    }
}
```

```cpp
#include <hip/hip_runtime.h>
#include <cstdio>
#include <cstdint>
namespace pg8 {
#define PG8_LAS __attribute__((address_space(3)))
typedef unsigned short bf16_t;
typedef short bf16x8 __attribute__((ext_vector_type(8)));
typedef float f32x4 __attribute__((ext_vector_type(4)));
typedef unsigned u32x4 __attribute__((ext_vector_type(4)));
constexpr int BM = 256, BK = 64, HALF = 128, HTB = HALF * BK * 2  , STAGE_BYTES = 8 * HTB, NXCD = 8, WGM = 8;

__host__ __device__ __forceinline__ int lds_byte(int r, int c) { const int st = (r >> 4) * 2 + (c >> 5), rr = r & 15, cc = c & 31, ob = rr * 64 + cc * 2; return st * 1024 + (ob ^ (((ob >> 9) & 1) << 5)); }
__host__ __device__ __forceinline__ void stage_rc(int b, int& R, int& C) { const int st = b / 1024, sb = b % 1024, swz = sb ^ (((sb >> 9) & 1) << 5); R = (st >> 1) * 16 + swz / 64; C = (st & 1) * 32 + (swz % 64) / 2; }
__host__ __device__ __forceinline__ int perm32(int rho) { const int n = rho >> 4, i = rho & 15; return 8 * (i >> 2) + 4 * n + (i & 3); }

struct Unit { int pm, pn; };
struct Gemm { const bf16_t* A; const bf16_t* Bt; int M, N, K; };

struct StaticOrder {
    int nM, nN, nwg, G, c;
    __host__ __device__ void init(int M, int N, int G_, int c_) { nM = M / BM; nN = N / BM; nwg = nM * nN; G = G_; c = c_; }
    __host__ __device__ bool next(int i, Unit& u) const {
        const long L = (long)i * G + c; if (L >= nwg) return false;
        int wgid = (int)L; { const int q = nwg / NXCD, r = nwg % NXCD, xcd = wgid % NXCD, off = wgid / NXCD; wgid = (xcd < r ? xcd * (q + 1) : r * (q + 1) + (xcd - r) * q) + off; }
        const int nig = WGM * nN, gid = wgid / nig, fm = gid * WGM, gsz = (nM - fm) < WGM ? (nM - fm) : WGM;
        u.pm = fm + ((wgid % nig) % gsz); u.pn = (wgid % nig) / gsz; return true;
    }
    __device__ __forceinline__ void a_ready(const Unit&) const {}
    __device__ __forceinline__ void done(const Unit&) const {}
};

__device__ __forceinline__ unsigned cvt_pk_bf16(float lo, float hi) { unsigned r; asm volatile("v_cvt_pk_bf16_f32 %0, %1, %2" : "=v"(r) : "v"(lo), "v"(hi)); return r; }
typedef float f32x2 __attribute__((ext_vector_type(2)));
template <class Epi, class Sched, bool ALIGN_EPI = false, bool SP2 = false>
__device__ __forceinline__ void gemm_phase(PG8_LAS unsigned char* lds, const Gemm g, const Sched& S, const Epi& E) {
    const int tid = threadIdx.x, wid = __builtin_amdgcn_readfirstlane(tid >> 6), lane = tid & 63, wr = wid >> 2, wc = wid & 3, fr = lane & 15, fq = lane >> 4;
    const int K = g.K, nt = K / BK;
    unsigned voffA[2], voffB[2];
#pragma unroll
    for (int i = 0; i < 2; ++i) { int R, C; stage_rc(tid * 16 + i * 8192, R, C); const int Rb = Epi::PERM ? ((R & ~31) + perm32(R & 31)) : R;
        voffA[i] = (unsigned)(R * K + C) * 2u; voffB[i] = (unsigned)(Rb * K + C) * 2u; }
    const size_t kstep = (size_t)(BK * 2);
    const size_t hstep = (size_t)HALF * K * 2;
    const size_t tstep = 2 * hstep;
    const unsigned ldsw = (unsigned)wid * 1024u;
    const int aoff = lds_byte(wr * 64 + fr, fq * 8), boff = lds_byte(wc * 32 + fr, fq * 8);
#define PG8_SA(b, h) (((b) * 2 + (h)) * HTB)
#define PG8_SB(b, h) ((4 + (b) * 2 + (h)) * HTB)
#define PG8_STAGE(bufoff, gbase, voff) do { _Pragma("unroll") for (int _i = 0; _i < 2; ++_i) \
        __builtin_amdgcn_global_load_lds((const unsigned*)((const char*)(gbase) + (voff)[_i]), (PG8_LAS unsigned*)(lds + (bufoff) + ldsw + _i * 8192), 16, 0, 0); } while (0)
#define PG8_LDA(dst, b, h) do { _Pragma("unroll") for (int m = 0; m < 4; ++m) _Pragma("unroll") for (int k = 0; k < 2; ++k) dst[m][k] = *(const PG8_LAS bf16x8*)(lds + PG8_SA(b, h) + aoff + m * 2048 + k * 1024); } while (0)
#define PG8_LDB(dst, b, h) do { _Pragma("unroll") for (int n = 0; n < 2; ++n) _Pragma("unroll") for (int k = 0; k < 2; ++k) dst[n][k] = *(const PG8_LAS bf16x8*)(lds + PG8_SB(b, h) + boff + n * 2048 + k * 1024); } while (0)
#define PG8_MMA(ai, bj, At, Bt) do { __builtin_amdgcn_s_setprio(1); _Pragma("unroll") for (int m = 0; m < 4; ++m) _Pragma("unroll") for (int n = 0; n < 2; ++n) _Pragma("unroll") for (int k = 0; k < 2; ++k) \
        acc[ai][bj][m][n] = __builtin_amdgcn_mfma_f32_16x16x32_bf16(Bt[n][k], At[m][k], acc[ai][bj][m][n], 0, 0, 0); __builtin_amdgcn_s_setprio(0); } while (0)
#define PG8_WAIT_V(n) asm volatile("s_waitcnt vmcnt(" #n ")" ::: "memory")
#define PG8_WAIT_L(n) asm volatile("s_waitcnt lgkmcnt(" #n ")" ::: "memory")
#define PG8_BAR __builtin_amdgcn_s_barrier()
#define PG8_SCHED __builtin_amdgcn_sched_barrier(0)
    Unit cur, nxt; int ui = 0;
    if (!S.next(0, cur)) return;
    f32x4 acc[2][2][4][2];
#pragma unroll
    for (int a = 0; a < 2; ++a)
#pragma unroll
        for (int b = 0; b < 2; ++b)
#pragma unroll
            for (int m = 0; m < 4; ++m)
#pragma unroll
                for (int n = 0; n < 2; ++n) acc[a][b][m][n] = (f32x4){0.f, 0.f, 0.f, 0.f};
    bf16x8 At[4][2], B0[2][2], B1[2][2];
    const char* cA = (const char*)g.A + (size_t)cur.pm * tstep; const char* cB = (const char*)g.Bt + (size_t)cur.pn * tstep;
    S.a_ready(cur);
    if constexpr (SP2) {
        PG8_STAGE(PG8_SB(0, 0), cB, voffB); PG8_STAGE(PG8_SB(0, 1), cB + hstep, voffB); PG8_STAGE(PG8_SA(0, 0), cA, voffA); PG8_STAGE(PG8_SA(0, 1), cA + hstep, voffA);
        if (wr == 1) PG8_BAR;
        PG8_WAIT_V(2); PG8_BAR;
        PG8_STAGE(PG8_SB(1, 0), cB + kstep, voffB); PG8_STAGE(PG8_SA(1, 0), cA + kstep, voffA); PG8_STAGE(PG8_SB(1, 1), cB + hstep + kstep, voffB);
        PG8_WAIT_V(6); PG8_BAR;
    } else {
        PG8_STAGE(PG8_SB(0, 0), cB, voffB); PG8_STAGE(PG8_SA(0, 0), cA, voffA); PG8_STAGE(PG8_SB(0, 1), cB + hstep, voffB); PG8_STAGE(PG8_SA(0, 1), cA + hstep, voffA);
        if (wr == 1) PG8_BAR;
        PG8_WAIT_V(4); PG8_BAR;
        PG8_STAGE(PG8_SB(1, 0), cB + kstep, voffB); PG8_STAGE(PG8_SA(1, 0), cA + kstep, voffA); PG8_STAGE(PG8_SB(1, 1), cB + hstep + kstep, voffB);
        PG8_WAIT_V(6); PG8_BAR;
    }
    for (;;) {
        const bool has_next = S.next(ui + 1, nxt);
        const char* nA = has_next ? (const char*)g.A + (size_t)nxt.pm * tstep : cA; const char* nB = has_next ? (const char*)g.Bt + (size_t)nxt.pn * tstep : cB;
        for (int t = 0; t < nt; t += 2) {
            const bool last = (t == nt - 2);
            const char* a1 = cA + (size_t)(t + 1) * kstep;
            const char* a2 = last ? nA : cA + (size_t)(t + 2) * kstep; const char* b2 = last ? nB : cB + (size_t)(t + 2) * kstep;
            const char* a3 = a2 + kstep; const char* b3 = b2 + kstep;
            if (last && has_next) S.a_ready(nxt);
            if constexpr (SP2) {
            PG8_LDB(B0, 0, 0); PG8_LDB(B1, 0, 1); PG8_SCHED; PG8_LDA(At, 0, 0); PG8_STAGE(PG8_SA(1, 1), a1 + hstep, voffA);
            PG8_WAIT_V(8); PG8_WAIT_L(0); PG8_BAR; PG8_MMA(0, 0, At, B0); PG8_MMA(0, 1, At, B1); PG8_BAR; PG8_SCHED;
            PG8_LDA(At, 0, 1); PG8_STAGE(PG8_SB(0, 0), b2, voffB); PG8_STAGE(PG8_SB(0, 1), b2 + hstep, voffB); PG8_STAGE(PG8_SA(0, 0), a2, voffA);
            PG8_WAIT_V(8); PG8_WAIT_L(0); PG8_BAR; PG8_MMA(1, 0, At, B0); PG8_MMA(1, 1, At, B1); PG8_BAR; PG8_SCHED;
            PG8_LDB(B0, 1, 0); PG8_LDB(B1, 1, 1); PG8_SCHED; PG8_LDA(At, 1, 0); PG8_STAGE(PG8_SA(0, 1), a2 + hstep, voffA);
            PG8_WAIT_V(8); PG8_WAIT_L(0); PG8_BAR; PG8_MMA(0, 0, At, B0); PG8_MMA(0, 1, At, B1); PG8_BAR; PG8_SCHED;
            PG8_LDA(At, 1, 1); PG8_STAGE(PG8_SB(1, 0), b3, voffB); PG8_STAGE(PG8_SB(1, 1), b3 + hstep, voffB); PG8_STAGE(PG8_SA(1, 0), a3, voffA);
            PG8_WAIT_V(8); PG8_WAIT_L(0); PG8_BAR; PG8_MMA(1, 0, At, B0); PG8_MMA(1, 1, At, B1); PG8_BAR; PG8_SCHED;
            } else {
            PG8_LDB(B0, 0, 0); PG8_SCHED; PG8_LDA(At, 0, 0); PG8_STAGE(PG8_SA(1, 1), a1 + hstep, voffA);
            PG8_WAIT_L(8); PG8_BAR; PG8_WAIT_L(0); PG8_MMA(0, 0, At, B0); PG8_BAR; PG8_SCHED;
            PG8_LDB(B1, 0, 1); PG8_STAGE(PG8_SB(0, 0), b2, voffB);
            PG8_BAR; PG8_WAIT_L(0); PG8_MMA(0, 1, At, B1); PG8_BAR;
            PG8_LDA(At, 0, 1); PG8_STAGE(PG8_SA(0, 0), a2, voffA);
            PG8_BAR; PG8_WAIT_L(0); PG8_MMA(1, 0, At, B0); PG8_BAR; PG8_SCHED;
            PG8_STAGE(PG8_SB(0, 1), b2 + hstep, voffB);
            PG8_WAIT_V(6); PG8_BAR; PG8_MMA(1, 1, At, B1); PG8_BAR;
            PG8_LDB(B0, 1, 0); PG8_SCHED; PG8_LDA(At, 1, 0); PG8_STAGE(PG8_SA(0, 1), a2 + hstep, voffA);
            PG8_WAIT_L(8); PG8_BAR; PG8_WAIT_L(0); PG8_MMA(0, 0, At, B0); PG8_BAR; PG8_SCHED;
            PG8_LDB(B1, 1, 1); PG8_STAGE(PG8_SB(1, 0), b3, voffB);
            PG8_BAR; PG8_WAIT_L(0); PG8_MMA(0, 1, At, B1); PG8_BAR;
            PG8_LDA(At, 1, 1); PG8_STAGE(PG8_SA(1, 0), a3, voffA);
            PG8_BAR; PG8_WAIT_L(0); PG8_MMA(1, 0, At, B0); PG8_BAR; PG8_SCHED;
            PG8_STAGE(PG8_SB(1, 1), b3 + hstep, voffB);
            PG8_WAIT_V(6); PG8_BAR; PG8_MMA(1, 1, At, B1); PG8_BAR;
            }
        }
        if constexpr (ALIGN_EPI) { if (wr == 0) PG8_BAR; }
        if constexpr (!Epi::AFTER_DRAIN) { E(acc, cur, wr, wc, fr, fq); S.done(cur); }
        if (!has_next) break;
#pragma unroll
        for (int a = 0; a < 2; ++a)
#pragma unroll
            for (int b = 0; b < 2; ++b)
#pragma unroll
                for (int m = 0; m < 4; ++m)
#pragma unroll
                    for (int n = 0; n < 2; ++n) acc[a][b][m][n] = (f32x4){0.f, 0.f, 0.f, 0.f};
        cur = nxt; cA = nA; cB = nB; ++ui;
        if constexpr (ALIGN_EPI) { if (wr == 1) PG8_BAR; }
    }
    PG8_WAIT_V(0);
    if constexpr (!ALIGN_EPI) { if (wr == 0) PG8_BAR; }
    PG8_BAR;
    if constexpr (Epi::AFTER_DRAIN) { E.fused(acc, cur, wr, wc, fr, fq, lds, wid, lane); S.done(cur); }
#undef PG8_SA
#undef PG8_SB
#undef PG8_STAGE
#undef PG8_LDA
#undef PG8_LDB
#undef PG8_MMA
#undef PG8_WAIT_V
#undef PG8_WAIT_L
#undef PG8_BAR
#undef PG8_SCHED
}
}

#ifndef PG8_SP2
#define PG8_SP2 true
#endif
#ifndef PG8_ALIGN
#define PG8_ALIGN true
#endif
#define GAS __attribute__((address_space(1)))
#define LAS __attribute__((address_space(3)))
typedef unsigned short bf16;
typedef unsigned v4u __attribute__((ext_vector_type(4)));
typedef float f32x4 __attribute__((ext_vector_type(4)));
typedef short bf16x8 __attribute__((ext_vector_type(8)));
typedef GAS unsigned gu32;
typedef GAS unsigned long long gu64;
#define RLX_AGENT __ATOMIC_RELAXED, __HIP_MEMORY_SCOPE_AGENT
#define LDS_WAIT() asm volatile("s_waitcnt lgkmcnt(0)" ::: "memory")
#define VM_WAIT() asm volatile("s_waitcnt vmcnt(0)" ::: "memory")
__device__ __forceinline__ unsigned long long rt() { return __builtin_amdgcn_s_memrealtime(); }
__device__ __forceinline__ unsigned f2bf(float f) { unsigned u = __builtin_bit_cast(unsigned, f); return (u + 0x7fffu + ((u >> 16) & 1u)) >> 16; }
__device__ __forceinline__ unsigned pk2(float lo, float hi) { typedef float f2_ __attribute__((ext_vector_type(2))); typedef __bf16 b2_ __attribute__((ext_vector_type(2))); f2_ v = {lo, hi}; b2_ b = __builtin_convertvector(v, b2_); return __builtin_bit_cast(unsigned, b); }

#define XB_TMO      128
#define XB_XCNT(j)  (256  + 64 * (j))
#define XB_XSUB(j)  (1280 + 64 * (j))
#define XB_XGEN(j)  (2304 + 64 * (j))
#define XB_TOP      3328
#define XB_TOPGEN   3392
#define XCD_BAR_WORDS 3456
#define XB_SPIN_CAP (1u << 18)

__device__ __forceinline__ unsigned xb_ld(unsigned* p)              { return __hip_atomic_load(p, __ATOMIC_RELAXED, __HIP_MEMORY_SCOPE_AGENT); }
__device__ __forceinline__ unsigned xb_add(unsigned* p, unsigned v) { return __hip_atomic_fetch_add(p, v, __ATOMIC_RELAXED, __HIP_MEMORY_SCOPE_AGENT); }
__device__ __forceinline__ unsigned xb_xcc_id() { return (unsigned)__builtin_amdgcn_s_getreg((3 << 11) | 20) & 0xFu; }
#define XB_SPIN(cond, bar) do { unsigned _sp = 0; while (cond) { __builtin_amdgcn_s_sleep(1); \
    if ((++_sp & 255u) == 0u) { if (xb_ld(&(bar)[XB_TMO])) break; if (_sp > XB_SPIN_CAP) { atomicAdd(&(bar)[XB_TMO], 1u); break; } } } } while (0)

struct XcdBarrier {
    unsigned* bar; unsigned x;
    volatile LAS unsigned* st;
};

__device__ __forceinline__ XcdBarrier xcd_barrier_post(unsigned* bar, volatile LAS unsigned* st) {
    XcdBarrier b; b.bar = bar; b.x = xb_xcc_id(); b.st = st;
    if (threadIdx.x == 0) (void)xb_add(&bar[XB_XCNT(b.x)], 1u);
    return b;
}
__device__ __forceinline__ void xcd_barrier_complete(unsigned* bar, unsigned x, unsigned& nloc, unsigned& nx) {
    const unsigned G = gridDim.x * gridDim.y * gridDim.z;
    unsigned sum, cnt, mine, sp = 0u;
    for (;;) {
        sum = 0u; cnt = 0u; mine = 0u;
#pragma unroll
        for (unsigned j = 0; j < 16; ++j) { const unsigned c = xb_ld(&bar[XB_XCNT(j)]); sum += c; cnt += (c > 0u) ? 1u : 0u; mine = (j == x) ? c : mine; }
        if (sum == G) break;
        __builtin_amdgcn_s_sleep(1);
        if ((++sp & 255u) == 0u) { if (xb_ld(&bar[XB_TMO])) break; if (sp > XB_SPIN_CAP) { atomicAdd(&bar[XB_TMO], 1u); break; } }
    }
    nloc = mine > 0u ? mine : 1u; nx = cnt > 0u ? cnt : 1u;
}

__device__ __forceinline__ void xcd_barrier(const XcdBarrier& b) {
    asm volatile("s_waitcnt vmcnt(0)" ::: "memory");
    __syncthreads();
    if (threadIdx.x == 0) {
        unsigned* bar = b.bar;
        __builtin_amdgcn_s_waitcnt(0);
        unsigned nloc = b.st[0], nx = b.st[1];
        if (nloc == 0u) { xcd_barrier_complete(bar, b.x, nloc, nx); b.st[0] = nloc; b.st[1] = nx; }
        const unsigned old = xb_add(&bar[XB_XSUB(b.x)], 1u);
        const unsigned gen = old / nloc;
        if (old + 1u == (gen + 1u) * nloc) {
            __builtin_amdgcn_fence(__ATOMIC_RELEASE, "agent");
            asm volatile("s_waitcnt vmcnt(0)" ::: "memory");
            const unsigned og = xb_add(&bar[XB_TOP], 1u);
            const unsigned tg = og / nx;
            if (og + 1u == (tg + 1u) * nx) xb_add(&bar[XB_TOPGEN], 1u);
            else XB_SPIN(xb_ld(&bar[XB_TOPGEN]) == tg, bar);
            __builtin_amdgcn_fence(__ATOMIC_ACQUIRE, "agent");
            xb_add(&bar[XB_XGEN(b.x)], 1u);
            asm volatile("s_waitcnt vmcnt(0)" ::: "memory");
        } else {
            XB_SPIN(xb_ld(&bar[XB_XGEN(b.x)]) == gen, bar);
            __builtin_amdgcn_fence(__ATOMIC_ACQUIRE, "agent");
            asm volatile("s_waitcnt vmcnt(0)" ::: "memory");
        }
    }
    __syncthreads();
}


constexpr int NWAVES = 8;
constexpr int DM = 1024, SEQ = 4096, NBP = 4, NBS = 32, TS = 8;
constexpr int MP = NBP * SEQ, MS = NBS * TS, MT = MP + MS;
constexpr int NH = 8, HD = 64, DSSM = 512, NST = 128, IN_LD = 3080, NIN = 3072;
constexpr int DFF = 2816, DFF2 = 5632, DPLE = 256, WBUF = 2048;
constexpr float EPS = 1e-6f, LOG2E = 1.4426950408889634f, C2 = 0.125f * 1.4426950408889634f;
constexpr int PC_K = 512, PC_V = 1024, PC_Z = 1536, PC_X = 2048;
constexpr size_t O_Y = 0, O_YS = 16777216, O_KP = 17039360, O_VP = 21233664, O_KS = 25427968, O_VS = 25559040, O_SP = 25690112, O_SS = 25952256,
                 O_CP = 28049408, O_CS = 28061696, O_FP = 28160000, O_FS = 28205056, O_END = 28565504;
constexpr size_t MiB = 1u << 20;
constexpr size_t WS_CTL = 0, CTL_ZERO_BYTES = 1 * MiB;
constexpr size_t WS_RS1 = 256 * 1024, WS_RSE = 384 * 1024, WS_RS3 = 512 * 1024;
constexpr size_t WS_WIN = 2 * MiB, WS_WOUT = 8 * MiB, WS_WUP = 10 * MiB, WS_WDOWN = 21 * MiB, WS_WPLE = 27 * MiB, WS_WGATE = 28 * MiB;
constexpr size_t WS_DT = 30 * MiB, WS_PB = 31 * MiB, WS_XN = 40 * MiB, WS_MIX = 73 * MiB, WS_H1 = 106 * MiB, WS_E = 171 * MiB;
constexpr size_t WS_PROJ = 236 * MiB, WS_OBR = 334 * MiB, WS_LSE = 382 * MiB, WS_XBS = 384 * MiB, WS_XC = 385 * MiB, WS_CC = 402 * MiB, WS_CS = 410 * MiB, WS_PREV = 442 * MiB,
                 WS_ACUM = 458 * MiB, WS_ACL = 458 * MiB + 768 * 1024, WS_YS = 459 * MiB;
constexpr size_t WS_U = 236 * MiB, WS_UH = 236 * MiB, WS_US = 244 * MiB, WS_ACT = 415 * MiB, WS_END = 505 * MiB;
static_assert(WS_PROJ + (size_t)MT * NIN * 2 <= WS_OBR && WS_OBR + (size_t)3 * MP * 512 * 2 <= WS_LSE && WS_LSE + (size_t)3 * MP * 8 * 4 <= WS_XBS, "ws map A");
static_assert(WS_XBS + (size_t)MS * 1024 * 4 <= WS_XC && WS_XC + (size_t)MT * 512 * 2 <= WS_CC && WS_CC + (size_t)MP * 256 * 2 <= WS_CS && WS_CS + (size_t)MP / 128 * 8 * 64 * 128 * 4 <= WS_PREV && WS_PREV + (size_t)MP / 128 * 8 * 64 * 128 * 2 <= WS_ACUM && WS_ACUM + (size_t)MP * 8 * 4 <= WS_ACL && WS_ACL + 4096 <= WS_YS && WS_YS + (size_t)MT * 512 * 4 <= WS_END, "ws map B");
static_assert(WS_U + (size_t)MT * DFF2 * 2 <= WS_ACT && WS_ACT + (size_t)MT * DFF * 2 <= WS_END, "ws map C");
static_assert(WS_XN + (size_t)MT * DM * 2 <= WS_MIX && WS_MIX + (size_t)MT * DM * 2 <= WS_H1 && WS_H1 + (size_t)MT * DM * 4 <= WS_E && WS_E + (size_t)MT * DM * 4 <= WS_PROJ, "ws map D");
static_assert(WS_PB + (size_t)MT * DPLE * 2 <= WS_XN && WS_DT + (size_t)MT * 8 * 4 <= WS_PB, "ws map E");
constexpr int CW_TMO = 0, CW_BAR = 4096;
constexpr int RING_BYTES = 131072, LDSCTL_OFF = RING_BYTES, MISC_OFF = LDSCTL_OFF + 320, LDS_BYTES = 147456;

typedef float f32x16 __attribute__((ext_vector_type(16)));
typedef short v4i16_t __attribute__((ext_vector_type(4)));
typedef unsigned u32x2 __attribute__((ext_vector_type(2)));

__device__ const unsigned char BUCKET_TAB[3][132] = {
 {0,1,2,3,4,5,6,7,8,9,10,11,12,13,14,15,16,16,16,16,16,16,17,17,17,17,17,17,17,17,18,18,18,18,18,18,18,18,18,18,19,19,19,19,19,19,19,19,19,19,19,19,19,19,20,20,20,20,20,20,20,20,20,20,20,20,20,20,20,20,20,20,20,21,21,21,21,21,21,21,21,21,21,21,21,21,21,21,21,21,21,21,21,21,21,21,21,21,21,22,22,22,22,22,22,22,22,22,22,22,22,22,22,22,22,22,22,22,22,22,22,22,22,22,22,22,22,22,22,0,0,0},
 {0,4,8,12,16,16,17,17,18,18,19,19,19,19,20,20,20,20,20,21,21,21,21,21,21,22,22,22,22,22,22,22,22,22,23,23,23,23,23,23,23,23,23,23,23,23,24,24,24,24,24,24,24,24,24,24,24,24,24,24,24,24,25,25,25,25,25,25,25,25,25,25,25,25,25,25,25,25,25,25,25,25,25,26,26,26,26,26,26,26,26,26,26,26,26,26,26,26,26,26,26,26,26,26,26,26,26,26,26,26,26,26,26,27,27,27,27,27,27,27,27,27,27,27,27,27,27,27,27,0,0,0},
 {0,16,18,19,20,21,21,22,22,23,23,23,24,24,24,24,25,25,25,25,25,26,26,26,26,26,26,26,26,27,27,27,27,27,27,27,27,27,27,28,28,28,28,28,28,28,28,28,28,28,28,28,29,29,29,29,29,29,29,29,29,29,29,29,29,29,29,29,29,29,30,30,30,30,30,30,30,30,30,30,30,30,30,30,30,30,30,30,30,30,30,30,30,30,30,31,31,31,31,31,31,31,31,31,31,31,31,31,31,31,31,31,31,31,31,31,31,31,31,31,31,31,31,31,31,31,31,31,31,0,0,0}};

__device__ __forceinline__ float row16_sum(float v) {
    v += __builtin_bit_cast(float, __builtin_amdgcn_update_dpp(0, __builtin_bit_cast(int, v), 0xB1, 0xf, 0xf, true));
    v += __builtin_bit_cast(float, __builtin_amdgcn_update_dpp(0, __builtin_bit_cast(int, v), 0x4E, 0xf, 0xf, true));
    v += __builtin_bit_cast(float, __builtin_amdgcn_update_dpp(0, __builtin_bit_cast(int, v), 0x141, 0xf, 0xf, true));
    v += __builtin_bit_cast(float, __builtin_amdgcn_update_dpp(0, __builtin_bit_cast(int, v), 0x140, 0xf, 0xf, true));
    return v;
}
__device__ __forceinline__ float row16_max(float v) {
    v = fmaxf(v, __builtin_bit_cast(float, __builtin_amdgcn_update_dpp(__builtin_bit_cast(int, v), __builtin_bit_cast(int, v), 0xB1, 0xf, 0xf, false)));
    v = fmaxf(v, __builtin_bit_cast(float, __builtin_amdgcn_update_dpp(__builtin_bit_cast(int, v), __builtin_bit_cast(int, v), 0x4E, 0xf, 0xf, false)));
    v = fmaxf(v, __builtin_bit_cast(float, __builtin_amdgcn_update_dpp(__builtin_bit_cast(int, v), __builtin_bit_cast(int, v), 0x141, 0xf, 0xf, false)));
    v = fmaxf(v, __builtin_bit_cast(float, __builtin_amdgcn_update_dpp(__builtin_bit_cast(int, v), __builtin_bit_cast(int, v), 0x140, 0xf, 0xf, false)));
    return v;
}
__device__ __forceinline__ float wave_sum(float v) {
    v = row16_sum(v);
    auto s = __builtin_amdgcn_permlane16_swap(__float_as_uint(v), __float_as_uint(v), false, false);
    v = __uint_as_float(s[0]) + __uint_as_float(s[1]);
    auto t = __builtin_amdgcn_permlane32_swap(__float_as_uint(v), __float_as_uint(v), false, false);
    return __uint_as_float(t[0]) + __uint_as_float(t[1]);
}
__device__ __forceinline__ float wave_max(float v) {
    v = row16_max(v);
    auto s = __builtin_amdgcn_permlane16_swap(__float_as_uint(v), __float_as_uint(v), false, false);
    v = fmaxf(__uint_as_float(s[0]), __uint_as_float(s[1]));
    auto t = __builtin_amdgcn_permlane32_swap(__float_as_uint(v), __float_as_uint(v), false, false);
    return fmaxf(__uint_as_float(t[0]), __uint_as_float(t[1]));
}
__device__ __forceinline__ float bf2f(unsigned short b) { return __uint_as_float((unsigned)b << 16); }
__device__ __forceinline__ float bflo(unsigned w) { return __uint_as_float(w << 16); }
__device__ __forceinline__ float bfhi(unsigned w) { return __uint_as_float(w & 0xffff0000u); }
__device__ __forceinline__ float siluf(float x) { return x * __builtin_amdgcn_rcpf(1.f + __builtin_amdgcn_exp2f(-LOG2E * x)); }
__device__ __forceinline__ float softplusf(float x) { return fmaxf(x, 0.f) + log1pf(__expf(-fabsf(x))); }
__device__ __forceinline__ int crow(int r, int hi) { return (r & 3) + 8 * (r >> 2) + 4 * hi; }

__device__ __forceinline__ v4i16_t vtr(const LAS unsigned char* p) { return __builtin_amdgcn_ds_read_tr16_b64_v4i16((LAS v4i16_t*)p); }
__device__ __forceinline__ unsigned cvtpk_s(float lo, float hi) { typedef float f2 __attribute__((ext_vector_type(2))); typedef __bf16 b2 __attribute__((ext_vector_type(2))); f2 v = {lo, hi}; b2 b = __builtin_convertvector(v, b2); return __builtin_bit_cast(unsigned, b); }
struct Args { const float* in[28]; float* out; unsigned char* ws; int ph_lo, ph_hi, li, pad; };

struct EpiIn {
    static constexpr bool PERM = true, AFTER_DRAIN = false;
    pg8::bf16_t* PROJ; float* out;
    __device__ __forceinline__ void operator()(const pg8::f32x4 (&acc)[2][2][4][2], const pg8::Unit& u, int wr, int wc, int fr, int fq) const {
        const int pn = u.pn; const float sc = (pn < 2) ? C2 : 1.f;
        const int colb = pn * 256 + wc * 32 + 8 * fq;
#pragma unroll
        for (int ai = 0; ai < 2; ++ai)
#pragma unroll
            for (int m = 0; m < 4; ++m) {
                const int row = u.pm * 256 + ai * 128 + wr * 64 + m * 16 + fr;
#pragma unroll
                for (int bj = 0; bj < 2; ++bj) {
                    const int col = colb + bj * 128; const pg8::f32x4 v0 = acc[ai][bj][m][0], v1 = acc[ai][bj][m][1];
                    pg8::u32x4 w; w.x = pg8::cvt_pk_bf16(v0[0] * sc, v0[1] * sc); w.y = pg8::cvt_pk_bf16(v0[2] * sc, v0[3] * sc); w.z = pg8::cvt_pk_bf16(v1[0] * sc, v1[1] * sc); w.w = pg8::cvt_pk_bf16(v1[2] * sc, v1[3] * sc);
                    *(pg8::u32x4*)(PROJ + (unsigned)(row * NIN + col)) = w;
                    float* dst = nullptr;
                    if (pn >= 2 && pn < 6) {
                        const bool isk = pn < 4; const int c = col - (isk ? PC_K : PC_V);
                        if (row < MP) { const int t = row & (SEQ - 1), b = row >> 12; if (t >= SEQ - WBUF) dst = out + (isk ? O_KP : O_VP) + ((size_t)(b * WBUF + t - (SEQ - WBUF))) * 512 + c; }
                        else dst = out + (isk ? O_KS : O_VS) + (size_t)(row - MP) * 512 + c;
                    } else if (pn >= 8) {
                        const int c = col - PC_X;
                        if (row < MP) { const int t = row & (SEQ - 1), b = row >> 12; if (t >= SEQ - 3) dst = out + O_CP + (size_t)(b * 3 + t - (SEQ - 3)) * 1024 + c; }
                        else { const int r = row - MP, t = r & 7, b = r >> 3; if (t >= TS - 3) dst = out + O_CS + (size_t)(b * 3 + t - (TS - 3)) * 1024 + c; }
                    }
                    if (dst) { *(pg8::f32x4*)dst = v0; *(pg8::f32x4*)(dst + 4) = v1; }
                }
            }
    }
};
struct EpiOut {
    static constexpr bool PERM = false, AFTER_DRAIN = false;
    const float* xp; pg8::bf16_t* H1b; float* RS;
    __device__ __forceinline__ void operator()(const pg8::f32x4 (&acc)[2][2][4][2], const pg8::Unit& u, int wr, int wc, int fr, int fq) const {
        const int col0 = u.pn * 256 + wc * 32 + 4 * fq;
#pragma unroll
        for (int ai = 0; ai < 2; ++ai)
#pragma unroll
            for (int m = 0; m < 4; ++m) {
                const int row = u.pm * 256 + ai * 128 + wr * 64 + m * 16 + fr;
                const float* xrow = xp + (unsigned)(row * DM);
                float ss = 0.f;
#pragma unroll
                for (int bj = 0; bj < 2; ++bj)
#pragma unroll
                    for (int n = 0; n < 2; ++n) {
                        const int c = col0 + bj * 128 + n * 16;
                        const pg8::f32x4 h = *(const pg8::f32x4*)(xrow + c) + acc[ai][bj][m][n];
                        u32x2 w; w.x = pg8::cvt_pk_bf16(h[0], h[1]); w.y = pg8::cvt_pk_bf16(h[2], h[3]);
                        *(u32x2*)(H1b + (unsigned)(row * DM + c)) = w;
                        ss += (h[0] * h[0] + h[1] * h[1]) + (h[2] * h[2] + h[3] * h[3]);
                    }
                ss += __shfl_xor(ss, 16); ss += __shfl_xor(ss, 32);
                if (fq == 0) atomicAdd(RS + row, ss);
                asm volatile("" ::: "memory");
            }
    }
};
template <int CTRL> __device__ __forceinline__ unsigned dppu(unsigned x) { return (unsigned)__builtin_amdgcn_update_dpp(0, (int)x, CTRL, 0xf, 0xf, true); }
constexpr int XCH_OFF = 139264;
struct EpiUp {
    static constexpr bool PERM = true, AFTER_DRAIN = false;
    pg8::bf16_t* ACT; const float* RS; float* out; float* UH; float* US; const float* fw; const float* fb; LAS unsigned char* lds;
    __device__ __forceinline__ void operator()(pg8::f32x4 (&acc)[2][2][4][2], const pg8::Unit& u, int wr, int wc, int fr, int fq) const {
        asm volatile("" : "+v"(fr), "+v"(fq));
        const int jb = wc * 32 + 8 * fq, ca = u.pn * 128 + jb;
        const bool samp = u.pm >= MP / 256;
        unsigned P[2][2][4][2][2];
#pragma unroll
        for (int ai = 0; ai < 2; ++ai)
#pragma unroll
            for (int m = 0; m < 4; ++m) {
                const int rt = ai * 128 + wr * 64 + m * 16 + fr, row = u.pm * 256 + rt;
                const float rs = __builtin_amdgcn_rsqf(RS[row] * (1.f / DM) + EPS);
                float* d = nullptr; float* d2 = nullptr;
                if (samp) { d = US + (unsigned)(rt * DFF2); if ((rt & 7) >= TS - 2) d2 = out + O_FS + (size_t)((rt >> 3) * 2 + (rt & 7) - (TS - 2)) * DFF2; }
                else {
                    if (ai == 0 && m == 0 && wr == 0 && fr < 2) d = UH + (unsigned)((u.pm * 4 + fr) * DFF2);
                    if (ai == 1 && m == 3 && wr == 1 && fr >= 14) { d = UH + (unsigned)((u.pm * 4 + 2 + fr - 14) * DFF2); if ((u.pm & 15) == 15) d2 = out + O_FP + (size_t)((u.pm >> 4) * 2 + fr - 14) * DFF2; }
                }
#pragma unroll
                for (int bj = 0; bj < 2; ++bj) {
                    const pg8::f32x4 v0 = acc[ai][bj][m][0] * rs, v1 = acc[ai][bj][m][1] * rs;
                    if (d) { *(pg8::f32x4*)(d + bj * DFF + ca) = v0; *(pg8::f32x4*)(d + bj * DFF + ca + 4) = v1; }
                    if (d2) { *(pg8::f32x4*)(d2 + bj * DFF + ca) = v0; *(pg8::f32x4*)(d2 + bj * DFF + ca + 4) = v1; }
                    P[ai][bj][m][0][0] = pg8::cvt_pk_bf16(v0[0], v0[1]); P[ai][bj][m][0][1] = pg8::cvt_pk_bf16(v0[2], v0[3]);
                    P[ai][bj][m][1][0] = pg8::cvt_pk_bf16(v1[0], v1[1]); P[ai][bj][m][1][1] = pg8::cvt_pk_bf16(v1[2], v1[3]);
                }
            }
        LAS unsigned char* xch = lds + XCH_OFF;
        if (fr >= 14) {
#pragma unroll
            for (int ai = 0; ai < 2; ++ai)
#pragma unroll
                for (int bj = 0; bj < 2; ++bj)
                    *(LAS pg8::u32x4*)(xch + (((1 + 2 * ai + wr) * 2 + fr - 14) * 256 + bj * 128 + jb) * 2) = (pg8::u32x4){P[ai][bj][3][0][0], P[ai][bj][3][0][1], P[ai][bj][3][1][0], P[ai][bj][3][1][1]};
        }
        asm volatile("s_waitcnt lgkmcnt(0)" ::: "memory"); __builtin_amdgcn_s_barrier(); asm volatile("" ::: "memory");
#pragma unroll
        for (int ai = 0; ai < 2; ++ai) {
            const int q = 2 * ai + wr;
            pg8::u32x4 H2[2], H1[2];
#pragma unroll
            for (int bj = 0; bj < 2; ++bj) { H2[bj] = *(const LAS pg8::u32x4*)(xch + ((q * 2 + 0) * 256 + bj * 128 + jb) * 2); H1[bj] = *(const LAS pg8::u32x4*)(xch + ((q * 2 + 1) * 256 + bj * 128 + jb) * 2); }
#pragma unroll
            for (int n = 0; n < 2; ++n)
#pragma unroll
                for (int h = 0; h < 2; ++h) {
                    const int cc = ca + 4 * n + 2 * h;
                    typedef float f2t __attribute__((ext_vector_type(2)));
                    f2t W0[2], W1[2], W2[2], BB[2];
#pragma unroll
                    for (int bj = 0; bj < 2; ++bj) { const float* wp = fw + bj * DFF + cc; W0[bj] = *(const f2t*)wp; W1[bj] = *(const f2t*)(wp + DFF2); W2[bj] = *(const f2t*)(wp + 2 * DFF2); BB[bj] = *(const f2t*)(fb + bj * DFF + cc); }
#pragma unroll
                    for (int m = 3; m >= 0; --m) {
                        float y[2][2];
#pragma unroll
                        for (int bj = 0; bj < 2; ++bj) {
                            const unsigned cur = P[ai][bj][m][n][h];
                            const unsigned c1 = dppu<0x121>(cur), c2 = dppu<0x122>(cur);
                            unsigned q1, q2;
                            if (m > 0) { const unsigned pv = P[ai][bj][m > 0 ? m - 1 : 0][n][h]; q1 = dppu<0x121>(pv); q2 = dppu<0x122>(pv); }
                            else { const unsigned hh1 = H1[bj][2 * n + h], hh2 = H2[bj][2 * n + h]; q1 = hh1; q2 = (fr == 0) ? hh2 : hh1; }
                            const unsigned p1 = (fr >= 1) ? c1 : q1, p2 = (fr >= 2) ? c2 : q2;
                            y[bj][0] = BB[bj].x + W0[bj].x * bflo(p2) + W1[bj].x * bflo(p1) + W2[bj].x * bflo(cur);
                            y[bj][1] = BB[bj].y + W0[bj].y * bfhi(p2) + W1[bj].y * bfhi(p1) + W2[bj].y * bfhi(cur);
                        }
                        P[ai][0][m][n][h] = pg8::cvt_pk_bf16(siluf(y[0][0]) * y[1][0], siluf(y[0][1]) * y[1][1]);
                        __builtin_amdgcn_sched_barrier(0);
                    }
                }
        }
#pragma unroll
        for (int ai = 0; ai < 2; ++ai)
#pragma unroll
            for (int m = 0; m < 4; ++m) {
                const int row = u.pm * 256 + ai * 128 + wr * 64 + m * 16 + fr;
                *(pg8::u32x4*)(ACT + (unsigned)(row * DFF + ca)) = (pg8::u32x4){P[ai][0][m][0][0], P[ai][0][m][0][1], P[ai][0][m][1][0], P[ai][0][m][1][1]};
            }
    }
};
struct EpiDown {
    static constexpr bool PERM = false, AFTER_DRAIN = false;
    pg8::bf16_t* Hb; float psc;
    __device__ __forceinline__ void operator()(const pg8::f32x4 (&acc)[2][2][4][2], const pg8::Unit& u, int wr, int wc, int fr, int fq) const {
        const int col0 = u.pn * 256 + wc * 32 + 4 * fq;
#pragma unroll
        for (int ai = 0; ai < 2; ++ai)
#pragma unroll
            for (int m = 0; m < 4; ++m) {
                const int row = u.pm * 256 + ai * 128 + wr * 64 + m * 16 + fr;
#pragma unroll
                for (int bj = 0; bj < 2; ++bj)
#pragma unroll
                    for (int n = 0; n < 2; ++n) {
                        const int c = col0 + bj * 128 + n * 16; u32x2* hp = (u32x2*)(Hb + (unsigned)(row * DM + c));
                        const u32x2 o = *hp; const pg8::f32x4 a = acc[ai][bj][m][n] * psc;
                        u32x2 w; w.x = pg8::cvt_pk_bf16(bflo(o.x) + a[0], bfhi(o.x) + a[1]); w.y = pg8::cvt_pk_bf16(bflo(o.y) + a[2], bfhi(o.y) + a[3]);
                        *hp = w;
                    }
                asm volatile("" ::: "memory");
            }
    }
};
struct EpiPle {
    static constexpr bool PERM = false, AFTER_DRAIN = false;
    pg8::bf16_t* E; float* RS;
    __device__ __forceinline__ void operator()(const pg8::f32x4 (&acc)[2][2][4][2], const pg8::Unit& u, int wr, int wc, int fr, int fq) const {
        const int col0 = u.pn * 256 + wc * 32 + 4 * fq;
#pragma unroll
        for (int ai = 0; ai < 2; ++ai)
#pragma unroll
            for (int m = 0; m < 4; ++m) {
                const int row = u.pm * 256 + ai * 128 + wr * 64 + m * 16 + fr; float ss = 0.f;
#pragma unroll
                for (int bj = 0; bj < 2; ++bj)
#pragma unroll
                    for (int n = 0; n < 2; ++n) {
                        const int c = col0 + bj * 128 + n * 16; const pg8::f32x4 h = acc[ai][bj][m][n];
                        u32x2 w; w.x = pg8::cvt_pk_bf16(h[0], h[1]); w.y = pg8::cvt_pk_bf16(h[2], h[3]);
                        *(u32x2*)(E + (unsigned)(row * DM + c)) = w;
                        ss += (h[0] * h[0] + h[1] * h[1]) + (h[2] * h[2] + h[3] * h[3]);
                    }
                ss += __shfl_xor(ss, 16); ss += __shfl_xor(ss, 32);
                if (fq == 0) atomicAdd(RS + row, ss);
            }
    }
};
struct EpiGate {
    static constexpr bool PERM = false, AFTER_DRAIN = false;
    const pg8::bf16_t* H2b; const pg8::bf16_t* E; const float* RSE; const float* gple; pg8::bf16_t* H3b; float* RS3;
    __device__ __forceinline__ void operator()(const pg8::f32x4 (&acc)[2][2][4][2], const pg8::Unit& u, int wr, int wc, int fr, int fq) const {
        const int col0 = u.pn * 256 + wc * 32 + 4 * fq;
        pg8::f32x4 gp[2][2];
#pragma unroll
        for (int bj = 0; bj < 2; ++bj)
#pragma unroll
            for (int n = 0; n < 2; ++n) gp[bj][n] = *(const pg8::f32x4*)(gple + col0 + bj * 128 + n * 16);
#pragma unroll
        for (int ai = 0; ai < 2; ++ai)
#pragma unroll
            for (int m = 0; m < 4; ++m) {
                const int row = u.pm * 256 + ai * 128 + wr * 64 + m * 16 + fr;
                const float rse = 1.0f / sqrtf(RSE[row] * (1.f / DM) + EPS);
                float ss = 0.f;
#pragma unroll
                for (int bj = 0; bj < 2; ++bj)
#pragma unroll
                    for (int n = 0; n < 2; ++n) {
                        const int c = col0 + bj * 128 + n * 16; const unsigned o = (unsigned)(row * DM + c);
                        const pg8::f32x4 a = acc[ai][bj][m][n]; const u32x2 eb = *(const u32x2*)(E + o), hb = *(const u32x2*)(H2b + o);
                        const float e4[4] = {bflo(eb.x), bfhi(eb.x), bflo(eb.y), bfhi(eb.y)}, h4[4] = {bflo(hb.x), bfhi(hb.x), bflo(hb.y), bfhi(hb.y)};
                        float h[4];
#pragma unroll
                        for (int k = 0; k < 4; ++k) { const float g = 1.f / (1.f + __expf(-a[k])); h[k] = h4[k] + g * (e4[k] * rse * gp[bj][n][k]); }
                        u32x2 w; w.x = pg8::cvt_pk_bf16(h[0], h[1]); w.y = pg8::cvt_pk_bf16(h[2], h[3]);
                        *(u32x2*)(H3b + o) = w;
                        ss += (h[0] * h[0] + h[1] * h[1]) + (h[2] * h[2] + h[3] * h[3]);
                    }
                ss += __shfl_xor(ss, 16); ss += __shfl_xor(ss, 32);
                if (fq == 0) atomicAdd(RS3 + row, ss);
                asm volatile("" ::: "memory");
            }
    }
};

__device__ __forceinline__ void load8bf(const bf16* p, float (&o)[8]) {
    const v4u w = *(const v4u*)p;
    o[0] = bflo(w.x); o[1] = bfhi(w.x); o[2] = bflo(w.y); o[3] = bfhi(w.y); o[4] = bflo(w.z); o[5] = bfhi(w.z); o[6] = bflo(w.w); o[7] = bfhi(w.w);
}
__device__ __forceinline__ void load8f(const float* p, float (&o)[8]) {
    const f32x4 a = *(const f32x4*)p, b = *(const f32x4*)(p + 4);
    o[0] = a.x; o[1] = a.y; o[2] = a.z; o[3] = a.w; o[4] = b.x; o[5] = b.y; o[6] = b.z; o[7] = b.w;
}
__device__ __forceinline__ void p0_transpose_item(const float* W, int ldn, int K, int N, bf16* WT, const float* gk, LAS float* scr, int item, int lane, bool upperm = false) {
    const int nblk = N / 32, kb = item / nblk, nb = item % nblk, k0 = 64 * kb, n0 = 32 * nb;
    const int nd0 = !upperm ? n0 : (n0 < DFF ? 256 * (n0 >> 7) + (n0 & 127) : 256 * ((n0 - DFF) >> 7) + 128 + ((n0 - DFF) & 127));
    const float* src = W + (size_t)(k0 + (lane >> 5)) * ldn + n0 + (lane & 31);
    float wv[32];
#pragma unroll
    for (int i = 0; i < 32; ++i) wv[i] = src[(size_t)(2 * i) * ldn];
#pragma unroll
    for (int i = 0; i < 32; ++i) scr[(2 * i + (lane >> 5)) * 33 + (lane & 31)] = wv[i];
    const int c = lane & 7;
    float g8[8];
    if (gk) load8f(gk + k0 + 8 * c, g8); else {
#pragma unroll
        for (int j = 0; j < 8; ++j) g8[j] = 1.f; }
    LDS_WAIT(); asm volatile("" ::: "memory");
#pragma unroll
    for (int j = 0; j < 4; ++j) { const int n = (lane >> 3) + 8 * j; const LAS float* sp = scr + (8 * c) * 33 + n;
        v4u o; o.x = pk2(sp[0 * 33] * g8[0], sp[1 * 33] * g8[1]); o.y = pk2(sp[2 * 33] * g8[2], sp[3 * 33] * g8[3]); o.z = pk2(sp[4 * 33] * g8[4], sp[5 * 33] * g8[5]); o.w = pk2(sp[6 * 33] * g8[6], sp[7 * 33] * g8[7]);
        *(GAS v4u*)(WT + (size_t)(nd0 + n) * K + k0 + 8 * c) = o; }
    LDS_WAIT(); asm volatile("" ::: "memory");
}
__device__ __forceinline__ void p0_prologue(const Args& a, LAS unsigned char* lds, int gw, int NGW, int wave, int lane, int part = 3) {
    unsigned char* ws = a.ws;
    LAS float* scr = (LAS float*)(lds + wave * 8704);
    constexpr int I_IN = (DM / 64) * (NIN / 32), I_OUT = (DM / 64) * (DM / 32), I_UP = (DM / 64) * (DFF2 / 32), I_DN = (DFF / 64) * (DM / 32), I_PLE = (DPLE / 64) * (DM / 32), I_G = I_OUT;
    constexpr int NITEMS = I_IN + I_OUT + I_UP + I_DN + I_PLE + I_G;
    if (part & 1) for (int it = gw; it < NITEMS; it += NGW) {
        int r = it;
        if (r < I_IN)  { p0_transpose_item(a.in[11], IN_LD, DM, NIN, (bf16*)(ws + WS_WIN), a.in[10], scr, r, lane); continue; } r -= I_IN;
        if (r < I_OUT) { p0_transpose_item(a.in[18], DM, DM, DM, (bf16*)(ws + WS_WOUT), nullptr, scr, r, lane); continue; } r -= I_OUT;
        if (r < I_UP)  { p0_transpose_item(a.in[20], DFF2, DM, DFF2, (bf16*)(ws + WS_WUP), a.in[19], scr, r, lane, true); continue; } r -= I_UP;
        if (r < I_DN)  { p0_transpose_item(a.in[23], DM, DFF, DM, (bf16*)(ws + WS_WDOWN), nullptr, scr, r, lane); continue; } r -= I_DN;
        if (r < I_PLE) { p0_transpose_item(a.in[24], DM, DPLE, DM, (bf16*)(ws + WS_WPLE), nullptr, scr, r, lane); continue; } r -= I_PLE;
        p0_transpose_item(a.in[26], DM, DM, DM, (bf16*)(ws + WS_WGATE), nullptr, scr, r, lane);
    }
    const float* gmix = a.in[10]; const float* win = a.in[11]; const float* dtb = a.in[14];
    bf16* XN = (bf16*)(ws + WS_XN); bf16* PB = (bf16*)(ws + WS_PB); float* DT = (float*)(ws + WS_DT);
    LAS unsigned char* dtw = lds + 81920;
    for (int k = threadIdx.x; k < DM; k += NWAVES * 64) {
        const float gk = gmix[k]; const f32x4 w0 = *(const f32x4*)(win + (size_t)k * IN_LD + NIN) * gk, w1 = *(const f32x4*)(win + (size_t)k * IN_LD + NIN + 4) * gk;
        LAS f32x4* d = (LAS f32x4*)(dtw + (k >> 2) * 144 + (k & 3) * 32); d[0] = w0; d[1] = w1;
    }
    LDS_WAIT(); __syncthreads();
    f32x4 vn[4];
    if (gw < MT) { const float* xrow = (gw < MP) ? a.in[0] + (size_t)gw * DM : a.in[1] + (size_t)(gw - MP) * DM;
#pragma unroll
        for (int j = 0; j < 4; ++j) vn[j] = ((const GAS f32x4*)xrow + lane)[64 * j]; }
    if (part & 2) for (int m = gw; m < MT; m += NGW) {
        f32x4 v[4]; float s = 0.f;
#pragma unroll
        for (int j = 0; j < 4; ++j) { v[j] = vn[j]; s += (v[j].x * v[j].x + v[j].y * v[j].y) + (v[j].z * v[j].z + v[j].w * v[j].w); }
        { const int mn = m + NGW; if (mn < MT) { const float* xrow = (mn < MP) ? a.in[0] + (size_t)mn * DM : a.in[1] + (size_t)(mn - MP) * DM;
#pragma unroll
            for (int j = 0; j < 4; ++j) vn[j] = ((const GAS f32x4*)xrow + lane)[64 * j]; } }
        const float rstd = 1.0f / sqrtf(wave_sum(s) * (1.f / DM) + EPS);
        GAS unsigned long long* o8 = (GAS unsigned long long*)(XN + (size_t)m * DM) + lane;
        float dacc[8];
#pragma unroll
        for (int h = 0; h < 8; ++h) dacc[h] = 0.f;
#pragma unroll
        for (int j = 0; j < 4; ++j) {
            v[j] = v[j] * rstd;
            o8[64 * j] = (unsigned long long)pk2(v[j].x, v[j].y) | ((unsigned long long)pk2(v[j].z, v[j].w) << 32);
#pragma unroll
            for (int e = 0; e < 4; ++e) {
                const float xv = v[j][e];
                const LAS f32x4* d = (const LAS f32x4*)(dtw + (64 * j + lane) * 144 + e * 32);
                const f32x4 w0 = d[0], w1 = d[1];
                dacc[0] += xv * w0.x; dacc[1] += xv * w0.y; dacc[2] += xv * w0.z; dacc[3] += xv * w0.w;
                dacc[4] += xv * w1.x; dacc[5] += xv * w1.y; dacc[6] += xv * w1.z; dacc[7] += xv * w1.w;
            }
        }
#pragma unroll
        for (int h = 0; h < 8; ++h) dacc[h] = softplusf(wave_sum(dacc[h]) + dtb[h]);
        if (lane == 0) { *(f32x4*)(DT + (size_t)m * 8) = (f32x4){dacc[0], dacc[1], dacc[2], dacc[3]}; *(f32x4*)(DT + (size_t)m * 8 + 4) = (f32x4){dacc[4], dacc[5], dacc[6], dacc[7]}; }
        const float* prow = (m < MP) ? a.in[2] + (size_t)m * DPLE : a.in[3] + (size_t)(m - MP) * DPLE;
        const f32x4 pv = *((const f32x4*)prow + lane);
        *((GAS unsigned long long*)(PB + (size_t)m * DPLE) + lane) = (unsigned long long)pk2(pv.x, pv.y) | ((unsigned long long)pk2(pv.z, pv.w) << 32);
    }
}

__device__ __forceinline__ void conv_sample_pass(const Args& a, int gtid, int NT) {
    const bf16* PROJ = (const bf16*)(a.ws + WS_PROJ); float* XB = (float*)(a.ws + WS_XBS); bf16* XC = (bf16*)(a.ws + WS_XC);
    const float* cw = a.in[12]; const float* cb = a.in[13]; const float* sconv = a.in[7];
    for (int it = gtid; it < NBS * 128; it += NT) {
        const int b = it >> 7, c = (it & 127) * 8, m0 = MP + b * 8;
        float w0[8], w1[8], w2[8], w3[8], bb[8], x3[8], x2[8], x1[8];
        load8f(cw + c, w0); load8f(cw + 1024 + c, w1); load8f(cw + 2048 + c, w2); load8f(cw + 3072 + c, w3); load8f(cb + c, bb);
        load8f(sconv + (size_t)(b * 3 + 0) * 1024 + c, x3); load8f(sconv + (size_t)(b * 3 + 1) * 1024 + c, x2); load8f(sconv + (size_t)(b * 3 + 2) * 1024 + c, x1);
#pragma unroll
        for (int r = 0; r < 8; ++r) {
            float cur[8], y[8]; load8bf(PROJ + (size_t)(m0 + r) * NIN + PC_X + c, cur);
#pragma unroll
            for (int k = 0; k < 8; ++k) { y[k] = siluf(bb[k] + w0[k] * x3[k] + w1[k] * x2[k] + w2[k] * x1[k] + w3[k] * cur[k]); x3[k] = x2[k]; x2[k] = x1[k]; x1[k] = cur[k]; }
            float* o = XB + (size_t)(b * 8 + r) * 1024 + c;
            *(f32x4*)o = (f32x4){y[0], y[1], y[2], y[3]}; *(f32x4*)(o + 4) = (f32x4){y[4], y[5], y[6], y[7]};
            if (c < 512) { v4u w; w.x = pk2(y[0], y[1]); w.y = pk2(y[2], y[3]); w.z = pk2(y[4], y[5]); w.w = pk2(y[6], y[7]); *(v4u*)(XC + (size_t)(m0 + r) * 512 + c) = w; }
        }
    }
}

#ifndef S1SUB
#define S1SUB 7
#endif
constexpr int S1_BR = 0, S1_CR = 32768, S1_BT = 65536, S1_XT = 98304, S1_XW = 114688, S1_AC = 133120;
__device__ __forceinline__ void ssd_s1_unit(const Args& a, LAS unsigned char* lds, int unit, int tid, int wave, int lane) {
    asm volatile("" : "+v"(tid), "+v"(lane));
    const int h = unit & 7, c = (unit >> 3) & 31, b = unit >> 8, g = h >> 2, m0 = b * SEQ + c * 128;
    const bf16* PROJ = (const bf16*)(a.ws + WS_PROJ); const float* DT = (const float*)(a.ws + WS_DT);
    LAS float* ac = (LAS float*)(lds + S1_AC); LAS float* dts = ac + 128;
    const int r32 = lane & 31, hh = lane >> 5;
    const int o = tid % 40, rc = tid / 40, s0 = rc * 11;
    const int xcol = (o < 8) ? h * 64 + 8 * o : (o < 24) ? 512 + g * 128 + 8 * (o - 8) : 768 + g * 128 + 8 * (o - 24);
    const bool cact = tid < 480;
    v4u raw[14];
    if (cact) {
#pragma unroll
        for (int i = 0; i < 14; ++i) { int sr = s0 - 3 + i; sr = sr > 127 ? 127 : sr; if (c == 0 && sr < 0) sr = 0; raw[i] = *(const v4u*)(PROJ + (size_t)(m0 + sr) * NIN + PC_X + xcol); }
    }
    if (wave == 0) {
        const float A = -__expf(a.in[15][h]);
        const float d0 = DT[(size_t)(m0 + 2 * lane) * 8 + h], d1 = DT[(size_t)(m0 + 2 * lane + 1) * 8 + h];
        const float a0 = d0 * A, a1 = d1 * A; float v = a0 + a1;
#pragma unroll
        for (int d = 1; d < 64; d <<= 1) { const float n = __shfl_up(v, d); if (lane >= d) v += n; }
        const float e0 = v - a1, e1 = v;
        ac[2 * lane] = e0; ac[2 * lane + 1] = e1; dts[2 * lane] = d0; dts[2 * lane + 1] = d1;
        float* ACUM = (float*)(a.ws + WS_ACUM); ACUM[(size_t)(m0 + 2 * lane) * 8 + h] = e0; ACUM[(size_t)(m0 + 2 * lane + 1) * 8 + h] = e1;
        if (lane == 63) ((float*)(a.ws + WS_ACL))[(b * 32 + c) * 8 + h] = e1;
    }
    __syncthreads();
    if ((S1SUB & 1) && cact) {
        const float* cw = a.in[12]; const float* cb = a.in[13];
        float w0[8], w1[8], w2[8], w3[8], bb[8], x3[8], x2[8], x1[8];
        load8f(cw + xcol, w0); load8f(cw + 1024 + xcol, w1); load8f(cw + 2048 + xcol, w2); load8f(cw + 3072 + xcol, w3); load8f(cb + xcol, bb);
        const bool z0 = (c == 0 && rc == 0);
        { const v4u r3 = raw[0], r2 = raw[1], r1 = raw[2];
          x3[0] = bflo(r3.x); x3[1] = bfhi(r3.x); x3[2] = bflo(r3.y); x3[3] = bfhi(r3.y); x3[4] = bflo(r3.z); x3[5] = bfhi(r3.z); x3[6] = bflo(r3.w); x3[7] = bfhi(r3.w);
          x2[0] = bflo(r2.x); x2[1] = bfhi(r2.x); x2[2] = bflo(r2.y); x2[3] = bfhi(r2.y); x2[4] = bflo(r2.z); x2[5] = bfhi(r2.z); x2[6] = bflo(r2.w); x2[7] = bfhi(r2.w);
          x1[0] = bflo(r1.x); x1[1] = bfhi(r1.x); x1[2] = bflo(r1.y); x1[3] = bfhi(r1.y); x1[4] = bflo(r1.z); x1[5] = bfhi(r1.z); x1[6] = bflo(r1.w); x1[7] = bfhi(r1.w);
          if (z0) {
#pragma unroll
              for (int k = 0; k < 8; ++k) { x3[k] = 0.f; x2[k] = 0.f; x1[k] = 0.f; } } }
        const float aL = ac[127];
        bf16* XC = (bf16*)(a.ws + WS_XC); bf16* CC = (bf16*)(a.ws + WS_CC);
#pragma unroll
        for (int r = 0; r < 11; ++r) {
            const int sr = s0 + r;
            if (sr < 128) {
                const v4u rw = raw[3 + r]; float cur[8], y[8];
                cur[0] = bflo(rw.x); cur[1] = bfhi(rw.x); cur[2] = bflo(rw.y); cur[3] = bfhi(rw.y); cur[4] = bflo(rw.z); cur[5] = bfhi(rw.z); cur[6] = bflo(rw.w); cur[7] = bfhi(rw.w);
#pragma unroll
                for (int k = 0; k < 8; ++k) { y[k] = siluf(bb[k] + w0[k] * x3[k] + w1[k] * x2[k] + w2[k] * x1[k] + w3[k] * cur[k]); x3[k] = x2[k]; x2[k] = x1[k]; x1[k] = cur[k]; }
                v4u w; w.x = pk2(y[0], y[1]); w.y = pk2(y[2], y[3]); w.z = pk2(y[4], y[5]); w.w = pk2(y[6], y[7]);
                if (o < 8) {
                    const int off = (o >> 2) * 8192 + (sr >> 4) * 1024 + (sr & 15) * 64 + (o & 3) * 16;
                    *(LAS v4u*)(lds + S1_XT + off) = w;
                    const float de = __expf(aL - ac[sr]) * dts[sr];
                    v4u ww; ww.x = pk2(y[0] * de, y[1] * de); ww.y = pk2(y[2] * de, y[3] * de); ww.z = pk2(y[4] * de, y[5] * de); ww.w = pk2(y[6] * de, y[7] * de);
                    *(LAS v4u*)(lds + S1_XW + off) = ww;
                    *(v4u*)(XC + (size_t)(m0 + sr) * 512 + h * 64 + 8 * o) = w;
                } else if (o < 24) {
                    const int ch = o - 8;
                    *(LAS v4u*)(lds + S1_BR + sr * 256 + ((ch ^ (sr & 15)) << 4)) = w;
                    *(LAS v4u*)(lds + S1_BT + (ch >> 2) * 8192 + (sr >> 4) * 1024 + (sr & 15) * 64 + (ch & 3) * 16) = w;
                } else {
                    const int ch = o - 24;
                    *(LAS v4u*)(lds + S1_CR + sr * 256 + ((ch ^ (sr & 15)) << 4)) = w;
                    if ((h & 3) == 0) *(v4u*)(CC + (size_t)(m0 + sr) * 256 + g * 128 + 8 * ch) = w;
                }
            }
        }
    }
    __syncthreads();
    const int laneoff = ((lane >> 4) & 1) * 32 + (lane & 3) * 8 + (4 * hh + ((lane & 15) >> 2)) * 64;
    if (S1SUB & 2) {
        const int tb = wave >> 1, ph = wave & 1, tq = 32 * tb + r32;
        bf16x8 cq[8];
#pragma unroll
        for (int k = 0; k < 8; ++k) cq[k] = *(const LAS bf16x8*)(lds + S1_CR + tq * 256 + (((2 * k + hh) ^ (tq & 15)) << 4));
        const float act = ac[tq] * LOG2E;
        f32x16 o;
#pragma unroll
        for (int i = 0; i < 16; ++i) o[i] = 0.f;
#pragma unroll 1
        for (int sb = 0; sb <= tb; ++sb) {
            {
                f32x16 S;
#pragma unroll
                for (int i = 0; i < 16; ++i) S[i] = 0.f;
                const int sq = 32 * sb + r32;
#pragma unroll
                for (int k = 0; k < 8; ++k) { const bf16x8 bf = *(const LAS bf16x8*)(lds + S1_BR + sq * 256 + (((2 * k + hh) ^ (sq & 15)) << 4)); S = __builtin_amdgcn_mfma_f32_32x32x16_bf16(bf, cq[k], S, 0, 0, 0); }
#pragma unroll
                for (int i = 0; i < 16; ++i) { const int si = 32 * sb + crow(i, hh); const float e = __builtin_amdgcn_exp2f(act - ac[si] * LOG2E) * dts[si]; S[i] = (si <= tq) ? S[i] * e : 0.f; }
#pragma unroll
                for (int ks = 0; ks < 2; ++ks) {
                    v4u pw; pw.x = cvtpk_s(S[8 * ks + 0], S[8 * ks + 1]); pw.y = cvtpk_s(S[8 * ks + 2], S[8 * ks + 3]); pw.z = cvtpk_s(S[8 * ks + 4], S[8 * ks + 5]); pw.w = cvtpk_s(S[8 * ks + 6], S[8 * ks + 7]);
                    const bf16x8 pa = __builtin_bit_cast(bf16x8, pw);
                    const LAS unsigned char* xp = lds + S1_XT + ph * 8192 + (2 * sb + ks) * 1024 + laneoff;
                    const v4i16_t lo = vtr(xp), hi2 = vtr(xp + 512);
                    const bf16x8 xb = (bf16x8){lo[0], lo[1], lo[2], lo[3], hi2[0], hi2[1], hi2[2], hi2[3]};
                    o = __builtin_amdgcn_mfma_f32_32x32x16_bf16(pa, xb, o, 0, 0, 0);
                }
            }
        }
        float* YS = (float*)(a.ws + WS_YS);
#pragma unroll
        for (int i = 0; i < 16; ++i) YS[(size_t)(m0 + 32 * tb + crow(i, hh)) * 512 + h * 64 + 32 * ph + r32] = o[i];
    }
    if (S1SUB & 4) {
        const int pb = wave & 1, nb = wave >> 1;
        f32x16 st;
#pragma unroll
        for (int i = 0; i < 16; ++i) st[i] = 0.f;
#pragma unroll
        for (int k = 0; k < 8; ++k) {
            const LAS unsigned char* ap = lds + S1_XW + pb * 8192 + k * 1024 + laneoff; const LAS unsigned char* bp = lds + S1_BT + nb * 8192 + k * 1024 + laneoff;
            const v4i16_t al = vtr(ap), ah = vtr(ap + 512), bl = vtr(bp), bh = vtr(bp + 512);
            const bf16x8 af = (bf16x8){al[0], al[1], al[2], al[3], ah[0], ah[1], ah[2], ah[3]}, bf = (bf16x8){bl[0], bl[1], bl[2], bl[3], bh[0], bh[1], bh[2], bh[3]};
            st = __builtin_amdgcn_mfma_f32_32x32x16_bf16(af, bf, st, 0, 0, 0);
        }
        float* CS = (float*)(a.ws + WS_CS) + (size_t)((b * 32 + c) * 8 + h) * 64 * 128;
#pragma unroll
        for (int i = 0; i < 16; ++i) CS[(size_t)(32 * pb + crow(i, hh)) * 128 + 32 * nb + r32] = st[i];
    }
    LDS_WAIT(); __syncthreads();
}
constexpr int G1_BR = 0, G1_CR = 32768, G1_BT = 65536, G1_XT = 0  , G1_AC = 133120  ;
__device__ __forceinline__ void unpack8(const v4u w, float (&o)[8]) { o[0] = bflo(w.x); o[1] = bfhi(w.x); o[2] = bflo(w.y); o[3] = bfhi(w.y); o[4] = bflo(w.z); o[5] = bfhi(w.z); o[6] = bflo(w.w); o[7] = bfhi(w.w); }
__device__ __forceinline__ void ssd_s1g_unit(const Args& a, LAS unsigned char* lds, int unit, int tid, int wave, int lane) {
    asm volatile("" : "+v"(tid), "+v"(lane));
    const int g = unit & 1, c = (unit >> 1) & 31, b = unit >> 6, m0 = b * SEQ + c * 128;
    const bf16* PROJ = (const bf16*)(a.ws + WS_PROJ); const float* DT = (const float*)(a.ws + WS_DT);
    LAS float* ac = (LAS float*)(lds + G1_AC); LAS float* dts = ac + 512; LAS float* des = ac + 1024;
    const int r32 = lane & 31, hh = lane >> 5;
    const int oct = tid & 31, rc = tid >> 5, s0 = rc * 8;
    const int bccol = (oct < 16) ? 512 + g * 128 + 8 * oct : 768 + g * 128 + 8 * (oct - 16), xcol = g * 256 + 8 * oct;
    const bool z0 = (c == 0 && rc == 0);
    v4u rbc[11], rx[11];
#pragma unroll
    for (int i = 0; i < 11; ++i) { int sr = s0 - 3 + i; if (c == 0 && sr < 0) sr = 0; const bf16* p = PROJ + (size_t)(m0 + sr) * NIN + PC_X; rbc[i] = *(const v4u*)(p + bccol); rx[i] = *(const v4u*)(p + xcol); }
    if (wave < 4) {
        const int h = 4 * g + wave; const float A = -__expf(a.in[15][h]);
        const float d0 = DT[(size_t)(m0 + 2 * lane) * 8 + h], d1 = DT[(size_t)(m0 + 2 * lane + 1) * 8 + h];
        const float a0 = d0 * A, a1 = d1 * A; float v = a0 + a1;
#pragma unroll
        for (int d = 1; d < 64; d <<= 1) { const float n = __shfl_up(v, d); if (lane >= d) v += n; }
        const float e0 = v - a1, e1 = v, aL = __builtin_bit_cast(float, __builtin_amdgcn_readlane(__builtin_bit_cast(int, v), 63));
        ac[wave * 128 + 2 * lane] = e0; ac[wave * 128 + 2 * lane + 1] = e1; dts[wave * 128 + 2 * lane] = d0; dts[wave * 128 + 2 * lane + 1] = d1;
        des[wave * 128 + 2 * lane] = __expf(aL - e0) * d0; des[wave * 128 + 2 * lane + 1] = __expf(aL - e1) * d1;
        float* ACUM = (float*)(a.ws + WS_ACUM); ACUM[(size_t)(m0 + 2 * lane) * 8 + h] = e0; ACUM[(size_t)(m0 + 2 * lane + 1) * 8 + h] = e1;
        if (lane == 63) ((float*)(a.ws + WS_ACL))[(b * 32 + c) * 8 + h] = e1;
    }
    const float* cw = a.in[12]; const float* cb = a.in[13];
    {
        float w0[8], w1[8], w2[8], w3[8], bb[8], x3[8], x2[8], x1[8];
        load8f(cw + bccol, w0); load8f(cw + 1024 + bccol, w1); load8f(cw + 2048 + bccol, w2); load8f(cw + 3072 + bccol, w3); load8f(cb + bccol, bb);
        unpack8(rbc[0], x3); unpack8(rbc[1], x2); unpack8(rbc[2], x1);
        if (z0) {
#pragma unroll
            for (int k = 0; k < 8; ++k) { x3[k] = 0.f; x2[k] = 0.f; x1[k] = 0.f; } }
        bf16* CC = (bf16*)(a.ws + WS_CC);
#pragma unroll
        for (int r = 0; r < 8; ++r) {
            const int sr = s0 + r; float cur[8], y[8]; unpack8(rbc[3 + r], cur);
#pragma unroll
            for (int k = 0; k < 8; ++k) { y[k] = siluf(bb[k] + w0[k] * x3[k] + w1[k] * x2[k] + w2[k] * x1[k] + w3[k] * cur[k]); x3[k] = x2[k]; x2[k] = x1[k]; x1[k] = cur[k]; }
            v4u w; w.x = pk2(y[0], y[1]); w.y = pk2(y[2], y[3]); w.z = pk2(y[4], y[5]); w.w = pk2(y[6], y[7]);
            if (oct < 16) { const int ch = oct;
                *(LAS v4u*)(lds + G1_BR + sr * 256 + ((ch ^ (sr & 15)) << 4)) = w;
                *(LAS v4u*)(lds + G1_BT + (ch >> 2) * 8192 + (sr >> 4) * 1024 + (sr & 15) * 64 + (ch & 3) * 16) = w;
            } else { const int ch = oct - 16;
                *(LAS v4u*)(lds + G1_CR + sr * 256 + ((ch ^ (sr & 15)) << 4)) = w;
                *(v4u*)(CC + (size_t)(m0 + sr) * 256 + g * 128 + 8 * ch) = w; }
        }
    }
    LDS_WAIT(); __syncthreads();
    const int tb = wave >> 1, ph = wave & 1, tq = 32 * tb + r32;
    f32x16 S[4];
    {
        bf16x8 cq[8];
#pragma unroll
        for (int k = 0; k < 8; ++k) cq[k] = *(const LAS bf16x8*)(lds + G1_CR + tq * 256 + (((2 * k + hh) ^ (tq & 15)) << 4));
#pragma unroll
        for (int sb = 0; sb < 4; ++sb) {
#pragma unroll
            for (int i = 0; i < 16; ++i) S[sb][i] = 0.f;
            if (sb <= tb) { const int sq = 32 * sb + r32;
#pragma unroll
                for (int k = 0; k < 8; ++k) { const bf16x8 bf = *(const LAS bf16x8*)(lds + G1_BR + sq * 256 + (((2 * k + hh) ^ (sq & 15)) << 4)); S[sb] = __builtin_amdgcn_mfma_f32_32x32x16_bf16(bf, cq[k], S[sb], 0, 0, 0); } }
        }
    }
    LDS_WAIT(); __syncthreads();
    {
        float w0[8], w1[8], w2[8], w3[8], bb[8], x3[8], x2[8], x1[8];
        load8f(cw + xcol, w0); load8f(cw + 1024 + xcol, w1); load8f(cw + 2048 + xcol, w2); load8f(cw + 3072 + xcol, w3); load8f(cb + xcol, bb);
        unpack8(rx[0], x3); unpack8(rx[1], x2); unpack8(rx[2], x1);
        if (z0) {
#pragma unroll
            for (int k = 0; k < 8; ++k) { x3[k] = 0.f; x2[k] = 0.f; x1[k] = 0.f; } }
        bf16* XC = (bf16*)(a.ws + WS_XC); const int hl = oct >> 3, o = oct & 7;
#pragma unroll
        for (int r = 0; r < 8; ++r) {
            const int sr = s0 + r; float cur[8], y[8]; unpack8(rx[3 + r], cur);
#pragma unroll
            for (int k = 0; k < 8; ++k) { y[k] = siluf(bb[k] + w0[k] * x3[k] + w1[k] * x2[k] + w2[k] * x1[k] + w3[k] * cur[k]); x3[k] = x2[k]; x2[k] = x1[k]; x1[k] = cur[k]; }
            v4u w; w.x = pk2(y[0], y[1]); w.y = pk2(y[2], y[3]); w.z = pk2(y[4], y[5]); w.w = pk2(y[6], y[7]);
            *(LAS v4u*)(lds + G1_XT + hl * 16384 + (o >> 2) * 8192 + (sr >> 4) * 1024 + (sr & 15) * 64 + (o & 3) * 16) = w;
            *(v4u*)(XC + (size_t)(m0 + sr) * 512 + g * 256 + 8 * oct) = w;
        }
    }
    LDS_WAIT(); __syncthreads();
    const int laneoff = ((lane >> 4) & 1) * 32 + (lane & 3) * 8 + (4 * hh + ((lane & 15) >> 2)) * 64;
    float* YS = (float*)(a.ws + WS_YS);
#pragma unroll 1
    for (int hl = 0; hl < 4; ++hl) {
        const int h = 4 * g + hl; const LAS float* ach = ac + hl * 128; const LAS float* dth = dts + hl * 128;
        {
            const float act = ach[tq] * LOG2E;
            f32x16 o;
#pragma unroll
            for (int i = 0; i < 16; ++i) o[i] = 0.f;
#pragma unroll
            for (int sb = 0; sb < 4; ++sb) {
                if (sb <= tb) {
                    float M[16];
#pragma unroll
                    for (int i = 0; i < 16; ++i) { const int si = 32 * sb + crow(i, hh); const float e = __builtin_amdgcn_exp2f(act - ach[si] * LOG2E) * dth[si]; M[i] = (si <= tq) ? S[sb][i] * e : 0.f; }
#pragma unroll
                    for (int ks = 0; ks < 2; ++ks) {
                        v4u pw; pw.x = cvtpk_s(M[8 * ks + 0], M[8 * ks + 1]); pw.y = cvtpk_s(M[8 * ks + 2], M[8 * ks + 3]); pw.z = cvtpk_s(M[8 * ks + 4], M[8 * ks + 5]); pw.w = cvtpk_s(M[8 * ks + 6], M[8 * ks + 7]);
                        const bf16x8 pa = __builtin_bit_cast(bf16x8, pw);
                        const LAS unsigned char* xp = lds + G1_XT + hl * 16384 + ph * 8192 + (2 * sb + ks) * 1024 + laneoff;
                        const v4i16_t lo = vtr(xp), hi2 = vtr(xp + 512);
                        const bf16x8 xb = (bf16x8){lo[0], lo[1], lo[2], lo[3], hi2[0], hi2[1], hi2[2], hi2[3]};
                        o = __builtin_amdgcn_mfma_f32_32x32x16_bf16(pa, xb, o, 0, 0, 0);
                    }
                }
            }
#pragma unroll
            for (int i = 0; i < 16; ++i) YS[(size_t)(m0 + 32 * tb + crow(i, hh)) * 512 + h * 64 + 32 * ph + r32] = o[i];
        }
        {
            const int pb = wave & 1, nb = wave >> 1; const LAS float* deh = des + hl * 128;
            f32x16 st;
#pragma unroll
            for (int i = 0; i < 16; ++i) st[i] = 0.f;
#pragma unroll
            for (int k = 0; k < 8; ++k) {
                const LAS unsigned char* ap = lds + G1_XT + hl * 16384 + pb * 8192 + k * 1024 + laneoff; const LAS unsigned char* bp = lds + G1_BT + nb * 8192 + k * 1024 + laneoff;
                const v4i16_t al = vtr(ap), ah = vtr(ap + 512), bl = vtr(bp), bh = vtr(bp + 512);
                const f32x4 dl = *(const LAS f32x4*)(deh + 16 * k + 4 * hh), dh = *(const LAS f32x4*)(deh + 16 * k + 8 + 4 * hh);
                v4u aw;
                aw.x = pk2(bf2f((unsigned short)al[0]) * dl.x, bf2f((unsigned short)al[1]) * dl.y); aw.y = pk2(bf2f((unsigned short)al[2]) * dl.z, bf2f((unsigned short)al[3]) * dl.w);
                aw.z = pk2(bf2f((unsigned short)ah[0]) * dh.x, bf2f((unsigned short)ah[1]) * dh.y); aw.w = pk2(bf2f((unsigned short)ah[2]) * dh.z, bf2f((unsigned short)ah[3]) * dh.w);
                const bf16x8 af = __builtin_bit_cast(bf16x8, aw), bf = (bf16x8){bl[0], bl[1], bl[2], bl[3], bh[0], bh[1], bh[2], bh[3]};
                st = __builtin_amdgcn_mfma_f32_32x32x16_bf16(af, bf, st, 0, 0, 0);
            }
            float* CS = (float*)(a.ws + WS_CS) + (size_t)((b * 32 + c) * 8 + h) * 64 * 128;
#pragma unroll
            for (int i = 0; i < 16; ++i) CS[(size_t)(32 * pb + crow(i, hh)) * 128 + 32 * nb + r32] = st[i];
        }
    }
    LDS_WAIT(); __syncthreads();
}
__device__ __forceinline__ void ssd_s2_pass(const Args& a, int gtid, int NT) {
    typedef float f32x2t __attribute__((ext_vector_type(2)));
    const float* CS = (const float*)(a.ws + WS_CS); const float* ACL = (const float*)(a.ws + WS_ACL); bf16* PREV = (bf16*)(a.ws + WS_PREV);
    for (int it = gtid; it < NBP * 8 * 64 * 64; it += NT) {
        const int n2 = it & 63, p = (it >> 6) & 63, h = (it >> 12) & 7, b = it >> 15;
        f32x2t s = {0.f, 0.f};
#pragma unroll 8
        for (int c = 0; c < 32; ++c) {
            const size_t idx = ((size_t)((b * 32 + c) * 8 + h) * 64 + p) * 128 + 2 * n2;
            const f32x2t cs = *(const f32x2t*)(CS + idx); const float dec = __expf(ACL[(b * 32 + c) * 8 + h]);
            *(unsigned*)(PREV + idx) = pk2(s.x, s.y);
            s = s * dec + cs;
        }
        *(f32x2t*)(a.out + O_SP + ((size_t)((b * 8 + h) * 64 + p)) * 128 + 2 * n2) = s;
    }
}
__device__ __forceinline__ void ssd_s3_unit(const Args& a, int unit, int wave, int lane, float psc = 1.f) {
    asm volatile("" : "+v"(lane));
    const int h = unit & 7, c = (unit >> 3) & 31, b = unit >> 8, g = h >> 2, m0 = b * SEQ + c * 128;
    const int r32 = lane & 31, hh = lane >> 5, tb = wave >> 1, ph = wave & 1;
    const bf16* cp = (const bf16*)(a.ws + WS_CC) + (size_t)(m0 + 32 * tb + r32) * 256 + g * 128 + 8 * hh;
    const bf16* pp = (const bf16*)(a.ws + WS_PREV) + ((size_t)((b * 32 + c) * 8 + h) * 64 + 32 * ph + r32) * 128 + 8 * hh;
    bf16x8 cf[8], pf[8];
#pragma unroll
    for (int k = 0; k < 8; ++k) { cf[k] = *(const bf16x8*)(cp + 16 * k); pf[k] = *(const bf16x8*)(pp + 16 * k); }
    f32x16 acc;
#pragma unroll
    for (int i = 0; i < 16; ++i) acc[i] = 0.f;
#pragma unroll
    for (int k = 0; k < 8; ++k) acc = __builtin_amdgcn_mfma_f32_32x32x16_bf16(cf[k], pf[k], acc, 0, 0, 0);
    float* YS = (float*)(a.ws + WS_YS); const float* ACUM = (const float*)(a.ws + WS_ACUM);
#pragma unroll
    for (int i = 0; i < 16; ++i) { const size_t t = (size_t)(m0 + 32 * tb + crow(i, hh)); float* yp = YS + t * 512 + h * 64 + 32 * ph + r32; *yp = *yp + psc * __expf(ACUM[t * 8 + h]) * acc[i]; }
}

constexpr int ATT_WAVE_BYTES = 8704, ATT_VB = 0, ATT_STG = 4096, ATT_WSF = 8192, ATT_BTAB_OFF = 8 * ATT_WAVE_BYTES  , ATT_BT_LD = 132;

__device__ __forceinline__ void attn_build_btab(const Args& a, LAS unsigned char* lds, int tid) {
    LAS float* bt = (LAS float*)(lds + ATT_BTAB_OFF); const float* rb = a.in[9];
    for (int i = tid; i < 3 * 8 * 129; i += NWAVES * 64) { const int br = i / (8 * 129), rem = i % (8 * 129), h = rem / 129, j = rem % 129; bt[(br * 8 + h) * ATT_BT_LD + j] = rb[BUCKET_TAB[br][j] * 8 + h] * LOG2E; }
}
__device__ __forceinline__ void attn_prompt_unit(const Args& a, LAS unsigned char* lds, int unit, int wave, int lane) {
    asm volatile("" : "+v"(lane));
    const bf16* PROJ = (const bf16*)(a.ws + WS_PROJ);
    const int r32 = lane & 31, hi = lane >> 5;
    const int rq = unit & 127, bhb = unit >> 7, br = bhb % 3, bh = bhb / 3, h = bh & 7, b = bh >> 3;
    const int sh = 2 * br, dil = 1 << sh, nqb = 128 >> sh, r = rq / nqb, qb = rq % nqb, l0 = qb * 32;
    const size_t rowb = (size_t)b * SEQ;
    LAS unsigned char* wl = lds + wave * ATT_WAVE_BYTES;
    const LAS float* bt = (const LAS float*)(lds + ATT_BTAB_OFF) + (br * 8 + h) * ATT_BT_LD;
    bf16x8 qr[4];
    { const bf16* qp = PROJ + (rowb + (size_t)(l0 + r32) * dil + r) * NIN + h * 64 + hi * 8;
#pragma unroll
      for (int d0 = 0; d0 < 4; ++d0) qr[d0] = *(const bf16x8*)(qp + d0 * 16); }
    const int kb0 = (l0 >= 128) ? 0 : (4 - (l0 >> 5));
    f32x16 s[5];
    bf16x8 kfa[4], kfb[4];
#define ATT_KLOAD(dst, kb_) do { int kk_ = l0 - 128 + 32 * (kb_) + r32; kk_ = kk_ < 0 ? 0 : kk_; const bf16* kp_ = PROJ + (rowb + (size_t)kk_ * dil + r) * NIN + PC_K + h * 64 + hi * 8; \
        _Pragma("unroll") for (int d0 = 0; d0 < 4; ++d0) dst[d0] = *(const bf16x8*)(kp_ + d0 * 16); } while (0)
#define ATT_QK(src, kb_) do { _Pragma("unroll") for (int i = 0; i < 16; ++i) s[kb_][i] = 0.f; \
        if ((kb_) >= kb0) { _Pragma("unroll") for (int d0 = 0; d0 < 4; ++d0) s[kb_] = __builtin_amdgcn_mfma_f32_32x32x16_bf16(src[d0], qr[d0], s[kb_], 0, 0, 0); } } while (0)
    ATT_KLOAD(kfa, 0); ATT_KLOAD(kfb, 1);
    __builtin_amdgcn_sched_barrier(0);
    ATT_QK(kfa, 0); ATT_KLOAD(kfa, 2);
    __builtin_amdgcn_sched_barrier(0);
    ATT_QK(kfb, 1); ATT_KLOAD(kfb, 3);
    __builtin_amdgcn_sched_barrier(0);
    ATT_QK(kfa, 2); ATT_KLOAD(kfa, 4);
    __builtin_amdgcn_sched_barrier(0);
    ATT_QK(kfb, 3);
    __builtin_amdgcn_sched_barrier(0);
    ATT_QK(kfa, 4);
#undef ATT_KLOAD
#undef ATT_QK
    __builtin_amdgcn_sched_barrier(0);
    v4u vpre[5][4];
#pragma unroll
    for (int kb = 0; kb < 3; ++kb)
#pragma unroll
        for (int i = 0; i < 4; ++i) {
            const int idx = i * 64 + lane, key = idx >> 3, ch = idx & 7;
            int kk = l0 - 128 + 32 * kb + key; kk = kk < 0 ? 0 : kk;
            vpre[kb][i] = *(const v4u*)(PROJ + (rowb + (size_t)kk * dil + r) * NIN + PC_V + h * 64 + ch * 8);
        }
    __builtin_amdgcn_sched_barrier(0);
    float mx = -INFINITY;
    int J0 = r32 - 4 * hi + 128, T0 = 128 - l0 - 4 * hi;
    asm volatile("" : "+v"(J0), "+v"(T0));
#pragma unroll
    for (int kb = 0; kb < 5; ++kb)
#pragma unroll
        for (int i = 0; i < 16; ++i) {
            const int cst = (i & 3) + 8 * (i >> 2) + 32 * kb, j = J0 - cst;
            const bool valid = ((unsigned)j <= 128u) && (cst >= T0) && (kb >= kb0);
            const int jc = j < 0 ? 0 : (j > 128 ? 128 : j);
            const float v = valid ? s[kb][i] + bt[jc] : -INFINITY;
            s[kb][i] = v; mx = fmaxf(mx, v);
        }
    mx = fmaxf(mx, __shfl_xor(mx, 32));
    float l = 0.f;
#pragma unroll
    for (int kb = 0; kb < 5; ++kb)
#pragma unroll
        for (int i = 0; i < 16; ++i) { const float p = __builtin_amdgcn_exp2f(s[kb][i] - mx); s[kb][i] = p; l += p; }
    l += __shfl_xor(l, 32);
    __builtin_amdgcn_sched_barrier(0);
#pragma unroll
    for (int kb = 3; kb < 5; ++kb)
#pragma unroll
        for (int i = 0; i < 4; ++i) {
            const int idx = i * 64 + lane, key = idx >> 3, ch = idx & 7;
            int kk = l0 - 128 + 32 * kb + key; kk = kk < 0 ? 0 : kk;
            vpre[kb][i] = *(const v4u*)(PROJ + (rowb + (size_t)kk * dil + r) * NIN + PC_V + h * 64 + ch * 8);
        }
    f32x16 o[2];
#pragma unroll
    for (int i = 0; i < 16; ++i) { o[0][i] = 0.f; o[1][i] = 0.f; }
    const LAS unsigned char* vrd = wl + ATT_VB + ((lane >> 4) & 1) * 32 + (lane & 3) * 8 + (4 * hi + ((lane & 15) >> 2)) * 64;
#pragma unroll
    for (int kb = 0; kb < 5; ++kb) {
        if (kb >= kb0) {
#pragma unroll
            for (int i = 0; i < 4; ++i) {
                const int idx = i * 64 + lane, key = idx >> 3, ch = idx & 7;
                *(LAS v4u*)(wl + ATT_VB + (ch >> 2) * 2048 + (key >> 4) * 1024 + (key & 15) * 64 + (ch & 3) * 16) = vpre[kb][i];
            }
            LDS_WAIT();
#pragma unroll
            for (int ks = 0; ks < 2; ++ks) {
                v4u pw;
                pw.x = cvtpk_s(s[kb][8 * ks + 0], s[kb][8 * ks + 1]); pw.y = cvtpk_s(s[kb][8 * ks + 2], s[kb][8 * ks + 3]);
                pw.z = cvtpk_s(s[kb][8 * ks + 4], s[kb][8 * ks + 5]); pw.w = cvtpk_s(s[kb][8 * ks + 6], s[kb][8 * ks + 7]);
                const bf16x8 pa = __builtin_bit_cast(bf16x8, pw);
#pragma unroll
                for (int d0 = 0; d0 < 2; ++d0) {
                    const v4i16_t lo = vtr(vrd + d0 * 2048 + ks * 1024), hh = vtr(vrd + d0 * 2048 + ks * 1024 + 512);
                    const bf16x8 vb = (bf16x8){lo[0], lo[1], lo[2], lo[3], hh[0], hh[1], hh[2], hh[3]};
                    o[d0] = __builtin_amdgcn_mfma_f32_32x32x16_bf16(pa, vb, o[d0], 0, 0, 0);
                }
            }
            LDS_WAIT();
        }
    }
    LAS float* wsf = (LAS float*)(wl + ATT_WSF);
    if (hi == 0) wsf[r32] = l;
    LDS_WAIT();
    LAS bf16* stg = (LAS bf16*)(wl + ATT_STG);
#pragma unroll
    for (int i = 0; i < 16; ++i) {
        const int orow = crow(i, hi); const float rl = 1.0f / wsf[orow];
        stg[orow * 64 + r32] = (bf16)f2bf(o[0][i] * rl); stg[orow * 64 + 32 + r32] = (bf16)f2bf(o[1][i] * rl);
    }
    LDS_WAIT();
    bf16* OBR = (bf16*)(a.ws + WS_OBR) + (size_t)br * MP * 512;
#pragma unroll
    for (int i = 0; i < 4; ++i) {
        const int row = i * 8 + (lane >> 3), ch = lane & 7;
        const v4u v = *(const LAS v4u*)(stg + row * 64 + ch * 8);
        *(v4u*)(OBR + (rowb + (size_t)(l0 + row) * dil + r) * 512 + h * 64 + ch * 8) = v;
    }
    if (hi == 0) { float* LSE = (float*)(a.ws + WS_LSE) + (size_t)br * MP * 8; LSE[(rowb + (size_t)(l0 + r32) * dil + r) * 8 + h] = mx + __builtin_amdgcn_logf(l); }
    LDS_WAIT();
}

__device__ __forceinline__ void attn_sample_task(const Args& a, LAS unsigned char* lds, int task, int wave, int lane) {
    const int h = task & 7, t = (task >> 3) & 7, b = task >> 6;
    const bf16* PROJ = (const bf16*)(a.ws + WS_PROJ);
    const float* ck = a.in[4]; const float* cv = a.in[5]; const float* kn = a.out + O_KS; const float* vn = a.out + O_VS;
    LAS float* pl = (LAS float*)(lds + wave * ATT_WAVE_BYTES + ATT_STG);
    const int ks = lane >> 4, dq = lane & 15;
    f32x4 q4;
    { const u32x2 w = *(const u32x2*)(PROJ + (size_t)(MP + b * 8 + t) * NIN + h * 64 + 4 * dq); q4 = (f32x4){bflo(w.x), bfhi(w.x), bflo(w.y), bfhi(w.y)}; }
    const size_t cbase = ((size_t)b * WBUF * 8 + h) * 64 + 4 * dq, nbase = ((size_t)b * 8 * 8 + h) * 64 + 4 * dq;
#pragma unroll 1
    for (int br = 0; br < 3; ++br) {
        const int dil = 1 << (2 * br);
        const LAS float* bt = (const LAS float*)(lds + ATT_BTAB_OFF) + (br * 8 + h) * ATT_BT_LD;
#pragma unroll 1
        for (int it0 = 0; it0 < 33; it0 += 11) {
            f32x4 kv[11];
#pragma unroll
            for (int u = 0; u < 11; ++u) { int j = 4 * (it0 + u) + ks; j = j > 128 ? 128 : j; const int idx = WBUF + t - j * dil;
                kv[u] = (idx < WBUF) ? *(const f32x4*)(ck + cbase + (size_t)idx * 512) : *(const f32x4*)(kn + nbase + (size_t)(idx - WBUF) * 512); }
#pragma unroll
            for (int u = 0; u < 11; ++u) { const int j = 4 * (it0 + u) + ks; float d = q4.x * kv[u].x + q4.y * kv[u].y + q4.z * kv[u].z + q4.w * kv[u].w; d = row16_sum(d);
                if (dq == 0 && j <= 128) pl[br * ATT_BT_LD + j] = d + bt[j]; }
        }
    }
    LDS_WAIT(); asm volatile("" ::: "memory");
    float mx = -INFINITY;
#pragma unroll 1
    for (int i = lane; i < 3 * ATT_BT_LD; i += 64) { const int j = i % ATT_BT_LD; if (j <= 128) mx = fmaxf(mx, pl[i]); }
    mx = wave_max(mx);
    float l = 0.f;
#pragma unroll 1
    for (int i = lane; i < 3 * ATT_BT_LD; i += 64) { const int j = i % ATT_BT_LD; if (j <= 128) { const float p = __builtin_amdgcn_exp2f(pl[i] - mx); pl[i] = p; l += p; } }
    l = wave_sum(l);
    LDS_WAIT(); asm volatile("" ::: "memory");
    f32x4 o4 = {0.f, 0.f, 0.f, 0.f};
#pragma unroll 1
    for (int br = 0; br < 3; ++br) {
        const int dil = 1 << (2 * br);
#pragma unroll 1
        for (int it0 = 0; it0 < 33; it0 += 11) {
            f32x4 vv[11]; float pp[11];
#pragma unroll
            for (int u = 0; u < 11; ++u) { const int j0 = 4 * (it0 + u) + ks, j = j0 > 128 ? 128 : j0; const int idx = WBUF + t - j * dil;
                vv[u] = (idx < WBUF) ? *(const f32x4*)(cv + cbase + (size_t)idx * 512) : *(const f32x4*)(vn + nbase + (size_t)(idx - WBUF) * 512);
                pp[u] = (j0 <= 128) ? pl[br * ATT_BT_LD + j] : 0.f; }
#pragma unroll
            for (int u = 0; u < 11; ++u) o4 += vv[u] * pp[u];
        }
    }
#pragma unroll
    for (int e = 0; e < 4; ++e) { o4[e] += __shfl_xor(o4[e], 16); o4[e] += __shfl_xor(o4[e], 32); }
    if (lane < 16) { const float il = 1.f / l; u32x2 w; w.x = pk2(o4.x * il, o4.y * il); w.y = pk2(o4.z * il, o4.w * il);
        *(u32x2*)((bf16*)(a.ws + WS_MIX) + (size_t)(MP + b * 8 + t) * DM + h * 64 + 4 * dq) = w; }
    LDS_WAIT(); asm volatile("" ::: "memory");
}

__device__ __forceinline__ void ssd_sample_task(const Args& a, int k, int lane) {
    const float* XB = (const float*)(a.ws + WS_XBS); const float* DT = (const float*)(a.ws + WS_DT); float* YS = (float*)(a.ws + WS_YS);
    const int p4 = k & 15, h = (k >> 4) & 7, b = k >> 7, g = h >> 2, p = 4 * p4 + (lane >> 4), ng = lane & 15;
    const size_t sidx = ((size_t)((b * 8 + h) * 64 + p)) * 128 + 8 * ng;
    float s[8]; load8f(a.in[6] + sidx, s);
    const float A = -__expf(a.in[15][h]);
#pragma unroll 1
    for (int t0 = 0; t0 < TS; t0 += 4) {
        float dtv[4], xv[4], Bv[4][8], Cv[4][8];
#pragma unroll
        for (int q = 0; q < 4; ++q) { const int r = b * TS + t0 + q; dtv[q] = DT[(size_t)(MP + r) * 8 + h]; const float* xr = XB + (size_t)r * 1024; xv[q] = xr[h * 64 + p]; load8f(xr + 512 + g * 128 + 8 * ng, Bv[q]); load8f(xr + 768 + g * 128 + 8 * ng, Cv[q]); }
#pragma unroll
        for (int q = 0; q < 4; ++q) {
            const float da = __expf(dtv[q] * A), xd = dtv[q] * xv[q]; float y = 0.f;
#pragma unroll
            for (int e = 0; e < 8; ++e) { s[e] = da * s[e] + xd * Bv[q][e]; y += Cv[q][e] * s[e]; }
            y = row16_sum(y);
            if (ng == 0) YS[(size_t)(MP + b * TS + t0 + q) * 512 + h * 64 + p] = y;
        }
    }
    float* so = a.out + O_SS + sidx;
    *(f32x4*)so = (f32x4){s[0], s[1], s[2], s[3]}; *(f32x4*)(so + 4) = (f32x4){s[4], s[5], s[6], s[7]};
}
__device__ __forceinline__ void attn_combine_pass(const Args& a, int gtid, int NT) {
    const bf16* OBR = (const bf16*)(a.ws + WS_OBR); const float* LSE = (const float*)(a.ws + WS_LSE); bf16* MIX = (bf16*)(a.ws + WS_MIX);
    for (int it = gtid; it < MP * 64; it += NT) {
        const int row = it >> 6, c8 = it & 63, h = c8 >> 3;
        const float l0 = LSE[(size_t)row * 8 + h], l1 = LSE[(size_t)(MP + row) * 8 + h], l2 = LSE[(size_t)(2 * MP + row) * 8 + h];
        const float mx = fmaxf(l0, fmaxf(l1, l2));
        float w0 = __builtin_amdgcn_exp2f(l0 - mx), w1 = __builtin_amdgcn_exp2f(l1 - mx), w2 = __builtin_amdgcn_exp2f(l2 - mx);
        const float inv = 1.f / (w0 + w1 + w2); w0 *= inv; w1 *= inv; w2 *= inv;
        float o0[8], o1[8], o2[8];
        load8bf(OBR + (size_t)row * 512 + c8 * 8, o0); load8bf(OBR + ((size_t)MP + row) * 512 + c8 * 8, o1); load8bf(OBR + ((size_t)2 * MP + row) * 512 + c8 * 8, o2);
        float r[8];
#pragma unroll
        for (int k = 0; k < 8; ++k) r[k] = w0 * o0[k] + w1 * o1[k] + w2 * o2[k];
        v4u w; w.x = pk2(r[0], r[1]); w.y = pk2(r[2], r[3]); w.z = pk2(r[4], r[5]); w.w = pk2(r[6], r[7]);
        *(v4u*)(MIX + (size_t)row * DM + c8 * 8) = w;
    }
}
__device__ __forceinline__ void ssd_finish_pass(const Args& a, int gw, int NGW, int lane) {
    const bf16* XC = (const bf16*)(a.ws + WS_XC); const float* YS = (const float*)(a.ws + WS_YS); const bf16* PROJ = (const bf16*)(a.ws + WS_PROJ); bf16* MIX = (bf16*)(a.ws + WS_MIX);
    const float* dsk = a.in[16]; const float* gs = a.in[17];
    const int c = lane * 8; const float dh = dsk[c >> 6];
    float g8[8]; load8f(gs + c, g8);
    for (int m = gw; m < MT; m += NGW) {
        float y[8], x[8], z[8], v[8]; load8f(YS + (size_t)m * 512 + c, y); load8bf(XC + (size_t)m * 512 + c, x); load8bf(PROJ + (size_t)m * NIN + PC_Z + c, z);
        float ss = 0.f;
#pragma unroll
        for (int k = 0; k < 8; ++k) { v[k] = (y[k] + dh * x[k]) * siluf(z[k]); ss += v[k] * v[k]; }
#pragma unroll
        for (int o = 1; o < 32; o <<= 1) ss += __shfl_xor(ss, o);
        const float rs = 1.0f / sqrtf(ss * (1.f / 256.f) + EPS);
        v4u w; w.x = pk2(v[0] * rs * g8[0], v[1] * rs * g8[1]); w.y = pk2(v[2] * rs * g8[2], v[3] * rs * g8[3]); w.z = pk2(v[4] * rs * g8[4], v[5] * rs * g8[5]); w.w = pk2(v[6] * rs * g8[6], v[7] * rs * g8[7]);
        *(v4u*)(MIX + (size_t)m * DM + 512 + c) = w;
    }
}
__device__ __forceinline__ void ffn_fixup_pass(const Args& a, int gtid, int NT) {
    const float* UH = (const float*)(a.ws + WS_UH); const float* US = (const float*)(a.ws + WS_US); bf16* ACT = (bf16*)(a.ws + WS_ACT);
    const float* fw = a.in[21]; const float* fb = a.in[22]; const float* sf = a.in[8];
    constexpr int NC8 = DFF / 8, NPT = MP / 256, NITEMS = (NPT + NBS) * NC8;
    for (int it = gtid; it < NITEMS; it += NT) {
        const int blk = it / NC8, c = (it % NC8) * 8;
        float wa0[8], wa1[8], wa2[8], wb0[8], wb1[8], wb2[8], ba[8], bb[8], a2[8], a1[8], b2[8], b1[8];
        load8f(fw + c, wa0); load8f(fw + DFF2 + c, wa1); load8f(fw + 2 * DFF2 + c, wa2); load8f(fb + c, ba);
        load8f(fw + DFF + c, wb0); load8f(fw + DFF2 + DFF + c, wb1); load8f(fw + 2 * DFF2 + DFF + c, wb2); load8f(fb + DFF + c, bb);
        const float* src; int m0, nr;
        if (blk < NPT) { m0 = blk * 256; nr = 2; src = UH + (size_t)(blk * 4) * DFF2;
            if ((blk & 15) == 0) {
#pragma unroll
                for (int k = 0; k < 8; ++k) { a2[k] = 0.f; a1[k] = 0.f; b2[k] = 0.f; b1[k] = 0.f; }
            } else { const float* pv = UH + (size_t)((blk - 1) * 4 + 2) * DFF2; load8f(pv + c, a2); load8f(pv + DFF2 + c, a1); load8f(pv + DFF + c, b2); load8f(pv + DFF2 + DFF + c, b1); }
        } else { const int b = blk - NPT; m0 = MP + b * 8; nr = 8; src = US + (size_t)(b * 8) * DFF2;
            load8f(sf + (size_t)(b * 2) * DFF2 + c, a2); load8f(sf + (size_t)(b * 2 + 1) * DFF2 + c, a1); load8f(sf + (size_t)(b * 2) * DFF2 + DFF + c, b2); load8f(sf + (size_t)(b * 2 + 1) * DFF2 + DFF + c, b1); }
        for (int r = 0; r < nr; ++r) {
            float ua[8], ub[8], o[8]; load8f(src + (size_t)r * DFF2 + c, ua); load8f(src + (size_t)r * DFF2 + DFF + c, ub);
#pragma unroll
            for (int k = 0; k < 8; ++k) {
                const float ya = ba[k] + wa0[k] * a2[k] + wa1[k] * a1[k] + wa2[k] * ua[k], yb = bb[k] + wb0[k] * b2[k] + wb1[k] * b1[k] + wb2[k] * ub[k];
                o[k] = siluf(ya) * yb; a2[k] = a1[k]; a1[k] = ua[k]; b2[k] = b1[k]; b1[k] = ub[k];
            }
            v4u w; w.x = pk2(o[0], o[1]); w.y = pk2(o[2], o[3]); w.z = pk2(o[4], o[5]); w.w = pk2(o[6], o[7]);
            *(v4u*)(ACT + (size_t)(m0 + r) * DFF + c) = w;
        }
    }
}
__device__ __forceinline__ void final_norm_pass(const Args& a, int gw, int NGW, int lane) {
    const float* RS3 = (const float*)(a.ws + WS_RS3); const float* gf = a.in[27]; const bf16* H3b = (const bf16*)(a.ws + WS_MIX);
    float g[16];
    load8f(gf + lane * 16, *(float(*)[8])&g[0]); load8f(gf + lane * 16 + 8, *(float(*)[8])&g[8]);
    for (int m = gw; m < MT; m += NGW) {
        float* orow = (m < MP) ? a.out + O_Y + (size_t)m * DM : a.out + O_YS + (size_t)(m - MP) * DM;
        const float rs = 1.0f / sqrtf(RS3[m] * (1.f / DM) + EPS);
        float h[16]; load8bf(H3b + (size_t)m * DM + lane * 16, *(float(*)[8])&h[0]); load8bf(H3b + (size_t)m * DM + lane * 16 + 8, *(float(*)[8])&h[8]);
#pragma unroll
        for (int j = 0; j < 4; ++j) *(f32x4*)(orow + lane * 16 + 4 * j) = (f32x4){h[4 * j] * rs * g[4 * j], h[4 * j + 1] * rs * g[4 * j + 1], h[4 * j + 2] * rs * g[4 * j + 2], h[4 * j + 3] * rs * g[4 * j + 3]};
    }
}

typedef float f32x4m __attribute__((ext_vector_type(4)));
template <class Epi>
__device__ __forceinline__ void skinny_gemm(LAS unsigned char* lds, const bf16* A, const bf16* Wt, int N, int K, const Epi& E, int vcu, int G, int tid, int wave, int lane) {
    const int npieces = (MS / 16) * (N / 64), kslice = K / 8, nsteps = kslice / 32;
    const int r16 = lane & 15, kg = lane >> 4;
    for (int piece = vcu; piece < npieces; piece += G) {
        const int mb = piece & 15, nb = piece >> 4, m0 = mb * 16, n0 = nb * 64;
        const bf16* ap = A + (size_t)(m0 + r16) * K + wave * kslice + 8 * kg;
        const bf16* wp = Wt + (size_t)(n0 + r16) * K + wave * kslice + 8 * kg;
        f32x4m acc[4];
#pragma unroll
        for (int j = 0; j < 4; ++j) acc[j] = (f32x4m){0.f, 0.f, 0.f, 0.f};
        for (int s0 = 0; s0 < nsteps; s0 += 4) {
            bf16x8 af[4], wf[4][4];
#pragma unroll
            for (int u = 0; u < 4; ++u) if (s0 + u < nsteps) {
                af[u] = *(const bf16x8*)(ap + (s0 + u) * 32);
#pragma unroll
                for (int j = 0; j < 4; ++j) wf[u][j] = *(const bf16x8*)(wp + (size_t)(16 * j) * K + (s0 + u) * 32);
            }
#pragma unroll
            for (int u = 0; u < 4; ++u) if (s0 + u < nsteps) {
#pragma unroll
                for (int j = 0; j < 4; ++j) acc[j] = __builtin_amdgcn_mfma_f32_16x16x32_bf16(wf[u][j], af[u], acc[j], 0, 0, 0);
            }
        }
#pragma unroll
        for (int j = 0; j < 4; ++j) *(LAS f32x4m*)(lds + ((wave * 4 + j) * 64 + lane) * 16) = acc[j];
        LDS_WAIT(); __syncthreads();
        if (tid < 256) {
            const int j = tid >> 6, l2 = tid & 63;
            f32x4m v = *(const LAS f32x4m*)(lds + (j * 64 + l2) * 16);
#pragma unroll
            for (int w = 1; w < 8; ++w) v += *(const LAS f32x4m*)(lds + ((w * 4 + j) * 64 + l2) * 16);
            E.apply(m0 + (l2 & 15), n0 + 16 * j + 4 * (l2 >> 4), v);
        }
        LDS_WAIT(); __syncthreads();
    }
}
struct SEpiIn { bf16* PROJ; float* out;
    __device__ __forceinline__ void apply(int r, int c, f32x4m v) const {
        const float sc = (c < PC_K) ? C2 : 1.f; u32x2 w; w.x = pk2(v.x * sc, v.y * sc); w.y = pk2(v.z * sc, v.w * sc);
        *(u32x2*)(PROJ + (size_t)(MP + r) * NIN + c) = w;
        if (c >= PC_K && c < PC_Z) { const bool isk = c < PC_V; *(f32x4m*)(out + (isk ? O_KS : O_VS) + (size_t)r * 512 + (c - (isk ? PC_K : PC_V))) = v; }
        else if (c >= PC_X) { const int t = r & 7, b = r >> 3; if (t >= TS - 3) *(f32x4m*)(out + O_CS + (size_t)(b * 3 + t - (TS - 3)) * 1024 + (c - PC_X)) = v; }
    } };
struct SEpiOut { const float* xs; bf16* H1b; float* RS;
    __device__ __forceinline__ void apply(int r, int c, f32x4m v) const {
        const f32x4m h = *(const f32x4m*)(xs + (size_t)r * DM + c) + v; const size_t o = (size_t)(MP + r) * DM + c;
        u32x2 w; w.x = pk2(h.x, h.y); w.y = pk2(h.z, h.w); *(u32x2*)(H1b + o) = w;
        atomicAdd(RS + MP + r, (h.x * h.x + h.y * h.y) + (h.z * h.z + h.w * h.w));
    } };
struct SEpiPle { bf16* E; float* RS;
    __device__ __forceinline__ void apply(int r, int c, f32x4m v) const {
        u32x2 w; w.x = pk2(v.x, v.y); w.y = pk2(v.z, v.w); *(u32x2*)(E + (size_t)(MP + r) * DM + c) = w; atomicAdd(RS + MP + r, (v.x * v.x + v.y * v.y) + (v.z * v.z + v.w * v.w));
    } };
struct SEpiDown { bf16* Hb;
    __device__ __forceinline__ void apply(int r, int c, f32x4m v) const {
        u32x2* hp = (u32x2*)(Hb + (size_t)(MP + r) * DM + c); const u32x2 o = *hp;
        u32x2 w; w.x = pk2(bflo(o.x) + v.x, bfhi(o.x) + v.y); w.y = pk2(bflo(o.y) + v.z, bfhi(o.y) + v.w); *hp = w;
    } };
struct SEpiGate { const bf16* H2b; const bf16* E; const float* RSE; const float* gple; bf16* H3b; float* RS3;
    __device__ __forceinline__ void apply(int r, int c, f32x4m v) const {
        const size_t o = (size_t)(MP + r) * DM + c; const float rse = 1.0f / sqrtf(RSE[MP + r] * (1.f / DM) + EPS);
        const u32x2 eb = *(const u32x2*)(E + o), hb = *(const u32x2*)(H2b + o); const f32x4m gp = *(const f32x4m*)(gple + c);
        const float e4[4] = {bflo(eb.x), bfhi(eb.x), bflo(eb.y), bfhi(eb.y)}, h4[4] = {bflo(hb.x), bfhi(hb.x), bflo(hb.y), bfhi(hb.y)}; float h[4];
#pragma unroll
        for (int k = 0; k < 4; ++k) { const float g = 1.f / (1.f + __expf(-v[k])); h[k] = h4[k] + g * (e4[k] * rse * gp[k]); }
        u32x2 w; w.x = pk2(h[0], h[1]); w.y = pk2(h[2], h[3]); *(u32x2*)(H3b + o) = w;
        atomicAdd(RS3 + MP + r, (h[0] * h[0] + h[1] * h[1]) + (h[2] * h[2] + h[3] * h[3]));
    } };

struct SubsetOrder {
    int nN, nwg, nsub, cl;
    __device__ void init(int M, int N, int G_, int c_, int c0) { nN = N / 256; nwg = (M / 256) * nN; nsub = G_ - c0; cl = c_ - c0; }
    __device__ bool next(int i, pg8::Unit& u) const { if (cl < 0) return false; const int L = i * nsub + cl; if (L >= nwg) return false; u.pm = L / nN; u.pn = L % nN; return true; }
    __device__ __forceinline__ void a_ready(const pg8::Unit&) const {}
    __device__ __forceinline__ void done(const pg8::Unit&) const {}
};
constexpr int NPH = 12;
#ifndef DUP
#define DUP -1
#endif
#define REP(k) for (int rep_ = 0; rep_ < ((DUP) == (k) ? args.pad : 1); ++rep_)
#ifndef MK_N_LAUNCHES
#define MK_N_LAUNCHES 1
#endif
constexpr int N_LAUNCHES = MK_N_LAUNCHES;
__global__ void __launch_bounds__(NWAVES * 64, 2) mk_fwd(Args args) {
    extern __shared__ __attribute__((aligned(16))) unsigned char lds_raw[];
    LAS unsigned char* lds = (LAS unsigned char*)lds_raw;
    volatile LAS unsigned* MISC = (volatile LAS unsigned*)(lds + MISC_OFF);
    const int tid = threadIdx.x, lane = tid & 63, wave = __builtin_amdgcn_readfirstlane(tid >> 6);
    const int G = gridDim.x, bx = blockIdx.x, vcu = (G % 8 == 0) ? (bx % 8) * (G / 8) + bx / 8 : bx;
    const int gw = vcu * NWAVES + wave, NGW = G * NWAVES, gtid = vcu * (NWAVES * 64) + tid, NT = G * NWAVES * 64;
    unsigned char* ws = args.ws;
    gu32* ctl = (gu32*)(ws + WS_CTL);
    for (int u = tid; u < (LDS_BYTES - LDSCTL_OFF) / 4; u += NWAVES * 64) ((LAS unsigned*)(lds + LDSCTL_OFF))[u] = 0u;
    __syncthreads();
    XcdBarrier bar; bar.bar = (unsigned*)(ctl + CW_BAR); bar.x = 0; bar.st = nullptr;
    if (N_LAUNCHES == 1) bar = xcd_barrier_post((unsigned*)(ctl + CW_BAR), MISC + 8);
    const int lo = args.ph_lo, hi = args.ph_hi;
#ifndef PHMASK
#define PHMASK 0xfff
#endif
#define IN(k) (((PHMASK >> (k)) & 1) && lo <= (k) && (k) < hi)
#define SEAM(k) do { if (IN(k) && IN((k) + 1)) xcd_barrier(bar); } while (0)

    if (IN(0)) { REP(0) { p0_prologue(args, lds, gw, NGW, wave, lane); VM_WAIT(); __syncthreads(); }
        if ((DUP) == 100) { p0_prologue(args, lds, gw, NGW, wave, lane, args.pad - 1); VM_WAIT(); __syncthreads(); }
        if ((DUP) == 101) { p0_prologue(args, lds, gw, NGW, wave, lane, args.pad); VM_WAIT(); __syncthreads(); } }
    SEAM(0);
    if (IN(1)) {
        pg8::Gemm g{(const pg8::bf16_t*)(ws + WS_XN), (const pg8::bf16_t*)(ws + WS_WIN), MP, NIN, DM}; pg8::StaticOrder S; S.init(MP, NIN, G, bx);
        EpiIn E{(pg8::bf16_t*)(ws + WS_PROJ), args.out};
        pg8::gemm_phase<EpiIn, pg8::StaticOrder, PG8_ALIGN, PG8_SP2>(lds, g, S, E);
        if ((DUP) == 1) pg8::gemm_phase<EpiIn, pg8::StaticOrder, PG8_ALIGN, PG8_SP2>(lds, g, S, E);
        { SEpiIn SE{(bf16*)(ws + WS_PROJ), args.out}; skinny_gemm(lds, (const bf16*)(ws + WS_XN) + (size_t)MP * DM, (const bf16*)(ws + WS_WIN), NIN, DM, SE, vcu, G, tid, wave, lane); }
    }
    SEAM(1);
    if (IN(2)) {
        attn_build_btab(args, lds, tid);
        conv_sample_pass(args, gtid, NT);
        __syncthreads();
#ifndef P2SUB
#define P2SUB 7
#endif
        REP(20) if (P2SUB & 1) for (int task = gw; task < NBS * TS * NH; task += NGW) attn_sample_task(args, lds, task, wave, lane);
        __syncthreads();
        REP(21) if (P2SUB & 2) for (int unit = gw; unit < NBP * NH * 3 * 128; unit += NGW) attn_prompt_unit(args, lds, unit, wave, lane);
        __syncthreads();
        REP(22) if (P2SUB & 4) for (int unit = vcu; unit < NBP * 32 * 2; unit += G) ssd_s1g_unit(args, lds, unit, tid, wave, lane);
        VM_WAIT(); __syncthreads();
    }
    SEAM(2);
    if (IN(3)) {
        REP(30) ssd_s2_pass(args, gtid, NT);
        REP(31) for (int task = gw; task < NBS * 8 * 16; task += NGW) ssd_sample_task(args, task, lane);
        REP(32) attn_combine_pass(args, gtid, NT);
        VM_WAIT(); __syncthreads();
    }
    SEAM(3);
    if ((DUP) == 99) { for (int q_ = 0; q_ < 5 * args.pad; ++q_) xcd_barrier(bar); }
    if (IN(4)) {
        REP(4) for (int unit = vcu; unit < NBP * 32 * 8; unit += G) ssd_s3_unit(args, unit, wave, lane, rep_ == 0 ? 1.f : 0.f);
        VM_WAIT(); __syncthreads();
    }
    SEAM(4);
    if (IN(5)) { REP(5) { ssd_finish_pass(args, gw, NGW, lane); VM_WAIT(); __syncthreads(); } }
    SEAM(5);
    if (IN(6)) {
        { pg8::Gemm g{(const pg8::bf16_t*)(ws + WS_MIX), (const pg8::bf16_t*)(ws + WS_WOUT), MP, DM, DM}; pg8::StaticOrder S; S.init(MP, DM, G, bx);
          REP(60) { EpiOut E{args.in[0], (pg8::bf16_t*)(ws + WS_XN), rep_ == 0 ? (float*)(ws + WS_RS1) : (float*)(ws + WS_H1)};
#ifndef NO_GOUT
          pg8::gemm_phase<EpiOut, pg8::StaticOrder, PG8_ALIGN, PG8_SP2>(lds, g, S, E);
#endif
        } }
#ifndef NOSK
        { SEpiOut SE{args.in[1], (bf16*)(ws + WS_XN), (float*)(ws + WS_RS1)}; skinny_gemm(lds, (const bf16*)(ws + WS_MIX) + (size_t)MP * DM, (const bf16*)(ws + WS_WOUT), DM, DM, SE, vcu, G, tid, wave, lane); }
#endif
        { SEpiPle SE{(bf16*)(ws + WS_E), (float*)(ws + WS_RSE)}; skinny_gemm(lds, (const bf16*)(ws + WS_PB) + (size_t)MP * DPLE, (const bf16*)(ws + WS_WPLE), DM, DPLE, SE, vcu, G, tid, wave, lane); }
    }
    SEAM(6);
    if (IN(7)) {
        pg8::Gemm g{(const pg8::bf16_t*)(ws + WS_XN), (const pg8::bf16_t*)(ws + WS_WUP), MT, DFF2, DM}; pg8::StaticOrder S; S.init(MT, DFF2, G, bx);
        EpiUp E{(pg8::bf16_t*)(ws + WS_ACT), (const float*)(ws + WS_RS1), args.out, (float*)(ws + WS_UH), (float*)(ws + WS_US), args.in[21], args.in[22], lds};
        REP(7) pg8::gemm_phase<EpiUp, pg8::StaticOrder, PG8_ALIGN, PG8_SP2>(lds, g, S, E);
        { int kple = DPLE; asm volatile("" : "+s"(kple));
          const int nup = (MT / 256) * (DFF2 / 256), c0 = (nup % G) ? (nup % G) : G;
          pg8::Gemm g{(const pg8::bf16_t*)(ws + WS_PB), (const pg8::bf16_t*)(ws + WS_WPLE), MP, DM, kple}; SubsetOrder S; S.init(MP, DM, G, bx, c0 < G ? c0 : 0);
          EpiPle E{(pg8::bf16_t*)(ws + WS_E), (float*)(ws + WS_RSE)};
          pg8::gemm_phase<EpiPle, SubsetOrder, PG8_ALIGN, PG8_SP2>(lds, g, S, E); }
    }
    SEAM(7);
    if (IN(8)) { REP(8) { ffn_fixup_pass(args, gtid, NT); VM_WAIT(); __syncthreads(); } }
    SEAM(8);
    if (IN(9)) {
        pg8::Gemm g{(const pg8::bf16_t*)(ws + WS_ACT), (const pg8::bf16_t*)(ws + WS_WDOWN), MP, DM, DFF}; pg8::StaticOrder S; S.init(MP, DM, G, bx);
        { EpiDown E{(pg8::bf16_t*)(ws + WS_XN), 1.f};
        pg8::gemm_phase<EpiDown, pg8::StaticOrder, PG8_ALIGN, PG8_SP2>(lds, g, S, E); }
        if ((DUP) == 9) { EpiDown E{(pg8::bf16_t*)(ws + WS_XN), 0.f};
        pg8::gemm_phase<EpiDown, pg8::StaticOrder, PG8_ALIGN, PG8_SP2>(lds, g, S, E); }
        { SEpiDown SE{(bf16*)(ws + WS_XN)}; skinny_gemm(lds, (const bf16*)(ws + WS_ACT) + (size_t)MP * DFF, (const bf16*)(ws + WS_WDOWN), DM, DFF, SE, vcu, G, tid, wave, lane); }
    }
    SEAM(9);
    if (IN(10)) {
        pg8::Gemm g{(const pg8::bf16_t*)(ws + WS_XN), (const pg8::bf16_t*)(ws + WS_WGATE), MP, DM, DM}; pg8::StaticOrder S; S.init(MP, DM, G, bx);
        REP(10) { EpiGate E{(const pg8::bf16_t*)(ws + WS_XN), (const pg8::bf16_t*)(ws + WS_E), (const float*)(ws + WS_RSE), args.in[25], (pg8::bf16_t*)(ws + WS_MIX), rep_ == 0 ? (float*)(ws + WS_RS3) : (float*)(ws + WS_H1)};
        pg8::gemm_phase<EpiGate, pg8::StaticOrder, PG8_ALIGN, PG8_SP2>(lds, g, S, E); }
        { SEpiGate SE{(const bf16*)(ws + WS_XN), (const bf16*)(ws + WS_E), (const float*)(ws + WS_RSE), args.in[25], (bf16*)(ws + WS_MIX), (float*)(ws + WS_RS3)}; skinny_gemm(lds, (const bf16*)(ws + WS_XN) + (size_t)MP * DM, (const bf16*)(ws + WS_WGATE), DM, DM, SE, vcu, G, tid, wave, lane); }
    }
    SEAM(10);
    if (IN(11)) { REP(11) final_norm_pass(args, gw, NGW, lane); }
#undef IN
#undef SEAM
}

extern "C" void kernel_launch(void* const* d_in, const int* in_sizes, int n_in, void* d_out, int out_size, void* d_ws, size_t ws_size, hipStream_t stream) {
    static int grid = 0;
    if (grid == 0) {
        if (n_in != 28 || out_size != (int)O_END || ws_size < WS_END) { fprintf(stderr, "kernel_launch: unexpected shapes: n_in %d out %d ws %zu\n", n_in, out_size, ws_size); grid = -1; return; }
        int dev = 0, cus = 0, per_cu = 0;
        if (hipGetDevice(&dev) != hipSuccess || hipDeviceGetAttribute(&cus, hipDeviceAttributeMultiprocessorCount, dev) != hipSuccess) { grid = -1; return; }
        if (hipFuncSetAttribute((const void*)mk_fwd, hipFuncAttributeMaxDynamicSharedMemorySize, LDS_BYTES) != hipSuccess) { fprintf(stderr, "kernel_launch: hipFuncSetAttribute failed\n"); grid = -1; return; }
        if (hipOccupancyMaxActiveBlocksPerMultiprocessor(&per_cu, (const void*)mk_fwd, NWAVES * 64, LDS_BYTES) != hipSuccess || per_cu < 1) fprintf(stderr, "kernel_launch: occupancy query says %d\n", per_cu);
        (void)hipGetLastError();
        grid = cus;
    }
    if (grid < 0) return;
    if (hipMemsetAsync((char*)d_ws + WS_CTL, 0, CTL_ZERO_BYTES, stream) != hipSuccess) { fprintf(stderr, "kernel_launch: memset failed\n"); return; }
    Args a{};
    for (int i = 0; i < 28; ++i) a.in[i] = (const float*)d_in[i];
    a.out = (float*)d_out; a.ws = (unsigned char*)d_ws; a.pad = 2;
    for (int li = 0; li < N_LAUNCHES; ++li) {
        if (N_LAUNCHES == 1) { a.ph_lo = 0; a.ph_hi = NPH; } else { a.ph_lo = li; a.ph_hi = li + 1; }
        a.li = li;
        hipLaunchKernelGGL(mk_fwd, dim3(grid), dim3(NWAVES * 64), LDS_BYTES, stream, a);
        const hipError_t le = hipPeekAtLastError();
        if (le != hipSuccess) { fprintf(stderr, "kernel_launch: launch %d failed: %s\n", li, hipGetErrorName(le)); break; }
    }
}
```

```cpp
#include <hip/hip_runtime.h>
#include <cstdio>
#include <cstdint>
namespace pg8 {
#define PG8_LAS __attribute__((address_space(3)))
typedef unsigned short bf16_t;
typedef short bf16x8 __attribute__((ext_vector_type(8)));
typedef float f32x4 __attribute__((ext_vector_type(4)));
typedef unsigned u32x4 __attribute__((ext_vector_type(4)));
constexpr int BM = 256, BK = 64, HALF = 128, HTB = HALF * BK * 2  , STAGE_BYTES = 8 * HTB, NXCD = 8, WGM = 8;

__host__ __device__ __forceinline__ int lds_byte(int r, int c) { const int st = (r >> 4) * 2 + (c >> 5), rr = r & 15, cc = c & 31, ob = rr * 64 + cc * 2; return st * 1024 + (ob ^ (((ob >> 9) & 1) << 5)); }
__host__ __device__ __forceinline__ void stage_rc(int b, int& R, int& C) { const int st = b / 1024, sb = b % 1024, swz = sb ^ (((sb >> 9) & 1) << 5); R = (st >> 1) * 16 + swz / 64; C = (st & 1) * 32 + (swz % 64) / 2; }
__host__ __device__ __forceinline__ int perm32(int rho) { const int n = rho >> 4, i = rho & 15; return 8 * (i >> 2) + 4 * n + (i & 3); }

struct Unit { int pm, pn; };
struct Gemm { const bf16_t* A; const bf16_t* Bt; int M, N, K; };

struct StaticOrder {
    int nM, nN, nwg, G, c;
    __host__ __device__ void init(int M, int N, int G_, int c_) { nM = M / BM; nN = N / BM; nwg = nM * nN; G = G_; c = c_; }
    __host__ __device__ bool next(int i, Unit& u) const {
        const long L = (long)i * G + c; if (L >= nwg) return false;
        int wgid = (int)L; { const int q = nwg / NXCD, r = nwg % NXCD, xcd = wgid % NXCD, off = wgid / NXCD; wgid = (xcd < r ? xcd * (q + 1) : r * (q + 1) + (xcd - r) * q) + off; }
        const int nig = WGM * nN, gid = wgid / nig, fm = gid * WGM, gsz = (nM - fm) < WGM ? (nM - fm) : WGM;
        u.pm = fm + ((wgid % nig) % gsz); u.pn = (wgid % nig) / gsz; return true;
    }
    __device__ __forceinline__ void a_ready(const Unit&) const {}
    __device__ __forceinline__ void done(const Unit&) const {}
};

__device__ __forceinline__ unsigned cvt_pk_bf16(float lo, float hi) { unsigned r; asm volatile("v_cvt_pk_bf16_f32 %0, %1, %2" : "=v"(r) : "v"(lo), "v"(hi)); return r; }
typedef float f32x2 __attribute__((ext_vector_type(2)));
template <class Epi, class Sched, bool ALIGN_EPI = false, bool SP2 = false>
__device__ __forceinline__ void gemm_phase(PG8_LAS unsigned char* lds, const Gemm g, const Sched& S, const Epi& E) {
    const int tid = threadIdx.x, wid = __builtin_amdgcn_readfirstlane(tid >> 6), lane = tid & 63, wr = wid >> 2, wc = wid & 3, fr = lane & 15, fq = lane >> 4;
    const int K = g.K, nt = K / BK;
    unsigned voffA[2], voffB[2];
#pragma unroll
    for (int i = 0; i < 2; ++i) { int R, C; stage_rc(tid * 16 + i * 8192, R, C); const int Rb = Epi::PERM ? ((R & ~31) + perm32(R & 31)) : R;
        voffA[i] = (unsigned)(R * K + C) * 2u; voffB[i] = (unsigned)(Rb * K + C) * 2u; }
    const size_t kstep = (size_t)(BK * 2);
    const size_t hstep = (size_t)HALF * K * 2;
    const size_t tstep = 2 * hstep;
    const unsigned ldsw = (unsigned)wid * 1024u;
    const int aoff = lds_byte(wr * 64 + fr, fq * 8), boff = lds_byte(wc * 32 + fr, fq * 8);
#define PG8_SA(b, h) (((b) * 2 + (h)) * HTB)
#define PG8_SB(b, h) ((4 + (b) * 2 + (h)) * HTB)
#define PG8_STAGE(bufoff, gbase, voff) do { _Pragma("unroll") for (int _i = 0; _i < 2; ++_i) \
        __builtin_amdgcn_global_load_lds((const unsigned*)((const char*)(gbase) + (voff)[_i]), (PG8_LAS unsigned*)(lds + (bufoff) + ldsw + _i * 8192), 16, 0, 0); } while (0)
#define PG8_LDA(dst, b, h) do { _Pragma("unroll") for (int m = 0; m < 4; ++m) _Pragma("unroll") for (int k = 0; k < 2; ++k) dst[m][k] = *(const PG8_LAS bf16x8*)(lds + PG8_SA(b, h) + aoff + m * 2048 + k * 1024); } while (0)
#define PG8_LDB(dst, b, h) do { _Pragma("unroll") for (int n = 0; n < 2; ++n) _Pragma("unroll") for (int k = 0; k < 2; ++k) dst[n][k] = *(const PG8_LAS bf16x8*)(lds + PG8_SB(b, h) + boff + n * 2048 + k * 1024); } while (0)
#define PG8_MMA(ai, bj, At, Bt) do { __builtin_amdgcn_s_setprio(1); _Pragma("unroll") for (int m = 0; m < 4; ++m) _Pragma("unroll") for (int n = 0; n < 2; ++n) _Pragma("unroll") for (int k = 0; k < 2; ++k) \
        acc[ai][bj][m][n] = __builtin_amdgcn_mfma_f32_16x16x32_bf16(Bt[n][k], At[m][k], acc[ai][bj][m][n], 0, 0, 0); __builtin_amdgcn_s_setprio(0); } while (0)
#define PG8_WAIT_V(n) asm volatile("s_waitcnt vmcnt(" #n ")" ::: "memory")
#define PG8_WAIT_L(n) asm volatile("s_waitcnt lgkmcnt(" #n ")" ::: "memory")
#define PG8_BAR __builtin_amdgcn_s_barrier()
#define PG8_SCHED __builtin_amdgcn_sched_barrier(0)
    Unit cur, nxt; int ui = 0;
    if (!S.next(0, cur)) return;
    f32x4 acc[2][2][4][2];
#pragma unroll
    for (int a = 0; a < 2; ++a)
#pragma unroll
        for (int b = 0; b < 2; ++b)
#pragma unroll
            for (int m = 0; m < 4; ++m)
#pragma unroll
                for (int n = 0; n < 2; ++n) acc[a][b][m][n] = (f32x4){0.f, 0.f, 0.f, 0.f};
    bf16x8 At[4][2], B0[2][2], B1[2][2];
    const char* cA = (const char*)g.A + (size_t)cur.pm * tstep; const char* cB = (const char*)g.Bt + (size_t)cur.pn * tstep;
    S.a_ready(cur);
    if constexpr (SP2) {
        PG8_STAGE(PG8_SB(0, 0), cB, voffB); PG8_STAGE(PG8_SB(0, 1), cB + hstep, voffB); PG8_STAGE(PG8_SA(0, 0), cA, voffA); PG8_STAGE(PG8_SA(0, 1), cA + hstep, voffA);
        if (wr == 1) PG8_BAR;
        PG8_WAIT_V(2); PG8_BAR;
        PG8_STAGE(PG8_SB(1, 0), cB + kstep, voffB); PG8_STAGE(PG8_SA(1, 0), cA + kstep, voffA); PG8_STAGE(PG8_SB(1, 1), cB + hstep + kstep, voffB);
        PG8_WAIT_V(6); PG8_BAR;
    } else {
        PG8_STAGE(PG8_SB(0, 0), cB, voffB); PG8_STAGE(PG8_SA(0, 0), cA, voffA); PG8_STAGE(PG8_SB(0, 1), cB + hstep, voffB); PG8_STAGE(PG8_SA(0, 1), cA + hstep, voffA);
        if (wr == 1) PG8_BAR;
        PG8_WAIT_V(4); PG8_BAR;
        PG8_STAGE(PG8_SB(1, 0), cB + kstep, voffB); PG8_STAGE(PG8_SA(1, 0), cA + kstep, voffA); PG8_STAGE(PG8_SB(1, 1), cB + hstep + kstep, voffB);
        PG8_WAIT_V(6); PG8_BAR;
    }
    for (;;) {
        const bool has_next = S.next(ui + 1, nxt);
        const char* nA = has_next ? (const char*)g.A + (size_t)nxt.pm * tstep : cA; const char* nB = has_next ? (const char*)g.Bt + (size_t)nxt.pn * tstep : cB;
        for (int t = 0; t < nt; t += 2) {
            const bool last = (t == nt - 2);
            const char* a1 = cA + (size_t)(t + 1) * kstep;
            const char* a2 = last ? nA : cA + (size_t)(t + 2) * kstep; const char* b2 = last ? nB : cB + (size_t)(t + 2) * kstep;
            const char* a3 = a2 + kstep; const char* b3 = b2 + kstep;
            if (last && has_next) S.a_ready(nxt);
            if constexpr (SP2) {
            PG8_LDB(B0, 0, 0); PG8_LDB(B1, 0, 1); PG8_SCHED; PG8_LDA(At, 0, 0); PG8_STAGE(PG8_SA(1, 1), a1 + hstep, voffA);
            PG8_WAIT_V(8); PG8_WAIT_L(0); PG8_BAR; PG8_MMA(0, 0, At, B0); PG8_MMA(0, 1, At, B1); PG8_BAR; PG8_SCHED;
            PG8_LDA(At, 0, 1); PG8_STAGE(PG8_SB(0, 0), b2, voffB); PG8_STAGE(PG8_SB(0, 1), b2 + hstep, voffB); PG8_STAGE(PG8_SA(0, 0), a2, voffA);
            PG8_WAIT_V(8); PG8_WAIT_L(0); PG8_BAR; PG8_MMA(1, 0, At, B0); PG8_MMA(1, 1, At, B1); PG8_BAR; PG8_SCHED;
            PG8_LDB(B0, 1, 0); PG8_LDB(B1, 1, 1); PG8_SCHED; PG8_LDA(At, 1, 0); PG8_STAGE(PG8_SA(0, 1), a2 + hstep, voffA);
            PG8_WAIT_V(8); PG8_WAIT_L(0); PG8_BAR; PG8_MMA(0, 0, At, B0); PG8_MMA(0, 1, At, B1); PG8_BAR; PG8_SCHED;
            PG8_LDA(At, 1, 1); PG8_STAGE(PG8_SB(1, 0), b3, voffB); PG8_STAGE(PG8_SB(1, 1), b3 + hstep, voffB); PG8_STAGE(PG8_SA(1, 0), a3, voffA);
            PG8_WAIT_V(8); PG8_WAIT_L(0); PG8_BAR; PG8_MMA(1, 0, At, B0); PG8_MMA(1, 1, At, B1); PG8_BAR; PG8_SCHED;
            } else {
            PG8_LDB(B0, 0, 0); PG8_SCHED; PG8_LDA(At, 0, 0); PG8_STAGE(PG8_SA(1, 1), a1 + hstep, voffA);
            PG8_WAIT_L(8); PG8_BAR; PG8_WAIT_L(0); PG8_MMA(0, 0, At, B0); PG8_BAR; PG8_SCHED;
            PG8_LDB(B1, 0, 1); PG8_STAGE(PG8_SB(0, 0), b2, voffB);
            PG8_BAR; PG8_WAIT_L(0); PG8_MMA(0, 1, At, B1); PG8_BAR;
            PG8_LDA(At, 0, 1); PG8_STAGE(PG8_SA(0, 0), a2, voffA);
            PG8_BAR; PG8_WAIT_L(0); PG8_MMA(1, 0, At, B0); PG8_BAR; PG8_SCHED;
            PG8_STAGE(PG8_SB(0, 1), b2 + hstep, voffB);
            PG8_WAIT_V(6); PG8_BAR; PG8_MMA(1, 1, At, B1); PG8_BAR;
            PG8_LDB(B0, 1, 0); PG8_SCHED; PG8_LDA(At, 1, 0); PG8_STAGE(PG8_SA(0, 1), a2 + hstep, voffA);
            PG8_WAIT_L(8); PG8_BAR; PG8_WAIT_L(0); PG8_MMA(0, 0, At, B0); PG8_BAR; PG8_SCHED;
            PG8_LDB(B1, 1, 1); PG8_STAGE(PG8_SB(1, 0), b3, voffB);
            PG8_BAR; PG8_WAIT_L(0); PG8_MMA(0, 1, At, B1); PG8_BAR;
            PG8_LDA(At, 1, 1); PG8_STAGE(PG8_SA(1, 0), a3, voffA);
            PG8_BAR; PG8_WAIT_L(0); PG8_MMA(1, 0, At, B0); PG8_BAR; PG8_SCHED;
            PG8_STAGE(PG8_SB(1, 1), b3 + hstep, voffB);
            PG8_WAIT_V(6); PG8_BAR; PG8_MMA(1, 1, At, B1); PG8_BAR;
            }
        }
        if constexpr (ALIGN_EPI) { if (wr == 0) PG8_BAR; }
        if constexpr (!Epi::AFTER_DRAIN) { E(acc, cur, wr, wc, fr, fq); S.done(cur); }
        if (!has_next) break;
#pragma unroll
        for (int a = 0; a < 2; ++a)
#pragma unroll
            for (int b = 0; b < 2; ++b)
#pragma unroll
                for (int m = 0; m < 4; ++m)
#pragma unroll
                    for (int n = 0; n < 2; ++n) acc[a][b][m][n] = (f32x4){0.f, 0.f, 0.f, 0.f};
        cur = nxt; cA = nA; cB = nB; ++ui;
        if constexpr (ALIGN_EPI) { if (wr == 1) PG8_BAR; }
    }
    PG8_WAIT_V(0);
    if constexpr (!ALIGN_EPI) { if (wr == 0) PG8_BAR; }
    PG8_BAR;
    if constexpr (Epi::AFTER_DRAIN) { E.fused(acc, cur, wr, wc, fr, fq, lds, wid, lane); S.done(cur); }
#undef PG8_SA
#undef PG8_SB
#undef PG8_STAGE
#undef PG8_LDA
#undef PG8_LDB
#undef PG8_MMA
#undef PG8_WAIT_V
#undef PG8_WAIT_L
#undef PG8_BAR
#undef PG8_SCHED
}
}

#ifndef PG8_SP2
#define PG8_SP2 true
#endif
#ifndef PG8_ALIGN
#define PG8_ALIGN true
#endif
#define GAS __attribute__((address_space(1)))
#define LAS __attribute__((address_space(3)))
typedef unsigned short bf16;
typedef unsigned v4u __attribute__((ext_vector_type(4)));
typedef float f32x4 __attribute__((ext_vector_type(4)));
typedef short bf16x8 __attribute__((ext_vector_type(8)));
typedef GAS unsigned gu32;
typedef GAS unsigned long long gu64;
#define RLX_AGENT __ATOMIC_RELAXED, __HIP_MEMORY_SCOPE_AGENT
#define LDS_WAIT() asm volatile("s_waitcnt lgkmcnt(0)" ::: "memory")
#define VM_WAIT() asm volatile("s_waitcnt vmcnt(0)" ::: "memory")
__device__ __forceinline__ unsigned long long rt() { return __builtin_amdgcn_s_memrealtime(); }
__device__ __forceinline__ unsigned f2bf(float f) { unsigned u = __builtin_bit_cast(unsigned, f); return (u + 0x7fffu + ((u >> 16) & 1u)) >> 16; }
__device__ __forceinline__ unsigned pk2(float lo, float hi) { typedef float f2_ __attribute__((ext_vector_type(2))); typedef __bf16 b2_ __attribute__((ext_vector_type(2))); f2_ v = {lo, hi}; b2_ b = __builtin_convertvector(v, b2_); return __builtin_bit_cast(unsigned, b); }

#define XB_TMO      128
#define XB_XCNT(j)  (256  + 64 * (j))
#define XB_XSUB(j)  (1280 + 64 * (j))
#define XB_XGEN(j)  (2304 + 64 * (j))
#define XB_TOP      3328
#define XB_TOPGEN   3392
#define XCD_BAR_WORDS 3456
#define XB_SPIN_CAP (1u << 18)

__device__ __forceinline__ unsigned xb_ld(unsigned* p)              { return __hip_atomic_load(p, __ATOMIC_RELAXED, __HIP_MEMORY_SCOPE_AGENT); }
__device__ __forceinline__ unsigned xb_add(unsigned* p, unsigned v) { return __hip_atomic_fetch_add(p, v, __ATOMIC_RELAXED, __HIP_MEMORY_SCOPE_AGENT); }
__device__ __forceinline__ unsigned xb_xcc_id() { return (unsigned)__builtin_amdgcn_s_getreg((3 << 11) | 20) & 0xFu; }
#define XB_SPIN(cond, bar) do { unsigned _sp = 0; while (cond) { __builtin_amdgcn_s_sleep(1); \
    if ((++_sp & 255u) == 0u) { if (xb_ld(&(bar)[XB_TMO])) break; if (_sp > XB_SPIN_CAP) { atomicAdd(&(bar)[XB_TMO], 1u); break; } } } } while (0)

struct XcdBarrier {
    unsigned* bar; unsigned x;
    volatile LAS unsigned* st;
};

__device__ __forceinline__ XcdBarrier xcd_barrier_post(unsigned* bar, volatile LAS unsigned* st) {
    XcdBarrier b; b.bar = bar; b.x = xb_xcc_id(); b.st = st;
    if (threadIdx.x == 0) (void)xb_add(&bar[XB_XCNT(b.x)], 1u);
    return b;
}
__device__ __forceinline__ void xcd_barrier_complete(unsigned* bar, unsigned x, unsigned& nloc, unsigned& nx) {
    const unsigned G = gridDim.x * gridDim.y * gridDim.z;
    unsigned sum, cnt, mine, sp = 0u;
    for (;;) {
        sum = 0u; cnt = 0u; mine = 0u;
#pragma unroll
        for (unsigned j = 0; j < 16; ++j) { const unsigned c = xb_ld(&bar[XB_XCNT(j)]); sum += c; cnt += (c > 0u) ? 1u : 0u; mine = (j == x) ? c : mine; }
        if (sum == G) break;
        __builtin_amdgcn_s_sleep(1);
        if ((++sp & 255u) == 0u) { if (xb_ld(&bar[XB_TMO])) break; if (sp > XB_SPIN_CAP) { atomicAdd(&bar[XB_TMO], 1u); break; } }
    }
    nloc = mine > 0u ? mine : 1u; nx = cnt > 0u ? cnt : 1u;
}

__device__ __forceinline__ void xcd_barrier(const XcdBarrier& b) {
    asm volatile("s_waitcnt vmcnt(0)" ::: "memory");
    __syncthreads();
    if (threadIdx.x == 0) {
        unsigned* bar = b.bar;
        __builtin_amdgcn_s_waitcnt(0);
        unsigned nloc = b.st[0], nx = b.st[1];
        if (nloc == 0u) { xcd_barrier_complete(bar, b.x, nloc, nx); b.st[0] = nloc; b.st[1] = nx; }
        const unsigned old = xb_add(&bar[XB_XSUB(b.x)], 1u);
        const unsigned gen = old / nloc;
        if (old + 1u == (gen + 1u) * nloc) {
            __builtin_amdgcn_fence(__ATOMIC_RELEASE, "agent");
            asm volatile("s_waitcnt vmcnt(0)" ::: "memory");
            const unsigned og = xb_add(&bar[XB_TOP], 1u);
            const unsigned tg = og / nx;
            if (og + 1u == (tg + 1u) * nx) xb_add(&bar[XB_TOPGEN], 1u);
            else XB_SPIN(xb_ld(&bar[XB_TOPGEN]) == tg, bar);
            __builtin_amdgcn_fence(__ATOMIC_ACQUIRE, "agent");
            xb_add(&bar[XB_XGEN(b.x)], 1u);
            asm volatile("s_waitcnt vmcnt(0)" ::: "memory");
        } else {
            XB_SPIN(xb_ld(&bar[XB_XGEN(b.x)]) == gen, bar);
            __builtin_amdgcn_fence(__ATOMIC_ACQUIRE, "agent");
            asm volatile("s_waitcnt vmcnt(0)" ::: "memory");
        }
    }
    __syncthreads();
}


constexpr int NWAVES = 8;
constexpr int DM = 1024, SEQ = 4096, NBP = 4, NBS = 32, TS = 8;
constexpr int MP = NBP * SEQ, MS = NBS * TS, MT = MP + MS;
constexpr int NH = 8, HD = 64, DSSM = 512, NST = 128, IN_LD = 3080, NIN = 3072;
constexpr int DFF = 2816, DFF2 = 5632, DPLE = 256, WBUF = 2048;
constexpr float EPS = 1e-6f, LOG2E = 1.4426950408889634f, C2 = 0.125f * 1.4426950408889634f;
constexpr int PC_K = 512, PC_V = 1024, PC_Z = 1536, PC_X = 2048;
constexpr size_t O_Y = 0, O_YS = 16777216, O_KP = 17039360, O_VP = 21233664, O_KS = 25427968, O_VS = 25559040, O_SP = 25690112, O_SS = 25952256,
                 O_CP = 28049408, O_CS = 28061696, O_FP = 28160000, O_FS = 28205056, O_END = 28565504;
constexpr size_t MiB = 1u << 20;
constexpr size_t WS_CTL = 0, CTL_ZERO_BYTES = 1 * MiB;
constexpr size_t WS_RS1 = 256 * 1024, WS_RSE = 384 * 1024, WS_RS3 = 512 * 1024;
constexpr size_t WS_WIN = 2 * MiB, WS_WOUT = 8 * MiB, WS_WUP = 10 * MiB, WS_WDOWN = 21 * MiB, WS_WPLE = 27 * MiB, WS_WGATE = 28 * MiB;
constexpr size_t WS_DT = 30 * MiB, WS_PB = 31 * MiB, WS_XN = 40 * MiB, WS_MIX = 73 * MiB, WS_H1 = 106 * MiB, WS_E = 171 * MiB;
constexpr size_t WS_PROJ = 236 * MiB, WS_OBR = 334 * MiB, WS_LSE = 382 * MiB, WS_XBS = 384 * MiB, WS_XC = 385 * MiB, WS_CC = 402 * MiB, WS_CS = 410 * MiB, WS_PREV = 442 * MiB,
                 WS_ACUM = 458 * MiB, WS_ACL = 458 * MiB + 768 * 1024, WS_YS = 459 * MiB;
constexpr size_t WS_U = 236 * MiB, WS_UH = 236 * MiB, WS_US = 244 * MiB, WS_ACT = 415 * MiB, WS_END = 505 * MiB;
static_assert(WS_PROJ + (size_t)MT * NIN * 2 <= WS_OBR && WS_OBR + (size_t)3 * MP * 512 * 2 <= WS_LSE && WS_LSE + (size_t)3 * MP * 8 * 4 <= WS_XBS, "ws map A");
static_assert(WS_XBS + (size_t)MS * 1024 * 4 <= WS_XC && WS_XC + (size_t)MT * 512 * 2 <= WS_CC && WS_CC + (size_t)MP * 256 * 2 <= WS_CS && WS_CS + (size_t)MP / 128 * 8 * 64 * 128 * 4 <= WS_PREV && WS_PREV + (size_t)MP / 128 * 8 * 64 * 128 * 2 <= WS_ACUM && WS_ACUM + (size_t)MP * 8 * 4 <= WS_ACL && WS_ACL + 4096 <= WS_YS && WS_YS + (size_t)MT * 512 * 4 <= WS_END, "ws map B");
static_assert(WS_U + (size_t)MT * DFF2 * 2 <= WS_ACT && WS_ACT + (size_t)MT * DFF * 2 <= WS_END, "ws map C");
static_assert(WS_XN + (size_t)MT * DM * 2 <= WS_MIX && WS_MIX + (size_t)MT * DM * 2 <= WS_H1 && WS_H1 + (size_t)MT * DM * 4 <= WS_E && WS_E + (size_t)MT * DM * 4 <= WS_PROJ, "ws map D");
static_assert(WS_PB + (size_t)MT * DPLE * 2 <= WS_XN && WS_DT + (size_t)MT * 8 * 4 <= WS_PB, "ws map E");
constexpr int CW_TMO = 0, CW_BAR = 4096;
constexpr int RING_BYTES = 131072, LDSCTL_OFF = RING_BYTES, MISC_OFF = LDSCTL_OFF + 320, LDS_BYTES = 147456;

typedef float f32x16 __attribute__((ext_vector_type(16)));
typedef short v4i16_t __attribute__((ext_vector_type(4)));
typedef unsigned u32x2 __attribute__((ext_vector_type(2)));

__device__ const unsigned char BUCKET_TAB[3][132] = {
 {0,1,2,3,4,5,6,7,8,9,10,11,12,13,14,15,16,16,16,16,16,16,17,17,17,17,17,17,17,17,18,18,18,18,18,18,18,18,18,18,19,19,19,19,19,19,19,19,19,19,19,19,19,19,20,20,20,20,20,20,20,20,20,20,20,20,20,20,20,20,20,20,20,21,21,21,21,21,21,21,21,21,21,21,21,21,21,21,21,21,21,21,21,21,21,21,21,21,21,22,22,22,22,22,22,22,22,22,22,22,22,22,22,22,22,22,22,22,22,22,22,22,22,22,22,22,22,22,22,0,0,0},
 {0,4,8,12,16,16,17,17,18,18,19,19,19,19,20,20,20,20,20,21,21,21,21,21,21,22,22,22,22,22,22,22,22,22,23,23,23,23,23,23,23,23,23,23,23,23,24,24,24,24,24,24,24,24,24,24,24,24,24,24,24,24,25,25,25,25,25,25,25,25,25,25,25,25,25,25,25,25,25,25,25,25,25,26,26,26,26,26,26,26,26,26,26,26,26,26,26,26,26,26,26,26,26,26,26,26,26,26,26,26,26,26,26,27,27,27,27,27,27,27,27,27,27,27,27,27,27,27,27,0,0,0},
 {0,16,18,19,20,21,21,22,22,23,23,23,24,24,24,24,25,25,25,25,25,26,26,26,26,26,26,26,26,27,27,27,27,27,27,27,27,27,27,28,28,28,28,28,28,28,28,28,28,28,28,28,29,29,29,29,29,29,29,29,29,29,29,29,29,29,29,29,29,29,30,30,30,30,30,30,30,30,30,30,30,30,30,30,30,30,30,30,30,30,30,30,30,30,30,31,31,31,31,31,31,31,31,31,31,31,31,31,31,31,31,31,31,31,31,31,31,31,31,31,31,31,31,31,31,31,31,31,31,0,0,0}};

__device__ __forceinline__ float row16_sum(float v) {
    v += __builtin_bit_cast(float, __builtin_amdgcn_update_dpp(0, __builtin_bit_cast(int, v), 0xB1, 0xf, 0xf, true));
    v += __builtin_bit_cast(float, __builtin_amdgcn_update_dpp(0, __builtin_bit_cast(int, v), 0x4E, 0xf, 0xf, true));
    v += __builtin_bit_cast(float, __builtin_amdgcn_update_dpp(0, __builtin_bit_cast(int, v), 0x141, 0xf, 0xf, true));
    v += __builtin_bit_cast(float, __builtin_amdgcn_update_dpp(0, __builtin_bit_cast(int, v), 0x140, 0xf, 0xf, true));
    return v;
}
__device__ __forceinline__ float row16_max(float v) {
    v = fmaxf(v, __builtin_bit_cast(float, __builtin_amdgcn_update_dpp(__builtin_bit_cast(int, v), __builtin_bit_cast(int, v), 0xB1, 0xf, 0xf, false)));
    v = fmaxf(v, __builtin_bit_cast(float, __builtin_amdgcn_update_dpp(__builtin_bit_cast(int, v), __builtin_bit_cast(int, v), 0x4E, 0xf, 0xf, false)));
    v = fmaxf(v, __builtin_bit_cast(float, __builtin_amdgcn_update_dpp(__builtin_bit_cast(int, v), __builtin_bit_cast(int, v), 0x141, 0xf, 0xf, false)));
    v = fmaxf(v, __builtin_bit_cast(float, __builtin_amdgcn_update_dpp(__builtin_bit_cast(int, v), __builtin_bit_cast(int, v), 0x140, 0xf, 0xf, false)));
    return v;
}
__device__ __forceinline__ float wave_sum(float v) {
    v = row16_sum(v);
    auto s = __builtin_amdgcn_permlane16_swap(__float_as_uint(v), __float_as_uint(v), false, false);
    v = __uint_as_float(s[0]) + __uint_as_float(s[1]);
    auto t = __builtin_amdgcn_permlane32_swap(__float_as_uint(v), __float_as_uint(v), false, false);
    return __uint_as_float(t[0]) + __uint_as_float(t[1]);
}
__device__ __forceinline__ float wave_max(float v) {
    v = row16_max(v);
    auto s = __builtin_amdgcn_permlane16_swap(__float_as_uint(v), __float_as_uint(v), false, false);
    v = fmaxf(__uint_as_float(s[0]), __uint_as_float(s[1]));
    auto t = __builtin_amdgcn_permlane32_swap(__float_as_uint(v), __float_as_uint(v), false, false);
    return fmaxf(__uint_as_float(t[0]), __uint_as_float(t[1]));
}
__device__ __forceinline__ float bf2f(unsigned short b) { return __uint_as_float((unsigned)b << 16); }
__device__ __forceinline__ float bflo(unsigned w) { return __uint_as_float(w << 16); }
__device__ __forceinline__ float bfhi(unsigned w) { return __uint_as_float(w & 0xffff0000u); }
__device__ __forceinline__ float siluf(float x) { return x * __builtin_amdgcn_rcpf(1.f + __builtin_amdgcn_exp2f(-LOG2E * x)); }
__device__ __forceinline__ float softplusf(float x) { return fmaxf(x, 0.f) + log1pf(__expf(-fabsf(x))); }
__device__ __forceinline__ int crow(int r, int hi) { return (r & 3) + 8 * (r >> 2) + 4 * hi; }

__device__ __forceinline__ v4i16_t vtr(const LAS unsigned char* p) { return __builtin_amdgcn_ds_read_tr16_b64_v4i16((LAS v4i16_t*)p); }
__device__ __forceinline__ unsigned cvtpk_s(float lo, float hi) { typedef float f2 __attribute__((ext_vector_type(2))); typedef __bf16 b2 __attribute__((ext_vector_type(2))); f2 v = {lo, hi}; b2 b = __builtin_convertvector(v, b2); return __builtin_bit_cast(unsigned, b); }
struct Args { const float* in[28]; float* out; unsigned char* ws; int ph_lo, ph_hi, li, pad; };

struct EpiIn {
    static constexpr bool PERM = true, AFTER_DRAIN = false;
    pg8::bf16_t* PROJ; float* out;
    __device__ __forceinline__ void operator()(const pg8::f32x4 (&acc)[2][2][4][2], const pg8::Unit& u, int wr, int wc, int fr, int fq) const {
        const int pn = u.pn; const float sc = (pn < 2) ? C2 : 1.f;
        const int colb = pn * 256 + wc * 32 + 8 * fq;
#pragma unroll
        for (int ai = 0; ai < 2; ++ai)
#pragma unroll
            for (int m = 0; m < 4; ++m) {
                const int row = u.pm * 256 + ai * 128 + wr * 64 + m * 16 + fr;
#pragma unroll
                for (int bj = 0; bj < 2; ++bj) {
                    const int col = colb + bj * 128; const pg8::f32x4 v0 = acc[ai][bj][m][0], v1 = acc[ai][bj][m][1];
                    pg8::u32x4 w; w.x = pg8::cvt_pk_bf16(v0[0] * sc, v0[1] * sc); w.y = pg8::cvt_pk_bf16(v0[2] * sc, v0[3] * sc); w.z = pg8::cvt_pk_bf16(v1[0] * sc, v1[1] * sc); w.w = pg8::cvt_pk_bf16(v1[2] * sc, v1[3] * sc);
                    *(pg8::u32x4*)(PROJ + (unsigned)(row * NIN + col)) = w;
                    float* dst = nullptr;
                    if (pn >= 2 && pn < 6) {
                        const bool isk = pn < 4; const int c = col - (isk ? PC_K : PC_V);
                        if (row < MP) { const int t = row & (SEQ - 1), b = row >> 12; if (t >= SEQ - WBUF) dst = out + (isk ? O_KP : O_VP) + ((size_t)(b * WBUF + t - (SEQ - WBUF))) * 512 + c; }
                        else dst = out + (isk ? O_KS : O_VS) + (size_t)(row - MP) * 512 + c;
                    } else if (pn >= 8) {
                        const int c = col - PC_X;
                        if (row < MP) { const int t = row & (SEQ - 1), b = row >> 12; if (t >= SEQ - 3) dst = out + O_CP + (size_t)(b * 3 + t - (SEQ - 3)) * 1024 + c; }
                        else { const int r = row - MP, t = r & 7, b = r >> 3; if (t >= TS - 3) dst = out + O_CS + (size_t)(b * 3 + t - (TS - 3)) * 1024 + c; }
                    }
                    if (dst) { *(pg8::f32x4*)dst = v0; *(pg8::f32x4*)(dst + 4) = v1; }
                }
            }
    }
};
struct EpiOut {
    static constexpr bool PERM = false, AFTER_DRAIN = false;
    const float* xp; pg8::bf16_t* H1b; float* RS;
    __device__ __forceinline__ void operator()(const pg8::f32x4 (&acc)[2][2][4][2], const pg8::Unit& u, int wr, int wc, int fr, int fq) const {
        const int col0 = u.pn * 256 + wc * 32 + 4 * fq;
#pragma unroll
        for (int ai = 0; ai < 2; ++ai)
#pragma unroll
            for (int m = 0; m < 4; ++m) {
                const int row = u.pm * 256 + ai * 128 + wr * 64 + m * 16 + fr;
                const float* xrow = xp + (unsigned)(row * DM);
                float ss = 0.f;
#pragma unroll
                for (int bj = 0; bj < 2; ++bj)
#pragma unroll
                    for (int n = 0; n < 2; ++n) {
                        const int c = col0 + bj * 128 + n * 16;
                        const pg8::f32x4 h = *(const pg8::f32x4*)(xrow + c) + acc[ai][bj][m][n];
                        u32x2 w; w.x = pg8::cvt_pk_bf16(h[0], h[1]); w.y = pg8::cvt_pk_bf16(h[2], h[3]);
                        *(u32x2*)(H1b + (unsigned)(row * DM + c)) = w;
                        ss += (h[0] * h[0] + h[1] * h[1]) + (h[2] * h[2] + h[3] * h[3]);
                    }
                ss += __shfl_xor(ss, 16); ss += __shfl_xor(ss, 32);
                if (fq == 0) atomicAdd(RS + row, ss);
                asm volatile("" ::: "memory");
            }
    }
};
template <int CTRL> __device__ __forceinline__ unsigned dppu(unsigned x) { return (unsigned)__builtin_amdgcn_update_dpp(0, (int)x, CTRL, 0xf, 0xf, true); }
constexpr int XCH_OFF = 139264;
struct EpiUp {
    static constexpr bool PERM = true, AFTER_DRAIN = false;
    pg8::bf16_t* ACT; const float* RS; float* out; float* UH; float* US; const float* fw; const float* fb; LAS unsigned char* lds;
    __device__ __forceinline__ void operator()(pg8::f32x4 (&acc)[2][2][4][2], const pg8::Unit& u, int wr, int wc, int fr, int fq) const {
        asm volatile("" : "+v"(fr), "+v"(fq));
        const int jb = wc * 32 + 8 * fq, ca = u.pn * 128 + jb;
        const bool samp = u.pm >= MP / 256;
        unsigned P[2][2][4][2][2];
#pragma unroll
        for (int ai = 0; ai < 2; ++ai)
#pragma unroll
            for (int m = 0; m < 4; ++m) {
                const int rt = ai * 128 + wr * 64 + m * 16 + fr, row = u.pm * 256 + rt;
                const float rs = __builtin_amdgcn_rsqf(RS[row] * (1.f / DM) + EPS);
                float* d = nullptr; float* d2 = nullptr;
                if (samp) { d = US + (unsigned)(rt * DFF2); if ((rt & 7) >= TS - 2) d2 = out + O_FS + (size_t)((rt >> 3) * 2 + (rt & 7) - (TS - 2)) * DFF2; }
                else {
                    if (ai == 0 && m == 0 && wr == 0 && fr < 2) d = UH + (unsigned)((u.pm * 4 + fr) * DFF2);
                    if (ai == 1 && m == 3 && wr == 1 && fr >= 14) { d = UH + (unsigned)((u.pm * 4 + 2 + fr - 14) * DFF2); if ((u.pm & 15) == 15) d2 = out + O_FP + (size_t)((u.pm >> 4) * 2 + fr - 14) * DFF2; }
                }
#pragma unroll
                for (int bj = 0; bj < 2; ++bj) {
                    const pg8::f32x4 v0 = acc[ai][bj][m][0] * rs, v1 = acc[ai][bj][m][1] * rs;
                    if (d) { *(pg8::f32x4*)(d + bj * DFF + ca) = v0; *(pg8::f32x4*)(d + bj * DFF + ca + 4) = v1; }
                    if (d2) { *(pg8::f32x4*)(d2 + bj * DFF + ca) = v0; *(pg8::f32x4*)(d2 + bj * DFF + ca + 4) = v1; }
                    P[ai][bj][m][0][0] = pg8::cvt_pk_bf16(v0[0], v0[1]); P[ai][bj][m][0][1] = pg8::cvt_pk_bf16(v0[2], v0[3]);
                    P[ai][bj][m][1][0] = pg8::cvt_pk_bf16(v1[0], v1[1]); P[ai][bj][m][1][1] = pg8::cvt_pk_bf16(v1[2], v1[3]);
                }
            }
        LAS unsigned char* xch = lds + XCH_OFF;
        if (fr >= 14) {
#pragma unroll
            for (int ai = 0; ai < 2; ++ai)
#pragma unroll
                for (int bj = 0; bj < 2; ++bj)
                    *(LAS pg8::u32x4*)(xch + (((1 + 2 * ai + wr) * 2 + fr - 14) * 256 + bj * 128 + jb) * 2) = (pg8::u32x4){P[ai][bj][3][0][0], P[ai][bj][3][0][1], P[ai][bj][3][1][0], P[ai][bj][3][1][1]};
        }
        asm volatile("s_waitcnt lgkmcnt(0)" ::: "memory"); __builtin_amdgcn_s_barrier(); asm volatile("" ::: "memory");
#pragma unroll
        for (int ai = 0; ai < 2; ++ai) {
            const int q = 2 * ai + wr;
            pg8::u32x4 H2[2], H1[2];
#pragma unroll
            for (int bj = 0; bj < 2; ++bj) { H2[bj] = *(const LAS pg8::u32x4*)(xch + ((q * 2 + 0) * 256 + bj * 128 + jb) * 2); H1[bj] = *(const LAS pg8::u32x4*)(xch + ((q * 2 + 1) * 256 + bj * 128 + jb) * 2); }
#pragma unroll
            for (int n = 0; n < 2; ++n)
#pragma unroll
                for (int h = 0; h < 2; ++h) {
                    const int cc = ca + 4 * n + 2 * h;
                    typedef float f2t __attribute__((ext_vector_type(2)));
                    f2t W0[2], W1[2], W2[2], BB[2];
#pragma unroll
                    for (int bj = 0; bj < 2; ++bj) { const float* wp = fw + bj * DFF + cc; W0[bj] = *(const f2t*)wp; W1[bj] = *(const f2t*)(wp + DFF2); W2[bj] = *(const f2t*)(wp + 2 * DFF2); BB[bj] = *(const f2t*)(fb + bj * DFF + cc); }
#pragma unroll
                    for (int m = 3; m >= 0; --m) {
                        float y[2][2];
#pragma unroll
                        for (int bj = 0; bj < 2; ++bj) {
                            const unsigned cur = P[ai][bj][m][n][h];
                            const unsigned c1 = dppu<0x121>(cur), c2 = dppu<0x122>(cur);
                            unsigned q1, q2;
                            if (m > 0) { const unsigned pv = P[ai][bj][m > 0 ? m - 1 : 0][n][h]; q1 = dppu<0x121>(pv); q2 = dppu<0x122>(pv); }
                            else { const unsigned hh1 = H1[bj][2 * n + h], hh2 = H2[bj][2 * n + h]; q1 = hh1; q2 = (fr == 0) ? hh2 : hh1; }
                            const unsigned p1 = (fr >= 1) ? c1 : q1, p2 = (fr >= 2) ? c2 : q2;
                            y[bj][0] = BB[bj].x + W0[bj].x * bflo(p2) + W1[bj].x * bflo(p1) + W2[bj].x * bflo(cur);
                            y[bj][1] = BB[bj].y + W0[bj].y * bfhi(p2) + W1[bj].y * bfhi(p1) + W2[bj].y * bfhi(cur);
                        }
                        P[ai][0][m][n][h] = pg8::cvt_pk_bf16(siluf(y[0][0]) * y[1][0], siluf(y[0][1]) * y[1][1]);
                        __builtin_amdgcn_sched_barrier(0);
                    }
                }
        }
#pragma unroll
        for (int ai = 0; ai < 2; ++ai)
#pragma unroll
            for (int m = 0; m < 4; ++m) {
                const int row = u.pm * 256 + ai * 128 + wr * 64 + m * 16 + fr;
                *(pg8::u32x4*)(ACT + (unsigned)(row * DFF + ca)) = (pg8::u32x4){P[ai][0][m][0][0], P[ai][0][m][0][1], P[ai][0][m][1][0], P[ai][0][m][1][1]};
            }
    }
};
struct EpiDown {
    static constexpr bool PERM = false, AFTER_DRAIN = false;
    pg8::bf16_t* Hb; float psc;
    __device__ __forceinline__ void operator()(const pg8::f32x4 (&acc)[2][2][4][2], const pg8::Unit& u, int wr, int wc, int fr, int fq) const {
        const int col0 = u.pn * 256 + wc * 32 + 4 * fq;
#pragma unroll
        for (int ai = 0; ai < 2; ++ai)
#pragma unroll
            for (int m = 0; m < 4; ++m) {
                const int row = u.pm * 256 + ai * 128 + wr * 64 + m * 16 + fr;
#pragma unroll
                for (int bj = 0; bj < 2; ++bj)
#pragma unroll
                    for (int n = 0; n < 2; ++n) {
                        const int c = col0 + bj * 128 + n * 16; u32x2* hp = (u32x2*)(Hb + (unsigned)(row * DM + c));
                        const u32x2 o = *hp; const pg8::f32x4 a = acc[ai][bj][m][n] * psc;
                        u32x2 w; w.x = pg8::cvt_pk_bf16(bflo(o.x) + a[0], bfhi(o.x) + a[1]); w.y = pg8::cvt_pk_bf16(bflo(o.y) + a[2], bfhi(o.y) + a[3]);
                        *hp = w;
                    }
                asm volatile("" ::: "memory");
            }
    }
};
struct EpiPle {
    static constexpr bool PERM = false, AFTER_DRAIN = false;
    pg8::bf16_t* E; float* RS;
    __device__ __forceinline__ void operator()(const pg8::f32x4 (&acc)[2][2][4][2], const pg8::Unit& u, int wr, int wc, int fr, int fq) const {
        const int col0 = u.pn * 256 + wc * 32 + 4 * fq;
#pragma unroll
        for (int ai = 0; ai < 2; ++ai)
#pragma unroll
            for (int m = 0; m < 4; ++m) {
                const int row = u.pm * 256 + ai * 128 + wr * 64 + m * 16 + fr; float ss = 0.f;
#pragma unroll
                for (int bj = 0; bj < 2; ++bj)
#pragma unroll
                    for (int n = 0; n < 2; ++n) {
                        const int c = col0 + bj * 128 + n * 16; const pg8::f32x4 h = acc[ai][bj][m][n];
                        u32x2 w; w.x = pg8::cvt_pk_bf16(h[0], h[1]); w.y = pg8::cvt_pk_bf16(h[2], h[3]);
                        *(u32x2*)(E + (unsigned)(row * DM + c)) = w;
                        ss += (h[0] * h[0] + h[1] * h[1]) + (h[2] * h[2] + h[3] * h[3]);
                    }
                ss += __shfl_xor(ss, 16); ss += __shfl_xor(ss, 32);
                if (fq == 0) atomicAdd(RS + row, ss);
            }
    }
};
struct EpiGate {
    static constexpr bool PERM = false, AFTER_DRAIN = false;
    const pg8::bf16_t* H2b; const pg8::bf16_t* E; const float* RSE; const float* gple; pg8::bf16_t* H3b; float* RS3;
    __device__ __forceinline__ void operator()(const pg8::f32x4 (&acc)[2][2][4][2], const pg8::Unit& u, int wr, int wc, int fr, int fq) const {
        const int col0 = u.pn * 256 + wc * 32 + 4 * fq;
        pg8::f32x4 gp[2][2];
#pragma unroll
        for (int bj = 0; bj < 2; ++bj)
#pragma unroll
            for (int n = 0; n < 2; ++n) gp[bj][n] = *(const pg8::f32x4*)(gple + col0 + bj * 128 + n * 16);
#pragma unroll
        for (int ai = 0; ai < 2; ++ai)
#pragma unroll
            for (int m = 0; m < 4; ++m) {
                const int row = u.pm * 256 + ai * 128 + wr * 64 + m * 16 + fr;
                const float rse = 1.0f / sqrtf(RSE[row] * (1.f / DM) + EPS);
                float ss = 0.f;
#pragma unroll
                for (int bj = 0; bj < 2; ++bj)
#pragma unroll
                    for (int n = 0; n < 2; ++n) {
                        const int c = col0 + bj * 128 + n * 16; const unsigned o = (unsigned)(row * DM + c);
                        const pg8::f32x4 a = acc[ai][bj][m][n]; const u32x2 eb = *(const u32x2*)(E + o), hb = *(const u32x2*)(H2b + o);
                        const float e4[4] = {bflo(eb.x), bfhi(eb.x), bflo(eb.y), bfhi(eb.y)}, h4[4] = {bflo(hb.x), bfhi(hb.x), bflo(hb.y), bfhi(hb.y)};
                        float h[4];
#pragma unroll
                        for (int k = 0; k < 4; ++k) { const float g = 1.f / (1.f + __expf(-a[k])); h[k] = h4[k] + g * (e4[k] * rse * gp[bj][n][k]); }
                        u32x2 w; w.x = pg8::cvt_pk_bf16(h[0], h[1]); w.y = pg8::cvt_pk_bf16(h[2], h[3]);
                        *(u32x2*)(H3b + o) = w;
                        ss += (h[0] * h[0] + h[1] * h[1]) + (h[2] * h[2] + h[3] * h[3]);
                    }
                ss += __shfl_xor(ss, 16); ss += __shfl_xor(ss, 32);
                if (fq == 0) atomicAdd(RS3 + row, ss);
                asm volatile("" ::: "memory");
            }
    }
};

__device__ __forceinline__ void load8bf(const bf16* p, float (&o)[8]) {
    const v4u w = *(const v4u*)p;
    o[0] = bflo(w.x); o[1] = bfhi(w.x); o[2] = bflo(w.y); o[3] = bfhi(w.y); o[4] = bflo(w.z); o[5] = bfhi(w.z); o[6] = bflo(w.w); o[7] = bfhi(w.w);
}
__device__ __forceinline__ void load8f(const float* p, float (&o)[8]) {
    const f32x4 a = *(const f32x4*)p, b = *(const f32x4*)(p + 4);
    o[0] = a.x; o[1] = a.y; o[2] = a.z; o[3] = a.w; o[4] = b.x; o[5] = b.y; o[6] = b.z; o[7] = b.w;
}
__device__ __forceinline__ void p0_transpose_item(const float* W, int ldn, int K, int N, bf16* WT, const float* gk, LAS float* scr, int item, int lane, bool upperm = false) {
    const int nblk = N / 32, kb = item / nblk, nb = item % nblk, k0 = 64 * kb, n0 = 32 * nb;
    const int nd0 = !upperm ? n0 : (n0 < DFF ? 256 * (n0 >> 7) + (n0 & 127) : 256 * ((n0 - DFF) >> 7) + 128 + ((n0 - DFF) & 127));
    const float* src = W + (size_t)(k0 + (lane >> 5)) * ldn + n0 + (lane & 31);
    float wv[32];
#pragma unroll
    for (int i = 0; i < 32; ++i) wv[i] = src[(size_t)(2 * i) * ldn];
#pragma unroll
    for (int i = 0; i < 32; ++i) scr[(2 * i + (lane >> 5)) * 33 + (lane & 31)] = wv[i];
    const int c = lane & 7;
    float g8[8];
    if (gk) load8f(gk + k0 + 8 * c, g8); else {
#pragma unroll
        for (int j = 0; j < 8; ++j) g8[j] = 1.f; }
    LDS_WAIT(); asm volatile("" ::: "memory");
#pragma unroll
    for (int j = 0; j < 4; ++j) { const int n = (lane >> 3) + 8 * j; const LAS float* sp = scr + (8 * c) * 33 + n;
        v4u o; o.x = pk2(sp[0 * 33] * g8[0], sp[1 * 33] * g8[1]); o.y = pk2(sp[2 * 33] * g8[2], sp[3 * 33] * g8[3]); o.z = pk2(sp[4 * 33] * g8[4], sp[5 * 33] * g8[5]); o.w = pk2(sp[6 * 33] * g8[6], sp[7 * 33] * g8[7]);
        *(GAS v4u*)(WT + (size_t)(nd0 + n) * K + k0 + 8 * c) = o; }
    LDS_WAIT(); asm volatile("" ::: "memory");
}
__device__ __forceinline__ void p0_prologue(const Args& a, LAS unsigned char* lds, int gw, int NGW, int wave, int lane, int part = 3) {
    unsigned char* ws = a.ws;
    LAS float* scr = (LAS float*)(lds + wave * 8704);
    constexpr int I_IN = (DM / 64) * (NIN / 32), I_OUT = (DM / 64) * (DM / 32), I_UP = (DM / 64) * (DFF2 / 32), I_DN = (DFF / 64) * (DM / 32), I_PLE = (DPLE / 64) * (DM / 32), I_G = I_OUT;
    constexpr int NITEMS = I_IN + I_OUT + I_UP + I_DN + I_PLE + I_G;
    if (part & 1) for (int it = gw; it < NITEMS; it += NGW) {
        int r = it;
        if (r < I_IN)  { p0_transpose_item(a.in[11], IN_LD, DM, NIN, (bf16*)(ws + WS_WIN), a.in[10], scr, r, lane); continue; } r -= I_IN;
        if (r < I_OUT) { p0_transpose_item(a.in[18], DM, DM, DM, (bf16*)(ws + WS_WOUT), nullptr, scr, r, lane); continue; } r -= I_OUT;
        if (r < I_UP)  { p0_transpose_item(a.in[20], DFF2, DM, DFF2, (bf16*)(ws + WS_WUP), a.in[19], scr, r, lane, true); continue; } r -= I_UP;
        if (r < I_DN)  { p0_transpose_item(a.in[23], DM, DFF, DM, (bf16*)(ws + WS_WDOWN), nullptr, scr, r, lane); continue; } r -= I_DN;
        if (r < I_PLE) { p0_transpose_item(a.in[24], DM, DPLE, DM, (bf16*)(ws + WS_WPLE), nullptr, scr, r, lane); continue; } r -= I_PLE;
        p0_transpose_item(a.in[26], DM, DM, DM, (bf16*)(ws + WS_WGATE), nullptr, scr, r, lane);
    }
    const float* gmix = a.in[10]; const float* win = a.in[11]; const float* dtb = a.in[14];
    bf16* XN = (bf16*)(ws + WS_XN); bf16* PB = (bf16*)(ws + WS_PB); float* DT = (float*)(ws + WS_DT);
    LAS unsigned char* dtw = lds + 81920;
    for (int k = threadIdx.x; k < DM; k += NWAVES * 64) {
        const float gk = gmix[k]; const f32x4 w0 = *(const f32x4*)(win + (size_t)k * IN_LD + NIN) * gk, w1 = *(const f32x4*)(win + (size_t)k * IN_LD + NIN + 4) * gk;
        LAS f32x4* d = (LAS f32x4*)(dtw + (k >> 2) * 144 + (k & 3) * 32); d[0] = w0; d[1] = w1;
    }
    LDS_WAIT(); __syncthreads();
    f32x4 vn[4];
    if (gw < MT) { const float* xrow = (gw < MP) ? a.in[0] + (size_t)gw * DM : a.in[1] + (size_t)(gw - MP) * DM;
#pragma unroll
        for (int j = 0; j < 4; ++j) vn[j] = ((const GAS f32x4*)xrow + lane)[64 * j]; }
    if (part & 2) for (int m = gw; m < MT; m += NGW) {
        f32x4 v[4]; float s = 0.f;
#pragma unroll
        for (int j = 0; j < 4; ++j) { v[j] = vn[j]; s += (v[j].x * v[j].x + v[j].y * v[j].y) + (v[j].z * v[j].z + v[j].w * v[j].w); }
        { const int mn = m + NGW; if (mn < MT) { const float* xrow = (mn < MP) ? a.in[0] + (size_t)mn * DM : a.in[1] + (size_t)(mn - MP) * DM;
#pragma unroll
            for (int j = 0; j < 4; ++j) vn[j] = ((const GAS f32x4*)xrow + lane)[64 * j]; } }
        const float rstd = 1.0f / sqrtf(wave_sum(s) * (1.f / DM) + EPS);
        GAS unsigned long long* o8 = (GAS unsigned long long*)(XN + (size_t)m * DM) + lane;
        float dacc[8];
#pragma unroll
        for (int h = 0; h < 8; ++h) dacc[h] = 0.f;
#pragma unroll
        for (int j = 0; j < 4; ++j) {
            v[j] = v[j] * rstd;
            o8[64 * j] = (unsigned long long)pk2(v[j].x, v[j].y) | ((unsigned long long)pk2(v[j].z, v[j].w) << 32);
#pragma unroll
            for (int e = 0; e < 4; ++e) {
                const float xv = v[j][e];
                const LAS f32x4* d = (const LAS f32x4*)(dtw + (64 * j + lane) * 144 + e * 32);
                const f32x4 w0 = d[0], w1 = d[1];
                dacc[0] += xv * w0.x; dacc[1] += xv * w0.y; dacc[2] += xv * w0.z; dacc[3] += xv * w0.w;
                dacc[4] += xv * w1.x; dacc[5] += xv * w1.y; dacc[6] += xv * w1.z; dacc[7] += xv * w1.w;
            }
        }
#pragma unroll
        for (int h = 0; h < 8; ++h) dacc[h] = softplusf(wave_sum(dacc[h]) + dtb[h]);
        if (lane == 0) { *(f32x4*)(DT + (size_t)m * 8) = (f32x4){dacc[0], dacc[1], dacc[2], dacc[3]}; *(f32x4*)(DT + (size_t)m * 8 + 4) = (f32x4){dacc[4], dacc[5], dacc[6], dacc[7]}; }
        const float* prow = (m < MP) ? a.in[2] + (size_t)m * DPLE : a.in[3] + (size_t)(m - MP) * DPLE;
        const f32x4 pv = *((const f32x4*)prow + lane);
        *((GAS unsigned long long*)(PB + (size_t)m * DPLE) + lane) = (unsigned long long)pk2(pv.x, pv.y) | ((unsigned long long)pk2(pv.z, pv.w) << 32);
    }
}

__device__ __forceinline__ void conv_sample_pass(const Args& a, int gtid, int NT) {
    const bf16* PROJ = (const bf16*)(a.ws + WS_PROJ); float* XB = (float*)(a.ws + WS_XBS); bf16* XC = (bf16*)(a.ws + WS_XC);
    const float* cw = a.in[12]; const float* cb = a.in[13]; const float* sconv = a.in[7];
    for (int it = gtid; it < NBS * 128; it += NT) {
        const int b = it >> 7, c = (it & 127) * 8, m0 = MP + b * 8;
        float w0[8], w1[8], w2[8], w3[8], bb[8], x3[8], x2[8], x1[8];
        load8f(cw + c, w0); load8f(cw + 1024 + c, w1); load8f(cw + 2048 + c, w2); load8f(cw + 3072 + c, w3); load8f(cb + c, bb);
        load8f(sconv + (size_t)(b * 3 + 0) * 1024 + c, x3); load8f(sconv + (size_t)(b * 3 + 1) * 1024 + c, x2); load8f(sconv + (size_t)(b * 3 + 2) * 1024 + c, x1);
#pragma unroll
        for (int r = 0; r < 8; ++r) {
            float cur[8], y[8]; load8bf(PROJ + (size_t)(m0 + r) * NIN + PC_X + c, cur);
#pragma unroll
            for (int k = 0; k < 8; ++k) { y[k] = siluf(bb[k] + w0[k] * x3[k] + w1[k] * x2[k] + w2[k] * x1[k] + w3[k] * cur[k]); x3[k] = x2[k]; x2[k] = x1[k]; x1[k] = cur[k]; }
            float* o = XB + (size_t)(b * 8 + r) * 1024 + c;
            *(f32x4*)o = (f32x4){y[0], y[1], y[2], y[3]}; *(f32x4*)(o + 4) = (f32x4){y[4], y[5], y[6], y[7]};
            if (c < 512) { v4u w; w.x = pk2(y[0], y[1]); w.y = pk2(y[2], y[3]); w.z = pk2(y[4], y[5]); w.w = pk2(y[6], y[7]); *(v4u*)(XC + (size_t)(m0 + r) * 512 + c) = w; }
        }
    }
}

#ifndef S1SUB
#define S1SUB 7
#endif
constexpr int S1_BR = 0, S1_CR = 32768, S1_BT = 65536, S1_XT = 98304, S1_XW = 114688, S1_AC = 133120;
__device__ __forceinline__ void ssd_s1_unit(const Args& a, LAS unsigned char* lds, int unit, int tid, int wave, int lane) {
    asm volatile("" : "+v"(tid), "+v"(lane));
    const int h = unit & 7, c = (unit >> 3) & 31, b = unit >> 8, g = h >> 2, m0 = b * SEQ + c * 128;
    const bf16* PROJ = (const bf16*)(a.ws + WS_PROJ); const float* DT = (const float*)(a.ws + WS_DT);
    LAS float* ac = (LAS float*)(lds + S1_AC); LAS float* dts = ac + 128;
    const int r32 = lane & 31, hh = lane >> 5;
    const int o = tid % 40, rc = tid / 40, s0 = rc * 11;
    const int xcol = (o < 8) ? h * 64 + 8 * o : (o < 24) ? 512 + g * 128 + 8 * (o - 8) : 768 + g * 128 + 8 * (o - 24);
    const bool cact = tid < 480;
    v4u raw[14];
    if (cact) {
#pragma unroll
        for (int i = 0; i < 14; ++i) { int sr = s0 - 3 + i; sr = sr > 127 ? 127 : sr; if (c == 0 && sr < 0) sr = 0; raw[i] = *(const v4u*)(PROJ + (size_t)(m0 + sr) * NIN + PC_X + xcol); }
    }
    if (wave == 0) {
        const float A = -__expf(a.in[15][h]);
        const float d0 = DT[(size_t)(m0 + 2 * lane) * 8 + h], d1 = DT[(size_t)(m0 + 2 * lane + 1) * 8 + h];
        const float a0 = d0 * A, a1 = d1 * A; float v = a0 + a1;
#pragma unroll
        for (int d = 1; d < 64; d <<= 1) { const float n = __shfl_up(v, d); if (lane >= d) v += n; }
        const float e0 = v - a1, e1 = v;
        ac[2 * lane] = e0; ac[2 * lane + 1] = e1; dts[2 * lane] = d0; dts[2 * lane + 1] = d1;
        float* ACUM = (float*)(a.ws + WS_ACUM); ACUM[(size_t)(m0 + 2 * lane) * 8 + h] = e0; ACUM[(size_t)(m0 + 2 * lane + 1) * 8 + h] = e1;
        if (lane == 63) ((float*)(a.ws + WS_ACL))[(b * 32 + c) * 8 + h] = e1;
    }
    __syncthreads();
    if ((S1SUB & 1) && cact) {
        const float* cw = a.in[12]; const float* cb = a.in[13];
        float w0[8], w1[8], w2[8], w3[8], bb[8], x3[8], x2[8], x1[8];
        load8f(cw + xcol, w0); load8f(cw + 1024 + xcol, w1); load8f(cw + 2048 + xcol, w2); load8f(cw + 3072 + xcol, w3); load8f(cb + xcol, bb);
        const bool z0 = (c == 0 && rc == 0);
        { const v4u r3 = raw[0], r2 = raw[1], r1 = raw[2];
          x3[0] = bflo(r3.x); x3[1] = bfhi(r3.x); x3[2] = bflo(r3.y); x3[3] = bfhi(r3.y); x3[4] = bflo(r3.z); x3[5] = bfhi(r3.z); x3[6] = bflo(r3.w); x3[7] = bfhi(r3.w);
          x2[0] = bflo(r2.x); x2[1] = bfhi(r2.x); x2[2] = bflo(r2.y); x2[3] = bfhi(r2.y); x2[4] = bflo(r2.z); x2[5] = bfhi(r2.z); x2[6] = bflo(r2.w); x2[7] = bfhi(r2.w);
          x1[0] = bflo(r1.x); x1[1] = bfhi(r1.x); x1[2] = bflo(r1.y); x1[3] = bfhi(r1.y); x1[4] = bflo(r1.z); x1[5] = bfhi(r1.z); x1[6] = bflo(r1.w); x1[7] = bfhi(r1.w);
          if (z0) {
#pragma unroll
              for (int k = 0; k < 8; ++k) { x3[k] = 0.f; x2[k] = 0.f; x1[k] = 0.f; } } }
        const float aL = ac[127];
        bf16* XC = (bf16*)(a.ws + WS_XC); bf16* CC = (bf16*)(a.ws + WS_CC);
#pragma unroll
        for (int r = 0; r < 11; ++r) {
            const int sr = s0 + r;
            if (sr < 128) {
                const v4u rw = raw[3 + r]; float cur[8], y[8];
                cur[0] = bflo(rw.x); cur[1] = bfhi(rw.x); cur[2] = bflo(rw.y); cur[3] = bfhi(rw.y); cur[4] = bflo(rw.z); cur[5] = bfhi(rw.z); cur[6] = bflo(rw.w); cur[7] = bfhi(rw.w);
#pragma unroll
                for (int k = 0; k < 8; ++k) { y[k] = siluf(bb[k] + w0[k] * x3[k] + w1[k] * x2[k] + w2[k] * x1[k] + w3[k] * cur[k]); x3[k] = x2[k]; x2[k] = x1[k]; x1[k] = cur[k]; }
                v4u w; w.x = pk2(y[0], y[1]); w.y = pk2(y[2], y[3]); w.z = pk2(y[4], y[5]); w.w = pk2(y[6], y[7]);
                if (o < 8) {
                    const int off = (o >> 2) * 8192 + (sr >> 4) * 1024 + (sr & 15) * 64 + (o & 3) * 16;
                    *(LAS v4u*)(lds + S1_XT + off) = w;
                    const float de = __expf(aL - ac[sr]) * dts[sr];
                    v4u ww; ww.x = pk2(y[0] * de, y[1] * de); ww.y = pk2(y[2] * de, y[3] * de); ww.z = pk2(y[4] * de, y[5] * de); ww.w = pk2(y[6] * de, y[7] * de);
                    *(LAS v4u*)(lds + S1_XW + off) = ww;
                    *(v4u*)(XC + (size_t)(m0 + sr) * 512 + h * 64 + 8 * o) = w;
                } else if (o < 24) {
                    const int ch = o - 8;
                    *(LAS v4u*)(lds + S1_BR + sr * 256 + ((ch ^ (sr & 15)) << 4)) = w;
                    *(LAS v4u*)(lds + S1_BT + (ch >> 2) * 8192 + (sr >> 4) * 1024 + (sr & 15) * 64 + (ch & 3) * 16) = w;
                } else {
                    const int ch = o - 24;
                    *(LAS v4u*)(lds + S1_CR + sr * 256 + ((ch ^ (sr & 15)) << 4)) = w;
                    if ((h & 3) == 0) *(v4u*)(CC + (size_t)(m0 + sr) * 256 + g * 128 + 8 * ch) = w;
                }
            }
        }
    }
    __syncthreads();
    const int laneoff = ((lane >> 4) & 1) * 32 + (lane & 3) * 8 + (4 * hh + ((lane & 15) >> 2)) * 64;
    if (S1SUB & 2) {
        const int tb = wave >> 1, ph = wave & 1, tq = 32 * tb + r32;
        bf16x8 cq[8];
#pragma unroll
        for (int k = 0; k < 8; ++k) cq[k] = *(const LAS bf16x8*)(lds + S1_CR + tq * 256 + (((2 * k + hh) ^ (tq & 15)) << 4));
        const float act = ac[tq] * LOG2E;
        f32x16 o;
#pragma unroll
        for (int i = 0; i < 16; ++i) o[i] = 0.f;
#pragma unroll 1
        for (int sb = 0; sb <= tb; ++sb) {
            {
                f32x16 S;
#pragma unroll
                for (int i = 0; i < 16; ++i) S[i] = 0.f;
                const int sq = 32 * sb + r32;
#pragma unroll
                for (int k = 0; k < 8; ++k) { const bf16x8 bf = *(const LAS bf16x8*)(lds + S1_BR + sq * 256 + (((2 * k + hh) ^ (sq & 15)) << 4)); S = __builtin_amdgcn_mfma_f32_32x32x16_bf16(bf, cq[k], S, 0, 0, 0); }
#pragma unroll
                for (int i = 0; i < 16; ++i) { const int si = 32 * sb + crow(i, hh); const float e = __builtin_amdgcn_exp2f(act - ac[si] * LOG2E) * dts[si]; S[i] = (si <= tq) ? S[i] * e : 0.f; }
#pragma unroll
                for (int ks = 0; ks < 2; ++ks) {
                    v4u pw; pw.x = cvtpk_s(S[8 * ks + 0], S[8 * ks + 1]); pw.y = cvtpk_s(S[8 * ks + 2], S[8 * ks + 3]); pw.z = cvtpk_s(S[8 * ks + 4], S[8 * ks + 5]); pw.w = cvtpk_s(S[8 * ks + 6], S[8 * ks + 7]);
                    const bf16x8 pa = __builtin_bit_cast(bf16x8, pw);
                    const LAS unsigned char* xp = lds + S1_XT + ph * 8192 + (2 * sb + ks) * 1024 + laneoff;
                    const v4i16_t lo = vtr(xp), hi2 = vtr(xp + 512);
                    const bf16x8 xb = (bf16x8){lo[0], lo[1], lo[2], lo[3], hi2[0], hi2[1], hi2[2], hi2[3]};
                    o = __builtin_amdgcn_mfma_f32_32x32x16_bf16(pa, xb, o, 0, 0, 0);
                }
            }
        }
        float* YS = (float*)(a.ws + WS_YS);
#pragma unroll
        for (int i = 0; i < 16; ++i) YS[(size_t)(m0 + 32 * tb + crow(i, hh)) * 512 + h * 64 + 32 * ph + r32] = o[i];
    }
    if (S1SUB & 4) {
        const int pb = wave & 1, nb = wave >> 1;
        f32x16 st;
#pragma unroll
        for (int i = 0; i < 16; ++i) st[i] = 0.f;
#pragma unroll
        for (int k = 0; k < 8; ++k) {
            const LAS unsigned char* ap = lds + S1_XW + pb * 8192 + k * 1024 + laneoff; const LAS unsigned char* bp = lds + S1_BT + nb * 8192 + k * 1024 + laneoff;
            const v4i16_t al = vtr(ap), ah = vtr(ap + 512), bl = vtr(bp), bh = vtr(bp + 512);
            const bf16x8 af = (bf16x8){al[0], al[1], al[2], al[3], ah[0], ah[1], ah[2], ah[3]}, bf = (bf16x8){bl[0], bl[1], bl[2], bl[3], bh[0], bh[1], bh[2], bh[3]};
            st = __builtin_amdgcn_mfma_f32_32x32x16_bf16(af, bf, st, 0, 0, 0);
        }
        float* CS = (float*)(a.ws + WS_CS) + (size_t)((b * 32 + c) * 8 + h) * 64 * 128;
#pragma unroll
        for (int i = 0; i < 16; ++i) CS[(size_t)(32 * pb + crow(i, hh)) * 128 + 32 * nb + r32] = st[i];
    }
    LDS_WAIT(); __syncthreads();
}
constexpr int G1_BR = 0, G1_CR = 32768, G1_BT = 65536, G1_XT = 0  , G1_AC = 133120  ;
__device__ __forceinline__ void unpack8(const v4u w, float (&o)[8]) { o[0] = bflo(w.x); o[1] = bfhi(w.x); o[2] = bflo(w.y); o[3] = bfhi(w.y); o[4] = bflo(w.z); o[5] = bfhi(w.z); o[6] = bflo(w.w); o[7] = bfhi(w.w); }
__device__ __forceinline__ void ssd_s1g_unit(const Args& a, LAS unsigned char* lds, int unit, int tid, int wave, int lane) {
    asm volatile("" : "+v"(tid), "+v"(lane));
    const int g = unit & 1, c = (unit >> 1) & 31, b = unit >> 6, m0 = b * SEQ + c * 128;
    const bf16* PROJ = (const bf16*)(a.ws + WS_PROJ); const float* DT = (const float*)(a.ws + WS_DT);
    LAS float* ac = (LAS float*)(lds + G1_AC); LAS float* dts = ac + 512; LAS float* des = ac + 1024;
    const int r32 = lane & 31, hh = lane >> 5;
    const int oct = tid & 31, rc = tid >> 5, s0 = rc * 8;
    const int bccol = (oct < 16) ? 512 + g * 128 + 8 * oct : 768 + g * 128 + 8 * (oct - 16), xcol = g * 256 + 8 * oct;
    const bool z0 = (c == 0 && rc == 0);
    v4u rbc[11], rx[11];
#pragma unroll
    for (int i = 0; i < 11; ++i) { int sr = s0 - 3 + i; if (c == 0 && sr < 0) sr = 0; const bf16* p = PROJ + (size_t)(m0 + sr) * NIN + PC_X; rbc[i] = *(const v4u*)(p + bccol); rx[i] = *(const v4u*)(p + xcol); }
    if (wave < 4) {
        const int h = 4 * g + wave; const float A = -__expf(a.in[15][h]);
        const float d0 = DT[(size_t)(m0 + 2 * lane) * 8 + h], d1 = DT[(size_t)(m0 + 2 * lane + 1) * 8 + h];
        const float a0 = d0 * A, a1 = d1 * A; float v = a0 + a1;
#pragma unroll
        for (int d = 1; d < 64; d <<= 1) { const float n = __shfl_up(v, d); if (lane >= d) v += n; }
        const float e0 = v - a1, e1 = v, aL = __builtin_bit_cast(float, __builtin_amdgcn_readlane(__builtin_bit_cast(int, v), 63));
        ac[wave * 128 + 2 * lane] = e0; ac[wave * 128 + 2 * lane + 1] = e1; dts[wave * 128 + 2 * lane] = d0; dts[wave * 128 + 2 * lane + 1] = d1;
        des[wave * 128 + 2 * lane] = __expf(aL - e0) * d0; des[wave * 128 + 2 * lane + 1] = __expf(aL - e1) * d1;
        float* ACUM = (float*)(a.ws + WS_ACUM); ACUM[(size_t)(m0 + 2 * lane) * 8 + h] = e0; ACUM[(size_t)(m0 + 2 * lane + 1) * 8 + h] = e1;
        if (lane == 63) ((float*)(a.ws + WS_ACL))[(b * 32 + c) * 8 + h] = e1;
    }
    const float* cw = a.in[12]; const float* cb = a.in[13];
    {
        float w0[8], w1[8], w2[8], w3[8], bb[8], x3[8], x2[8], x1[8];
        load8f(cw + bccol, w0); load8f(cw + 1024 + bccol, w1); load8f(cw + 2048 + bccol, w2); load8f(cw + 3072 + bccol, w3); load8f(cb + bccol, bb);
        unpack8(rbc[0], x3); unpack8(rbc[1], x2); unpack8(rbc[2], x1);
        if (z0) {
#pragma unroll
            for (int k = 0; k < 8; ++k) { x3[k] = 0.f; x2[k] = 0.f; x1[k] = 0.f; } }
        bf16* CC = (bf16*)(a.ws + WS_CC);
#pragma unroll
        for (int r = 0; r < 8; ++r) {
            const int sr = s0 + r; float cur[8], y[8]; unpack8(rbc[3 + r], cur);
#pragma unroll
            for (int k = 0; k < 8; ++k) { y[k] = siluf(bb[k] + w0[k] * x3[k] + w1[k] * x2[k] + w2[k] * x1[k] + w3[k] * cur[k]); x3[k] = x2[k]; x2[k] = x1[k]; x1[k] = cur[k]; }
            v4u w; w.x = pk2(y[0], y[1]); w.y = pk2(y[2], y[3]); w.z = pk2(y[4], y[5]); w.w = pk2(y[6], y[7]);
            if (oct < 16) { const int ch = oct;
                *(LAS v4u*)(lds + G1_BR + sr * 256 + ((ch ^ (sr & 15)) << 4)) = w;
                *(LAS v4u*)(lds + G1_BT + (ch >> 2) * 8192 + (sr >> 4) * 1024 + (sr & 15) * 64 + (ch & 3) * 16) = w;
            } else { const int ch = oct - 16;
                *(LAS v4u*)(lds + G1_CR + sr * 256 + ((ch ^ (sr & 15)) << 4)) = w;
                *(v4u*)(CC + (size_t)(m0 + sr) * 256 + g * 128 + 8 * ch) = w; }
        }
    }
    LDS_WAIT(); __syncthreads();
    const int tb = wave >> 1, ph = wave & 1, tq = 32 * tb + r32;
    f32x16 S[4];
    {
        bf16x8 cq[8];
#pragma unroll
        for (int k = 0; k < 8; ++k) cq[k] = *(const LAS bf16x8*)(lds + G1_CR + tq * 256 + (((2 * k + hh) ^ (tq & 15)) << 4));
#pragma unroll
        for (int sb = 0; sb < 4; ++sb) {
#pragma unroll
            for (int i = 0; i < 16; ++i) S[sb][i] = 0.f;
            if (sb <= tb) { const int sq = 32 * sb + r32;
#pragma unroll
                for (int k = 0; k < 8; ++k) { const bf16x8 bf = *(const LAS bf16x8*)(lds + G1_BR + sq * 256 + (((2 * k + hh) ^ (sq & 15)) << 4)); S[sb] = __builtin_amdgcn_mfma_f32_32x32x16_bf16(bf, cq[k], S[sb], 0, 0, 0); } }
        }
    }
    LDS_WAIT(); __syncthreads();
    {
        float w0[8], w1[8], w2[8], w3[8], bb[8], x3[8], x2[8], x1[8];
        load8f(cw + xcol, w0); load8f(cw + 1024 + xcol, w1); load8f(cw + 2048 + xcol, w2); load8f(cw + 3072 + xcol, w3); load8f(cb + xcol, bb);
        unpack8(rx[0], x3); unpack8(rx[1], x2); unpack8(rx[2], x1);
        if (z0) {
#pragma unroll
            for (int k = 0; k < 8; ++k) { x3[k] = 0.f; x2[k] = 0.f; x1[k] = 0.f; } }
        bf16* XC = (bf16*)(a.ws + WS_XC); const int hl = oct >> 3, o = oct & 7;
#pragma unroll
        for (int r = 0; r < 8; ++r) {
            const int sr = s0 + r; float cur[8], y[8]; unpack8(rx[3 + r], cur);
#pragma unroll
            for (int k = 0; k < 8; ++k) { y[k] = siluf(bb[k] + w0[k] * x3[k] + w1[k] * x2[k] + w2[k] * x1[k] + w3[k] * cur[k]); x3[k] = x2[k]; x2[k] = x1[k]; x1[k] = cur[k]; }
            v4u w; w.x = pk2(y[0], y[1]); w.y = pk2(y[2], y[3]); w.z = pk2(y[4], y[5]); w.w = pk2(y[6], y[7]);
            *(LAS v4u*)(lds + G1_XT + hl * 16384 + (o >> 2) * 8192 + (sr >> 4) * 1024 + (sr & 15) * 64 + (o & 3) * 16) = w;
            *(v4u*)(XC + (size_t)(m0 + sr) * 512 + g * 256 + 8 * oct) = w;
        }
    }
    LDS_WAIT(); __syncthreads();
    const int laneoff = ((lane >> 4) & 1) * 32 + (lane & 3) * 8 + (4 * hh + ((lane & 15) >> 2)) * 64;
    float* YS = (float*)(a.ws + WS_YS);
#pragma unroll 1
    for (int hl = 0; hl < 4; ++hl) {
        const int h = 4 * g + hl; const LAS float* ach = ac + hl * 128; const LAS float* dth = dts + hl * 128;
        {
            const float act = ach[tq] * LOG2E;
            f32x16 o;
#pragma unroll
            for (int i = 0; i < 16; ++i) o[i] = 0.f;
#pragma unroll
            for (int sb = 0; sb < 4; ++sb) {
                if (sb <= tb) {
                    float M[16];
#pragma unroll
                    for (int i = 0; i < 16; ++i) { const int si = 32 * sb + crow(i, hh); const float e = __builtin_amdgcn_exp2f(act - ach[si] * LOG2E) * dth[si]; M[i] = (si <= tq) ? S[sb][i] * e : 0.f; }
#pragma unroll
                    for (int ks = 0; ks < 2; ++ks) {
                        v4u pw; pw.x = cvtpk_s(M[8 * ks + 0], M[8 * ks + 1]); pw.y = cvtpk_s(M[8 * ks + 2], M[8 * ks + 3]); pw.z = cvtpk_s(M[8 * ks + 4], M[8 * ks + 5]); pw.w = cvtpk_s(M[8 * ks + 6], M[8 * ks + 7]);
                        const bf16x8 pa = __builtin_bit_cast(bf16x8, pw);
                        const LAS unsigned char* xp = lds + G1_XT + hl * 16384 + ph * 8192 + (2 * sb + ks) * 1024 + laneoff;
                        const v4i16_t lo = vtr(xp), hi2 = vtr(xp + 512);
                        const bf16x8 xb = (bf16x8){lo[0], lo[1], lo[2], lo[3], hi2[0], hi2[1], hi2[2], hi2[3]};
                        o = __builtin_amdgcn_mfma_f32_32x32x16_bf16(pa, xb, o, 0, 0, 0);
                    }
                }
            }
#pragma unroll
            for (int i = 0; i < 16; ++i) YS[(size_t)(m0 + 32 * tb + crow(i, hh)) * 512 + h * 64 + 32 * ph + r32] = o[i];
        }
        {
            const int pb = wave & 1, nb = wave >> 1; const LAS float* deh = des + hl * 128;
            f32x16 st;
#pragma unroll
            for (int i = 0; i < 16; ++i) st[i] = 0.f;
#pragma unroll
            for (int k = 0; k < 8; ++k) {
                const LAS unsigned char* ap = lds + G1_XT + hl * 16384 + pb * 8192 + k * 1024 + laneoff; const LAS unsigned char* bp = lds + G1_BT + nb * 8192 + k * 1024 + laneoff;
                const v4i16_t al = vtr(ap), ah = vtr(ap + 512), bl = vtr(bp), bh = vtr(bp + 512);
                const f32x4 dl = *(const LAS f32x4*)(deh + 16 * k + 4 * hh), dh = *(const LAS f32x4*)(deh + 16 * k + 8 + 4 * hh);
                v4u aw;
                aw.x = pk2(bf2f((unsigned short)al[0]) * dl.x, bf2f((unsigned short)al[1]) * dl.y); aw.y = pk2(bf2f((unsigned short)al[2]) * dl.z, bf2f((unsigned short)al[3]) * dl.w);
                aw.z = pk2(bf2f((unsigned short)ah[0]) * dh.x, bf2f((unsigned short)ah[1]) * dh.y); aw.w = pk2(bf2f((unsigned short)ah[2]) * dh.z, bf2f((unsigned short)ah[3]) * dh.w);
                const bf16x8 af = __builtin_bit_cast(bf16x8, aw), bf = (bf16x8){bl[0], bl[1], bl[2], bl[3], bh[0], bh[1], bh[2], bh[3]};
                st = __builtin_amdgcn_mfma_f32_32x32x16_bf16(af, bf, st, 0, 0, 0);
            }
            float* CS = (float*)(a.ws + WS_CS) + (size_t)((b * 32 + c) * 8 + h) * 64 * 128;
#pragma unroll
            for (int i = 0; i < 16; ++i) CS[(size_t)(32 * pb + crow(i, hh)) * 128 + 32 * nb + r32] = st[i];
        }
    }
    LDS_WAIT(); __syncthreads();
}
__device__ __forceinline__ void ssd_s2_pass(const Args& a, int gtid, int NT) {
    typedef float f32x2t __attribute__((ext_vector_type(2)));
    const float* CS = (const float*)(a.ws + WS_CS); const float* ACL = (const float*)(a.ws + WS_ACL); bf16* PREV = (bf16*)(a.ws + WS_PREV);
    for (int it = gtid; it < NBP * 8 * 64 * 64; it += NT) {
        const int n2 = it & 63, p = (it >> 6) & 63, h = (it >> 12) & 7, b = it >> 15;
        f32x2t s = {0.f, 0.f};
#pragma unroll 8
        for (int c = 0; c < 32; ++c) {
            const size_t idx = ((size_t)((b * 32 + c) * 8 + h) * 64 + p) * 128 + 2 * n2;
            const f32x2t cs = *(const f32x2t*)(CS + idx); const float dec = __expf(ACL[(b * 32 + c) * 8 + h]);
            *(unsigned*)(PREV + idx) = pk2(s.x, s.y);
            s = s * dec + cs;
        }
        *(f32x2t*)(a.out + O_SP + ((size_t)((b * 8 + h) * 64 + p)) * 128 + 2 * n2) = s;
    }
}
__device__ __forceinline__ void ssd_s3_unit(const Args& a, int unit, int wave, int lane, float psc = 1.f) {
    asm volatile("" : "+v"(lane));
    const int h = unit & 7, c = (unit >> 3) & 31, b = unit >> 8, g = h >> 2, m0 = b * SEQ + c * 128;
    const int r32 = lane & 31, hh = lane >> 5, tb = wave >> 1, ph = wave & 1;
    const bf16* cp = (const bf16*)(a.ws + WS_CC) + (size_t)(m0 + 32 * tb + r32) * 256 + g * 128 + 8 * hh;
    const bf16* pp = (const bf16*)(a.ws + WS_PREV) + ((size_t)((b * 32 + c) * 8 + h) * 64 + 32 * ph + r32) * 128 + 8 * hh;
    bf16x8 cf[8], pf[8];
#pragma unroll
    for (int k = 0; k < 8; ++k) { cf[k] = *(const bf16x8*)(cp + 16 * k); pf[k] = *(const bf16x8*)(pp + 16 * k); }
    f32x16 acc;
#pragma unroll
    for (int i = 0; i < 16; ++i) acc[i] = 0.f;
#pragma unroll
    for (int k = 0; k < 8; ++k) acc = __builtin_amdgcn_mfma_f32_32x32x16_bf16(cf[k], pf[k], acc, 0, 0, 0);
    float* YS = (float*)(a.ws + WS_YS); const float* ACUM = (const float*)(a.ws + WS_ACUM);
#pragma unroll
    for (int i = 0; i < 16; ++i) { const size_t t = (size_t)(m0 + 32 * tb + crow(i, hh)); float* yp = YS + t * 512 + h * 64 + 32 * ph + r32; *yp = *yp + psc * __expf(ACUM[t * 8 + h]) * acc[i]; }
}

constexpr int ATT_WAVE_BYTES = 8704, ATT_VB = 0, ATT_STG = 4096, ATT_WSF = 8192, ATT_BTAB_OFF = 98304, ATT_BT_LD = 132;

__device__ __forceinline__ void attn_build_btab(const Args& a, LAS unsigned char* lds, int tid) {
    LAS float* bt = (LAS float*)(lds + ATT_BTAB_OFF); const float* rb = a.in[9];
    for (int i = tid; i < 3 * 8 * 129; i += NWAVES * 64) { const int br = i / (8 * 129), rem = i % (8 * 129), h = rem / 129, j = rem % 129; bt[(br * 8 + h) * ATT_BT_LD + j] = rb[BUCKET_TAB[br][j] * 8 + h] * LOG2E; }
}
__device__ __forceinline__ void attn_prompt_unit(const Args& a, LAS unsigned char* lds, int unit, int wave, int lane) {
    asm volatile("" : "+v"(lane));
    const bf16* PROJ = (const bf16*)(a.ws + WS_PROJ);
    const int r32 = lane & 31, hi = lane >> 5;
    const int rq = unit & 127, bhb = unit >> 7, br = bhb % 3, bh = bhb / 3, h = bh & 7, b = bh >> 3;
    const int sh = 2 * br, dil = 1 << sh, nqb = 128 >> sh, r = rq / nqb, qb = rq % nqb, l0 = qb * 32;
    const size_t rowb = (size_t)b * SEQ;
    LAS unsigned char* wl = lds + wave * ATT_WAVE_BYTES;
    const LAS float* bt = (const LAS float*)(lds + ATT_BTAB_OFF) + (br * 8 + h) * ATT_BT_LD;
    bf16x8 qr[4];
    { const bf16* qp = PROJ + (rowb + (size_t)(l0 + r32) * dil + r) * NIN + h * 64 + hi * 8;
#pragma unroll
      for (int d0 = 0; d0 < 4; ++d0) qr[d0] = *(const bf16x8*)(qp + d0 * 16); }
    const int kb0 = (l0 >= 128) ? 0 : (4 - (l0 >> 5));
    f32x16 s[5];
    bf16x8 kfa[4], kfb[4];
#define ATT_KLOAD(dst, kb_) do { int kk_ = l0 - 128 + 32 * (kb_) + r32; kk_ = kk_ < 0 ? 0 : kk_; const bf16* kp_ = PROJ + (rowb + (size_t)kk_ * dil + r) * NIN + PC_K + h * 64 + hi * 8; \
        _Pragma("unroll") for (int d0 = 0; d0 < 4; ++d0) dst[d0] = *(const bf16x8*)(kp_ + d0 * 16); } while (0)
#define ATT_QK(src, kb_) do { _Pragma("unroll") for (int i = 0; i < 16; ++i) s[kb_][i] = 0.f; \
        if ((kb_) >= kb0) { _Pragma("unroll") for (int d0 = 0; d0 < 4; ++d0) s[kb_] = __builtin_amdgcn_mfma_f32_32x32x16_bf16(src[d0], qr[d0], s[kb_], 0, 0, 0); } } while (0)
    ATT_KLOAD(kfa, 0); ATT_KLOAD(kfb, 1);
    __builtin_amdgcn_sched_barrier(0);
    ATT_QK(kfa, 0); ATT_KLOAD(kfa, 2);
    __builtin_amdgcn_sched_barrier(0);
    ATT_QK(kfb, 1); ATT_KLOAD(kfb, 3);
    __builtin_amdgcn_sched_barrier(0);
    ATT_QK(kfa, 2); ATT_KLOAD(kfa, 4);
    __builtin_amdgcn_sched_barrier(0);
    ATT_QK(kfb, 3);
    __builtin_amdgcn_sched_barrier(0);
    ATT_QK(kfa, 4);
#undef ATT_KLOAD
#undef ATT_QK
    __builtin_amdgcn_sched_barrier(0);
    v4u vpre[5][4];
#pragma unroll
    for (int kb = 0; kb < 3; ++kb)
#pragma unroll
        for (int i = 0; i < 4; ++i) {
            const int idx = i * 64 + lane, key = idx >> 3, ch = idx & 7;
            int kk = l0 - 128 + 32 * kb + key; kk = kk < 0 ? 0 : kk;
            vpre[kb][i] = *(const v4u*)(PROJ + (rowb + (size_t)kk * dil + r) * NIN + PC_V + h * 64 + ch * 8);
        }
    __builtin_amdgcn_sched_barrier(0);
    float mx = -INFINITY;
    int J0 = r32 - 4 * hi + 128, T0 = 128 - l0 - 4 * hi;
    asm volatile("" : "+v"(J0), "+v"(T0));
#pragma unroll
    for (int kb = 0; kb < 5; ++kb)
#pragma unroll
        for (int i = 0; i < 16; ++i) {
            const int cst = (i & 3) + 8 * (i >> 2) + 32 * kb, j = J0 - cst;
            const bool valid = ((unsigned)j <= 128u) && (cst >= T0) && (kb >= kb0);
            const int jc = j < 0 ? 0 : (j > 128 ? 128 : j);
            const float v = valid ? s[kb][i] + bt[jc] : -INFINITY;
            s[kb][i] = v; mx = fmaxf(mx, v);
        }
    mx = fmaxf(mx, __shfl_xor(mx, 32));
    float l = 0.f;
#pragma unroll
    for (int kb = 0; kb < 5; ++kb)
#pragma unroll
        for (int i = 0; i < 16; ++i) { const float p = __builtin_amdgcn_exp2f(s[kb][i] - mx); s[kb][i] = p; l += p; }
    l += __shfl_xor(l, 32);
    __builtin_amdgcn_sched_barrier(0);
#pragma unroll
    for (int kb = 3; kb < 5; ++kb)
#pragma unroll
        for (int i = 0; i < 4; ++i) {
            const int idx = i * 64 + lane, key = idx >> 3, ch = idx & 7;
            int kk = l0 - 128 + 32 * kb + key; kk = kk < 0 ? 0 : kk;
            vpre[kb][i] = *(const v4u*)(PROJ + (rowb + (size_t)kk * dil + r) * NIN + PC_V + h * 64 + ch * 8);
        }
    f32x16 o[2];
#pragma unroll
    for (int i = 0; i < 16; ++i) { o[0][i] = 0.f; o[1][i] = 0.f; }
    const LAS unsigned char* vrd = wl + ATT_VB + ((lane >> 4) & 1) * 32 + (lane & 3) * 8 + (4 * hi + ((lane & 15) >> 2)) * 64;
#pragma unroll
    for (int kb = 0; kb < 5; ++kb) {
        if (kb >= kb0) {
#pragma unroll
            for (int i = 0; i < 4; ++i) {
                const int idx = i * 64 + lane, key = idx >> 3, ch = idx & 7;
                *(LAS v4u*)(wl + ATT_VB + (ch >> 2) * 2048 + (key >> 4) * 1024 + (key & 15) * 64 + (ch & 3) * 16) = vpre[kb][i];
            }
            LDS_WAIT();
#pragma unroll
            for (int ks = 0; ks < 2; ++ks) {
                v4u pw;
                pw.x = cvtpk_s(s[kb][8 * ks + 0], s[kb][8 * ks + 1]); pw.y = cvtpk_s(s[kb][8 * ks + 2], s[kb][8 * ks + 3]);
                pw.z = cvtpk_s(s[kb][8 * ks + 4], s[kb][8 * ks + 5]); pw.w = cvtpk_s(s[kb][8 * ks + 6], s[kb][8 * ks + 7]);
                const bf16x8 pa = __builtin_bit_cast(bf16x8, pw);
#pragma unroll
                for (int d0 = 0; d0 < 2; ++d0) {
                    const v4i16_t lo = vtr(vrd + d0 * 2048 + ks * 1024), hh = vtr(vrd + d0 * 2048 + ks * 1024 + 512);
                    const bf16x8 vb = (bf16x8){lo[0], lo[1], lo[2], lo[3], hh[0], hh[1], hh[2], hh[3]};
                    o[d0] = __builtin_amdgcn_mfma_f32_32x32x16_bf16(pa, vb, o[d0], 0, 0, 0);
                }
            }
            LDS_WAIT();
        }
    }
    LAS float* wsf = (LAS float*)(wl + ATT_WSF);
    if (hi == 0) wsf[r32] = l;
    LDS_WAIT();
    LAS bf16* stg = (LAS bf16*)(wl + ATT_STG);
#pragma unroll
    for (int i = 0; i < 16; ++i) {
        const int orow = crow(i, hi); const float rl = 1.0f / wsf[orow];
        stg[orow * 64 + r32] = (bf16)f2bf(o[0][i] * rl); stg[orow * 64 + 32 + r32] = (bf16)f2bf(o[1][i] * rl);
    }
    LDS_WAIT();
    bf16* OBR = (bf16*)(a.ws + WS_OBR) + (size_t)br * MP * 512;
#pragma unroll
    for (int i = 0; i < 4; ++i) {
        const int row = i * 8 + (lane >> 3), ch = lane & 7;
        const v4u v = *(const LAS v4u*)(stg + row * 64 + ch * 8);
        *(v4u*)(OBR + (rowb + (size_t)(l0 + row) * dil + r) * 512 + h * 64 + ch * 8) = v;
    }
    if (hi == 0) { float* LSE = (float*)(a.ws + WS_LSE) + (size_t)br * MP * 8; LSE[(rowb + (size_t)(l0 + r32) * dil + r) * 8 + h] = mx + __builtin_amdgcn_logf(l); }
    LDS_WAIT();
}

constexpr int AW_K = 0, AW_V = 49152, AW_WSF = 110976;
struct AwUnit { int b, h, br, dil, r, L0; };
__device__ __forceinline__ AwUnit aw_decode(int unit) {
    AwUnit u; const int wq = unit & 15, bhb = unit >> 4; u.br = bhb % 3; const int bh = bhb / 3; u.h = bh & 7; u.b = bh >> 3;
    const int sh = 2 * u.br, nqb = 128 >> sh, rq0 = wq * 8; u.dil = 1 << sh; u.r = rq0 / nqb; u.L0 = (rq0 % nqb) * 32; return u;
}
__device__ __forceinline__ void aw_issue(const Args& a, const AwUnit& u, int tid, v4u (&kr)[6], v4u (&vr)[6]) {
    const bf16* PROJ = (const bf16*)(a.ws + WS_PROJ);
#pragma unroll
    for (int i = 0; i < 6; ++i) {
        const int id = tid + 512 * i, slot = id >> 3, ch = id & 7; int kk = u.L0 - 128 + slot; kk = kk < 0 ? 0 : kk;
        const bf16* p = PROJ + ((size_t)u.b * SEQ + (size_t)kk * u.dil + u.r) * NIN + u.h * 64 + ch * 8;
        kr[i] = *(const v4u*)(p + PC_K); vr[i] = *(const v4u*)(p + PC_V);
    }
}
__device__ __forceinline__ void attn_prompt_wg(const Args& a, LAS unsigned char* lds, int vcu, int G, int tid, int wave, int lane) {
    asm volatile("" : "+v"(tid), "+v"(lane));
    const bf16* PROJ = (const bf16*)(a.ws + WS_PROJ);
    const int r32 = lane & 31, hi = lane >> 5;
    constexpr int NUNITS = NBP * NH * 3 * 16;
    int unit = vcu; if (unit >= NUNITS) return;
    AwUnit u = aw_decode(unit);
    v4u kr[6], vr[6];
    aw_issue(a, u, tid, kr, vr);
    for (;;) {
#pragma unroll
        for (int i = 0; i < 6; ++i) {
            const int id = tid + 512 * i, slot = id >> 3, ch = id & 7;
            *(LAS v4u*)(lds + AW_K + slot * 128 + ((ch ^ (slot & 7)) << 4)) = kr[i];
            *(LAS v4u*)(lds + AW_V + (ch >> 2) * 24576 + (slot >> 4) * 1024 + (slot & 15) * 64 + (ch & 3) * 16) = vr[i];
        }
        const AwUnit cu = u; const int nunit = unit + G; const bool more = nunit < NUNITS;
        const int l0 = cu.L0 + 32 * wave, dil = cu.dil, h = cu.h, r = cu.r; const size_t rowb = (size_t)cu.b * SEQ;
        bf16x8 qr[4];
        { const bf16* qp = PROJ + (rowb + (size_t)(l0 + r32) * dil + r) * NIN + h * 64 + hi * 8;
#pragma unroll
          for (int d0 = 0; d0 < 4; ++d0) qr[d0] = *(const bf16x8*)(qp + d0 * 16); }
        LDS_WAIT(); __syncthreads();
        if (more) { u = aw_decode(nunit); aw_issue(a, u, tid, kr, vr); }
        const LAS float* bt = (const LAS float*)(lds + ATT_BTAB_OFF) + (cu.br * 8 + h) * ATT_BT_LD;
        const int kb0 = (l0 >= 128) ? 0 : (4 - (l0 >> 5));
        f32x16 s[5];
#pragma unroll
        for (int kb = 0; kb < 5; ++kb) {
#pragma unroll
            for (int i = 0; i < 16; ++i) s[kb][i] = 0.f;
            if (kb >= kb0) {
                const int row = 32 * wave + 32 * kb + r32;
#pragma unroll
                for (int d0 = 0; d0 < 4; ++d0) { const bf16x8 kf = *(const LAS bf16x8*)(lds + AW_K + row * 128 + (((2 * d0 + hi) ^ (row & 7)) << 4)); s[kb] = __builtin_amdgcn_mfma_f32_32x32x16_bf16(kf, qr[d0], s[kb], 0, 0, 0); }
            }
        }
        float mx = -INFINITY;
        int J0 = r32 - 4 * hi + 128, T0 = 128 - l0 - 4 * hi;
        asm volatile("" : "+v"(J0), "+v"(T0));
#pragma unroll
        for (int kb = 0; kb < 5; ++kb)
#pragma unroll
            for (int i = 0; i < 16; ++i) {
                const int cst = (i & 3) + 8 * (i >> 2) + 32 * kb, j = J0 - cst;
                const bool valid = ((unsigned)j <= 128u) && (cst >= T0) && (kb >= kb0);
                const int jc = j < 0 ? 0 : (j > 128 ? 128 : j);
                const float v = valid ? s[kb][i] + bt[jc] : -INFINITY;
                s[kb][i] = v; mx = fmaxf(mx, v);
            }
        mx = fmaxf(mx, __shfl_xor(mx, 32));
        float l = 0.f;
#pragma unroll
        for (int kb = 0; kb < 5; ++kb)
#pragma unroll
            for (int i = 0; i < 16; ++i) { const float p = __builtin_amdgcn_exp2f(s[kb][i] - mx); s[kb][i] = p; l += p; }
        l += __shfl_xor(l, 32);
        f32x16 o[2];
#pragma unroll
        for (int i = 0; i < 16; ++i) { o[0][i] = 0.f; o[1][i] = 0.f; }
        const int laneoff = ((lane >> 4) & 1) * 32 + (lane & 3) * 8 + (4 * hi + ((lane & 15) >> 2)) * 64;
#pragma unroll
        for (int kb = 0; kb < 5; ++kb) {
            if (kb >= kb0) {
#pragma unroll
                for (int ks = 0; ks < 2; ++ks) {
                    v4u pw;
                    pw.x = cvtpk_s(s[kb][8 * ks + 0], s[kb][8 * ks + 1]); pw.y = cvtpk_s(s[kb][8 * ks + 2], s[kb][8 * ks + 3]);
                    pw.z = cvtpk_s(s[kb][8 * ks + 4], s[kb][8 * ks + 5]); pw.w = cvtpk_s(s[kb][8 * ks + 6], s[kb][8 * ks + 7]);
                    const bf16x8 pa = __builtin_bit_cast(bf16x8, pw);
#pragma unroll
                    for (int d0 = 0; d0 < 2; ++d0) {
                        const LAS unsigned char* vp = lds + AW_V + d0 * 24576 + (2 * (wave + kb) + ks) * 1024 + laneoff;
                        const v4i16_t lo = vtr(vp), hh = vtr(vp + 512);
                        const bf16x8 vb = (bf16x8){lo[0], lo[1], lo[2], lo[3], hh[0], hh[1], hh[2], hh[3]};
                        o[d0] = __builtin_amdgcn_mfma_f32_32x32x16_bf16(pa, vb, o[d0], 0, 0, 0);
                    }
                }
            }
        }
        LAS float* wsf = (LAS float*)(lds + AW_WSF) + wave * 64;
        if (hi == 0) wsf[r32] = l;
        LDS_WAIT(); __syncthreads();
        LAS bf16* stg = (LAS bf16*)(lds + AW_K + wave * 4096);
#pragma unroll
        for (int i = 0; i < 16; ++i) {
            const int orow = crow(i, hi); const float rl = __builtin_amdgcn_rcpf(wsf[orow]);
            stg[orow * 64 + r32] = (bf16)f2bf(o[0][i] * rl); stg[orow * 64 + 32 + r32] = (bf16)f2bf(o[1][i] * rl);
        }
        LDS_WAIT();
        bf16* OBR = (bf16*)(a.ws + WS_OBR) + (size_t)cu.br * MP * 512;
#pragma unroll
        for (int i = 0; i < 4; ++i) {
            const int row = i * 8 + (lane >> 3), ch = lane & 7;
            const v4u v = *(const LAS v4u*)(stg + row * 64 + ch * 8);
            *(v4u*)(OBR + (rowb + (size_t)(l0 + row) * dil + r) * 512 + h * 64 + ch * 8) = v;
        }
        if (hi == 0) { float* LSE = (float*)(a.ws + WS_LSE) + (size_t)cu.br * MP * 8; LSE[(rowb + (size_t)(l0 + r32) * dil + r) * 8 + h] = mx + __builtin_amdgcn_logf(l); }
        LDS_WAIT(); __syncthreads();
        if (!more) break;
        unit = nunit;
    }
}

__device__ __forceinline__ void attn_sample_task(const Args& a, LAS unsigned char* lds, int task, int wave, int lane) {
    const int h = task & 7, t = (task >> 3) & 7, b = task >> 6;
    const bf16* PROJ = (const bf16*)(a.ws + WS_PROJ);
    const float* ck = a.in[4]; const float* cv = a.in[5]; const float* kn = a.out + O_KS; const float* vn = a.out + O_VS;
    LAS float* pl = (LAS float*)(lds + wave * ATT_WAVE_BYTES + ATT_STG);
    const int ks = lane >> 4, dq = lane & 15;
    f32x4 q4;
    { const u32x2 w = *(const u32x2*)(PROJ + (size_t)(MP + b * 8 + t) * NIN + h * 64 + 4 * dq); q4 = (f32x4){bflo(w.x), bfhi(w.x), bflo(w.y), bfhi(w.y)}; }
    const size_t cbase = ((size_t)b * WBUF * 8 + h) * 64 + 4 * dq, nbase = ((size_t)b * 8 * 8 + h) * 64 + 4 * dq;
#pragma unroll 1
    for (int br = 0; br < 3; ++br) {
        const int dil = 1 << (2 * br);
        const LAS float* bt = (const LAS float*)(lds + ATT_BTAB_OFF) + (br * 8 + h) * ATT_BT_LD;
#pragma unroll 1
        for (int it0 = 0; it0 < 33; it0 += 11) {
            f32x4 kv[11];
#pragma unroll
            for (int u = 0; u < 11; ++u) { int j = 4 * (it0 + u) + ks; j = j > 128 ? 128 : j; const int idx = WBUF + t - j * dil;
                kv[u] = (idx < WBUF) ? *(const f32x4*)(ck + cbase + (size_t)idx * 512) : *(const f32x4*)(kn + nbase + (size_t)(idx - WBUF) * 512); }
#pragma unroll
            for (int u = 0; u < 11; ++u) { const int j = 4 * (it0 + u) + ks; float d = q4.x * kv[u].x + q4.y * kv[u].y + q4.z * kv[u].z + q4.w * kv[u].w; d = row16_sum(d);
                if (dq == 0 && j <= 128) pl[br * ATT_BT_LD + j] = d + bt[j]; }
        }
    }
    LDS_WAIT(); asm volatile("" ::: "memory");
    float mx = -INFINITY;
#pragma unroll 1
    for (int i = lane; i < 3 * ATT_BT_LD; i += 64) { const int j = i % ATT_BT_LD; if (j <= 128) mx = fmaxf(mx, pl[i]); }
    mx = wave_max(mx);
    float l = 0.f;
#pragma unroll 1
    for (int i = lane; i < 3 * ATT_BT_LD; i += 64) { const int j = i % ATT_BT_LD; if (j <= 128) { const float p = __builtin_amdgcn_exp2f(pl[i] - mx); pl[i] = p; l += p; } }
    l = wave_sum(l);
    LDS_WAIT(); asm volatile("" ::: "memory");
    f32x4 o4 = {0.f, 0.f, 0.f, 0.f};
#pragma unroll 1
    for (int br = 0; br < 3; ++br) {
        const int dil = 1 << (2 * br);
#pragma unroll 1
        for (int it0 = 0; it0 < 33; it0 += 11) {
            f32x4 vv[11]; float pp[11];
#pragma unroll
            for (int u = 0; u < 11; ++u) { const int j0 = 4 * (it0 + u) + ks, j = j0 > 128 ? 128 : j0; const int idx = WBUF + t - j * dil;
                vv[u] = (idx < WBUF) ? *(const f32x4*)(cv + cbase + (size_t)idx * 512) : *(const f32x4*)(vn + nbase + (size_t)(idx - WBUF) * 512);
                pp[u] = (j0 <= 128) ? pl[br * ATT_BT_LD + j] : 0.f; }
#pragma unroll
            for (int u = 0; u < 11; ++u) o4 += vv[u] * pp[u];
        }
    }
#pragma unroll
    for (int e = 0; e < 4; ++e) { o4[e] += __shfl_xor(o4[e], 16); o4[e] += __shfl_xor(o4[e], 32); }
    if (lane < 16) { const float il = 1.f / l; u32x2 w; w.x = pk2(o4.x * il, o4.y * il); w.y = pk2(o4.z * il, o4.w * il);
        *(u32x2*)((bf16*)(a.ws + WS_MIX) + (size_t)(MP + b * 8 + t) * DM + h * 64 + 4 * dq) = w; }
    LDS_WAIT(); asm volatile("" ::: "memory");
}

__device__ __forceinline__ void ssd_sample_task(const Args& a, int k, int lane) {
    const float* XB = (const float*)(a.ws + WS_XBS); const float* DT = (const float*)(a.ws + WS_DT); float* YS = (float*)(a.ws + WS_YS);
    const int p4 = k & 15, h = (k >> 4) & 7, b = k >> 7, g = h >> 2, p = 4 * p4 + (lane >> 4), ng = lane & 15;
    const size_t sidx = ((size_t)((b * 8 + h) * 64 + p)) * 128 + 8 * ng;
    float s[8]; load8f(a.in[6] + sidx, s);
    const float A = -__expf(a.in[15][h]);
#pragma unroll 1
    for (int t0 = 0; t0 < TS; t0 += 4) {
        float dtv[4], xv[4], Bv[4][8], Cv[4][8];
#pragma unroll
        for (int q = 0; q < 4; ++q) { const int r = b * TS + t0 + q; dtv[q] = DT[(size_t)(MP + r) * 8 + h]; const float* xr = XB + (size_t)r * 1024; xv[q] = xr[h * 64 + p]; load8f(xr + 512 + g * 128 + 8 * ng, Bv[q]); load8f(xr + 768 + g * 128 + 8 * ng, Cv[q]); }
#pragma unroll
        for (int q = 0; q < 4; ++q) {
            const float da = __expf(dtv[q] * A), xd = dtv[q] * xv[q]; float y = 0.f;
#pragma unroll
            for (int e = 0; e < 8; ++e) { s[e] = da * s[e] + xd * Bv[q][e]; y += Cv[q][e] * s[e]; }
            y = row16_sum(y);
            if (ng == 0) YS[(size_t)(MP + b * TS + t0 + q) * 512 + h * 64 + p] = y;
        }
    }
    float* so = a.out + O_SS + sidx;
    *(f32x4*)so = (f32x4){s[0], s[1], s[2], s[3]}; *(f32x4*)(so + 4) = (f32x4){s[4], s[5], s[6], s[7]};
}
__device__ __forceinline__ void attn_combine_pass(const Args& a, int gtid, int NT) {
    const bf16* OBR = (const bf16*)(a.ws + WS_OBR); const float* LSE = (const float*)(a.ws + WS_LSE); bf16* MIX = (bf16*)(a.ws + WS_MIX);
    for (int it = gtid; it < MP * 64; it += NT) {
        const int row = it >> 6, c8 = it & 63, h = c8 >> 3;
        const float l0 = LSE[(size_t)row * 8 + h], l1 = LSE[(size_t)(MP + row) * 8 + h], l2 = LSE[(size_t)(2 * MP + row) * 8 + h];
        const float mx = fmaxf(l0, fmaxf(l1, l2));
        float w0 = __builtin_amdgcn_exp2f(l0 - mx), w1 = __builtin_amdgcn_exp2f(l1 - mx), w2 = __builtin_amdgcn_exp2f(l2 - mx);
        const float inv = 1.f / (w0 + w1 + w2); w0 *= inv; w1 *= inv; w2 *= inv;
        float o0[8], o1[8], o2[8];
        load8bf(OBR + (size_t)row * 512 + c8 * 8, o0); load8bf(OBR + ((size_t)MP + row) * 512 + c8 * 8, o1); load8bf(OBR + ((size_t)2 * MP + row) * 512 + c8 * 8, o2);
        float r[8];
#pragma unroll
        for (int k = 0; k < 8; ++k) r[k] = w0 * o0[k] + w1 * o1[k] + w2 * o2[k];
        v4u w; w.x = pk2(r[0], r[1]); w.y = pk2(r[2], r[3]); w.z = pk2(r[4], r[5]); w.w = pk2(r[6], r[7]);
        *(v4u*)(MIX + (size_t)row * DM + c8 * 8) = w;
    }
}
__device__ __forceinline__ void ssd_finish_pass(const Args& a, int gw, int NGW, int lane) {
    const bf16* XC = (const bf16*)(a.ws + WS_XC); const float* YS = (const float*)(a.ws + WS_YS); const bf16* PROJ = (const bf16*)(a.ws + WS_PROJ); bf16* MIX = (bf16*)(a.ws + WS_MIX);
    const float* dsk = a.in[16]; const float* gs = a.in[17];
    const int c = lane * 8; const float dh = dsk[c >> 6];
    float g8[8]; load8f(gs + c, g8);
    for (int m = gw; m < MT; m += NGW) {
        float y[8], x[8], z[8], v[8]; load8f(YS + (size_t)m * 512 + c, y); load8bf(XC + (size_t)m * 512 + c, x); load8bf(PROJ + (size_t)m * NIN + PC_Z + c, z);
        float ss = 0.f;
#pragma unroll
        for (int k = 0; k < 8; ++k) { v[k] = (y[k] + dh * x[k]) * siluf(z[k]); ss += v[k] * v[k]; }
#pragma unroll
        for (int o = 1; o < 32; o <<= 1) ss += __shfl_xor(ss, o);
        const float rs = 1.0f / sqrtf(ss * (1.f / 256.f) + EPS);
        v4u w; w.x = pk2(v[0] * rs * g8[0], v[1] * rs * g8[1]); w.y = pk2(v[2] * rs * g8[2], v[3] * rs * g8[3]); w.z = pk2(v[4] * rs * g8[4], v[5] * rs * g8[5]); w.w = pk2(v[6] * rs * g8[6], v[7] * rs * g8[7]);
        *(v4u*)(MIX + (size_t)m * DM + 512 + c) = w;
    }
}
__device__ __forceinline__ void ffn_fixup_pass(const Args& a, int gtid, int NT) {
    const float* UH = (const float*)(a.ws + WS_UH); const float* US = (const float*)(a.ws + WS_US); bf16* ACT = (bf16*)(a.ws + WS_ACT);
    const float* fw = a.in[21]; const float* fb = a.in[22]; const float* sf = a.in[8];
    constexpr int NC8 = DFF / 8, NPT = MP / 256, NITEMS = (NPT + NBS) * NC8;
    for (int it = gtid; it < NITEMS; it += NT) {
        const int blk = it / NC8, c = (it % NC8) * 8;
        float wa0[8], wa1[8], wa2[8], wb0[8], wb1[8], wb2[8], ba[8], bb[8], a2[8], a1[8], b2[8], b1[8];
        load8f(fw + c, wa0); load8f(fw + DFF2 + c, wa1); load8f(fw + 2 * DFF2 + c, wa2); load8f(fb + c, ba);
        load8f(fw + DFF + c, wb0); load8f(fw + DFF2 + DFF + c, wb1); load8f(fw + 2 * DFF2 + DFF + c, wb2); load8f(fb + DFF + c, bb);
        const float* src; int m0, nr;
        if (blk < NPT) { m0 = blk * 256; nr = 2; src = UH + (size_t)(blk * 4) * DFF2;
            if ((blk & 15) == 0) {
#pragma unroll
                for (int k = 0; k < 8; ++k) { a2[k] = 0.f; a1[k] = 0.f; b2[k] = 0.f; b1[k] = 0.f; }
            } else { const float* pv = UH + (size_t)((blk - 1) * 4 + 2) * DFF2; load8f(pv + c, a2); load8f(pv + DFF2 + c, a1); load8f(pv + DFF + c, b2); load8f(pv + DFF2 + DFF + c, b1); }
        } else { const int b = blk - NPT; m0 = MP + b * 8; nr = 8; src = US + (size_t)(b * 8) * DFF2;
            load8f(sf + (size_t)(b * 2) * DFF2 + c, a2); load8f(sf + (size_t)(b * 2 + 1) * DFF2 + c, a1); load8f(sf + (size_t)(b * 2) * DFF2 + DFF + c, b2); load8f(sf + (size_t)(b * 2 + 1) * DFF2 + DFF + c, b1); }
        for (int r = 0; r < nr; ++r) {
            float ua[8], ub[8], o[8]; load8f(src + (size_t)r * DFF2 + c, ua); load8f(src + (size_t)r * DFF2 + DFF + c, ub);
#pragma unroll
            for (int k = 0; k < 8; ++k) {
                const float ya = ba[k] + wa0[k] * a2[k] + wa1[k] * a1[k] + wa2[k] * ua[k], yb = bb[k] + wb0[k] * b2[k] + wb1[k] * b1[k] + wb2[k] * ub[k];
                o[k] = siluf(ya) * yb; a2[k] = a1[k]; a1[k] = ua[k]; b2[k] = b1[k]; b1[k] = ub[k];
            }
            v4u w; w.x = pk2(o[0], o[1]); w.y = pk2(o[2], o[3]); w.z = pk2(o[4], o[5]); w.w = pk2(o[6], o[7]);
            *(v4u*)(ACT + (size_t)(m0 + r) * DFF + c) = w;
        }
    }
}
__device__ __forceinline__ void final_norm_pass(const Args& a, int gw, int NGW, int lane) {
    const float* RS3 = (const float*)(a.ws + WS_RS3); const float* gf = a.in[27]; const bf16* H3b = (const bf16*)(a.ws + WS_MIX);
    float g[16];
    load8f(gf + lane * 16, *(float(*)[8])&g[0]); load8f(gf + lane * 16 + 8, *(float(*)[8])&g[8]);
    for (int m = gw; m < MT; m += NGW) {
        float* orow = (m < MP) ? a.out + O_Y + (size_t)m * DM : a.out + O_YS + (size_t)(m - MP) * DM;
        const float rs = 1.0f / sqrtf(RS3[m] * (1.f / DM) + EPS);
        float h[16]; load8bf(H3b + (size_t)m * DM + lane * 16, *(float(*)[8])&h[0]); load8bf(H3b + (size_t)m * DM + lane * 16 + 8, *(float(*)[8])&h[8]);
#pragma unroll
        for (int j = 0; j < 4; ++j) *(f32x4*)(orow + lane * 16 + 4 * j) = (f32x4){h[4 * j] * rs * g[4 * j], h[4 * j + 1] * rs * g[4 * j + 1], h[4 * j + 2] * rs * g[4 * j + 2], h[4 * j + 3] * rs * g[4 * j + 3]};
    }
}

typedef float f32x4m __attribute__((ext_vector_type(4)));
template <class Epi>
__device__ __forceinline__ void skinny_gemm(LAS unsigned char* lds, const bf16* A, const bf16* Wt, int N, int K, const Epi& E, int vcu, int G, int tid, int wave, int lane) {
    const int npieces = (MS / 16) * (N / 64), kslice = K / 8, nsteps = kslice / 32;
    const int r16 = lane & 15, kg = lane >> 4;
    for (int piece = vcu; piece < npieces; piece += G) {
        const int mb = piece & 15, nb = piece >> 4, m0 = mb * 16, n0 = nb * 64;
        const bf16* ap = A + (size_t)(m0 + r16) * K + wave * kslice + 8 * kg;
        const bf16* wp = Wt + (size_t)(n0 + r16) * K + wave * kslice + 8 * kg;
        f32x4m acc[4];
#pragma unroll
        for (int j = 0; j < 4; ++j) acc[j] = (f32x4m){0.f, 0.f, 0.f, 0.f};
        for (int s0 = 0; s0 < nsteps; s0 += 4) {
            bf16x8 af[4], wf[4][4];
#pragma unroll
            for (int u = 0; u < 4; ++u) if (s0 + u < nsteps) {
                af[u] = *(const bf16x8*)(ap + (s0 + u) * 32);
#pragma unroll
                for (int j = 0; j < 4; ++j) wf[u][j] = *(const bf16x8*)(wp + (size_t)(16 * j) * K + (s0 + u) * 32);
            }
#pragma unroll
            for (int u = 0; u < 4; ++u) if (s0 + u < nsteps) {
#pragma unroll
                for (int j = 0; j < 4; ++j) acc[j] = __builtin_amdgcn_mfma_f32_16x16x32_bf16(wf[u][j], af[u], acc[j], 0, 0, 0);
            }
        }
#pragma unroll
        for (int j = 0; j < 4; ++j) *(LAS f32x4m*)(lds + ((wave * 4 + j) * 64 + lane) * 16) = acc[j];
        LDS_WAIT(); __syncthreads();
        if (tid < 256) {
            const int j = tid >> 6, l2 = tid & 63;
            f32x4m v = *(const LAS f32x4m*)(lds + (j * 64 + l2) * 16);
#pragma unroll
            for (int w = 1; w < 8; ++w) v += *(const LAS f32x4m*)(lds + ((w * 4 + j) * 64 + l2) * 16);
            E.apply(m0 + (l2 & 15), n0 + 16 * j + 4 * (l2 >> 4), v);
        }
        LDS_WAIT(); __syncthreads();
    }
}
struct SEpiIn { bf16* PROJ; float* out;
    __device__ __forceinline__ void apply(int r, int c, f32x4m v) const {
        const float sc = (c < PC_K) ? C2 : 1.f; u32x2 w; w.x = pk2(v.x * sc, v.y * sc); w.y = pk2(v.z * sc, v.w * sc);
        *(u32x2*)(PROJ + (size_t)(MP + r) * NIN + c) = w;
        if (c >= PC_K && c < PC_Z) { const bool isk = c < PC_V; *(f32x4m*)(out + (isk ? O_KS : O_VS) + (size_t)r * 512 + (c - (isk ? PC_K : PC_V))) = v; }
        else if (c >= PC_X) { const int t = r & 7, b = r >> 3; if (t >= TS - 3) *(f32x4m*)(out + O_CS + (size_t)(b * 3 + t - (TS - 3)) * 1024 + (c - PC_X)) = v; }
    } };
struct SEpiOut { const float* xs; bf16* H1b; float* RS;
    __device__ __forceinline__ void apply(int r, int c, f32x4m v) const {
        const f32x4m h = *(const f32x4m*)(xs + (size_t)r * DM + c) + v; const size_t o = (size_t)(MP + r) * DM + c;
        u32x2 w; w.x = pk2(h.x, h.y); w.y = pk2(h.z, h.w); *(u32x2*)(H1b + o) = w;
        atomicAdd(RS + MP + r, (h.x * h.x + h.y * h.y) + (h.z * h.z + h.w * h.w));
    } };
struct SEpiPle { bf16* E; float* RS;
    __device__ __forceinline__ void apply(int r, int c, f32x4m v) const {
        u32x2 w; w.x = pk2(v.x, v.y); w.y = pk2(v.z, v.w); *(u32x2*)(E + (size_t)(MP + r) * DM + c) = w; atomicAdd(RS + MP + r, (v.x * v.x + v.y * v.y) + (v.z * v.z + v.w * v.w));
    } };
struct SEpiDown { bf16* Hb;
    __device__ __forceinline__ void apply(int r, int c, f32x4m v) const {
        u32x2* hp = (u32x2*)(Hb + (size_t)(MP + r) * DM + c); const u32x2 o = *hp;
        u32x2 w; w.x = pk2(bflo(o.x) + v.x, bfhi(o.x) + v.y); w.y = pk2(bflo(o.y) + v.z, bfhi(o.y) + v.w); *hp = w;
    } };
struct SEpiGate { const bf16* H2b; const bf16* E; const float* RSE; const float* gple; bf16* H3b; float* RS3;
    __device__ __forceinline__ void apply(int r, int c, f32x4m v) const {
        const size_t o = (size_t)(MP + r) * DM + c; const float rse = 1.0f / sqrtf(RSE[MP + r] * (1.f / DM) + EPS);
        const u32x2 eb = *(const u32x2*)(E + o), hb = *(const u32x2*)(H2b + o); const f32x4m gp = *(const f32x4m*)(gple + c);
        const float e4[4] = {bflo(eb.x), bfhi(eb.x), bflo(eb.y), bfhi(eb.y)}, h4[4] = {bflo(hb.x), bfhi(hb.x), bflo(hb.y), bfhi(hb.y)}; float h[4];
#pragma unroll
        for (int k = 0; k < 4; ++k) { const float g = 1.f / (1.f + __expf(-v[k])); h[k] = h4[k] + g * (e4[k] * rse * gp[k]); }
        u32x2 w; w.x = pk2(h[0], h[1]); w.y = pk2(h[2], h[3]); *(u32x2*)(H3b + o) = w;
        atomicAdd(RS3 + MP + r, (h[0] * h[0] + h[1] * h[1]) + (h[2] * h[2] + h[3] * h[3]));
    } };

struct SubsetOrder {
    int nN, nwg, nsub, cl;
    __device__ void init(int M, int N, int G_, int c_, int c0) { nN = N / 256; nwg = (M / 256) * nN; nsub = G_ - c0; cl = c_ - c0; }
    __device__ bool next(int i, pg8::Unit& u) const { if (cl < 0) return false; const int L = i * nsub + cl; if (L >= nwg) return false; u.pm = L / nN; u.pn = L % nN; return true; }
    __device__ __forceinline__ void a_ready(const pg8::Unit&) const {}
    __device__ __forceinline__ void done(const pg8::Unit&) const {}
};
constexpr int NPH = 12;
#ifndef DUP
#define DUP -1
#endif
#define REP(k) for (int rep_ = 0; rep_ < ((DUP) == (k) ? args.pad : 1); ++rep_)
#ifndef MK_N_LAUNCHES
#define MK_N_LAUNCHES 1
#endif
constexpr int N_LAUNCHES = MK_N_LAUNCHES;
__global__ void __launch_bounds__(NWAVES * 64, 2) mk_fwd(Args args) {
    extern __shared__ __attribute__((aligned(16))) unsigned char lds_raw[];
    LAS unsigned char* lds = (LAS unsigned char*)lds_raw;
    volatile LAS unsigned* MISC = (volatile LAS unsigned*)(lds + MISC_OFF);
    const int tid = threadIdx.x, lane = tid & 63, wave = __builtin_amdgcn_readfirstlane(tid >> 6);
    const int G = gridDim.x, bx = blockIdx.x, vcu = (G % 8 == 0) ? (bx % 8) * (G / 8) + bx / 8 : bx;
    const int gw = vcu * NWAVES + wave, NGW = G * NWAVES, gtid = vcu * (NWAVES * 64) + tid, NT = G * NWAVES * 64;
    unsigned char* ws = args.ws;
    gu32* ctl = (gu32*)(ws + WS_CTL);
    for (int u = tid; u < (LDS_BYTES - LDSCTL_OFF) / 4; u += NWAVES * 64) ((LAS unsigned*)(lds + LDSCTL_OFF))[u] = 0u;
    __syncthreads();
    XcdBarrier bar; bar.bar = (unsigned*)(ctl + CW_BAR); bar.x = 0; bar.st = nullptr;
    if (N_LAUNCHES == 1) bar = xcd_barrier_post((unsigned*)(ctl + CW_BAR), MISC + 8);
    const int lo = args.ph_lo, hi = args.ph_hi;
#ifndef PHMASK
#define PHMASK 0xfff
#endif
#define IN(k) (((PHMASK >> (k)) & 1) && lo <= (k) && (k) < hi)
#define SEAM(k) do { if (IN(k) && IN((k) + 1)) xcd_barrier(bar); } while (0)

    if (IN(0)) { REP(0) { p0_prologue(args, lds, gw, NGW, wave, lane); VM_WAIT(); __syncthreads(); }
        if ((DUP) == 100) { p0_prologue(args, lds, gw, NGW, wave, lane, args.pad - 1); VM_WAIT(); __syncthreads(); }
        if ((DUP) == 101) { p0_prologue(args, lds, gw, NGW, wave, lane, args.pad); VM_WAIT(); __syncthreads(); } }
    SEAM(0);
    if (IN(1)) {
        pg8::Gemm g{(const pg8::bf16_t*)(ws + WS_XN), (const pg8::bf16_t*)(ws + WS_WIN), MP, NIN, DM}; pg8::StaticOrder S; S.init(MP, NIN, G, bx);
        EpiIn E{(pg8::bf16_t*)(ws + WS_PROJ), args.out};
        pg8::gemm_phase<EpiIn, pg8::StaticOrder, PG8_ALIGN, PG8_SP2>(lds, g, S, E);
        if ((DUP) == 1) pg8::gemm_phase<EpiIn, pg8::StaticOrder, PG8_ALIGN, PG8_SP2>(lds, g, S, E);
        { SEpiIn SE{(bf16*)(ws + WS_PROJ), args.out}; skinny_gemm(lds, (const bf16*)(ws + WS_XN) + (size_t)MP * DM, (const bf16*)(ws + WS_WIN), NIN, DM, SE, vcu, G, tid, wave, lane); }
    }
    SEAM(1);
    if (IN(2)) {
        attn_build_btab(args, lds, tid);
        conv_sample_pass(args, gtid, NT);
        __syncthreads();
#ifndef P2SUB
#define P2SUB 7
#endif
        REP(20) if (P2SUB & 1) for (int task = gw; task < NBS * TS * NH; task += NGW) attn_sample_task(args, lds, task, wave, lane);
        __syncthreads();
        REP(21) if (P2SUB & 2) attn_prompt_wg(args, lds, vcu, G, tid, wave, lane);
        __syncthreads();
        REP(22) if (P2SUB & 4) for (int unit = vcu; unit < NBP * 32 * 2; unit += G) ssd_s1g_unit(args, lds, unit, tid, wave, lane);
        VM_WAIT(); __syncthreads();
    }
    SEAM(2);
    if (IN(3)) {
        REP(30) ssd_s2_pass(args, gtid, NT);
        REP(31) for (int task = gw; task < NBS * 8 * 16; task += NGW) ssd_sample_task(args, task, lane);
        REP(32) attn_combine_pass(args, gtid, NT);
        VM_WAIT(); __syncthreads();
    }
    SEAM(3);
    if ((DUP) == 99) { for (int q_ = 0; q_ < 5 * args.pad; ++q_) xcd_barrier(bar); }
    if (IN(4)) {
        REP(4) for (int unit = vcu; unit < NBP * 32 * 8; unit += G) ssd_s3_unit(args, unit, wave, lane, rep_ == 0 ? 1.f : 0.f);
        VM_WAIT(); __syncthreads();
    }
    SEAM(4);
    if (IN(5)) { REP(5) { ssd_finish_pass(args, gw, NGW, lane); VM_WAIT(); __syncthreads(); } }
    SEAM(5);
    if (IN(6)) {
        { pg8::Gemm g{(const pg8::bf16_t*)(ws + WS_MIX), (const pg8::bf16_t*)(ws + WS_WOUT), MP, DM, DM}; pg8::StaticOrder S; S.init(MP, DM, G, bx);
          REP(60) { EpiOut E{args.in[0], (pg8::bf16_t*)(ws + WS_XN), rep_ == 0 ? (float*)(ws + WS_RS1) : (float*)(ws + WS_H1)};
#ifndef NO_GOUT
          pg8::gemm_phase<EpiOut, pg8::StaticOrder, PG8_ALIGN, PG8_SP2>(lds, g, S, E);
#endif
        } }
#ifndef NOSK
        { SEpiOut SE{args.in[1], (bf16*)(ws + WS_XN), (float*)(ws + WS_RS1)}; skinny_gemm(lds, (const bf16*)(ws + WS_MIX) + (size_t)MP * DM, (const bf16*)(ws + WS_WOUT), DM, DM, SE, vcu, G, tid, wave, lane); }
#endif
        { SEpiPle SE{(bf16*)(ws + WS_E), (float*)(ws + WS_RSE)}; skinny_gemm(lds, (const bf16*)(ws + WS_PB) + (size_t)MP * DPLE, (const bf16*)(ws + WS_WPLE), DM, DPLE, SE, vcu, G, tid, wave, lane); }
    }
    SEAM(6);
    if (IN(7)) {
        pg8::Gemm g{(const pg8::bf16_t*)(ws + WS_XN), (const pg8::bf16_t*)(ws + WS_WUP), MT, DFF2, DM}; pg8::StaticOrder S; S.init(MT, DFF2, G, bx);
        EpiUp E{(pg8::bf16_t*)(ws + WS_ACT), (const float*)(ws + WS_RS1), args.out, (float*)(ws + WS_UH), (float*)(ws + WS_US), args.in[21], args.in[22], lds};
        REP(7) pg8::gemm_phase<EpiUp, pg8::StaticOrder, PG8_ALIGN, PG8_SP2>(lds, g, S, E);
        { int kple = DPLE; asm volatile("" : "+s"(kple));
          const int nup = (MT / 256) * (DFF2 / 256), c0 = (nup % G) ? (nup % G) : G;
          pg8::Gemm g{(const pg8::bf16_t*)(ws + WS_PB), (const pg8::bf16_t*)(ws + WS_WPLE), MP, DM, kple}; SubsetOrder S; S.init(MP, DM, G, bx, c0 < G ? c0 : 0);
          EpiPle E{(pg8::bf16_t*)(ws + WS_E), (float*)(ws + WS_RSE)};
          pg8::gemm_phase<EpiPle, SubsetOrder, PG8_ALIGN, PG8_SP2>(lds, g, S, E); }
    }
    SEAM(7);
    if (IN(8)) { REP(8) { ffn_fixup_pass(args, gtid, NT); VM_WAIT(); __syncthreads(); } }
    SEAM(8);
    if (IN(9)) {
        pg8::Gemm g{(const pg8::bf16_t*)(ws + WS_ACT), (const pg8::bf16_t*)(ws + WS_WDOWN), MP, DM, DFF}; pg8::StaticOrder S; S.init(MP, DM, G, bx);
        { EpiDown E{(pg8::bf16_t*)(ws + WS_XN), 1.f};
        pg8::gemm_phase<EpiDown, pg8::StaticOrder, PG8_ALIGN, PG8_SP2>(lds, g, S, E); }
        if ((DUP) == 9) { EpiDown E{(pg8::bf16_t*)(ws + WS_XN), 0.f};
        pg8::gemm_phase<EpiDown, pg8::StaticOrder, PG8_ALIGN, PG8_SP2>(lds, g, S, E); }
        { SEpiDown SE{(bf16*)(ws + WS_XN)}; skinny_gemm(lds, (const bf16*)(ws + WS_ACT) + (size_t)MP * DFF, (const bf16*)(ws + WS_WDOWN), DM, DFF, SE, vcu, G, tid, wave, lane); }
    }
    SEAM(9);
    if (IN(10)) {
        pg8::Gemm g{(const pg8::bf16_t*)(ws + WS_XN), (const pg8::bf16_t*)(ws + WS_WGATE), MP, DM, DM}; pg8::StaticOrder S; S.init(MP, DM, G, bx);
        REP(10) { EpiGate E{(const pg8::bf16_t*)(ws + WS_XN), (const pg8::bf16_t*)(ws + WS_E), (const float*)(ws + WS_RSE), args.in[25], (pg8::bf16_t*)(ws + WS_MIX), rep_ == 0 ? (float*)(ws + WS_RS3) : (float*)(ws + WS_H1)};
        pg8::gemm_phase<EpiGate, pg8::StaticOrder, PG8_ALIGN, PG8_SP2>(lds, g, S, E); }
        { SEpiGate SE{(const bf16*)(ws + WS_XN), (const bf16*)(ws + WS_E), (const float*)(ws + WS_RSE), args.in[25], (bf16*)(ws + WS_MIX), (float*)(ws + WS_RS3)}; skinny_gemm(lds, (const bf16*)(ws + WS_XN) + (size_t)MP * DM, (const bf16*)(ws + WS_WGATE), DM, DM, SE, vcu, G, tid, wave, lane); }
    }
    SEAM(10);
    if (IN(11)) { REP(11) final_norm_pass(args, gw, NGW, lane); }
#undef IN
#undef SEAM
}

extern "C" void kernel_launch(void* const* d_in, const int* in_sizes, int n_in, void* d_out, int out_size, void* d_ws, size_t ws_size, hipStream_t stream) {
    static int grid = 0;
    if (grid == 0) {
        if (n_in != 28 || out_size != (int)O_END || ws_size < WS_END) { fprintf(stderr, "kernel_launch: unexpected shapes: n_in %d out %d ws %zu\n", n_in, out_size, ws_size); grid = -1; return; }
        int dev = 0, cus = 0, per_cu = 0;
        if (hipGetDevice(&dev) != hipSuccess || hipDeviceGetAttribute(&cus, hipDeviceAttributeMultiprocessorCount, dev) != hipSuccess) { grid = -1; return; }
        if (hipFuncSetAttribute((const void*)mk_fwd, hipFuncAttributeMaxDynamicSharedMemorySize, LDS_BYTES) != hipSuccess) { fprintf(stderr, "kernel_launch: hipFuncSetAttribute failed\n"); grid = -1; return; }
        if (hipOccupancyMaxActiveBlocksPerMultiprocessor(&per_cu, (const void*)mk_fwd, NWAVES * 64, LDS_BYTES) != hipSuccess || per_cu < 1) fprintf(stderr, "kernel_launch: occupancy query says %d\n", per_cu);
        (void)hipGetLastError();
        grid = cus;
    }
    if (grid < 0) return;
    if (hipMemsetAsync((char*)d_ws + WS_CTL, 0, CTL_ZERO_BYTES, stream) != hipSuccess) { fprintf(stderr, "kernel_launch: memset failed\n"); return; }
    Args a{};
    for (int i = 0; i < 28; ++i) a.in[i] = (const float*)d_in[i];
    a.out = (float*)d_out; a.ws = (unsigned char*)d_ws; a.pad = 2;
    for (int li = 0; li < N_LAUNCHES; ++li) {
        if (N_LAUNCHES == 1) { a.ph_lo = 0; a.ph_hi = NPH; } else { a.ph_lo = li; a.ph_hi = li + 1; }
        a.li = li;
        hipLaunchKernelGGL(mk_fwd, dim3(grid), dim3(NWAVES * 64), LDS_BYTES, stream, a);
        const hipError_t le = hipPeekAtLastError();
        if (le != hipSuccess) { fprintf(stderr, "kernel_launch: launch %d failed: %s\n", li, hipGetErrorName(le)); break; }
    }
}
```
